# Optimizing an MI355X kernel written in HIP

```python
import math
import jax
import jax.numpy as jnp
from jax import lax
import numpy as np

D_MODEL = 1024
BATCH = 2
SEQ = 8192
DEPTH = 2

CTX_LEN = 256
GRID_W = 64
D_MIX = D_MODEL
N_DIR = 2
RWKV_WIDTH = D_MIX // 2
RWKV_HEAD = 64
RWKV_HEADS = RWKV_WIDTH // RWKV_HEAD
DECAY_RANK = 64
ICL_RANK = 64
GATE_RANK = 128
RWKV_SLAB = 3 * RWKV_WIDTH + N_DIR * (DECAY_RANK + ICL_RANK + GATE_RANK)
S5_WIDTH = D_MIX - RWKV_WIDTH
S5_GROUP = 16
S5_GROUPS = S5_WIDTH // S5_GROUP
S5_STATE = 64
D_IN = RWKV_SLAB + S5_WIDTH
D_FF = 2816
N_EXPERTS = 8
TOP_K = 2
D_FF_EXPERT = 3584
N_DENSE = (DEPTH + 1) // 2
N_MOE = DEPTH // 2
NORM_EPS = 1e-6
GN_EPS = 64e-5
L2_EPS = 1e-12
LAM_RE_MAX = -1e-4

kernel_name = "hybrid_rwkv7_s5_moe_diffusion_block"


def rmsnorm(x, g):
    xf = x.astype(jnp.float32)
    y = xf * lax.rsqrt(jnp.mean(xf * xf, axis=-1, keepdims=True) + NORM_EPS)
    return (y * g.astype(jnp.float32)).astype(x.dtype)


def modulate(h, shift, scale):
    return h * (1 + scale) + shift


def qshift_grid(x, rows):
    b, t, ch = x.shape
    g = x.reshape(b, rows, GRID_W, ch // 4, 4)
    left = jnp.pad(g[:, :, :-1, :, 0], ((0, 0), (0, 0), (1, 0), (0, 0)))
    right = jnp.pad(g[:, :, 1:, :, 1], ((0, 0), (0, 0), (0, 1), (0, 0)))
    up = jnp.pad(g[:, :-1, :, :, 2], ((0, 0), (1, 0), (0, 0), (0, 0)))
    down = jnp.pad(g[:, 1:, :, :, 3], ((0, 0), (0, 1), (0, 0), (0, 0)))
    return jnp.stack([left, right, up, down], axis=-1).reshape(b, t, ch)


def shift_seq(x):
    b, t, ch = x.shape
    g = x.reshape(b, t, ch // 2, 2)
    prev = jnp.pad(g[:, :-1, :, 0], ((0, 0), (1, 0), (0, 0)))
    nxt = jnp.pad(g[:, 1:, :, 1], ((0, 0), (0, 1), (0, 0)))
    return jnp.stack([prev, nxt], axis=-1).reshape(b, t, ch)


def heads(t):
    return t.reshape(t.shape[:-1] + (RWKV_HEADS, RWKV_HEAD))


def split_slab(slab):
    sizes = [RWKV_WIDTH] * 3 + [N_DIR * DECAY_RANK, N_DIR * ICL_RANK, N_DIR * GATE_RANK]
    return jnp.split(slab, np.cumsum(sizes)[:-1].tolist(), axis=-1)


def wkv_scan(r, w, k, v, kk, a, state0, reverse):
    def step(s, inp):
        r_t, w_t, k_t, v_t, kk_t, a_t = inp
        sa = jnp.einsum('bhvk,bhk->bhv', s, -kk_t)
        s = (s * w_t[:, :, None, :] + sa[..., None] * (kk_t * a_t)[:, :, None, :]
             + v_t[..., None] * k_t[:, :, None, :])
        return s, jnp.einsum('bhvk,bhk->bhv', s, r_t)
    xs = tuple(jnp.moveaxis(t, 1, 0) for t in (r, w, k, v, kk, a))
    s_final, y = lax.scan(step, state0, xs, reverse=reverse)
    return s_final, jnp.moveaxis(y, 0, 1)


def rwkv_stream(slab, w0, w_up, a0, a_up, k_k, k_a):
    r, k, v, wd, ad, gd = split_slab(slab.astype(jnp.float32))
    kk = heads(k * k_k)
    kk = kk / jnp.maximum(jnp.sqrt(jnp.sum(kk * kk, axis=-1, keepdims=True)), L2_EPS)
    per_dir = []
    for d in range(N_DIR):
        wd_d = wd[..., d * DECAY_RANK:(d + 1) * DECAY_RANK]
        ad_d = ad[..., d * ICL_RANK:(d + 1) * ICL_RANK]
        gd_d = gd[..., d * GATE_RANK:(d + 1) * GATE_RANK]
        w_log = -jax.nn.softplus(-(w0[d] + jnp.tanh(wd_d) @ w_up[d])) - 0.5
        w = jnp.exp(-jnp.exp(w_log))
        a = jax.nn.sigmoid(a0[d] + ad_d @ a_up[d])
        kt = k * (1 + (a - 1) * k_a)
        per_dir.append((heads(w), heads(a), heads(kt), gd_d))
    return heads(r), heads(v), kk, per_dir


def rwkv_readout(y, r, kt, v, gd, g_up, ln_w, ln_b, r_k):
    mean = jnp.mean(y, axis=-1, keepdims=True)
    var = jnp.mean(jnp.square(y - mean), axis=-1, keepdims=True)
    yn = (y - mean) * lax.rsqrt(var + GN_EPS) * ln_w + ln_b
    bonus = jnp.sum(r * kt * r_k, axis=-1, keepdims=True) * v
    g = heads(jax.nn.sigmoid(gd) @ g_up)
    return (yn + bonus) * g


def rwkv_group(slab_c, slab_l, w0, w_up, a0, a_up, g_up, k_k, k_a, r_k, ln_w, ln_b, need_ctx):
    r_c, v_c, kk_c, dir_c = rwkv_stream(slab_c, w0, w_up, a0, a_up, k_k, k_a)
    r_l, v_l, kk_l, dir_l = rwkv_stream(slab_l, w0, w_up, a0, a_up, k_k, k_a)
    state0 = jnp.zeros((slab_l.shape[0], RWKV_HEADS, RWKV_HEAD, RWKV_HEAD), jnp.float32)
    outs_c, outs_l = [], []
    for d in range(N_DIR):
        rev = d == 1
        w_c, a_c, kt_c, gd_c = dir_c[d]
        w_l, a_l, kt_l, gd_l = dir_l[d]
        s_c, y_c = wkv_scan(r_c, w_c, kt_c, v_c, kk_c, a_c, state0, rev)
        _, y_l = wkv_scan(r_l, w_l, kt_l, v_l, kk_l, a_l, s_c, rev)
        outs_l.append(rwkv_readout(y_l, r_l, kt_l, v_l, gd_l, g_up[d], ln_w, ln_b, r_k))
        if need_ctx:
            outs_c.append(rwkv_readout(y_c, r_c, kt_c, v_c, gd_c, g_up[d], ln_w, ln_b, r_k))
    out_l = outs_l[0] + outs_l[1]
    out_l = out_l.reshape(out_l.shape[:2] + (RWKV_WIDTH,))
    if not need_ctx:
        return None, out_l
    out_c = outs_c[0] + outs_c[1]
    return out_c.reshape(out_c.shape[:2] + (RWKV_WIDTH,)), out_l


def s5_discretize(lam_re, lam_im, log_dt, b_re, b_im):
    lr = jnp.minimum(lam_re.astype(jnp.float32), LAM_RE_MAX)
    li = lam_im.astype(jnp.float32)
    dt = jnp.exp(log_dt.astype(jnp.float32))[:, None]
    mag = jnp.exp(lr * dt)
    ar = mag * jnp.cos(li * dt)
    ai = mag * jnp.sin(li * dt)
    den = lr * lr + li * li
    xr = ar - 1.0
    cr = (xr * lr + ai * li) / den
    ci = (ai * lr - xr * li) / den
    br = cr[..., None] * b_re - ci[..., None] * b_im
    bi = cr[..., None] * b_im + ci[..., None] * b_re
    return ar, ai, br, bi


def complex_affine_combine(e1, e2):
    a1r, a1i, b1r, b1i = e1
    a2r, a2i, b2r, b2i = e2
    return (a1r * a2r - a1i * a2i, a1r * a2i + a1i * a2r,
            a2r * b1r - a2i * b1i + b2r, a2r * b1i + a2i * b1r + b2i)


def s5_scan(u, ar, ai, br, bi, s0r, s0i, reverse):
    bur = jnp.einsum('btgc,gpc->btgp', u, br)
    bui = jnp.einsum('btgc,gpc->btgp', u, bi)
    first = -1 if reverse else 0
    bur = bur.at[:, first].add(ar * s0r - ai * s0i)
    bui = bui.at[:, first].add(ar * s0i + ai * s0r)
    a_r = jnp.broadcast_to(ar, bur.shape)
    a_i = jnp.broadcast_to(ai, bur.shape)
    _, _, xr, xi = lax.associative_scan(complex_affine_combine, (a_r, a_i, bur, bui),
                                        reverse=reverse, axis=1)
    return xr, xi


def s5_readout(xr, xi, c_re, c_im):
    return jnp.einsum('btgp,gcp->btgc', xr, c_re) - jnp.einsum('btgp,gcp->btgc', xi, c_im)


def s5_group(u_c, u_l, lam_re, lam_im, log_dt, b_re, b_im, c_re, c_im, d_skip, glu_w, glu_b, need_ctx):
    def groups(u):
        u = u.astype(jnp.float32)
        return u.reshape(u.shape[:2] + (S5_GROUPS, S5_GROUP))
    uc, ul = groups(u_c), groups(u_l)
    zero = jnp.zeros((uc.shape[0], S5_GROUPS, S5_STATE), jnp.float32)
    ys_c, ys_l = [], []
    for d in range(N_DIR):
        rev = d == 1
        ar, ai, br, bi = s5_discretize(lam_re[d], lam_im[d], log_dt[d], b_re[d], b_im[d])
        xr_c, xi_c = s5_scan(uc, ar, ai, br, bi, zero, zero, rev)
        last = 0 if rev else -1
        xr_l, xi_l = s5_scan(ul, ar, ai, br, bi, xr_c[:, last], xi_c[:, last], rev)
        ys_l.append(s5_readout(xr_l, xi_l, c_re[d], c_im[d]))
        if need_ctx:
            ys_c.append(s5_readout(xr_c, xi_c, c_re[d], c_im[d]))

    def finish(ys, u):
        y = (ys[0] + ys[1]).reshape(u.shape[:2] + (S5_WIDTH,)) + d_skip * u.astype(jnp.float32)
        y = jax.nn.gelu(y)
        return y * jax.nn.sigmoid(y @ glu_w + glu_b)

    return (finish(ys_c, u_c) if need_ctx else None), finish(ys_l, u_l)


def swiglu(h, w_gate, w_up, w_down):
    return (jax.nn.silu(h @ w_gate) * (h @ w_up)) @ w_down


def moe_swiglu(h, router, w_gate, w_up, w_down):
    logits = (h @ router).astype(jnp.float32)
    top_val, top_idx = lax.top_k(logits, TOP_K)
    top_p = jax.nn.softmax(top_val, axis=-1)
    combine = jnp.einsum('btk,btke->bte', top_p,
                         jax.nn.one_hot(top_idx, N_EXPERTS, dtype=jnp.float32))
    out = jnp.zeros(h.shape, jnp.float32)
    for e in range(N_EXPERTS):
        out = out + combine[..., e:e + 1] * swiglu(h, w_gate[e], w_up[e], w_down[e]).astype(jnp.float32)
    return out.astype(h.dtype)


def setup_inputs(seed: int = 0) -> dict:
    key = jax.random.key(seed)
    keys = iter(jax.random.split(key, 64))
    f32 = jnp.float32

    def nrm(shape, scale):
        return jax.random.normal(next(keys), shape, f32) * scale

    def uni(shape, lo, hi):
        return jax.random.uniform(next(keys), shape, f32, lo, hi)

    lam_im0 = math.pi * jnp.arange(S5_STATE, dtype=f32)
    return {
        "x": nrm((BATCH, SEQ, D_MODEL), 1.0),
        "c": nrm((BATCH, D_MODEL), 1.0),
        "ctx": nrm((BATCH, CTX_LEN, D_MODEL), 1.0),
        "c_ctx": nrm((D_MODEL,), 1.0),
        "ada_w": nrm((DEPTH, D_MODEL, 6 * D_MODEL), 0.5 * D_MODEL ** -0.5),
        "ada_b": nrm((DEPTH, 6 * D_MODEL), 0.02),
        "norm1_g": 1.0 + nrm((DEPTH, D_MODEL), 0.1),
        "norm2_g": 1.0 + nrm((DEPTH, D_MODEL), 0.1),
        "w_in": nrm((DEPTH, D_MODEL, D_IN), D_MODEL ** -0.5),
        "w_out": nrm((DEPTH, D_MIX, D_MODEL), D_MIX ** -0.5),
        "shift_mu": uni((DEPTH, RWKV_SLAB), 0.0, 1.0),
        "rwkv_w0": uni((DEPTH, N_DIR, RWKV_WIDTH), -6.5, -1.5),
        "rwkv_w_up": nrm((DEPTH, N_DIR, DECAY_RANK, RWKV_WIDTH), 0.1 * DECAY_RANK ** -0.5),
        "rwkv_a0": nrm((DEPTH, N_DIR, RWKV_WIDTH), 0.1),
        "rwkv_a_up": nrm((DEPTH, N_DIR, ICL_RANK, RWKV_WIDTH), ICL_RANK ** -0.5),
        "rwkv_g_up": nrm((DEPTH, N_DIR, GATE_RANK, RWKV_WIDTH), GATE_RANK ** -0.5),
        "rwkv_k_k": 0.85 + nrm((DEPTH, RWKV_WIDTH), 0.05),
        "rwkv_k_a": 1.0 + nrm((DEPTH, RWKV_WIDTH), 0.05),
        "rwkv_r_k": nrm((DEPTH, RWKV_HEADS, RWKV_HEAD), 0.1),
        "rwkv_ln_w": 1.0 + nrm((DEPTH, RWKV_HEADS, RWKV_HEAD), 0.1),
        "rwkv_ln_b": nrm((DEPTH, RWKV_HEADS, RWKV_HEAD), 0.01),
        "s5_lam_re": -0.5 + nrm((DEPTH, N_DIR, S5_GROUPS, S5_STATE), 0.01),
        "s5_lam_im": lam_im0 + nrm((DEPTH, N_DIR, S5_GROUPS, S5_STATE), 0.01),
        "s5_log_dt": uni((DEPTH, N_DIR, S5_GROUPS), math.log(1e-3), math.log(1e-1)),
        "s5_b_re": nrm((DEPTH, N_DIR, S5_GROUPS, S5_STATE, S5_GROUP), (2 * S5_GROUP) ** -0.5),
        "s5_b_im": nrm((DEPTH, N_DIR, S5_GROUPS, S5_STATE, S5_GROUP), (2 * S5_GROUP) ** -0.5),
        "s5_c_re": nrm((DEPTH, N_DIR, S5_GROUPS, S5_GROUP, S5_STATE), S5_STATE ** -0.5),
        "s5_c_im": nrm((DEPTH, N_DIR, S5_GROUPS, S5_GROUP, S5_STATE), S5_STATE ** -0.5),
        "s5_d": nrm((DEPTH, S5_WIDTH), 1.0),
        "s5_glu_w": nrm((DEPTH, S5_WIDTH, S5_WIDTH), S5_WIDTH ** -0.5),
        "s5_glu_b": nrm((DEPTH, S5_WIDTH), 0.01),
        "ffn_w_gate": nrm((N_DENSE, D_MODEL, D_FF), D_MODEL ** -0.5),
        "ffn_w_up": nrm((N_DENSE, D_MODEL, D_FF), D_MODEL ** -0.5),
        "ffn_w_down": nrm((N_DENSE, D_FF, D_MODEL), D_FF ** -0.5),
        "moe_router": nrm((N_MOE, D_MODEL, N_EXPERTS), D_MODEL ** -0.5),
        "moe_w_gate": nrm((N_MOE, N_EXPERTS, D_MODEL, D_FF_EXPERT), D_MODEL ** -0.5),
        "moe_w_up": nrm((N_MOE, N_EXPERTS, D_MODEL, D_FF_EXPERT), D_MODEL ** -0.5),
        "moe_w_down": nrm((N_MOE, N_EXPERTS, D_FF_EXPERT, D_MODEL), D_FF_EXPERT ** -0.5),
        "final_g": 1.0 + nrm((D_MODEL,), 0.1),
    }


def reference(x, c, ctx, c_ctx, ada_w, ada_b, norm1_g, norm2_g, w_in, w_out, shift_mu,
              rwkv_w0, rwkv_w_up, rwkv_a0, rwkv_a_up, rwkv_g_up, rwkv_k_k, rwkv_k_a, rwkv_r_k,
              rwkv_ln_w, rwkv_ln_b, s5_lam_re, s5_lam_im, s5_log_dt, s5_b_re, s5_b_im,
              s5_c_re, s5_c_im, s5_d, s5_glu_w, s5_glu_b, ffn_w_gate, ffn_w_up, ffn_w_down,
              moe_router, moe_w_gate, moe_w_up, moe_w_down, final_g):
    rows = x.shape[1] // GRID_W
    x_l, x_c = x, ctx
    act_l = jax.nn.silu(c)
    act_c = jax.nn.silu(c_ctx)
    for i in range(DEPTH):
        need_ctx = i < DEPTH - 1
        mod_l = jnp.split((act_l @ ada_w[i] + ada_b[i])[:, None, :], 6, axis=-1)
        mod_c = jnp.split(act_c @ ada_w[i] + ada_b[i], 6, axis=-1)

        h_l = modulate(rmsnorm(x_l, norm1_g[i]), mod_l[0], mod_l[1])
        h_c = modulate(rmsnorm(x_c, norm1_g[i]), mod_c[0], mod_c[1])
        p_l = h_l @ w_in[i]
        p_c = h_c @ w_in[i]
        slab_l, u_l = p_l[..., :RWKV_SLAB], p_l[..., RWKV_SLAB:]
        slab_c, u_c = p_c[..., :RWKV_SLAB], p_c[..., RWKV_SLAB:]
        slab_l = slab_l + (qshift_grid(slab_l, rows) - slab_l) * shift_mu[i]
        slab_c = slab_c + (shift_seq(slab_c) - slab_c) * shift_mu[i]
        rw_c, rw_l = rwkv_group(slab_c, slab_l, rwkv_w0[i], rwkv_w_up[i], rwkv_a0[i], rwkv_a_up[i],
                                rwkv_g_up[i], rwkv_k_k[i], rwkv_k_a[i], rwkv_r_k[i],
                                rwkv_ln_w[i], rwkv_ln_b[i], need_ctx)
        ss_c, ss_l = s5_group(u_c, u_l, s5_lam_re[i], s5_lam_im[i], s5_log_dt[i], s5_b_re[i],
                              s5_b_im[i], s5_c_re[i], s5_c_im[i], s5_d[i], s5_glu_w[i],
                              s5_glu_b[i], need_ctx)
        mix_l = jnp.concatenate([rw_l, ss_l], axis=-1).astype(x_l.dtype) @ w_out[i]
        x_l = x_l + mod_l[2] * mix_l
        if need_ctx:
            mix_c = jnp.concatenate([rw_c, ss_c], axis=-1).astype(x_c.dtype) @ w_out[i]
            x_c = x_c + mod_c[2] * mix_c

        j = i // 2

        def channel_mix(h):
            if i % 2 == 0:
                return swiglu(h, ffn_w_gate[j], ffn_w_up[j], ffn_w_down[j])
            return moe_swiglu(h, moe_router[j], moe_w_gate[j], moe_w_up[j], moe_w_down[j])

        h2_l = modulate(rmsnorm(x_l, norm2_g[i]), mod_l[3], mod_l[4])
        x_l = x_l + mod_l[5] * channel_mix(h2_l)
        if need_ctx:
            h2_c = modulate(rmsnorm(x_c, norm2_g[i]), mod_c[3], mod_c[4])
            x_c = x_c + mod_c[5] * channel_mix(h2_c)
    return rmsnorm(x_l, final_g)
```

```cpp
#include <hip/hip_runtime.h>
#include <cstdio>
#include <cstdint>
namespace pg8 {
#define PG8_LAS __attribute__((address_space(3)))
typedef unsigned short bf16_t;
typedef short bf16x8 __attribute__((ext_vector_type(8)));
typedef float f32x4 __attribute__((ext_vector_type(4)));
typedef unsigned u32x4 __attribute__((ext_vector_type(4)));
constexpr int BM = 256, BK = 64, HALF = 128, HTB = HALF * BK * 2  , STAGE_BYTES = 8 * HTB, NXCD = 8, WGM = 8;

__host__ __device__ __forceinline__ int lds_byte(int r, int c) { const int st = (r >> 4) * 2 + (c >> 5), rr = r & 15, cc = c & 31, ob = rr * 64 + cc * 2; return st * 1024 + (ob ^ (((ob >> 9) & 1) << 5)); }
__host__ __device__ __forceinline__ void stage_rc(int b, int& R, int& C) { const int st = b / 1024, sb = b % 1024, swz = sb ^ (((sb >> 9) & 1) << 5); R = (st >> 1) * 16 + swz / 64; C = (st & 1) * 32 + (swz % 64) / 2; }
__host__ __device__ __forceinline__ int perm32(int rho) { const int n = rho >> 4, i = rho & 15; return 8 * (i >> 2) + 4 * n + (i & 3); }

struct Unit { int pm, pn, pa, pb, po, ko; };
struct Gemm { const bf16_t* A; const bf16_t* Bt; int M, N, K, ld; };

struct StaticOrder {
    int nM, nN, nwg, G, c;
    __host__ __device__ void init(int M, int N, int G_, int c_) { nM = M / BM; nN = N / BM; nwg = nM * nN; G = G_; c = c_; }
    __host__ __device__ bool next(int i, Unit& u) const {
        const long L = (long)i * G + c; if (L >= nwg) return false;
        int wgid = (int)L; { const int q = nwg / NXCD, r = nwg % NXCD, xcd = wgid % NXCD, off = wgid / NXCD; wgid = (xcd < r ? xcd * (q + 1) : r * (q + 1) + (xcd - r) * q) + off; }
        const int nig = WGM * nN, gid = wgid / nig, fm = gid * WGM, gsz = (nM - fm) < WGM ? (nM - fm) : WGM;
        u.pm = fm + ((wgid % nig) % gsz); u.pn = (wgid % nig) / gsz; u.pa = u.pm; u.pb = u.pn; u.po = u.pm; u.ko = 0; return true;
    }
    __device__ __forceinline__ void a_ready(const Unit&) const {}
    __device__ __forceinline__ void done(const Unit&) const {}
};

struct GroupOrder : StaticOrder {
    int t0, a0, o0, nNr, kslice; int toff[9];
    __device__ __forceinline__ bool next(int i, Unit& u) const {
        if (!StaticOrder::next(i, u)) return false;
        u.pm += t0; int e = 0;
#pragma unroll
        for (int q = 1; q < 8; ++q) e += (u.pm >= toff[q]) ? 1 : 0;
        const int ks = u.pn / nNr; u.pn -= ks * nNr; u.ko = ks * kslice;
        u.pa = u.pm - a0; u.po = u.pm - o0; u.pb = e * nNr + u.pn; return true;
    }
};
__device__ __forceinline__ unsigned cvt_pk_bf16(float lo, float hi) { unsigned r; asm volatile("v_cvt_pk_bf16_f32 %0, %1, %2" : "=v"(r) : "v"(lo), "v"(hi)); return r; }
typedef float f32x2 __attribute__((ext_vector_type(2)));
__device__ __forceinline__ f32x2 gelu_pk(f32x2 v) {
    const f32x2 av = __builtin_elementwise_abs(v), d = av * 0.2316418882f + 1.0f;
    f32x2 t; t.x = __builtin_amdgcn_rcpf(d.x); t.y = __builtin_amdgcn_rcpf(d.y);
    f32x2 q = t * 0.5307027145f + (-0.7265760135f); q = q * t + 0.7107068705f; q = q * t + (-0.142248368f); q = q * t + 0.127414796f; q = q * t;
    const f32x2 s = (v * v) * (-0.72134752044f);
    f32x2 e; e.x = __builtin_amdgcn_exp2f(s.x); e.y = __builtin_amdgcn_exp2f(s.y);
    const f32x2 m = v * (q * e), r = v - m;
    f32x2 o; o.x = v.x < 0.f ? m.x : r.x; o.y = v.y < 0.f ? m.y : r.y; return o;
}

template <int ACT  > struct EpiBf16 {
    static constexpr bool PERM = true, AFTER_DRAIN = false; static_assert(ACT == 0 || ACT == 1, "EpiBf16: ACT is 0 (none) or 1 (gelu_pk)");
    bf16_t* O; int ldc; const float* bias; int split_cols; size_t split_stride; float scale0;
    __device__ __forceinline__ void operator()(const f32x4 (&acc)[2][2][4][2], const Unit& u, int wr, int wc, int fr, int fq) const {
        const int row0 = u.pm * BM + wr * 64 + fr; int colt = u.pn * BM; bf16_t* base = O;
        float sc = 1.f; if (split_cols) { const int t = colt / split_cols; base += (size_t)t * split_stride; colt -= t * split_cols; if (t == 0) sc = scale0; }
        const int col0 = colt + wc * 32 + 8 * fq, bcol0 = u.pn * BM + wc * 32 + 8 * fq;
        f32x4 bv[2][2];
#pragma unroll
        for (int bj = 0; bj < 2; ++bj)
#pragma unroll
            for (int n = 0; n < 2; ++n) bv[bj][n] = bias ? *(const f32x4*)(bias + bcol0 + bj * HALF + 4 * n) : (f32x4){0.f, 0.f, 0.f, 0.f};
#pragma unroll
        for (int ai = 0; ai < 2; ++ai)
#pragma unroll
            for (int m = 0; m < 4; ++m) { bf16_t* rowp = base + (size_t)(row0 + ai * HALF + m * 16) * ldc + col0;
#pragma unroll
                for (int bj = 0; bj < 2; ++bj) { f32x4 v0 = acc[ai][bj][m][0] + bv[bj][0], v1 = acc[ai][bj][m][1] + bv[bj][1];
                    if (ACT == 1) { f32x2 a = gelu_pk((f32x2){v0[0], v0[1]}), b = gelu_pk((f32x2){v0[2], v0[3]}), c = gelu_pk((f32x2){v1[0], v1[1]}), d = gelu_pk((f32x2){v1[2], v1[3]});
                        v0 = (f32x4){a.x, a.y, b.x, b.y}; v1 = (f32x4){c.x, c.y, d.x, d.y}; }
                    v0 = v0 * sc; v1 = v1 * sc; u32x4 w; w.x = cvt_pk_bf16(v0[0], v0[1]); w.y = cvt_pk_bf16(v0[2], v0[3]); w.z = cvt_pk_bf16(v1[0], v1[1]); w.w = cvt_pk_bf16(v1[2], v1[3]);
                    *(u32x4*)(rowp + bj * HALF) = w; } }
    }
};

__device__ __forceinline__ float bf_lo(unsigned w) { return __uint_as_float(w << 16); }
__device__ __forceinline__ float bf_hi(unsigned w) { return __uint_as_float(w & 0xffff0000u); }
__device__ __forceinline__ float sigm(float x) { return 1.0f / (1.0f + __expf(-x)); }
constexpr int T_ROWS = 16896, N_LAT = 16384;
struct EpiGLU {
    static constexpr bool PERM = true, AFTER_DRAIN = false;
    const bf16_t* YG; bf16_t* A2; const float* bias;
    __device__ __forceinline__ void operator()(const f32x4 (&acc)[2][2][4][2], const Unit& u, int wr, int wc, int fr, int fq) const {
        const int row0 = u.pm * BM + wr * 64 + fr, cb = u.pn * BM + wc * 32 + 8 * fq;
#pragma unroll
        for (int ai = 0; ai < 2; ++ai)
#pragma unroll
            for (int m = 0; m < 4; ++m) { const int row = row0 + ai * HALF + m * 16;
#pragma unroll
                for (int bj = 0; bj < 2; ++bj) { const int c = cb + bj * HALF; const f32x4 v0 = acc[ai][bj][m][0], v1 = acc[ai][bj][m][1];
                    const float v[8] = {v0[0], v0[1], v0[2], v0[3], v1[0], v1[1], v1[2], v1[3]};
                    const u32x4 y8 = *(const u32x4*)(YG + (size_t)row * 512 + c);
                    const float yf[8] = {bf_lo(y8.x), bf_hi(y8.x), bf_lo(y8.y), bf_hi(y8.y), bf_lo(y8.z), bf_hi(y8.z), bf_lo(y8.w), bf_hi(y8.w)};
                    float s[8];
#pragma unroll
                    for (int j = 0; j < 8; ++j) s[j] = yf[j] * sigm(v[j] + bias[c + j]);
                    u32x4 w1; w1.x = cvt_pk_bf16(s[0], s[1]); w1.y = cvt_pk_bf16(s[2], s[3]); w1.z = cvt_pk_bf16(s[4], s[5]); w1.w = cvt_pk_bf16(s[6], s[7]);
                    *(u32x4*)(A2 + (size_t)row * 1024 + 512 + c) = w1; } }
    }
};
struct EpiRes {
    static constexpr bool PERM = false, AFTER_DRAIN = false;
    float* X; const float* gate; const float* comb; int e;
    __device__ __forceinline__ void operator()(const f32x4 (&acc)[2][2][4][2], const Unit& u, int wr, int wc, int fr, int fq) const {
        const int midx = (u.pm < 64) ? (u.pm >> 5) : 2; const float* gp = gate + midx * 6144;
        const int row0 = u.pm * BM + wr * 64 + fr, col0 = u.pn * BM + wc * 32 + 4 * fq;
        f32x4 gv[2][2];
#pragma unroll
        for (int bj = 0; bj < 2; ++bj)
#pragma unroll
            for (int n = 0; n < 2; ++n) gv[bj][n] = *(const f32x4*)(gp + col0 + bj * HALF + n * 16);
#pragma unroll
        for (int ai = 0; ai < 2; ++ai) {
            f32x4 xv[4][2][2]; float cf4[4];
#pragma unroll
            for (int m = 0; m < 4; ++m) { const int row = row0 + ai * HALF + m * 16; cf4[m] = comb ? comb[(size_t)row * 8 + e] : 1.0f; const float* rowp = X + (size_t)row * 1024 + col0;
#pragma unroll
                for (int bj = 0; bj < 2; ++bj)
#pragma unroll
                    for (int n = 0; n < 2; ++n) xv[m][bj][n] = *(const f32x4*)(rowp + bj * HALF + n * 16); }
#pragma unroll
            for (int m = 0; m < 4; ++m) { const int row = row0 + ai * HALF + m * 16; float* rowp = X + (size_t)row * 1024 + col0;
#pragma unroll
                for (int bj = 0; bj < 2; ++bj)
#pragma unroll
                    for (int n = 0; n < 2; ++n) *(f32x4*)(rowp + bj * HALF + n * 16) = xv[m][bj][n] + gv[bj][n] * acc[ai][bj][m][n] * cf4[m]; }
        }
    }
};
struct EpiSwiGLU {
    static constexpr bool PERM = true, AFTER_DRAIN = false;
    bf16_t* ACT; int ldc;
    __device__ __forceinline__ void operator()(const f32x4 (&acc)[2][2][4][2], const Unit& u, int wr, int wc, int fr, int fq) const {
        const int row0 = u.po * BM + wr * 64 + fr, c = u.pn * HALF + wc * 32 + 8 * fq;
#pragma unroll
        for (int ai = 0; ai < 2; ++ai)
#pragma unroll
            for (int m = 0; m < 4; ++m) { const int row = row0 + ai * HALF + m * 16;
                const f32x4 g0 = acc[ai][0][m][0], g1 = acc[ai][0][m][1], u0 = acc[ai][1][m][0], u1 = acc[ai][1][m][1];
                float s[8];
#pragma unroll
                for (int j = 0; j < 4; ++j) { s[j] = g0[j] * sigm(g0[j]) * u0[j]; s[4 + j] = g1[j] * sigm(g1[j]) * u1[j]; }
                u32x4 w1; w1.x = cvt_pk_bf16(s[0], s[1]); w1.y = cvt_pk_bf16(s[2], s[3]); w1.z = cvt_pk_bf16(s[4], s[5]); w1.w = cvt_pk_bf16(s[6], s[7]);
                *(u32x4*)(ACT + (size_t)row * ldc + c) = w1; }
    }
};


struct EpiPartF32 {
    static constexpr bool PERM = false, AFTER_DRAIN = false;
    float* PART; int row_base, rows, kslice;
    __device__ __forceinline__ void operator()(const f32x4 (&acc)[2][2][4][2], const Unit& u, int wr, int wc, int fr, int fq) const {
        const int ks = u.ko / kslice; float* P0 = PART + (size_t)ks * rows * 1024;
        const int row0 = u.pm * BM - row_base + wr * 64 + fr, col0 = u.pn * BM + wc * 32 + 4 * fq;
#pragma unroll
        for (int ai = 0; ai < 2; ++ai)
#pragma unroll
            for (int m = 0; m < 4; ++m) { float* rowp = P0 + (size_t)(row0 + ai * HALF + m * 16) * 1024 + col0;
#pragma unroll
                for (int bj = 0; bj < 2; ++bj)
#pragma unroll
                    for (int n = 0; n < 2; ++n) *(f32x4*)(rowp + bj * HALF + n * 16) = acc[ai][bj][m][n]; }
    }
};

struct EpiPartBf16 {
    static constexpr bool PERM = true, AFTER_DRAIN = false;
    bf16_t* PART; int row_base, rows, kslice;
    __device__ __forceinline__ void operator()(const f32x4 (&acc)[2][2][4][2], const Unit& u, int wr, int wc, int fr, int fq) const {
        const int ks = u.ko / kslice; bf16_t* P0 = PART + (size_t)ks * rows * 1024;
        const int row0 = u.pm * BM - row_base + wr * 64 + fr, col0 = u.pn * BM + wc * 32 + 8 * fq;
#pragma unroll
        for (int ai = 0; ai < 2; ++ai)
#pragma unroll
            for (int m = 0; m < 4; ++m) { bf16_t* rowp = P0 + (size_t)(row0 + ai * HALF + m * 16) * 1024 + col0;
#pragma unroll
                for (int bj = 0; bj < 2; ++bj) { const f32x4 v0 = acc[ai][bj][m][0], v1 = acc[ai][bj][m][1];
                    u32x4 w; w.x = cvt_pk_bf16(v0[0], v0[1]); w.y = cvt_pk_bf16(v0[2], v0[3]); w.z = cvt_pk_bf16(v1[0], v1[1]); w.w = cvt_pk_bf16(v1[2], v1[3]);
                    *(u32x4*)(rowp + bj * HALF) = w; } }
    }
};
template <class Epi, class Sched, bool ALIGN_EPI = false, bool SP2 = false>
__device__ __forceinline__ void gemm_phase(PG8_LAS unsigned char* lds, const Gemm g, const Sched& S, const Epi& E, const int tid) {
    const int wid = __builtin_amdgcn_readfirstlane(tid >> 6), lane = tid & 63, wr = wid >> 2, wc = wid & 3, fr = lane & 15, fq = lane >> 4;
    const int K = g.ld, nt = g.K / BK;
    unsigned voffA[2], voffB[2];
#pragma unroll
    for (int i = 0; i < 2; ++i) { int R, C; stage_rc(tid * 16 + i * 8192, R, C); const int Rb = Epi::PERM ? ((R & ~31) + perm32(R & 31)) : R;
        voffA[i] = (unsigned)(R * K + C) * 2u; voffB[i] = (unsigned)(Rb * K + C) * 2u; }
    const size_t kstep = (size_t)(BK * 2);
    const size_t hstep = (size_t)HALF * K * 2;
    const size_t tstep = 2 * hstep;
    const unsigned ldsw = (unsigned)wid * 1024u;
    const int aoff = lds_byte(wr * 64 + fr, fq * 8), boff = lds_byte(wc * 32 + fr, fq * 8);
#define PG8_SA(b, h) (((b) * 2 + (h)) * HTB)
#define PG8_SB(b, h) ((4 + (b) * 2 + (h)) * HTB)
#define PG8_STAGE(bufoff, gbase, voff) do { _Pragma("unroll") for (int _i = 0; _i < 2; ++_i) \
        __builtin_amdgcn_global_load_lds((const unsigned*)((const char*)(gbase) + (voff)[_i]), (PG8_LAS unsigned*)(lds + (bufoff) + ldsw + _i * 8192), 16, 0, 0); } while (0)
#define PG8_LDA(dst, b, h) do { _Pragma("unroll") for (int m = 0; m < 4; ++m) _Pragma("unroll") for (int k = 0; k < 2; ++k) dst[m][k] = *(const PG8_LAS bf16x8*)(lds + PG8_SA(b, h) + aoff + m * 2048 + k * 1024); } while (0)
#define PG8_LDB(dst, b, h) do { _Pragma("unroll") for (int n = 0; n < 2; ++n) _Pragma("unroll") for (int k = 0; k < 2; ++k) dst[n][k] = *(const PG8_LAS bf16x8*)(lds + PG8_SB(b, h) + boff + n * 2048 + k * 1024); } while (0)
#define PG8_MMA(ai, bj, At, Bt) do { __builtin_amdgcn_s_setprio(1); _Pragma("unroll") for (int m = 0; m < 4; ++m) _Pragma("unroll") for (int n = 0; n < 2; ++n) _Pragma("unroll") for (int k = 0; k < 2; ++k) \
        acc[ai][bj][m][n] = __builtin_amdgcn_mfma_f32_16x16x32_bf16(Bt[n][k], At[m][k], acc[ai][bj][m][n], 0, 0, 0); __builtin_amdgcn_s_setprio(0); } while (0)
#define PG8_WAIT_V(n) asm volatile("s_waitcnt vmcnt(" #n ")" ::: "memory")
#define PG8_WAIT_L(n) asm volatile("s_waitcnt lgkmcnt(" #n ")" ::: "memory")
#define PG8_BAR __builtin_amdgcn_s_barrier()
#define PG8_SCHED __builtin_amdgcn_sched_barrier(0)
    Unit cur, nxt; int ui = 0;
    if (!S.next(0, cur)) return;
    f32x4 acc[2][2][4][2];
#pragma unroll
    for (int a = 0; a < 2; ++a)
#pragma unroll
        for (int b = 0; b < 2; ++b)
#pragma unroll
            for (int m = 0; m < 4; ++m)
#pragma unroll
                for (int n = 0; n < 2; ++n) acc[a][b][m][n] = (f32x4){0.f, 0.f, 0.f, 0.f};
    bf16x8 At[4][2], B0[2][2], B1[2][2];
    const char* cA = (const char*)g.A + (size_t)cur.pa * tstep + (size_t)cur.ko * 2; const char* cB = (const char*)g.Bt + (size_t)cur.pb * tstep + (size_t)cur.ko * 2;
    S.a_ready(cur);
    if constexpr (SP2) {
        PG8_STAGE(PG8_SB(0, 0), cB, voffB); PG8_STAGE(PG8_SB(0, 1), cB + hstep, voffB); PG8_STAGE(PG8_SA(0, 0), cA, voffA); PG8_STAGE(PG8_SA(0, 1), cA + hstep, voffA);
        if (wr == 1) PG8_BAR;
        PG8_WAIT_V(2); PG8_BAR;
        PG8_STAGE(PG8_SB(1, 0), cB + kstep, voffB); PG8_STAGE(PG8_SA(1, 0), cA + kstep, voffA); PG8_STAGE(PG8_SB(1, 1), cB + hstep + kstep, voffB);
        PG8_WAIT_V(6); PG8_BAR;
    } else {
        PG8_STAGE(PG8_SB(0, 0), cB, voffB); PG8_STAGE(PG8_SA(0, 0), cA, voffA); PG8_STAGE(PG8_SB(0, 1), cB + hstep, voffB); PG8_STAGE(PG8_SA(0, 1), cA + hstep, voffA);
        if (wr == 1) PG8_BAR;
        PG8_WAIT_V(4); PG8_BAR;
        PG8_STAGE(PG8_SB(1, 0), cB + kstep, voffB); PG8_STAGE(PG8_SA(1, 0), cA + kstep, voffA); PG8_STAGE(PG8_SB(1, 1), cB + hstep + kstep, voffB);
        PG8_WAIT_V(6); PG8_BAR;
    }
    for (;;) {
        const bool has_next = S.next(ui + 1, nxt);
        const char* nA = has_next ? (const char*)g.A + (size_t)nxt.pa * tstep + (size_t)nxt.ko * 2 : cA; const char* nB = has_next ? (const char*)g.Bt + (size_t)nxt.pb * tstep + (size_t)nxt.ko * 2 : cB;
        for (int t = 0; t < nt; t += 2) {
            const bool last = (t == nt - 2);
            const char* a1 = cA + (size_t)(t + 1) * kstep;
            const char* a2 = last ? nA : cA + (size_t)(t + 2) * kstep; const char* b2 = last ? nB : cB + (size_t)(t + 2) * kstep;
            const char* a3 = a2 + kstep; const char* b3 = b2 + kstep;
            if (last && has_next) S.a_ready(nxt);
            if constexpr (SP2) {
            PG8_LDB(B0, 0, 0); PG8_LDB(B1, 0, 1); PG8_SCHED; PG8_LDA(At, 0, 0); PG8_STAGE(PG8_SA(1, 1), a1 + hstep, voffA);
            PG8_WAIT_V(8); PG8_WAIT_L(0); PG8_BAR; PG8_MMA(0, 0, At, B0); PG8_MMA(0, 1, At, B1); PG8_BAR; PG8_SCHED;
            PG8_LDA(At, 0, 1); PG8_STAGE(PG8_SB(0, 0), b2, voffB); PG8_STAGE(PG8_SB(0, 1), b2 + hstep, voffB); PG8_STAGE(PG8_SA(0, 0), a2, voffA);
            PG8_WAIT_V(8); PG8_WAIT_L(0); PG8_BAR; PG8_MMA(1, 0, At, B0); PG8_MMA(1, 1, At, B1); PG8_BAR; PG8_SCHED;
            PG8_LDB(B0, 1, 0); PG8_LDB(B1, 1, 1); PG8_SCHED; PG8_LDA(At, 1, 0); PG8_STAGE(PG8_SA(0, 1), a2 + hstep, voffA);
            PG8_WAIT_V(8); PG8_WAIT_L(0); PG8_BAR; PG8_MMA(0, 0, At, B0); PG8_MMA(0, 1, At, B1); PG8_BAR; PG8_SCHED;
            PG8_LDA(At, 1, 1); PG8_STAGE(PG8_SB(1, 0), b3, voffB); PG8_STAGE(PG8_SB(1, 1), b3 + hstep, voffB); PG8_STAGE(PG8_SA(1, 0), a3, voffA);
            PG8_WAIT_V(8); PG8_WAIT_L(0); PG8_BAR; PG8_MMA(1, 0, At, B0); PG8_MMA(1, 1, At, B1); PG8_BAR; PG8_SCHED;
            } else {
            PG8_LDB(B0, 0, 0); PG8_SCHED; PG8_LDA(At, 0, 0); PG8_STAGE(PG8_SA(1, 1), a1 + hstep, voffA);
            PG8_WAIT_L(8); PG8_BAR; PG8_WAIT_L(0); PG8_MMA(0, 0, At, B0); PG8_BAR; PG8_SCHED;
            PG8_LDB(B1, 0, 1); PG8_STAGE(PG8_SB(0, 0), b2, voffB);
            PG8_BAR; PG8_WAIT_L(0); PG8_MMA(0, 1, At, B1); PG8_BAR;
            PG8_LDA(At, 0, 1); PG8_STAGE(PG8_SA(0, 0), a2, voffA);
            PG8_BAR; PG8_WAIT_L(0); PG8_MMA(1, 0, At, B0); PG8_BAR; PG8_SCHED;
            PG8_STAGE(PG8_SB(0, 1), b2 + hstep, voffB);
            PG8_WAIT_V(6); PG8_BAR; PG8_MMA(1, 1, At, B1); PG8_BAR;
            PG8_LDB(B0, 1, 0); PG8_SCHED; PG8_LDA(At, 1, 0); PG8_STAGE(PG8_SA(0, 1), a2 + hstep, voffA);
            PG8_WAIT_L(8); PG8_BAR; PG8_WAIT_L(0); PG8_MMA(0, 0, At, B0); PG8_BAR; PG8_SCHED;
            PG8_LDB(B1, 1, 1); PG8_STAGE(PG8_SB(1, 0), b3, voffB);
            PG8_BAR; PG8_WAIT_L(0); PG8_MMA(0, 1, At, B1); PG8_BAR;
            PG8_LDA(At, 1, 1); PG8_STAGE(PG8_SA(1, 0), a3, voffA);
            PG8_BAR; PG8_WAIT_L(0); PG8_MMA(1, 0, At, B0); PG8_BAR; PG8_SCHED;
            PG8_STAGE(PG8_SB(1, 1), b3 + hstep, voffB);
            PG8_WAIT_V(6); PG8_BAR; PG8_MMA(1, 1, At, B1); PG8_BAR;
            }
        }
        if constexpr (ALIGN_EPI) { if (wr == 0) PG8_BAR; }
        if constexpr (!Epi::AFTER_DRAIN) { E(acc, cur, wr, wc, fr, fq); S.done(cur); }
        if (!has_next) break;
#pragma unroll
        for (int a = 0; a < 2; ++a)
#pragma unroll
            for (int b = 0; b < 2; ++b)
#pragma unroll
                for (int m = 0; m < 4; ++m)
#pragma unroll
                    for (int n = 0; n < 2; ++n) acc[a][b][m][n] = (f32x4){0.f, 0.f, 0.f, 0.f};
        cur = nxt; cA = nA; cB = nB; ++ui;
        if constexpr (ALIGN_EPI) { if (wr == 1) PG8_BAR; }
    }
    PG8_WAIT_V(0);
    if constexpr (!ALIGN_EPI) { if (wr == 0) PG8_BAR; }
    PG8_BAR;
    if constexpr (Epi::AFTER_DRAIN) { E.fused(acc, cur, wr, wc, fr, fq, lds, wid, lane); S.done(cur); }
#undef PG8_SA
#undef PG8_SB
#undef PG8_STAGE
#undef PG8_LDA
#undef PG8_LDB
#undef PG8_MMA
#undef PG8_WAIT_V
#undef PG8_WAIT_L
#undef PG8_BAR
#undef PG8_SCHED
}
}

namespace mk {
typedef unsigned short bf16;
typedef float f32x4 __attribute__((ext_vector_type(4)));
typedef unsigned u32x4 __attribute__((ext_vector_type(4)));
typedef unsigned u32x2 __attribute__((ext_vector_type(2)));
#define LAS __attribute__((address_space(3)))
constexpr int D = 1024, NB = 2, SEQ = 8192, CTXL = 256, NLAT = NB * SEQ, NCTX = NB * CTXL, T = NLAT + NCTX;
constexpr int DIN = 2560, DFF = 2816, NE = 8, DFE = 3584, SPOS = SEQ + CTXL  , NCH = SPOS / 64;
static_assert(T == pg8::T_ROWS && NLAT == pg8::N_LAT, "rows");
enum { I_X = 0, I_C, I_CTX, I_CCTX, I_ADAW, I_ADAB, I_N1G, I_N2G, I_WIN, I_WOUT, I_MU, I_W0, I_WUP, I_A0, I_AUP, I_GUP, I_KK, I_KA, I_RK, I_LNW, I_LNB,
       I_LRE, I_LIM, I_LDT, I_BRE, I_BIM, I_CRE, I_CIM, I_S5D, I_GLUW, I_GLUB, I_FG, I_FU, I_FD, I_ROUT, I_MG, I_MU2, I_MD, I_FING, N_IN };
constexpr size_t MiB = 1u << 20, QMiB = 1u << 18;
constexpr size_t WS_CTL = 0, CTL_ZERO_BYTES = 65536;
constexpr size_t WS_MOD = 1 * MiB;
constexpr size_t WS_COMB = 1 * MiB + 2 * QMiB;
constexpr size_t WS_WIN = 2 * MiB;
constexpr size_t WS_WOUT = 12 * MiB;
constexpr size_t WS_WGLU = 16 * MiB;
constexpr size_t WS_WLR = 17 * MiB;
constexpr size_t WS_WFUP = 23 * MiB;
constexpr size_t WS_WFDN = 34 * MiB;
constexpr size_t WS_X = 40 * MiB;
constexpr size_t WS_H = 106 * MiB;
constexpr size_t WS_LRIN = 106 * MiB;
constexpr size_t WS_U = 122 * MiB + 2 * QMiB;
constexpr size_t WS_P = 370 * MiB;
constexpr size_t WS_LW = 139 * MiB;
constexpr size_t WS_XEND = 205 * MiB;
constexpr size_t WS_CARRY = 213 * MiB + QMiB;
constexpr size_t WS_Y = 139 * MiB;
constexpr size_t WS_YG = 221 * MiB + 2 * QMiB;
constexpr size_t WS_BONUS = 106 * MiB;
constexpr size_t WS_R = 221 * MiB + 2 * QMiB, WS_V = 238 * MiB, WS_KKN = 254 * MiB + 2 * QMiB;
constexpr size_t WS_KT = 271 * MiB, WS_BB = 304 * MiB, WS_GD = 337 * MiB;
constexpr size_t WS_K = 370 * MiB;
constexpr size_t WS_PARTO = 370 * MiB;
constexpr size_t WS_PARTF = 380 * MiB;
constexpr size_t WS_CH = 370 * MiB;
constexpr size_t WS_S5E = 271 * MiB;
constexpr size_t WS_S5BP = 304 * MiB;
constexpr size_t WS_S5K = 287 * MiB;
constexpr size_t WS_A2 = 304 * MiB;
constexpr size_t WS_ACT = 221 * MiB + 2 * QMiB;
constexpr size_t WS_RE = 1 * MiB + 2 * QMiB;
constexpr size_t WS_RP = WS_RE + 65536;
constexpr size_t WS_SEGCNT = WS_RE + 131072;
constexpr size_t WS_PROW = WS_RE + 196608;
constexpr size_t WS_PGW = WS_PROW + 147456;
constexpr size_t WS_TOFF = WS_PGW + 147456;
constexpr size_t WS_PPOS = 1 * MiB + QMiB;
constexpr size_t WS_APERM = 139 * MiB;
constexpr size_t WS_ACT1 = 207 * MiB;
constexpr int MOE_PASS_TILES = 64, MOE_MAX_TILES = 136, MOE_ACT_TILES = 72;
constexpr size_t WS_PARTM = 2 * MiB;
static_assert(WS_TOFF + 64 <= 2 * MiB && WS_APERM + (size_t)MOE_MAX_TILES * 256 * 2048 <= WS_ACT1 && WS_ACT1 + (size_t)MOE_ACT_TILES * 256 * DFE * 2 <= 333 * MiB + 2 * QMiB, "moe ws map");
constexpr size_t WS_WMUP = 333 * MiB + 2 * QMiB;
constexpr size_t WS_WMDN = 445 * MiB + 2 * QMiB;
constexpr size_t WS_END = 502 * MiB;
constexpr int NCC = 2 * NB * NCH * 8;
static_assert(WS_CH + (size_t)NCC * 32768 <= WS_END && WS_WMDN + (size_t)8 * 1024 * 3584 * 2 <= WS_END && WS_ACT + (size_t)NLAT * DFE * 2 <= WS_WMUP && WS_GD + (size_t)2 * T * 512 * 2 <= WS_K, "ws map");
constexpr int LDS_BYTES = 147456, RING_BYTES = 131072, MISC_OFF = LDS_BYTES - 1024, LDS_GC = LDS_BYTES - 2048;

struct Params { const float* in[N_IN]; float* out; unsigned char* ws; int lo, hi; };
static_assert(sizeof(Params) == 8 * N_IN + 24, "no padding");

__device__ __forceinline__ float bf2f(bf16 v) { return __uint_as_float(((unsigned)v) << 16); }
__device__ __forceinline__ unsigned f2bf(float f) { unsigned u = __float_as_uint(f); return (u + 0x7fffu + ((u >> 16) & 1u)) >> 16; }
__device__ __forceinline__ unsigned pk2(float lo, float hi) { return f2bf(lo) | (f2bf(hi) << 16); }
__device__ __forceinline__ float blo(unsigned w) { return __uint_as_float(w << 16); }
__device__ __forceinline__ float bhi(unsigned w) { return __uint_as_float(w & 0xffff0000u); }
__device__ __forceinline__ float sigm(float x) { return 1.0f / (1.0f + __expf(-x)); }
__device__ __forceinline__ float wave_sum(float v) {
#pragma unroll
    for (int o = 1; o < 64; o <<= 1) v += __shfl_xor(v, o);
    return v;
}
#define LDS_WAIT() asm volatile("s_waitcnt lgkmcnt(0)" ::: "memory")
__device__ __forceinline__ int row_of(int b, int d, int s) {
    return s < CTXL ? NLAT + b * CTXL + (d ? CTXL - 1 - s : s) : b * SEQ + (d ? SEQ - 1 - (s - CTXL) : (s - CTXL));
}

#define XB_TMO      128
#define XB_XCNT(j)  (256  + 64 * (j))
#define XB_XSUB(j)  (1280 + 64 * (j))
#define XB_XGEN(j)  (2304 + 64 * (j))
#define XB_TOP      3328
#define XB_TOPGEN   3392
#define XCD_BAR_WORDS 3456
#define XB_SPIN_CAP (1u << 25)
__device__ __forceinline__ unsigned xb_ld(unsigned* p)              { return __hip_atomic_load(p, __ATOMIC_RELAXED, __HIP_MEMORY_SCOPE_AGENT); }
__device__ __forceinline__ unsigned xb_add(unsigned* p, unsigned v) { return __hip_atomic_fetch_add(p, v, __ATOMIC_RELAXED, __HIP_MEMORY_SCOPE_AGENT); }
__device__ __forceinline__ unsigned xb_xcc_id() { return (unsigned)__builtin_amdgcn_s_getreg((3 << 11) | 20) & 0xFu; }
#define XB_SPIN(cond, bar) do { unsigned _sp = 0; while (cond) { __builtin_amdgcn_s_sleep(1); \
    if ((++_sp & 255u) == 0u) { if (xb_ld(&(bar)[XB_TMO])) break; if (_sp > XB_SPIN_CAP) { atomicAdd(&(bar)[XB_TMO], 1u); break; } } } } while (0)
struct XcdBarrier { unsigned* bar; unsigned x; volatile LAS unsigned* st; };
__device__ __forceinline__ XcdBarrier xcd_barrier_post(unsigned* bar, volatile LAS unsigned* st) {
    XcdBarrier b; b.bar = bar; b.x = xb_xcc_id(); b.st = st;
    if (threadIdx.x == 0) (void)xb_add(&bar[XB_XCNT(b.x)], 1u);
    return b;
}
__device__ __forceinline__ void xcd_barrier_complete(unsigned* bar, unsigned x, unsigned& nloc, unsigned& nx) {
    const unsigned G = gridDim.x * gridDim.y * gridDim.z;
    unsigned sum, cnt, mine, sp = 0u;
    for (;;) {
        sum = 0u; cnt = 0u; mine = 0u;
#pragma unroll
        for (unsigned j = 0; j < 16; ++j) { const unsigned c = xb_ld(&bar[XB_XCNT(j)]); sum += c; cnt += (c > 0u) ? 1u : 0u; mine = (j == x) ? c : mine; }
        if (sum == G) break;
        __builtin_amdgcn_s_sleep(1);
        if ((++sp & 255u) == 0u) { if (xb_ld(&bar[XB_TMO])) break; if (sp > XB_SPIN_CAP) { atomicAdd(&bar[XB_TMO], 1u); break; } }
    }
    nloc = mine > 0u ? mine : 1u; nx = cnt > 0u ? cnt : 1u;
}
__device__ __forceinline__ void xcd_barrier(const XcdBarrier& b) {
    asm volatile("s_waitcnt vmcnt(0)" ::: "memory");
    __syncthreads();
    if (threadIdx.x == 0) {
        unsigned* bar = b.bar;
        __builtin_amdgcn_s_waitcnt(0);
        unsigned nloc = b.st[0], nx = b.st[1];
        if (nloc == 0u) { xcd_barrier_complete(bar, b.x, nloc, nx); b.st[0] = nloc; b.st[1] = nx; }
        const unsigned old = xb_add(&bar[XB_XSUB(b.x)], 1u);
        const unsigned gen = old / nloc;
        if (old + 1u == (gen + 1u) * nloc) {
            __builtin_amdgcn_fence(__ATOMIC_RELEASE, "agent");
            asm volatile("s_waitcnt vmcnt(0)" ::: "memory");
            const unsigned og = xb_add(&bar[XB_TOP], 1u);
            const unsigned tg = og / nx;
            if (og + 1u == (tg + 1u) * nx) xb_add(&bar[XB_TOPGEN], 1u);
            else XB_SPIN(xb_ld(&bar[XB_TOPGEN]) == tg, bar);
            __builtin_amdgcn_fence(__ATOMIC_ACQUIRE, "agent");
            xb_add(&bar[XB_XGEN(b.x)], 1u);
            asm volatile("s_waitcnt vmcnt(0)" ::: "memory");
        } else {
            XB_SPIN(xb_ld(&bar[XB_XGEN(b.x)]) == gen, bar);
            __builtin_amdgcn_fence(__ATOMIC_ACQUIRE, "agent");
            asm volatile("s_waitcnt vmcnt(0)" ::: "memory");
        }
    }
    __syncthreads();
}

__device__ __forceinline__ void tr_item(const float* W, int Nsrc, int k0, int n0, bf16* dst, int ldk, int drow0, int dk0, bool zero, LAS float* scr, int lane) {
    if (!zero) {
#pragma unroll 8
        for (int i = 0; i < 32; ++i) { const int kk = 2 * i + (lane >> 5); scr[kk * 33 + (lane & 31)] = W[(size_t)(k0 + kk) * Nsrc + n0 + (lane & 31)]; }
    }
    LDS_WAIT(); asm volatile("" ::: "memory");
    const int c = lane & 7;
#pragma unroll
    for (int j = 0; j < 4; ++j) { const int n = (lane >> 3) + 8 * j; const LAS float* s = scr + (8 * c) * 33 + n;
        u32x4 o = (u32x4){0u, 0u, 0u, 0u};
        if (!zero) { o.x = pk2(s[0 * 33], s[1 * 33]); o.y = pk2(s[2 * 33], s[3 * 33]); o.z = pk2(s[4 * 33], s[5 * 33]); o.w = pk2(s[6 * 33], s[7 * 33]); }
        *(u32x4*)(dst + (size_t)(drow0 + n) * ldk + dk0 + 8 * c) = o; }
    LDS_WAIT(); asm volatile("" ::: "memory");
}

__device__ __forceinline__ void phase_prologue(const Params& p, LAS unsigned char* lds, int tid, int lane, int wave) {
    unsigned char* ws = p.ws;
    const int G = gridDim.x;
    {
        LAS float* act = (LAS float*)lds;
        LAS float* red = (LAS float*)(lds + 12288);
        for (int i = tid; i < 3 * 1024; i += 512) { const float v = i < 2048 ? p.in[I_C][i] : p.in[I_CCTX][i - 2048]; act[i] = v * sigm(v); }
        __syncthreads();
        float* MOD = (float*)(ws + WS_MOD);
        for (int task = blockIdx.x; task < 192; task += G) {
            const int l = task / 96, j = (task % 96) * 64 + lane;
            const float* Wp = p.in[I_ADAW] + (size_t)l * 1024 * 6144 + (size_t)(wave * 128) * 6144 + j;
            float a0 = 0.f, a1 = 0.f, a2 = 0.f;
#pragma unroll 8
            for (int k = 0; k < 128; ++k) { const float w = Wp[(size_t)k * 6144]; const int kk = wave * 128 + k; a0 += act[kk] * w; a1 += act[1024 + kk] * w; a2 += act[2048 + kk] * w; }
            red[(wave * 3 + 0) * 64 + lane] = a0; red[(wave * 3 + 1) * 64 + lane] = a1; red[(wave * 3 + 2) * 64 + lane] = a2;
            __syncthreads();
            if (wave < 3) { float s = p.in[I_ADAB][l * 6144 + j];
#pragma unroll
                for (int w = 0; w < 8; ++w) s += red[(w * 3 + wave) * 64 + lane];
                MOD[(size_t)(l * 3 + wave) * 6144 + j] = s; }
            __syncthreads();
        }
    }
    LAS float* scr = (LAS float*)(lds + 32768 + wave * 8448);
    const int gw = blockIdx.x * 8 + wave, NGW = G * 8;
    constexpr int PL = 1280 + 512 + 128 + 128, NIT = 2 * PL + 3 * 1408;
    for (int it0 = gw; it0 < NIT; it0 += NGW) {
        int it = it0;
        if (it < 2 * PL) {
            const int l = it / PL; it -= l * PL;
            if (it < 1280) { const int kb = it / 80, nb = it % 80; tr_item(p.in[I_WIN] + (size_t)l * 1024 * 2560, 2560, kb * 64, nb * 32, (bf16*)(ws + WS_WIN) + (size_t)l * 2560 * 1024, 1024, nb * 32, kb * 64, false, scr, lane); continue; }
            it -= 1280;
            if (it < 512) { const int kb = it / 32, nb = it % 32; tr_item(p.in[I_WOUT] + (size_t)l * 1024 * 1024, 1024, kb * 64, nb * 32, (bf16*)(ws + WS_WOUT) + (size_t)l * 1024 * 1024, 1024, nb * 32, kb * 64, false, scr, lane); continue; }
            it -= 512;
            if (it < 128) { const int kb = it / 16, nb = it % 16; tr_item(p.in[I_GLUW] + (size_t)l * 512 * 512, 512, kb * 64, nb * 32, (bf16*)(ws + WS_WGLU) + (size_t)l * 512 * 512, 512, nb * 32, kb * 64, false, scr, lane); continue; }
            it -= 128;
            {
                const int d = it / 64, q = it % 64; bf16* dst = (bf16*)(ws + WS_WLR) + (size_t)(l * 2 + d) * 131072;
                if (q < 16) tr_item(p.in[I_WUP] + (size_t)(l * 2 + d) * 64 * 512, 512, 0, q * 32, dst, 64, q * 32, 0, false, scr, lane);
                else if (q < 32) tr_item(p.in[I_AUP] + (size_t)(l * 2 + d) * 64 * 512, 512, 0, (q - 16) * 32, dst + 32768, 64, (q - 16) * 32, 0, false, scr, lane);
                else { const int kb = (q - 32) / 16, nb = (q - 32) % 16; tr_item(p.in[I_GUP] + (size_t)(l * 2 + d) * 128 * 512, 512, kb * 64, nb * 32, dst + 65536, 128, nb * 32, kb * 64, false, scr, lane); }
            }
            continue;
        }
        it -= 2 * PL;
        if (it < 1408) { const int kb = it / 88, nb = it % 88, n0 = nb * 32; tr_item(p.in[I_FG], 2816, kb * 64, n0, (bf16*)(ws + WS_WFUP), 1024, (n0 / 128) * 256 + n0 % 128, kb * 64, false, scr, lane); continue; }
        it -= 1408;
        if (it < 1408) { const int kb = it / 88, nb = it % 88, n0 = nb * 32; tr_item(p.in[I_FU], 2816, kb * 64, n0, (bf16*)(ws + WS_WFUP), 1024, (n0 / 128) * 256 + 128 + n0 % 128, kb * 64, false, scr, lane); continue; }
        it -= 1408;
        { const int kb = it / 32, nb = it % 32; tr_item(p.in[I_FD], 1024, kb * 64, nb * 32, (bf16*)(ws + WS_WFDN), 2816, nb * 32, kb * 64, false, scr, lane); }
    }
}
__device__ __forceinline__ void phase_moe_cvt(const Params& p, LAS unsigned char* lds, int lane, int wave) {
    unsigned char* ws = p.ws;
    LAS float* scr = (LAS float*)(lds + 32768 + wave * 8448);
    const int gw = blockIdx.x * 8 + wave, NGW = gridDim.x * 8;
    for (int it0 = gw; it0 < 8 * 5376; it0 += NGW) {
        const int e = it0 / 5376; int it = it0 % 5376;
        if (it < 1792) { const int kb = it / 112, nb = it % 112, n0 = nb * 32; tr_item(p.in[I_MG] + (size_t)e * 1024 * 3584, 3584, kb * 64, n0, (bf16*)(ws + WS_WMUP) + (size_t)e * 7168 * 1024, 1024, (n0 / 128) * 256 + n0 % 128, kb * 64, false, scr, lane); continue; }
        it -= 1792;
        if (it < 1792) { const int kb = it / 112, nb = it % 112, n0 = nb * 32; tr_item(p.in[I_MU2] + (size_t)e * 1024 * 3584, 3584, kb * 64, n0, (bf16*)(ws + WS_WMUP) + (size_t)e * 7168 * 1024, 1024, (n0 / 128) * 256 + 128 + n0 % 128, kb * 64, false, scr, lane); continue; }
        it -= 1792;
        { const int kb = it / 32, nb = it % 32; tr_item(p.in[I_MD] + (size_t)e * 3584 * 1024, 1024, kb * 64, nb * 32, (bf16*)(ws + WS_WMDN) + (size_t)e * 1024 * 3584, 3584, nb * 32, kb * 64, false, scr, lane); }
    }
}

__device__ __forceinline__ void phase_norm(const Params& p, int l, int which, bool first, bool router, int lane, int wave, int npart = 0, const float* part = nullptr, const float* pgate = nullptr) {
    unsigned char* ws = p.ws;
    float* X = (float*)(ws + WS_X); bf16* H = (bf16*)(ws + WS_H); const float* MOD = (const float*)(ws + WS_MOD);
    const float* g = p.in[which ? I_N2G : I_N1G] + l * 1024;
    const int gw = blockIdx.x * 8 + wave, NGW = gridDim.x * 8;
    f32x4 gq[4];
#pragma unroll
    for (int j = 0; j < 4; ++j) gq[j] = *(const f32x4*)(g + 4 * lane + 256 * j);
#define NORM_FETCH(r_, V, SH, SC) do { const int rf_ = (r_); \
        const float* src_ = first ? (rf_ < NLAT ? p.in[I_X] + (size_t)rf_ * 1024 : p.in[I_CTX] + (size_t)(rf_ - NLAT) * 1024) : X + (size_t)rf_ * 1024; \
        const float* mp_ = MOD + (size_t)(l * 3 + (rf_ < NLAT ? (rf_ >> 13) : 2)) * 6144 + which * 3072; \
        _Pragma("unroll") for (int j = 0; j < 4; ++j) V[j] = *(const f32x4*)(src_ + 4 * lane + 256 * j); \
        _Pragma("unroll") for (int j = 0; j < 4; ++j) { SH[j] = *(const f32x4*)(mp_ + 4 * lane + 256 * j); SC[j] = *(const f32x4*)(mp_ + 1024 + 4 * lane + 256 * j); } } while (0)
    f32x4 vn[4], shn[4], scn[4];
    if (gw < T) NORM_FETCH(gw, vn, shn, scn);
    for (int row = gw; row < T; row += NGW) {
        f32x4 v[4], shq[4], scq[4]; float ss = 0.f;
#pragma unroll
        for (int j = 0; j < 4; ++j) { v[j] = vn[j]; shq[j] = shn[j]; scq[j] = scn[j]; }
        asm volatile("" ::: "memory");
        NORM_FETCH(row + NGW < T ? row + NGW : row, vn, shn, scn);
        asm volatile("" ::: "memory");
#pragma unroll
        for (int j = 0; j < 4; ++j) ss += (v[j][0] * v[j][0] + v[j][1] * v[j][1]) + (v[j][2] * v[j][2] + v[j][3] * v[j][3]);
        if (first) {
#pragma unroll
            for (int j = 0; j < 4; ++j) *(f32x4*)(X + (size_t)row * 1024 + 4 * lane + 256 * j) = v[j];
        }
        if (npart > 0 && row >= NLAT) {
            ss = 0.f;
#pragma unroll
            for (int j = 0; j < 4; ++j) { const int c = 4 * lane + 256 * j; f32x4 sacc = (f32x4){0.f, 0.f, 0.f, 0.f};
                for (int k = 0; k < npart; ++k) sacc += *(const f32x4*)(part + ((size_t)k * NCTX + (row - NLAT)) * 1024 + c);
                v[j] += *(const f32x4*)(pgate + c) * sacc; *(f32x4*)(X + (size_t)row * 1024 + c) = v[j];
                ss += (v[j][0] * v[j][0] + v[j][1] * v[j][1]) + (v[j][2] * v[j][2] + v[j][3] * v[j][3]); }
        }
        const float inv = rsqrtf(wave_sum(ss) * (1.0f / 1024.0f) + 1e-6f);
        f32x4 h[4];
#pragma unroll
        for (int j = 0; j < 4; ++j) { const int c = 4 * lane + 256 * j; const f32x4 gg = gq[j], sh = shq[j], sc = scq[j];
            h[j] = (v[j] * inv * gg) * (1.0f + sc) + sh;
            u32x2 o; o.x = pk2(h[j][0], h[j][1]); o.y = pk2(h[j][2], h[j][3]); *(u32x2*)(H + (size_t)row * 1024 + c) = o; }
        if (router && row < NLAT) {
            float lg[8] = {0.f, 0.f, 0.f, 0.f, 0.f, 0.f, 0.f, 0.f};
#pragma unroll
            for (int j = 0; j < 4; ++j)
#pragma unroll
                for (int q = 0; q < 4; ++q) { const float* rp = p.in[I_ROUT] + (size_t)(4 * lane + 256 * j + q) * 8; const f32x4 r0 = *(const f32x4*)rp, r1 = *(const f32x4*)(rp + 4); const float hv = h[j][q];
                    lg[0] += hv * r0[0]; lg[1] += hv * r0[1]; lg[2] += hv * r0[2]; lg[3] += hv * r0[3]; lg[4] += hv * r1[0]; lg[5] += hv * r1[1]; lg[6] += hv * r1[2]; lg[7] += hv * r1[3]; }
#pragma unroll
            for (int e = 0; e < 8; ++e) lg[e] = wave_sum(lg[e]);
            int e0 = 0; float v0 = lg[0];
#pragma unroll
            for (int e = 1; e < 8; ++e) if (lg[e] > v0) { v0 = lg[e]; e0 = e; }
            int e1 = -1; float v1 = -3.0e38f;
#pragma unroll
            for (int e = 0; e < 8; ++e) if (e != e0 && lg[e] > v1) { v1 = lg[e]; e1 = e; }
            const float p1 = 1.0f / (1.0f + __expf(v0 - v1)), p0 = 1.0f - p1;
            if (lane < 8) ((float*)(ws + WS_COMB))[(size_t)row * 8 + lane] = lane == e0 ? p0 : (lane == e1 ? p1 : 0.0f);
        }
    }
}
#undef NORM_FETCH
__device__ __forceinline__ void phase_final(const Params& p, int lane, int wave) {
    unsigned char* ws = p.ws;
    const float* X = (const float*)(ws + WS_X); const float* g = p.in[I_FING];
    const bf16* YP = (const bf16*)(ws + WS_APERM); const bf16* PM = (const bf16*)(ws + WS_PARTM); const int* PPOS = (const int*)(ws + WS_PPOS); const float* RP = (const float*)(ws + WS_RP);
    const float* MOD1 = (const float*)(ws + WS_MOD) + (size_t)3 * 6144 + 5120;
    const int gw = blockIdx.x * 8 + wave, NGW = gridDim.x * 8;
    f32x4 gq[4];
#pragma unroll
    for (int j = 0; j < 4; ++j) gq[j] = *(const f32x4*)(g + 4 * lane + 256 * j);
    int s0n = 0, s1n = 0; float p0n = 0.f;
    if (gw < NLAT) { s0n = PPOS[2 * gw]; s1n = PPOS[2 * gw + 1]; p0n = RP[gw]; }
    for (int row = gw; row < NLAT; row += NGW) {
        const int s0 = s0n, s1 = s1n; const float p0 = p0n, p1 = 1.0f - p0;
        { const int rn = row + NGW < NLAT ? row + NGW : row; s0n = PPOS[2 * rn]; s1n = PPOS[2 * rn + 1]; p0n = RP[rn]; }
        const float* gt = MOD1 + (size_t)(row >> 13) * 6144;
        const bool big0 = s0 >= 128 * 256, big1 = s1 >= 128 * 256;
        const bf16* y0p = YP + (size_t)(big0 ? 0 : s0) * 1024; const bf16* y1p = YP + (size_t)(big1 ? 0 : s1) * 1024;
        u32x2 y0r[4], y1r[4]; f32x4 xr[4], gvr[4];
#pragma unroll
        for (int j = 0; j < 4; ++j) { const int c = 4 * lane + 256 * j; y0r[j] = *(const u32x2*)(y0p + c); y1r[j] = *(const u32x2*)(y1p + c); xr[j] = *(const f32x4*)(X + (size_t)row * 1024 + c); gvr[j] = *(const f32x4*)(gt + c); }
        f32x4 v[4]; float ss = 0.f;
#pragma unroll
        for (int j = 0; j < 4; ++j) { const int c = 4 * lane + 256 * j;
            f32x4 e0v = (f32x4){blo(y0r[j].x), bhi(y0r[j].x), blo(y0r[j].y), bhi(y0r[j].y)}, e1v = (f32x4){blo(y1r[j].x), bhi(y1r[j].x), blo(y1r[j].y), bhi(y1r[j].y)};
            if (big0) { e0v = (f32x4){0.f, 0.f, 0.f, 0.f}; for (int k = 0; k < 7; ++k) { const u32x2 y0 = *(const u32x2*)(PM + ((size_t)k * 2048 + (s0 - 128 * 256)) * 1024 + c); e0v += (f32x4){blo(y0.x), bhi(y0.x), blo(y0.y), bhi(y0.y)}; } }
            if (big1) { e1v = (f32x4){0.f, 0.f, 0.f, 0.f}; for (int k = 0; k < 7; ++k) { const u32x2 y1 = *(const u32x2*)(PM + ((size_t)k * 2048 + (s1 - 128 * 256)) * 1024 + c); e1v += (f32x4){blo(y1.x), bhi(y1.x), blo(y1.y), bhi(y1.y)}; } }
            const f32x4 mix = e0v * p0 + e1v * p1;
            v[j] = xr[j] + gvr[j] * mix;
            ss += (v[j][0] * v[j][0] + v[j][1] * v[j][1]) + (v[j][2] * v[j][2] + v[j][3] * v[j][3]); }
        const float inv = rsqrtf(wave_sum(ss) * (1.0f / 1024.0f) + 1e-6f);
#pragma unroll
        for (int j = 0; j < 4; ++j) { const int c = 4 * lane + 256 * j; *(f32x4*)(p.out + (size_t)row * 1024 + c) = v[j] * inv * gq[j]; }
    }
}

__device__ __forceinline__ void phase_norm2_moe(const Params& p, LAS unsigned char* lds, int tid, int lane, int wave) {
    unsigned char* ws = p.ws; const int l = 1;
    const float* X = (const float*)(ws + WS_X); bf16* H = (bf16*)(ws + WS_H); const float* MOD = (const float*)(ws + WS_MOD);
    int* RE = (int*)(ws + WS_RE); float* RP = (float*)(ws + WS_RP); int* SEGCNT = (int*)(ws + WS_SEGCNT);
    const float* g = p.in[I_N2G] + l * 1024;
    LAS int* wc = (LAS int*)lds;
    LAS float* RT = (LAS float*)(lds + 1024);
    for (int ch = tid; ch < 1024; ch += 512) { const f32x4 r0 = *(const f32x4*)(p.in[I_ROUT] + (size_t)ch * 8), r1 = *(const f32x4*)(p.in[I_ROUT] + (size_t)ch * 8 + 4);
        RT[0 * 1024 + ch] = r0[0]; RT[1 * 1024 + ch] = r0[1]; RT[2 * 1024 + ch] = r0[2]; RT[3 * 1024 + ch] = r0[3]; RT[4 * 1024 + ch] = r1[0]; RT[5 * 1024 + ch] = r1[1]; RT[6 * 1024 + ch] = r1[2]; RT[7 * 1024 + ch] = r1[3]; }
    __syncthreads();
    for (int seg = blockIdx.x; seg < NLAT / 64; seg += gridDim.x) {
        int cnt[8] = {0, 0, 0, 0, 0, 0, 0, 0};
        const float* mp = MOD + (size_t)(l * 3 + ((seg * 64) >> 13)) * 6144 + 3072;
        f32x4 gq[4], shq[4], scq[4], vn[4];
#pragma unroll
        for (int j = 0; j < 4; ++j) { const int c = 4 * lane + 256 * j; gq[j] = *(const f32x4*)(g + c); shq[j] = *(const f32x4*)(mp + c); scq[j] = *(const f32x4*)(mp + 1024 + c); }
#pragma unroll
        for (int j = 0; j < 4; ++j) vn[j] = *(const f32x4*)(X + (size_t)(seg * 64 + wave * 8) * 1024 + 4 * lane + 256 * j);
        for (int rr = 0; rr < 8; ++rr) {
            const int row = seg * 64 + wave * 8 + rr;
            asm volatile("" ::: "memory");
            f32x4 v[4]; float ss = 0.f;
#pragma unroll
            for (int j = 0; j < 4; ++j) v[j] = vn[j];
            { const int rn = seg * 64 + wave * 8 + (rr < 7 ? rr + 1 : 7);
#pragma unroll
              for (int j = 0; j < 4; ++j) vn[j] = *(const f32x4*)(X + (size_t)rn * 1024 + 4 * lane + 256 * j); }
#pragma unroll
            for (int j = 0; j < 4; ++j) ss += (v[j][0] * v[j][0] + v[j][1] * v[j][1]) + (v[j][2] * v[j][2] + v[j][3] * v[j][3]);
            const float inv = rsqrtf(wave_sum(ss) * (1.0f / 1024.0f) + 1e-6f);
            float lg[8] = {0.f, 0.f, 0.f, 0.f, 0.f, 0.f, 0.f, 0.f};
#pragma unroll
            for (int j = 0; j < 4; ++j) { const int c = 4 * lane + 256 * j;
                const f32x4 h = (v[j] * inv * gq[j]) * (1.0f + scq[j]) + shq[j];
                u32x2 o; o.x = pk2(h[0], h[1]); o.y = pk2(h[2], h[3]); *(u32x2*)(H + (size_t)row * 1024 + c) = o;
#pragma unroll
                for (int e = 0; e < 8; ++e) { const f32x4 w = *(const LAS f32x4*)(RT + e * 1024 + c); lg[e] += (h[0] * w[0] + h[1] * w[1]) + (h[2] * w[2] + h[3] * w[3]); } }
#pragma unroll
            for (int e = 0; e < 8; ++e) lg[e] = wave_sum(lg[e]);
            int e0 = 0; float v0 = lg[0];
#pragma unroll
            for (int e = 1; e < 8; ++e) if (lg[e] > v0) { v0 = lg[e]; e0 = e; }
            int e1 = -1; float v1 = -3.0e38f;
#pragma unroll
            for (int e = 0; e < 8; ++e) if (e != e0 && lg[e] > v1) { v1 = lg[e]; e1 = e; }
            e0 = __builtin_amdgcn_readfirstlane(e0); e1 = __builtin_amdgcn_readfirstlane(e1);
            const float p1 = 1.0f / (1.0f + __expf(v0 - v1));
            if (lane == 0) { RE[row] = e0 | (e1 << 8); RP[row] = 1.0f - p1; }
#pragma unroll
            for (int e = 0; e < 8; ++e) cnt[e] += (e0 == e ? 1 : 0) + (e1 == e ? 1 : 0);
        }
        if (lane < 8) { int c = 0;
#pragma unroll
            for (int e = 0; e < 8; ++e) c = (lane == e) ? cnt[e] : c;
            wc[wave * 8 + lane] = c; }
        __syncthreads();
        if (tid < 8) { int c = 0;
#pragma unroll
            for (int w = 0; w < 8; ++w) c += wc[w * 8 + tid];
            SEGCNT[seg * 8 + tid] = c; }
        __syncthreads();
    }
}
__device__ __forceinline__ void phase_moe_prep(const Params& p, LAS unsigned char* lds, int tid, int lane, int wave) {
    unsigned char* ws = p.ws;
    const int* RE = (const int*)(ws + WS_RE); const float* RP = (const float*)(ws + WS_RP); const int* SEGCNT = (const int*)(ws + WS_SEGCNT);
    int* PROW = (int*)(ws + WS_PROW); float* PGW = (float*)(ws + WS_PGW); int* TOFF = (int*)(ws + WS_TOFF);
    const bf16* H = (const bf16*)(ws + WS_H); bf16* AP = (bf16*)(ws + WS_APERM);
    LAS int* sc = (LAS int*)lds;
    LAS int* tot = (LAS int*)(lds + 8192);
    LAS int* perm = (LAS int*)(lds + 8192 + 256);
    constexpr int NSEG = NLAT / 64;
    for (int i = tid; i < NSEG * 8; i += 512) sc[i] = SEGCNT[i];
    __syncthreads();
    if (tid < 8) { int t = 0; for (int s2 = 0; s2 < NSEG; ++s2) t += sc[s2 * 8 + tid]; tot[tid] = t; }
    __syncthreads();
    if (tid == 0) { int o = 0; for (int e = 0; e < 8; ++e) { tot[8 + e] = o; o += (tot[e] + 255) >> 8; } tot[16] = o;
        if (blockIdx.x == 0) { for (int e = 0; e <= 8; ++e) TOFF[e] = tot[8 + e]; } }
    __syncthreads();
    for (int seg = blockIdx.x; seg < NSEG; seg += gridDim.x) {
        if (tid < 8) { int bs = 0; for (int s2 = 0; s2 < seg; ++s2) bs += sc[s2 * 8 + tid]; tot[32 + tid] = bs; }
        __syncthreads();
        if (wave == 0) {
            const int row = seg * 64 + lane; const int re = RE[row], e0 = re & 0xff, e1 = re >> 8; const float p0 = RP[row];
            int s0 = 0, s1 = 0;
#pragma unroll
            for (int e = 0; e < 8; ++e) { const bool mine = (e0 == e) || (e1 == e); const unsigned long long m = __ballot(mine);
                const int rank = __popcll(m & ((1ull << lane) - 1ull)); const int slot = (tot[8 + e] << 8) + tot[32 + e] + rank;
                s0 = (e0 == e) ? slot : s0; s1 = (e1 == e) ? slot : s1; }
            PROW[s0] = row; PGW[s0] = p0; PROW[s1] = row; PGW[s1] = 1.0f - p0;
            ((int*)(ws + WS_PPOS))[2 * row] = s0; ((int*)(ws + WS_PPOS))[2 * row + 1] = s1;
            perm[lane * 2] = s0; perm[lane * 2 + 1] = s1;
        }
        __syncthreads();
        for (int rr = 0; rr < 8; ++rr) { const int lr = wave * 8 + rr, row = seg * 64 + lr; const int s0 = perm[lr * 2], s1 = perm[lr * 2 + 1];
            const u32x4 a = *(const u32x4*)(H + (size_t)row * 1024 + lane * 16), b2 = *(const u32x4*)(H + (size_t)row * 1024 + lane * 16 + 8);
            *(u32x4*)(AP + (size_t)s0 * 1024 + lane * 16) = a; *(u32x4*)(AP + (size_t)s0 * 1024 + lane * 16 + 8) = b2;
            *(u32x4*)(AP + (size_t)s1 * 1024 + lane * 16) = a; *(u32x4*)(AP + (size_t)s1 * 1024 + lane * 16 + 8) = b2; }
        __syncthreads();
    }
    for (int e = blockIdx.x; e < 8; e += gridDim.x) {
        const int lo = (tot[8 + e] << 8) + tot[e], hi = tot[9 + e] << 8;
        for (int r = lo + wave; r < hi; r += 8) { if (lane == 0) { PROW[r] = -1; PGW[r] = 0.f; }
            *(u32x4*)(AP + (size_t)r * 1024 + lane * 16) = (u32x4){0u, 0u, 0u, 0u}; *(u32x4*)(AP + (size_t)r * 1024 + lane * 16 + 8) = (u32x4){0u, 0u, 0u, 0u}; }
    }
}

typedef short bf16x8s __attribute__((ext_vector_type(8)));
__device__ __forceinline__ unsigned cvtpk_(float lo, float hi) { typedef float f2_ __attribute__((ext_vector_type(2))); typedef __bf16 b2_ __attribute__((ext_vector_type(2))); f2_ v = {lo, hi}; return __builtin_bit_cast(unsigned, __builtin_convertvector(v, b2_)); }
constexpr int SLR_ROWS = 33, SLR_PITCH = 520;
__device__ __forceinline__ void phase_stream_lr(const Params& p, int l, LAS unsigned char* lds, int tid, int lane, int wave) {
    unsigned char* ws = p.ws;
    const bf16* P = (const bf16*)(ws + WS_P);
    bf16* R = (bf16*)(ws + WS_R); bf16* V = (bf16*)(ws + WS_V); bf16* KKn = (bf16*)(ws + WS_KKN); bf16* U = (bf16*)(ws + WS_U);
    LAS bf16* lrin = (LAS bf16*)lds;
    LAS bf16* kbuf = (LAS bf16*)(lds + 48 * SLR_PITCH * 2);
    LAS bf16* kkbuf = (LAS bf16*)(lds + (48 + SLR_ROWS) * SLR_PITCH * 2);
    const int hrow = tid >> 8, t8 = tid & 255, c8 = 8 * t8;
    float mu8[8]; { const f32x4 m0 = *(const f32x4*)(p.in[I_MU] + l * 2048 + c8), m1 = *(const f32x4*)(p.in[I_MU] + l * 2048 + c8 + 4); mu8[0] = m0[0]; mu8[1] = m0[1]; mu8[2] = m0[2]; mu8[3] = m0[3]; mu8[4] = m1[0]; mu8[5] = m1[1]; mu8[6] = m1[2]; mu8[7] = m1[3]; }
    for (int i = tid; i < 15 * SLR_PITCH / 2; i += 512) ((LAS unsigned*)(lrin + SLR_ROWS * SLR_PITCH))[i] = 0u;
    const int r16 = lane & 15, g4 = lane >> 4;
    for (int tq = blockIdx.x; tq < T / SLR_ROWS; tq += gridDim.x) {
        const int tix = (gridDim.x == 256) ? ((tq & 7) * 64 + ((tq >> 3) & 31) + 32 * (tq >> 8)) : tq;
        const int row0 = tix * SLR_ROWS;
        for (int pr0 = 0; pr0 < 18; pr0 += 3) {
            u32x4 ow3[3], nb3[3][4], uw3[3];
#pragma unroll
            for (int u = 0; u < 3; ++u) { const int lr = 2 * (pr0 + u) + hrow, row = row0 + (lr < SLR_ROWS ? lr : 0); int nr[4];
                if (row < NLAT) { const int t = row & (SEQ - 1), gc = t & 63, gr = t >> 6; nr[0] = gc > 0 ? row - 1 : -1; nr[1] = gc < 63 ? row + 1 : -1; nr[2] = gr > 0 ? row - 64 : -1; nr[3] = gr < 127 ? row + 64 : -1; }
                else { const int t = (row - NLAT) & (CTXL - 1); nr[0] = nr[2] = t > 0 ? row - 1 : -1; nr[1] = nr[3] = t < CTXL - 1 ? row + 1 : -1; }
                ow3[u] = *(const u32x4*)(P + (size_t)row * DIN + c8);
#pragma unroll
                for (int j = 0; j < 4; ++j) nb3[u][j] = nr[j] >= 0 ? *(const u32x4*)(P + (size_t)nr[j] * DIN + c8) : (u32x4){0u, 0u, 0u, 0u};
                if (t8 < 64) uw3[u] = *(const u32x4*)(P + (size_t)row * DIN + 2048 + c8); }
#pragma unroll
            for (int u = 0; u < 3; ++u) { const int lr = 2 * (pr0 + u) + hrow, row = row0 + lr;
              if (lr < SLR_ROWS) {
                const u32x4 ow = ow3[u];
                const float own[8] = {blo(ow.x), bhi(ow.x), blo(ow.y), bhi(ow.y), blo(ow.z), bhi(ow.z), blo(ow.w), bhi(ow.w)};
                const float shv[8] = {blo(nb3[u][0].x), bhi(nb3[u][1].x), blo(nb3[u][2].y), bhi(nb3[u][3].y), blo(nb3[u][0].z), bhi(nb3[u][1].z), blo(nb3[u][2].w), bhi(nb3[u][3].w)};
                float sv[8];
#pragma unroll
                for (int q = 0; q < 8; ++q) sv[q] = own[q] + (shv[q] - own[q]) * mu8[q];
                if (c8 < 512) { u32x4 o; o.x = cvtpk_(sv[0], sv[1]); o.y = cvtpk_(sv[2], sv[3]); o.z = cvtpk_(sv[4], sv[5]); o.w = cvtpk_(sv[6], sv[7]); *(u32x4*)(R + (size_t)row * 512 + c8) = o; }
                else if (c8 < 1024) { const int cc = c8 - 512; u32x4 o; o.x = cvtpk_(sv[0], sv[1]); o.y = cvtpk_(sv[2], sv[3]); o.z = cvtpk_(sv[4], sv[5]); o.w = cvtpk_(sv[6], sv[7]); *(LAS u32x4*)(kbuf + lr * SLR_PITCH + cc) = o;
                    const f32x4 ka_ = *(const f32x4*)(p.in[I_KK] + l * 512 + cc), kb_ = *(const f32x4*)(p.in[I_KK] + l * 512 + cc + 4); const float kkw[8] = {ka_[0], ka_[1], ka_[2], ka_[3], kb_[0], kb_[1], kb_[2], kb_[3]};
                    float q8[8]; float ssq = 0.f;
#pragma unroll
                    for (int q = 0; q < 8; ++q) { q8[q] = sv[q] * kkw[q]; ssq += q8[q] * q8[q]; }
                    ssq += __shfl_xor(ssq, 1); ssq += __shfl_xor(ssq, 2); ssq += __shfl_xor(ssq, 4);
                    const float inv = 1.0f / fmaxf(sqrtf(ssq), 1e-12f);
                    u32x4 o2; o2.x = cvtpk_(q8[0] * inv, q8[1] * inv); o2.y = cvtpk_(q8[2] * inv, q8[3] * inv); o2.z = cvtpk_(q8[4] * inv, q8[5] * inv); o2.w = cvtpk_(q8[6] * inv, q8[7] * inv);
                    *(u32x4*)(KKn + (size_t)row * 512 + cc) = o2; *(LAS u32x4*)(kkbuf + lr * SLR_PITCH + cc) = o2; }
                else if (c8 < 1536) { u32x4 o; o.x = cvtpk_(sv[0], sv[1]); o.y = cvtpk_(sv[2], sv[3]); o.z = cvtpk_(sv[4], sv[5]); o.w = cvtpk_(sv[6], sv[7]); *(u32x4*)(V + (size_t)row * 512 + c8 - 1024) = o; }
                else { const int cc = c8 - 1536; float f[8];
#pragma unroll
                    for (int q = 0; q < 8; ++q) { const float e2 = __expf(2.0f * sv[q]); f[q] = cc < 128 ? 1.0f - 2.0f * __builtin_amdgcn_rcpf(e2 + 1.0f) : (cc < 256 ? sv[q] : sigm(sv[q])); }
                    u32x4 o; o.x = cvtpk_(f[0], f[1]); o.y = cvtpk_(f[2], f[3]); o.z = cvtpk_(f[4], f[5]); o.w = cvtpk_(f[6], f[7]); *(LAS u32x4*)(lrin + lr * SLR_PITCH + cc) = o; }
                if (t8 < 64) { int tbu, ju; if (row < NLAT) { const int bb_ = row >> 13, tt_ = row & (SEQ - 1); tbu = bb_ * NCH + 4 + (tt_ >> 6); ju = tt_ & 63; } else { const int rc = row - NLAT, bb_ = rc >> 8, tt_ = rc & 255; tbu = bb_ * NCH + (tt_ >> 6); ju = tt_ & 63; }
                    *(u32x4*)(U + ((size_t)((c8 >> 4) * 64 + ju) * (2 * NCH) + tbu) * 16 + (c8 & 15)) = uw3[u]; }
              }
            }
        }
        __syncthreads();
#pragma unroll 1
        for (int d = 0; d < 2; ++d) {
            const bf16* Wd = (const bf16*)(ws + WS_WLR) + (size_t)(l * 2 + d) * 131072 + 8 * g4;
            const size_t dT = (size_t)d * T * 512;
#pragma unroll
            for (int sec = 0; sec < 3; ++sec) {
                constexpr int dummy_ = 0; (void)dummy_;
                const int KK_ = sec == 2 ? 128 : 64, NKS = sec == 2 ? 4 : 2, koff = sec == 0 ? d * 64 : (sec == 1 ? 128 + d * 64 : 256 + d * 128);
                const bf16* Ws = Wd + (sec == 0 ? 0 : (sec == 1 ? 32768 : 65536));
#pragma unroll
                for (int i2 = 0; i2 < 4; i2 += 2) {
                bf16x8s wf[2][4];
#pragma unroll
                for (int i = 0; i < 2; ++i)
#pragma unroll
                    for (int ks = 0; ks < 4; ++ks) if (ks < NKS) wf[i][ks] = *(const bf16x8s*)(Ws + (size_t)(16 * (wave + 8 * (i2 + i)) + r16) * KK_ + 32 * ks);
#pragma unroll
                for (int ii = 0; ii < 2; ++ii) { const int i = i2 + ii;
                    const int c = 16 * (wave + 8 * i) + 4 * g4;
                    f32x4 acc[3];
#pragma unroll
                    for (int rt = 0; rt < 3; ++rt) acc[rt] = (f32x4){0.f, 0.f, 0.f, 0.f};
#pragma unroll
                    for (int ks = 0; ks < 4; ++ks) if (ks < NKS) {
#pragma unroll
                        for (int rt = 0; rt < 3; ++rt) { const bf16x8s bq = *(const LAS bf16x8s*)(lrin + (16 * rt + r16) * SLR_PITCH + koff + 32 * ks + 8 * g4);
                            acc[rt] = __builtin_amdgcn_mfma_f32_16x16x32_bf16(wf[ii][ks], bq, acc[rt], 0, 0, 0); } }
                    if (sec == 0) { const f32x4 w0 = *(const f32x4*)(p.in[I_W0] + l * 1024 + d * 512 + c); float* LW = (float*)(ws + WS_LW) + dT;
#pragma unroll
                        for (int rt = 0; rt < 3; ++rt) { const int lr = 16 * rt + r16; if (lr < SLR_ROWS) { f32x4 o;
#pragma unroll
                                for (int q = 0; q < 4; ++q) o[q] = -sigm(w0[q] + acc[rt][q]) * 0.60653065971f;
                                *(f32x4*)(LW + (size_t)(row0 + lr) * 512 + c) = o; } }
                    } else if (sec == 1) { const f32x4 a0 = *(const f32x4*)(p.in[I_A0] + l * 1024 + d * 512 + c), ka = *(const f32x4*)(p.in[I_KA] + l * 512 + c);
                        bf16* KT = (bf16*)(ws + WS_KT) + dT; bf16* BB = (bf16*)(ws + WS_BB) + dT;
#pragma unroll
                        for (int rt = 0; rt < 3; ++rt) { const int lr = 16 * rt + r16; if (lr < SLR_ROWS) {
                                const u32x2 k4 = *(const LAS u32x2*)(kbuf + lr * SLR_PITCH + c), q4 = *(const LAS u32x2*)(kkbuf + lr * SLR_PITCH + c);
                                const float kf[4] = {blo(k4.x), bhi(k4.x), blo(k4.y), bhi(k4.y)}, qf[4] = {blo(q4.x), bhi(q4.x), blo(q4.y), bhi(q4.y)}; float kt[4], bb[4];
#pragma unroll
                                for (int q = 0; q < 4; ++q) { const float a = sigm(a0[q] + acc[rt][q]); kt[q] = kf[q] * (1.0f + (a - 1.0f) * ka[q]); bb[q] = qf[q] * a; }
                                u32x2 o1, o2; o1.x = cvtpk_(kt[0], kt[1]); o1.y = cvtpk_(kt[2], kt[3]); o2.x = cvtpk_(bb[0], bb[1]); o2.y = cvtpk_(bb[2], bb[3]);
                                *(u32x2*)(KT + (size_t)(row0 + lr) * 512 + c) = o1; *(u32x2*)(BB + (size_t)(row0 + lr) * 512 + c) = o2; } }
                    } else { bf16* GD = (bf16*)(ws + WS_GD) + dT;
#pragma unroll
                        for (int rt = 0; rt < 3; ++rt) { const int lr = 16 * rt + r16; if (lr < SLR_ROWS) { u32x2 o; o.x = cvtpk_(acc[rt][0], acc[rt][1]); o.y = cvtpk_(acc[rt][2], acc[rt][3]);
                                *(u32x2*)(GD + (size_t)(row0 + lr) * 512 + c) = o; } }
                    }
                    asm volatile("" ::: "memory");
                }
                }
            }
        }
        __syncthreads();
    }
}

typedef short bf16x8 __attribute__((ext_vector_type(8)));
typedef float f32x2v __attribute__((ext_vector_type(2)));
typedef __bf16 bf16x2v __attribute__((ext_vector_type(2)));
__device__ __forceinline__ unsigned cvtpk(float lo, float hi) { f32x2v v = {lo, hi}; return __builtin_bit_cast(unsigned, __builtin_convertvector(v, bf16x2v)); }
__device__ __forceinline__ int lds_off(int slot, int row, int col) { return slot * 8192 + row * 128 + ((((col >> 3) ^ (row & 7) ^ ((row & 8) ? 7 : 0) ^ ((row >> 3) & 6))) << 4) + (col & 7) * 2; }
struct Acc2 { f32x4 t[2]; };
__device__ __forceinline__ void prod2(LAS unsigned char* lds, int aslot, int btslot, int wave, int lane, Acc2& acc) {
    const int tr = wave >> 1, r = lane & 15, g = lane >> 4;
#pragma unroll
    for (int ks = 0; ks < 2; ++ks) {
        const bf16x8 a = *(const LAS bf16x8*)(lds + lds_off(aslot, 16 * tr + r, 32 * ks + 8 * g));
#pragma unroll
        for (int t = 0; t < 2; ++t) { const int tc = 2 * (wave & 1) + t;
            const bf16x8 bb = *(const LAS bf16x8*)(lds + lds_off(btslot, 16 * tc + r, 32 * ks + 8 * g));
            acc.t[t] = __builtin_amdgcn_mfma_f32_16x16x32_bf16(a, bb, acc.t[t], 0, 0, 0); }
    }
}
__device__ __forceinline__ void wr_tr(LAS unsigned char* lds, int slot, int wave, int lane, const Acc2& acc) {
    const int tr = wave >> 1, r = lane & 15, g = lane >> 4;
#pragma unroll
    for (int t = 0; t < 2; ++t) { const int col = 16 * (2 * (wave & 1) + t) + r;
        u32x2 o; o.x = cvtpk(acc.t[t][0], acc.t[t][1]); o.y = cvtpk(acc.t[t][2], acc.t[t][3]);
        *(LAS u32x2*)(lds + lds_off(slot, col, 16 * tr + 4 * g)) = o; }
}
struct Frag2 { bf16x8 a[2]; bf16x8 b[2][2]; };
__device__ __forceinline__ void prod2_ld(LAS unsigned char* lds, int aslot, int btslot, int wave, int lane, Frag2& f) {
    const int tr = wave >> 1, r = lane & 15, g = lane >> 4;
#pragma unroll
    for (int ks = 0; ks < 2; ++ks) {
        f.a[ks] = *(const LAS bf16x8*)(lds + lds_off(aslot, 16 * tr + r, 32 * ks + 8 * g));
#pragma unroll
        for (int t = 0; t < 2; ++t) f.b[ks][t] = *(const LAS bf16x8*)(lds + lds_off(btslot, 16 * (2 * (wave & 1) + t) + r, 32 * ks + 8 * g)); }
}
__device__ __forceinline__ void prod2_mm(const Frag2& f, Acc2& acc) {
#pragma unroll
    for (int ks = 0; ks < 2; ++ks)
#pragma unroll
        for (int t = 0; t < 2; ++t) acc.t[t] = __builtin_amdgcn_mfma_f32_16x16x32_bf16(f.a[ks], f.b[ks][t], acc.t[t], 0, 0, 0);
}
__device__ __forceinline__ void phase_chunk(const Params& p, int l, LAS unsigned char* lds, int tid, int lane, int wave) {
    unsigned char* ws = p.ws;
    const bf16* R = (const bf16*)(ws + WS_R); const bf16* V = (const bf16*)(ws + WS_V); const bf16* KKn = (const bf16*)(ws + WS_KKN);
    LAS float* Lf = (LAS float*)(lds + 14 * 8192);
    LAS float* segtot = (LAS float*)(lds + 13 * 8192);
    LAS float* gc = (LAS float*)(lds + LDS_GC);
    const int tr = wave >> 1, r16 = lane & 15, g4 = lane >> 4;
    const int pos = tid >> 3, c8 = (tid & 7) * 8;
    u32x4 n_kk8, n_b8, n_kt8, n_r8, n_v8; f32x4 n_l0, n_l1;
#define CHUNK_FETCH(cc_) do { const int h_ = (cc_) & 7, j_ = ((cc_) >> 3) % NCH, db_ = ((cc_) >> 3) / NCH, b_ = db_ & 1, d_ = db_ >> 1; \
        const size_t go_ = (size_t)row_of(b_, d_, j_ * 64 + pos) * 512 + h_ * 64 + c8, do_ = (size_t)d_ * T * 512 + go_; \
        n_kk8 = *(const u32x4*)(KKn + go_); n_b8 = *(const u32x4*)((const bf16*)(ws + WS_BB) + do_); n_kt8 = *(const u32x4*)((const bf16*)(ws + WS_KT) + do_); n_r8 = *(const u32x4*)(R + go_); n_v8 = *(const u32x4*)(V + go_); \
        n_l0 = *(const f32x4*)((const float*)(ws + WS_LW) + do_); n_l1 = *(const f32x4*)((const float*)(ws + WS_LW) + do_ + 4); } while (0)
    if ((int)blockIdx.x < NCC) CHUNK_FETCH((int)blockIdx.x);
    asm volatile("" :: "v"(n_kk8), "v"(n_b8), "v"(n_kt8), "v"(n_r8), "v"(n_v8), "v"(n_l0), "v"(n_l1));
    for (int cc = blockIdx.x; cc < NCC; cc += gridDim.x) {
        const int h = cc & 7, j = (cc >> 3) % NCH, db = (cc >> 3) / NCH, b = db & 1, d = db >> 1;
        bf16* CH = (bf16*)(ws + WS_CH) + (size_t)cc * 16384;
        const int row = row_of(b, d, j * 64 + pos);
        const u32x4 kk8 = n_kk8, b8 = n_b8, kt8 = n_kt8, r8 = n_r8, v8 = n_v8; const f32x4 l0 = n_l0, l1 = n_l1;
        const f32x4 rk0_ = *(const f32x4*)(p.in[I_RK] + l * 512 + h * 64 + c8), rk1_ = *(const f32x4*)(p.in[I_RK] + l * 512 + h * 64 + c8 + 4);
        asm volatile("" ::: "memory");
        { const int ccn = cc + (int)gridDim.x < NCC ? cc + (int)gridDim.x : cc; CHUNK_FETCH(ccn); }
        *(LAS f32x4*)(Lf + pos * 64 + c8) = l0; *(LAS f32x4*)(Lf + pos * 64 + c8 + 4) = l1;
        __syncthreads();
        { const int ch = tid & 63, seg = tid >> 6; float pre[8]; float run = 0.f;
#pragma unroll
          for (int q = 0; q < 8; ++q) { run += Lf[(8 * seg + q) * 64 + ch]; pre[q] = run; }
          segtot[seg * 64 + ch] = run;
          __syncthreads();
          float off = 0.f;
#pragma unroll
          for (int s2 = 0; s2 < 8; ++s2) off += (s2 < seg) ? segtot[s2 * 64 + ch] : 0.f;
#pragma unroll
          for (int q = 0; q < 8; ++q) Lf[(8 * seg + q) * 64 + ch] = pre[q] + off;
          if (seg == 7) gc[ch] = pre[7] + off; }
        __syncthreads();
        {
            const f32x4 g0 = *(const LAS f32x4*)(Lf + pos * 64 + c8), g1 = *(const LAS f32x4*)(Lf + pos * 64 + c8 + 4);
            const f32x4 q0 = *(const LAS f32x4*)(gc + c8), q1 = *(const LAS f32x4*)(gc + c8 + 4);
            const float G[8] = {g0[0], g0[1], g0[2], g0[3], g1[0], g1[1], g1[2], g1[3]}, GC[8] = {q0[0], q0[1], q0[2], q0[3], q1[0], q1[1], q1[2], q1[3]};
            const float Lv[8] = {l0[0], l0[1], l0[2], l0[3], l1[0], l1[1], l1[2], l1[3]};
            const unsigned kkw[4] = {kk8.x, kk8.y, kk8.z, kk8.w}, bw[4] = {b8.x, b8.y, b8.z, b8.w}, ktw[4] = {kt8.x, kt8.y, kt8.z, kt8.w}, rw[4] = {r8.x, r8.y, r8.z, r8.w}, vw[4] = {v8.x, v8.y, v8.z, v8.w};
            float at[8], bt[8], kb[8], qt[8], bg[8], kg[8], vv[8]; float bon = 0.f;
            const float rk[8] = {rk0_[0], rk0_[1], rk0_[2], rk0_[3], rk1_[0], rk1_[1], rk1_[2], rk1_[3]};
#pragma unroll
            for (int q = 0; q < 8; ++q) { const int w2 = q >> 1; const bool hi = q & 1;
                const float kkv = hi ? bhi(kkw[w2]) : blo(kkw[w2]), bv = hi ? bhi(bw[w2]) : blo(bw[w2]), ktv = hi ? bhi(ktw[w2]) : blo(ktw[w2]), rv = hi ? bhi(rw[w2]) : blo(rw[w2]);
                vv[q] = hi ? bhi(vw[w2]) : blo(vw[w2]);
                const float eg = __expf(G[q]), egi = __expf(-G[q]), egp = __expf(G[q] - Lv[q]), egc = __expf(GC[q] - G[q]);
                at[q] = -kkv * egp; bt[q] = bv * egi; kb[q] = ktv * egi; qt[q] = rv * eg; bg[q] = bv * egc; kg[q] = ktv * egc;
                bon += rv * ktv * rk[q]; }
            bon += __shfl_xor(bon, 1); bon += __shfl_xor(bon, 2); bon += __shfl_xor(bon, 4);
            if ((tid & 7) == 0) ((float*)(ws + WS_BONUS))[((size_t)d * T + row) * 8 + h] = bon;
            u32x4 o;
            o.x = cvtpk(at[0], at[1]); o.y = cvtpk(at[2], at[3]); o.z = cvtpk(at[4], at[5]); o.w = cvtpk(at[6], at[7]); *(LAS u32x4*)(lds + lds_off(0, pos, c8)) = o;
            o.x = cvtpk(bt[0], bt[1]); o.y = cvtpk(bt[2], bt[3]); o.z = cvtpk(bt[4], bt[5]); o.w = cvtpk(bt[6], bt[7]); *(LAS u32x4*)(lds + lds_off(2, pos, c8)) = o;
            o.x = cvtpk(kb[0], kb[1]); o.y = cvtpk(kb[2], kb[3]); o.z = cvtpk(kb[4], kb[5]); o.w = cvtpk(kb[6], kb[7]); *(LAS u32x4*)(lds + lds_off(3, pos, c8)) = o;
            o.x = cvtpk(qt[0], qt[1]); o.y = cvtpk(qt[2], qt[3]); o.z = cvtpk(qt[4], qt[5]); o.w = cvtpk(qt[6], qt[7]); *(LAS u32x4*)(lds + lds_off(4, pos, c8)) = o;
            const unsigned atw[4] = {cvtpk(at[0], at[1]), cvtpk(at[2], at[3]), cvtpk(at[4], at[5]), cvtpk(at[6], at[7])};
            const unsigned bgw[4] = {cvtpk(bg[0], bg[1]), cvtpk(bg[2], bg[3]), cvtpk(bg[4], bg[5]), cvtpk(bg[6], bg[7])};
            const unsigned kgw[4] = {cvtpk(kg[0], kg[1]), cvtpk(kg[2], kg[3]), cvtpk(kg[4], kg[5]), cvtpk(kg[6], kg[7])};
#pragma unroll
            for (int q = 0; q < 8; ++q) { const int w2 = q >> 1, sh = (q & 1) * 16;
                *(LAS unsigned short*)(lds + lds_off(1, c8 + q, pos)) = (unsigned short)(atw[w2] >> sh);
                *(LAS unsigned short*)(lds + lds_off(5, c8 + q, pos)) = (unsigned short)(vw[w2] >> sh);
                *(LAS unsigned short*)(lds + lds_off(6, c8 + q, pos)) = (unsigned short)(bgw[w2] >> sh);
                *(LAS unsigned short*)(lds + lds_off(7, c8 + q, pos)) = (unsigned short)(kgw[w2] >> sh); }
        }
        __syncthreads();
        Acc2 accTt;
        { Frag2 f0, f1, f2, f3, f4;
          prod2_ld(lds, 0, 2, wave, lane, f0); prod2_ld(lds, 2, 0, wave, lane, f1); prod2_ld(lds, 3, 0, wave, lane, f2); prod2_ld(lds, 2, 4, wave, lane, f3); prod2_ld(lds, 3, 4, wave, lane, f4);
          Acc2 a0, a1, a2, a3, a4; a0.t[0] = a0.t[1] = a1.t[0] = a1.t[1] = a2.t[0] = a2.t[1] = a3.t[0] = a3.t[1] = a4.t[0] = a4.t[1] = (f32x4){0.f, 0.f, 0.f, 0.f};
          prod2_mm(f0, a0); prod2_mm(f1, a1); prod2_mm(f2, a2); prod2_mm(f3, a3); prod2_mm(f4, a4);
#pragma unroll
          for (int t = 0; t < 2; ++t) { const int col = 16 * (2 * (wave & 1) + t) + r16;
#pragma unroll
              for (int q = 0; q < 4; ++q) { const int rw_ = 16 * tr + 4 * g4 + q;
                  a0.t[t][q] = col < rw_ ? a0.t[t][q] : 0.f;
                  a1.t[t][q] = col > rw_ ? a1.t[t][q] : 0.f; accTt.t[t][q] = a1.t[t][q] + (col == rw_ ? 1.f : 0.f);
                  a2.t[t][q] = col > rw_ ? a2.t[t][q] : 0.f;
                  a3.t[t][q] = col >= rw_ ? a3.t[t][q] : 0.f;
                  a4.t[t][q] = col >= rw_ ? a4.t[t][q] : 0.f; } }
          wr_tr(lds, 9, wave, lane, a0);
          wr_tr(lds, 8, wave, lane, a1); wr_tr(lds, 10, wave, lane, accTt);
          wr_tr(lds, 11, wave, lane, a2);
          wr_tr(lds, 12, wave, lane, a3);
          wr_tr(lds, 13, wave, lane, a4); }
        __syncthreads();
        { Frag2 f1, f2, f3; prod2_ld(lds, 8, 9, wave, lane, f1); prod2_ld(lds, 9, 8, wave, lane, f2); prod2_ld(lds, 11, 5, wave, lane, f3);
          Acc2 a1, a2, a3; a1.t[0] = a1.t[1] = a2.t[0] = a2.t[1] = a3.t[0] = a3.t[1] = (f32x4){0.f, 0.f, 0.f, 0.f};
          prod2_mm(f1, a1); prod2_mm(f2, a2); prod2_mm(f3, a3);
          wr_tr(lds, 3, wave, lane, a1);
          wr_tr(lds, 2, wave, lane, a2);
          wr_tr(lds, 14, wave, lane, a3); }
        __syncthreads();
#pragma unroll
        for (int lvl = 1; lvl <= 4; ++lvl) {
            const int zc = (lvl & 1) ? 2 : 8, zn = (lvl & 1) ? 8 : 2, tc_ = (lvl & 1) ? 10 : 15, tn = (lvl & 1) ? 15 : 10;
            if (lvl < 4) { Frag2 f1, f2, f3; prod2_ld(lds, zc + 1, tc_, wave, lane, f1); prod2_ld(lds, zc, zc + 1, wave, lane, f2); prod2_ld(lds, zc + 1, zc, wave, lane, f3);
                Acc2 a2, a3; a2.t[0] = a2.t[1] = a3.t[0] = a3.t[1] = (f32x4){0.f, 0.f, 0.f, 0.f};
                prod2_mm(f1, accTt); prod2_mm(f2, a2); prod2_mm(f3, a3);
                wr_tr(lds, tn, wave, lane, accTt); wr_tr(lds, zn + 1, wave, lane, a2); wr_tr(lds, zn, wave, lane, a3); }
            else { prod2(lds, zc + 1, tc_, wave, lane, accTt); wr_tr(lds, tn, wave, lane, accTt); }
            __syncthreads();
        }
        { Frag2 f1, f2; prod2_ld(lds, 10, 1, wave, lane, f1); prod2_ld(lds, 10, 14, wave, lane, f2);
          Acc2 a1, a2; a1.t[0] = a1.t[1] = a2.t[0] = a2.t[1] = (f32x4){0.f, 0.f, 0.f, 0.f};
          prod2_mm(f1, a1); prod2_mm(f2, a2);
          wr_tr(lds, 8, wave, lane, a1); wr_tr(lds, 9, wave, lane, a2); }
        __syncthreads();
        { Acc2 a; a.t[0] = a.t[1] = (f32x4){0.f, 0.f, 0.f, 0.f}; prod2(lds, 8, 12, wave, lane, a);
#pragma unroll
          for (int t = 0; t < 2; ++t) { const int col = 16 * (2 * (wave & 1) + t) + r16, r0 = 16 * tr + 4 * g4;
              const u32x2 qq = *(const LAS u32x2*)(lds + lds_off(4, col, r0));
              u32x2 o; o.x = cvtpk(a.t[t][0] + blo(qq.x), a.t[t][1] + bhi(qq.x)); o.y = cvtpk(a.t[t][2] + blo(qq.y), a.t[t][3] + bhi(qq.y));
              *(u32x2*)(CH + 8192 + (((col >> 4) * 2 + (tr >> 1)) * 64 + g4 * 16 + (col & 15)) * 8 + (tr & 1) * 4) = o; } }
        { Acc2 a; a.t[0] = a.t[1] = (f32x4){0.f, 0.f, 0.f, 0.f}; prod2(lds, 12, 9, wave, lane, a); prod2(lds, 13, 5, wave, lane, a);
#pragma unroll
          for (int t = 0; t < 2; ++t) { const int col = 16 * (2 * (wave & 1) + t) + r16, r0 = 16 * tr + 4 * g4;
              u32x2 o; o.x = cvtpk(a.t[t][0], a.t[t][1]); o.y = cvtpk(a.t[t][2], a.t[t][3]); *(u32x2*)(CH + 12288 + (((col >> 4) * 4 + tr) * 64 + g4 * 16 + (col & 15)) * 4) = o; } }
        { Acc2 a; a.t[0] = a.t[1] = (f32x4){0.f, 0.f, 0.f, 0.f}; prod2(lds, 8, 6, wave, lane, a);
#pragma unroll
          for (int t = 0; t < 2; ++t) { const int col = 16 * (2 * (wave & 1) + t) + r16, r0 = 16 * tr + 4 * g4; const float dg = __expf(gc[col]);
#pragma unroll
              for (int q = 0; q < 4; ++q) a.t[t][q] += (r0 + q == col) ? dg : 0.f;
              u32x2 o; o.x = cvtpk(a.t[t][0], a.t[t][1]); o.y = cvtpk(a.t[t][2], a.t[t][3]); *(u32x2*)(CH + (((col >> 4) * 2 + (tr >> 1)) * 64 + g4 * 16 + (col & 15)) * 8 + (tr & 1) * 4) = o; } }
        { Acc2 a; a.t[0] = a.t[1] = (f32x4){0.f, 0.f, 0.f, 0.f}; prod2(lds, 6, 9, wave, lane, a); prod2(lds, 7, 5, wave, lane, a);
#pragma unroll
          for (int t = 0; t < 2; ++t) { const int col = 16 * (2 * (wave & 1) + t) + r16, r0 = 16 * tr + 4 * g4;
              u32x2 o; o.x = cvtpk(a.t[t][0], a.t[t][1]); o.y = cvtpk(a.t[t][2], a.t[t][3]); *(u32x2*)(CH + 4096 + (((col >> 4) * 4 + tr) * 64 + g4 * 16 + (col & 15)) * 4) = o; } }
        __syncthreads();
    }
}
#undef CHUNK_FETCH
struct SeqS { u32x4 mt[4][2]; u32x2 nc[4]; };
struct SeqY { u32x4 qe[4][2]; u32x2 yl[4]; };
__device__ __forceinline__ void seq_load_s(SeqS& B, const bf16* CH, int vs, int lane) {
#pragma unroll
    for (int t = 0; t < 4; ++t) {
#pragma unroll
        for (int s = 0; s < 2; ++s) B.mt[t][s] = *(const u32x4*)(CH + ((t * 2 + s) * 64 + lane) * 8);
        B.nc[t] = *(const u32x2*)(CH + 4096 + ((vs * 4 + t) * 64 + lane) * 4); }
}
__device__ __forceinline__ void seq_load_y(SeqY& B, const bf16* CH, int vs, int lane) {
#pragma unroll
    for (int t = 0; t < 4; ++t) {
#pragma unroll
        for (int s = 0; s < 2; ++s) B.qe[t][s] = *(const u32x4*)(CH + 8192 + ((t * 2 + s) * 64 + lane) * 8);
        B.yl[t] = *(const u32x2*)(CH + 12288 + ((vs * 4 + t) * 64 + lane) * 4); }
}
__device__ __forceinline__ void seq_wait_ge(volatile LAS int* w, int v) { while (*w < v) __builtin_amdgcn_s_sleep(1); asm volatile("" ::: "memory"); }
__device__ __forceinline__ void phase_seq(const Params& p, LAS unsigned char* lds, int lane, int wave) {
    if (blockIdx.x >= 128) return;
    unsigned char* ws = p.ws;
    const int chain = (blockIdx.x & 7) * 4 + (blockIdx.x >> 5), vs = (blockIdx.x >> 3) & 3, db = chain >> 3, h = chain & 7, b = db & 1, d = db >> 1;
    const int r = lane & 15, g = lane >> 4;
    const bf16* CH0 = (const bf16*)(ws + WS_CH) + ((size_t)(db * NCH) * 8 + h) * 16384;
    volatile LAS int* flg = (volatile LAS int*)(lds + 16384);
    LAS u32x4* ring = (LAS u32x4*)lds;
    if (wave == 0 && lane == 0) { flg[0] = 0; flg[1] = 0; }
    __syncthreads();
    if (wave == 0) {
        u32x4 sf[2]; sf[0] = sf[1] = (u32x4){0u, 0u, 0u, 0u};
        SeqS q0, q1, q2, q3;
        seq_load_s(q0, CH0, vs, lane); seq_load_s(q1, CH0 + (size_t)1 * 8 * 16384, vs, lane); seq_load_s(q2, CH0 + (size_t)2 * 8 * 16384, vs, lane);
        seq_load_s(q3, CH0 + (size_t)3 * 8 * 16384, vs, lane);
#define SEQ_USE_S(Q) asm volatile("" :: "v"(Q.mt[0][0]), "v"(Q.mt[0][1]), "v"(Q.mt[1][0]), "v"(Q.mt[1][1]), "v"(Q.mt[2][0]), "v"(Q.mt[2][1]), "v"(Q.mt[3][0]), "v"(Q.mt[3][1]), "v"(Q.nc[0]), "v"(Q.nc[1]), "v"(Q.nc[2]), "v"(Q.nc[3]))
        SEQ_USE_S(q0); SEQ_USE_S(q1); SEQ_USE_S(q2); SEQ_USE_S(q3);
#undef SEQ_USE_S
#define SEQ_S_STEP(Q, jj) do { const int j_ = (jj); \
            if (j_ >= 8) seq_wait_ge(flg + 1, j_ - 7); \
            ring[((j_ & 7) * 2 + 0) * 64 + lane] = sf[0]; ring[((j_ & 7) * 2 + 1) * 64 + lane] = sf[1]; \
            asm volatile("s_waitcnt lgkmcnt(0)" ::: "memory"); if (lane == 0) flg[0] = j_ + 1; \
            f32x4 accS[4]; \
            _Pragma("unroll") for (int t = 0; t < 4; ++t) { f32x4 as = (f32x4){blo(Q.nc[t].x), bhi(Q.nc[t].x), blo(Q.nc[t].y), bhi(Q.nc[t].y)}; \
                _Pragma("unroll") for (int s2 = 0; s2 < 2; ++s2) as = __builtin_amdgcn_mfma_f32_16x16x32_bf16(__builtin_bit_cast(bf16x8, Q.mt[t][s2]), __builtin_bit_cast(bf16x8, sf[s2]), as, 0, 0, 0); \
                accS[t] = as; } \
            _Pragma("unroll") for (int s2 = 0; s2 < 2; ++s2) { sf[s2].x = cvtpk(accS[2 * s2][0], accS[2 * s2][1]); sf[s2].y = cvtpk(accS[2 * s2][2], accS[2 * s2][3]); sf[s2].z = cvtpk(accS[2 * s2 + 1][0], accS[2 * s2 + 1][1]); sf[s2].w = cvtpk(accS[2 * s2 + 1][2], accS[2 * s2 + 1][3]); } \
            { const int jn_ = j_ + 4 < NCH ? j_ + 4 : NCH - 1; seq_load_s(Q, CH0 + (size_t)jn_ * 8 * 16384, vs, lane); } } while (0)
        for (int j = 0; j < NCH; j += 4) { SEQ_S_STEP(q0, j); SEQ_S_STEP(q1, j + 1); SEQ_S_STEP(q2, j + 2); SEQ_S_STEP(q3, j + 3); }
#undef SEQ_S_STEP
    } else if (wave == 1) {
        float* Y = (float*)(ws + WS_Y) + (size_t)d * T * 512 + h * 64 + 16 * vs + r;
        SeqY q0, q1, q2; const int sgs = d ? -1 : 1;
        seq_load_y(q0, CH0, vs, lane); seq_load_y(q1, CH0 + (size_t)1 * 8 * 16384, vs, lane); seq_load_y(q2, CH0 + (size_t)2 * 8 * 16384, vs, lane);
#define SEQ_USE_Y(Q) asm volatile("" :: "v"(Q.qe[0][0]), "v"(Q.qe[0][1]), "v"(Q.qe[1][0]), "v"(Q.qe[1][1]), "v"(Q.qe[2][0]), "v"(Q.qe[2][1]), "v"(Q.qe[3][0]), "v"(Q.qe[3][1]), "v"(Q.yl[0]), "v"(Q.yl[1]), "v"(Q.yl[2]), "v"(Q.yl[3]))
        SEQ_USE_Y(q0); SEQ_USE_Y(q1); SEQ_USE_Y(q2);
#undef SEQ_USE_Y
#define SEQ_Y_STEP(Q, jj) do { const int j_ = (jj); \
            float* Yc_ = Y + ((ptrdiff_t)row_of(b, d, j_ * 64) + (ptrdiff_t)(sgs * 4 * g)) * 512;     \
            seq_wait_ge(flg, j_ + 1); \
            const u32x4 s0_ = ring[((j_ & 7) * 2 + 0) * 64 + lane], s1_ = ring[((j_ & 7) * 2 + 1) * 64 + lane]; \
            asm volatile("s_waitcnt lgkmcnt(0)" ::: "memory"); if (lane == 0) flg[1] = j_ + 1; \
            _Pragma("unroll") for (int t = 0; t < 4; ++t) { f32x4 ay = (f32x4){blo(Q.yl[t].x), bhi(Q.yl[t].x), blo(Q.yl[t].y), bhi(Q.yl[t].y)}; \
                ay = __builtin_amdgcn_mfma_f32_16x16x32_bf16(__builtin_bit_cast(bf16x8, Q.qe[t][0]), __builtin_bit_cast(bf16x8, s0_), ay, 0, 0, 0); \
                ay = __builtin_amdgcn_mfma_f32_16x16x32_bf16(__builtin_bit_cast(bf16x8, Q.qe[t][1]), __builtin_bit_cast(bf16x8, s1_), ay, 0, 0, 0); \
                _Pragma("unroll") for (int qq = 0; qq < 4; ++qq) Yc_[(ptrdiff_t)((16 * t + qq) * sgs) * 512] = ay[qq]; } \
            { const int jn_ = j_ + 3 < NCH ? j_ + 3 : NCH - 1; seq_load_y(Q, CH0 + (size_t)jn_ * 8 * 16384, vs, lane); } } while (0)
        for (int j = 0; j < NCH; j += 3) { SEQ_Y_STEP(q0, j); SEQ_Y_STEP(q1, j + 1); SEQ_Y_STEP(q2, j + 2); }
#undef SEQ_Y_STEP
    }
}

struct S5Disc { float ar, ai; float br[16], bi[16]; };
__device__ __forceinline__ void s5_disc(const Params& p, int l, int d, int g, int lane, S5Disc& q) {
    const int gi = (l * 2 + d) * 32 + g; const size_t pi = (size_t)gi * 64 + lane;
    const float lr = fminf(p.in[I_LRE][pi], -1e-4f), li = p.in[I_LIM][pi], dt = __expf(p.in[I_LDT][gi]);
    const float mag = __expf(lr * dt); float sn, cs; sincosf(li * dt, &sn, &cs);
    q.ar = mag * cs; q.ai = mag * sn;
    const float den = lr * lr + li * li, xr = q.ar - 1.0f, cr = (xr * lr + q.ai * li) / den, ci = (q.ai * lr - xr * li) / den;
    const float* bre = p.in[I_BRE] + pi * 16; const float* bim = p.in[I_BIM] + pi * 16;
#pragma unroll
    for (int c = 0; c < 16; c += 4) { const f32x4 a = *(const f32x4*)(bre + c), b = *(const f32x4*)(bim + c);
#pragma unroll
        for (int j = 0; j < 4; ++j) { q.br[c + j] = cr * a[j] - ci * b[j]; q.bi[c + j] = cr * b[j] + ci * a[j]; } }
}
__device__ __forceinline__ void phase_s5_carry(const Params& p, int l, int lane, int wave) {
    unsigned char* ws = p.ws;
    const float2* XEND = (const float2*)(ws + WS_XEND); float2* CARRY = (float2*)(ws + WS_CARRY);
    const int gw = blockIdx.x * 8 + wave;
    if (gw >= 128) return;
    const int g = gw & 31, b = (gw >> 5) & 1, d = gw >> 6;
    const int gi = (l * 2 + d) * 32 + g; const size_t pi = (size_t)gi * 64 + lane;
    const float lr = fminf(p.in[I_LRE][pi], -1e-4f), li = p.in[I_LIM][pi], dt = __expf(p.in[I_LDT][gi]);
    const float mag = __expf(lr * dt); float sn, cs; sincosf(li * dt, &sn, &cs);
    float ar = mag * cs, ai = mag * sn;
#pragma unroll
    for (int i = 0; i < 6; ++i) { const float nr = ar * ar - ai * ai, ni = 2.0f * ar * ai; ar = nr; ai = ni; }
    const size_t base = ((size_t)((d * 2 + b) * NCH)) * 2048 + g * 64 + lane;
    float xr = 0.f, xi = 0.f;
    for (int j0 = 0; j0 < NCH; j0 += 12) {
        float2 e[12];
#pragma unroll
        for (int i = 0; i < 12; ++i) e[i] = XEND[base + (size_t)(j0 + i) * 2048];
#pragma unroll
        for (int i = 0; i < 12; ++i) { CARRY[base + (size_t)(j0 + i) * 2048] = make_float2(xr, xi); const float nr = ar * xr - ai * xi + e[i].x, ni = ar * xi + ai * xr + e[i].y; xr = nr; xi = ni; }
    }
}

__device__ __forceinline__ void phase_s5_tables(const Params& p, int l, int item, int lane) {
    unsigned char* ws = p.ws;
    const int mr = item & 7, d = (item >> 3) & 1, g = item >> 4;
    const int gi = (l * 2 + d) * 32 + g; const size_t pi = (size_t)gi * 64 + lane;
    const float lr = fminf(p.in[I_LRE][pi], -1e-4f), li = p.in[I_LIM][pi], dt = __expf(p.in[I_LDT][gi]);
    S5Disc q; s5_disc(p, l, d, g, lane, q);
    float cre[16], cim[16];
    { const float* cr_ = p.in[I_CRE] + ((size_t)gi * 16) * 64 + lane; const float* ci_ = p.in[I_CIM] + ((size_t)gi * 16) * 64 + lane;
#pragma unroll
      for (int c = 0; c < 16; ++c) { cre[c] = cr_[c * 64]; cim[c] = ci_[c * 64]; } }
    bf16* Et = (bf16*)(ws + WS_S5E) + (size_t)(g * 2 + d) * 1024 * 128;
    bf16* Kt = (bf16*)(ws + WS_S5K) + (size_t)(g * 2 + d) * 72 * 256;
    if (mr == 0) {
#pragma unroll
        for (int z = 0; z < 8; ++z) *(u32x2*)(Kt + z * 256 + lane * 4) = (u32x2){0u, 0u}; }
    const int m0 = 8 * mr, m1 = (mr == 7) ? 65 : m0 + 8;
    float pr, pim; { const float mg = __expf(lr * dt * (float)m0); float sn, cs; sincosf(li * dt * (float)m0, &sn, &cs); pr = mg * cs; pim = mg * sn; }
    for (int m = m0; m < m1; ++m) {
#pragma unroll 1
        for (int cp = 0; cp < 16; ++cp) {
            float c_r = 0.f, c_i = 0.f;
#pragma unroll
            for (int c = 0; c < 16; ++c) { c_r = (cp == c) ? cre[c] : c_r; c_i = (cp == c) ? cim[c] : c_i; }
            const float car = c_r * pr - c_i * pim, cai = c_r * pim + c_i * pr;
            if (m >= 1) {
                bf16* eb = Et + (size_t)(m - 1) * 4 * 512;
                eb[((lane >> 5) * 64 + ((lane >> 3) & 3) * 16 + cp) * 8 + (lane & 7)] = (bf16)f2bf(car);
                eb[((2 + (lane >> 5)) * 64 + ((lane >> 3) & 3) * 16 + cp) * 8 + (lane & 7)] = (bf16)f2bf(-cai); }
            if (m <= 63) {
                float vals[16];
#pragma unroll
                for (int c = 0; c < 16; ++c) vals[c] = car * q.br[c] - cai * q.bi[c];
                { const bool hi = (lane & 32) != 0;
#pragma unroll
                  for (int i = 0; i < 8; ++i) { const float send = hi ? vals[i] : vals[i + 8], keep = hi ? vals[i + 8] : vals[i]; vals[i] = keep + __shfl_xor(send, 32); } }
                { const bool hi = (lane & 16) != 0;
#pragma unroll
                  for (int i = 0; i < 4; ++i) { const float send = hi ? vals[i] : vals[i + 4], keep = hi ? vals[i + 4] : vals[i]; vals[i] = keep + __shfl_xor(send, 16); } }
                { const bool hi = (lane & 8) != 0;
#pragma unroll
                  for (int i = 0; i < 2; ++i) { const float send = hi ? vals[i] : vals[i + 2], keep = hi ? vals[i + 2] : vals[i]; vals[i] = keep + __shfl_xor(send, 8); } }
                { const bool hi = (lane & 4) != 0; const float send = hi ? vals[0] : vals[1], keep = hi ? vals[1] : vals[0]; vals[0] = keep + __shfl_xor(send, 4); }
                vals[0] += __shfl_xor(vals[0], 2); vals[0] += __shfl_xor(vals[0], 1);
                if ((lane & 3) == 0) Kt[(size_t)(m + 8) * 256 + cp * 16 + (lane >> 2)] = (bf16)f2bf(vals[0]);
            }
        }
        const float nr = pr * q.ar - pim * q.ai, ni = pr * q.ai + pim * q.ar; pr = nr; pim = ni;
    }
    { bf16* BP = (bf16*)(ws + WS_S5BP) + (size_t)(g * 2 + d) * 128 * 1024;
      for (int j = 8 * mr; j < 8 * mr + 8; ++j) { const float pw = (float)(d ? j : 63 - j); const float mg = __expf(lr * dt * pw); float sn, cs; sincosf(li * dt * pw, &sn, &cs); const float xr = mg * cs, xi = mg * sn;
          float re[16], im[16];
#pragma unroll
          for (int c = 0; c < 16; ++c) { re[c] = xr * q.br[c] - xi * q.bi[c]; im[c] = xr * q.bi[c] + xi * q.br[c]; }
          u32x4 o; bf16* fb = BP + (size_t)(j >> 1) * 8 * 512;
          bf16* dr = fb + ((size_t)(lane >> 4) * 64 + ((j & 1) * 2) * 16 + (lane & 15)) * 8; bf16* di = fb + ((size_t)(4 + (lane >> 4)) * 64 + ((j & 1) * 2) * 16 + (lane & 15)) * 8;
          o.x = cvtpk(re[0], re[1]); o.y = cvtpk(re[2], re[3]); o.z = cvtpk(re[4], re[5]); o.w = cvtpk(re[6], re[7]); *(u32x4*)dr = o;
          o.x = cvtpk(re[8], re[9]); o.y = cvtpk(re[10], re[11]); o.z = cvtpk(re[12], re[13]); o.w = cvtpk(re[14], re[15]); *(u32x4*)(dr + 128) = o;
          o.x = cvtpk(im[0], im[1]); o.y = cvtpk(im[2], im[3]); o.z = cvtpk(im[4], im[5]); o.w = cvtpk(im[6], im[7]); *(u32x4*)di = o;
          o.x = cvtpk(im[8], im[9]); o.y = cvtpk(im[10], im[11]); o.z = cvtpk(im[12], im[13]); o.w = cvtpk(im[14], im[15]); *(u32x4*)(di + 128) = o; } }
}
__device__ __forceinline__ int row_tb(int tb, int t) { const int b = tb >= NCH ? 1 : 0, k = tb - b * NCH; return k < 4 ? NLAT + b * CTXL + 64 * k + t : b * SEQ + 64 * (k - 4) + t; }
__device__ __forceinline__ bf16x8 s5_ufrag(const bf16* Ug, int ct, int j0, int r, int g4) { return *(const bf16x8*)(Ug + ((size_t)(j0 + (g4 >> 1)) * (2 * NCH) + 16 * ct + r) * 16 + 8 * (g4 & 1)); }
__device__ __forceinline__ void phase_s5_end(const Params& p, int lane, int wave) {
    unsigned char* ws = p.ws;
    float2* XEND = (float2*)(ws + WS_XEND);
    const int r = lane & 15, g4 = lane >> 4;
    for (int it = blockIdx.x * 8 + wave; it < 32 * 17 * 2; it += gridDim.x * 8) {
        const int d = it & 1, ct = (it >> 1) % 17, g = (it >> 1) / 17;
        const int tb = 16 * ct + r, tbc = tb < 2 * NCH ? tb : 2 * NCH - 1; const bool valid = tb < 2 * NCH;
        const int b = tbc >= NCH ? 1 : 0, k = tbc - b * NCH;
        const bf16* Ug = (const bf16*)(ws + WS_U) + (size_t)g * 64 * (2 * NCH) * 16;
        const bf16* BPf = (const bf16*)(ws + WS_S5BP) + (size_t)(g * 2 + d) * 128 * 1024 + lane * 8;
        f32x4 acc[8];
#pragma unroll
        for (int rt = 0; rt < 8; ++rt) acc[rt] = (f32x4){0.f, 0.f, 0.f, 0.f};
#pragma unroll 1
        for (int kb = 0; kb < 32; kb += 4) {
            bf16x8 bu[4];
#pragma unroll
            for (int i = 0; i < 4; ++i) bu[i] = s5_ufrag(Ug, ct, 2 * (kb + i), r, g4);
            bf16x8 a[4][8];
#pragma unroll
            for (int i = 0; i < 4; ++i)
#pragma unroll
                for (int rt = 0; rt < 8; ++rt) a[i][rt] = *(const bf16x8*)(BPf + ((size_t)(kb + i) * 8 + rt) * 512);
            asm volatile("" : "+v"(acc[0]), "+v"(acc[1]), "+v"(acc[2]), "+v"(acc[3]), "+v"(acc[4]), "+v"(acc[5]), "+v"(acc[6]), "+v"(acc[7]) :: "memory");
#pragma unroll
            for (int i = 0; i < 4; ++i)
#pragma unroll
                for (int rt = 0; rt < 8; ++rt) acc[rt] = __builtin_amdgcn_mfma_f32_16x16x32_bf16(a[i][rt], bu[i], acc[rt], 0, 0, 0);
            asm volatile("" ::: "memory");
        }
        if (valid) { const int js = d ? (k < 4 ? 3 - k : NCH + 3 - k) : k;
            float2* xe = XEND + ((size_t)((d * 2 + b) * NCH + js)) * 2048 + g * 64;
#pragma unroll
            for (int rt = 0; rt < 4; ++rt)
#pragma unroll
                for (int q = 0; q < 4; ++q) xe[16 * rt + 4 * g4 + q] = make_float2(acc[rt][q], acc[rt + 4][q]); }
    }
}
__device__ __forceinline__ void phase_s5_out(const Params& p, int l, LAS unsigned char* lds, int tid, int lane, int wave) {
    unsigned char* ws = p.ws;
    bf16* YG = (bf16*)(ws + WS_YG); const float2* CARRY = (const float2*)(ws + WS_CARRY);
    const int r = lane & 15, g4 = lane >> 4;
    for (int gb = blockIdx.x; gb < 256; gb += gridDim.x) {
        const int g = (gridDim.x == 256) ? ((gb & 7) * 4 + (gb >> 6)) : (gb >> 3), tg = (gridDim.x == 256) ? ((gb >> 3) & 7) : (gb & 7);
        __syncthreads();
        { const u32x4* src = (const u32x4*)((const bf16*)(ws + WS_S5K) + (size_t)g * 2 * 72 * 256);
          { u32x4 tk_[9];
#pragma unroll
            for (int q = 0; q < 9; ++q) tk_[q] = src[tid + 512 * q];
#pragma unroll
            for (int q = 0; q < 9; ++q) ((LAS u32x4*)lds)[tid + 512 * q] = tk_[q]; }
          const u32x4* e0s = (const u32x4*)((const bf16*)(ws + WS_S5E) + (size_t)(g * 2) * 1024 * 128 + (size_t)(8 * tg) * 4 * 512);
          const u32x4* e1s = (const u32x4*)((const bf16*)(ws + WS_S5E) + (size_t)(g * 2 + 1) * 1024 * 128 + (size_t)(56 - 8 * tg) * 4 * 512);
          u32x4 t0_[4], t1_[4];
#pragma unroll
          for (int q = 0; q < 4; ++q) { t0_[q] = e0s[tid + 512 * q]; t1_[q] = e1s[tid + 512 * q]; }
#pragma unroll
          for (int q = 0; q < 4; ++q) { *(LAS u32x4*)(lds + 73728 + (tid + 512 * q) * 16) = t0_[q]; *(LAS u32x4*)(lds + 73728 + 32768 + (tid + 512 * q) * 16) = t1_[q]; } }
        __syncthreads();
        const bf16* Ug = (const bf16*)(ws + WS_U) + (size_t)g * 64 * (2 * NCH) * 16;
        for (int ct = wave; ct < 17; ct += 8) {
            const int tb = 16 * ct + r, tbc = tb < 2 * NCH ? tb : 2 * NCH - 1; const bool valid = tb < 2 * NCH;
            const int b = tbc >= NCH ? 1 : 0, k = tbc - b * NCH;
            bf16x8 xc[2][4];
#pragma unroll
            for (int d = 0; d < 2; ++d) { const int js = d ? (k < 4 ? 3 - k : NCH + 3 - k) : k;
                const float2* cp = CARRY + ((size_t)((d * 2 + b) * NCH + js)) * 2048 + g * 64;
#pragma unroll
                for (int ks = 0; ks < 4; ++ks) { const int p0 = 32 * (ks & 1) + 8 * g4; const f32x4* c4 = (const f32x4*)(cp + p0);
                    const f32x4 a = c4[0], b2 = c4[1], c2 = c4[2], d2 = c4[3]; u32x4 o;
                    if (ks < 2) { o.x = cvtpk(a[0], a[2]); o.y = cvtpk(b2[0], b2[2]); o.z = cvtpk(c2[0], c2[2]); o.w = cvtpk(d2[0], d2[2]); }
                    else { o.x = cvtpk(a[1], a[3]); o.y = cvtpk(b2[1], b2[3]); o.z = cvtpk(c2[1], c2[3]); o.w = cvtpk(d2[1], d2[3]); }
                    xc[d][ks] = __builtin_bit_cast(bf16x8, o); } }
            u32x2 uu8[8];
#pragma unroll
            for (int tt = 0; tt < 8; ++tt) uu8[tt] = *(const u32x2*)(Ug + ((size_t)(8 * tg + tt) * (2 * NCH) + tbc) * 16 + 4 * g4);
            f32x4 acc[8];
#pragma unroll
            for (int tt = 0; tt < 8; ++tt) acc[tt] = (f32x4){0.f, 0.f, 0.f, 0.f};
            bf16x8 bu[4], bn[4];
#pragma unroll
            for (int i = 0; i < 4; ++i) bu[i] = s5_ufrag(Ug, ct, (2 * i) & 63, r, g4);
            for (int jb = 0; jb <= 8 * tg + 6; jb += 8) {
                { const int jn = jb + 8 <= 8 * tg + 6 ? jb + 8 : jb;
#pragma unroll
                  for (int i = 0; i < 4; ++i) bn[i] = s5_ufrag(Ug, ct, (jn + 2 * i) & 63, r, g4); }
#pragma unroll
                for (int i = 0; i < 4; ++i) { const int j = jb + 2 * i + (g4 >> 1);
                    if (jb + 2 * i <= 8 * tg + 6) {
                    const LAS unsigned char* ab = lds + (8 * tg - j + 8) * 512 + r * 32 + (g4 & 1) * 16;
                    bf16x8 a8[8];
#pragma unroll
                    for (int tt = 0; tt < 8; ++tt) a8[tt] = *(const LAS bf16x8*)(ab + tt * 512);
                    asm volatile("" : "+v"(acc[0]), "+v"(acc[1]), "+v"(acc[2]), "+v"(acc[3]), "+v"(acc[4]), "+v"(acc[5]), "+v"(acc[6]), "+v"(acc[7]) :: "memory");
#pragma unroll
                    for (int tt = 0; tt < 8; ++tt) acc[tt] = __builtin_amdgcn_mfma_f32_16x16x32_bf16(a8[tt], bu[i], acc[tt], 0, 0, 0); }
                    asm volatile("" ::: "memory"); }
#pragma unroll
                for (int i = 0; i < 4; ++i) bu[i] = bn[i];
            }
#pragma unroll
            for (int i = 0; i < 4; ++i) bu[i] = s5_ufrag(Ug, ct, 8 * tg + 2 * i, r, g4);
            for (int jb = 8 * tg; jb <= 62; jb += 8) {
                { const int jn = jb + 8 <= 62 ? jb + 8 : jb;
#pragma unroll
                  for (int i = 0; i < 4; ++i) bn[i] = s5_ufrag(Ug, ct, jn + 2 * i, r, g4); }
#pragma unroll
                for (int i = 0; i < 4; ++i) { const int j = jb + 2 * i + (g4 >> 1);
                    if (jb + 2 * i + 1 >= 8 * tg) {
                    const LAS unsigned char* ab = lds + 36864 + (j - 8 * tg + 8) * 512 + r * 32 + (g4 & 1) * 16;
                    bf16x8 a8[8];
#pragma unroll
                    for (int tt = 0; tt < 8; ++tt) a8[tt] = *(const LAS bf16x8*)(ab - tt * 512);
                    asm volatile("" : "+v"(acc[0]), "+v"(acc[1]), "+v"(acc[2]), "+v"(acc[3]), "+v"(acc[4]), "+v"(acc[5]), "+v"(acc[6]), "+v"(acc[7]) :: "memory");
#pragma unroll
                    for (int tt = 0; tt < 8; ++tt) acc[tt] = __builtin_amdgcn_mfma_f32_16x16x32_bf16(a8[tt], bu[i], acc[tt], 0, 0, 0); }
                    asm volatile("" ::: "memory"); }
#pragma unroll
                for (int i = 0; i < 4; ++i) bu[i] = bn[i];
            }
            const f32x4 dsk = *(const f32x4*)(p.in[I_S5D] + l * 512 + g * 16 + 4 * g4);
#pragma unroll
            for (int tt = 0; tt < 8; ++tt) { const int t = 8 * tg + tt;
                const u32x2 uu = uu8[tt];
#pragma unroll
                for (int ks = 0; ks < 4; ++ks) {
                    const bf16x8 e0 = *(const LAS bf16x8*)(lds + 73728 + ((tt * 4 + ks) * 64 + lane) * 16), e1 = *(const LAS bf16x8*)(lds + 73728 + 32768 + (((7 - tt) * 4 + ks) * 64 + lane) * 16);
                    acc[tt] = __builtin_amdgcn_mfma_f32_16x16x32_bf16(e0, xc[0][ks], acc[tt], 0, 0, 0); acc[tt] = __builtin_amdgcn_mfma_f32_16x16x32_bf16(e1, xc[1][ks], acc[tt], 0, 0, 0); }
                const float uf[4] = {blo(uu.x), bhi(uu.x), blo(uu.y), bhi(uu.y)}; float o[4];
#pragma unroll
                for (int q = 0; q < 4; ++q) { const float ys = acc[tt][q] + dsk[q] * uf[q]; o[q] = ys * __builtin_amdgcn_rcpf(1.0f + __expf(-1.5957691216f * (ys + 0.044715f * ys * ys * ys))); }
                if (valid) { u32x2 w2; w2.x = cvtpk(o[0], o[1]); w2.y = cvtpk(o[2], o[3]); *(u32x2*)(YG + (size_t)row_tb(tbc, t) * 512 + g * 16 + 4 * g4) = w2; }
                if (tt & 1) asm volatile("" ::: "memory");
            }
        }
    }
}

__device__ __forceinline__ void phase_readout(const Params& p, int l, int lane, int wave, int blk, int nblk) {
    unsigned char* ws = p.ws;
    const bf16* V = (const bf16*)(ws + WS_V); const bf16* GD = (const bf16*)(ws + WS_GD); const float* BON = (const float*)(ws + WS_BONUS);
    const float* Y = (const float*)(ws + WS_Y);
    bf16* A2 = (bf16*)(ws + WS_A2);
    const int c = lane * 8, h = lane >> 3;
    const f32x4 lw0 = *(const f32x4*)(p.in[I_LNW] + l * 512 + c), lw1 = *(const f32x4*)(p.in[I_LNW] + l * 512 + c + 4), lb0 = *(const f32x4*)(p.in[I_LNB] + l * 512 + c), lb1 = *(const f32x4*)(p.in[I_LNB] + l * 512 + c + 4);
    const float lnw[8] = {lw0[0], lw0[1], lw0[2], lw0[3], lw1[0], lw1[1], lw1[2], lw1[3]}, lnb[8] = {lb0[0], lb0[1], lb0[2], lb0[3], lb1[0], lb1[1], lb1[2], lb1[3]};
    const int gw = blk * 8 + wave, NGW = nblk * 8;
#define RO_FETCH(r_, V8, Y0, Y1, G8, BN) do { const int rf_ = (r_); V8 = *(const u32x4*)(V + (size_t)rf_ * 512 + c); \
        _Pragma("unroll") for (int d = 0; d < 2; ++d) { const size_t o_ = ((size_t)d * T + rf_) * 512 + c; Y0[d] = *(const f32x4*)(Y + o_); Y1[d] = *(const f32x4*)(Y + o_ + 4); G8[d] = *(const u32x4*)(GD + o_); BN[d] = BON[((size_t)d * T + rf_) * 8 + h]; } } while (0)
    u32x4 v8n, g8n[2]; f32x4 y0n[2], y1n[2]; float bnn[2];
    if (gw < T) RO_FETCH(gw, v8n, y0n, y1n, g8n, bnn);
    for (int row = gw; row < T; row += NGW) {
        const u32x4 v8 = v8n; const u32x4 g8c[2] = {g8n[0], g8n[1]}; const f32x4 y0c[2] = {y0n[0], y0n[1]}, y1c[2] = {y1n[0], y1n[1]}; const float bnc[2] = {bnn[0], bnn[1]};
        asm volatile("" ::: "memory");
        RO_FETCH(row + NGW < T ? row + NGW : row, v8n, y0n, y1n, g8n, bnn);
        asm volatile("" ::: "memory");
        const float vf[8] = {blo(v8.x), bhi(v8.x), blo(v8.y), bhi(v8.y), blo(v8.z), bhi(v8.z), blo(v8.w), bhi(v8.w)};
        float out[8] = {0.f, 0.f, 0.f, 0.f, 0.f, 0.f, 0.f, 0.f};
#pragma unroll
        for (int d = 0; d < 2; ++d) {
            const f32x4 y0 = y0c[d], y1 = y1c[d]; const u32x4 g8 = g8c[d];
            const float y[8] = {y0[0], y0[1], y0[2], y0[3], y1[0], y1[1], y1[2], y1[3]};
            const float gf[8] = {blo(g8.x), bhi(g8.x), blo(g8.y), bhi(g8.y), blo(g8.z), bhi(g8.z), blo(g8.w), bhi(g8.w)};
            float sm = ((y[0] + y[1]) + (y[2] + y[3])) + ((y[4] + y[5]) + (y[6] + y[7]));
            sm += __shfl_xor(sm, 1); sm += __shfl_xor(sm, 2); sm += __shfl_xor(sm, 4);
            const float mean = sm * (1.0f / 64.0f); float q = 0.f;
#pragma unroll
            for (int i = 0; i < 8; ++i) { const float dv = y[i] - mean; q += dv * dv; }
            q += __shfl_xor(q, 1); q += __shfl_xor(q, 2); q += __shfl_xor(q, 4);
            const float rs = rsqrtf(q * (1.0f / 64.0f) + 64e-5f), bon = bnc[d];
#pragma unroll
            for (int i = 0; i < 8; ++i) out[i] += ((y[i] - mean) * rs * lnw[i] + lnb[i] + bon * vf[i]) * gf[i]; }
        u32x4 w; w.x = cvtpk(out[0], out[1]); w.y = cvtpk(out[2], out[3]); w.z = cvtpk(out[4], out[5]); w.w = cvtpk(out[6], out[7]);
        *(u32x4*)(A2 + (size_t)row * 1024 + c) = w;
    }
#undef RO_FETCH
}

enum { PH_PRO = 0, PH_NORM1, PH_GIN, PH_STREAM, PH_GLR, PH_S5A, PH_S5B, PH_CHUNK, PH_SEQ, PH_S5C, PH_READOUT, PH_GGLU, PH_GOUT, PH_NORM2, PH_GFUP, PH_GFDN, PH_NORM2M, PH_MPREP, PH_GMUP, PH_GMDN, PH_FINAL, N_PH };
template <int PH>
__device__ __forceinline__ void run_phase(const Params& p, int l, int e, LAS unsigned char* lds, int tid, int lane, int wave) {
    unsigned char* ws = p.ws; const int G = gridDim.x;
    const float* MODl = (const float*)(ws + WS_MOD) + (size_t)l * 3 * 6144;
    if constexpr (PH == PH_PRO) phase_prologue(p, lds, tid, lane, wave);
    if constexpr (PH == PH_NORM1) { if (l == 0) phase_norm(p, l, 0, true, false, lane, wave); else phase_norm(p, l, 0, false, false, lane, wave, 11, (const float*)(ws + WS_PARTF), (const float*)(ws + WS_MOD) + 2 * 6144 + 5120); }
    if constexpr (PH == PH_GIN) {
        pg8::Gemm g{(const bf16*)(ws + WS_H), (const bf16*)(ws + WS_WIN) + (size_t)l * DIN * 1024, T, DIN, 1024, 1024}; pg8::StaticOrder S; S.init(T, DIN, G, (int)blockIdx.x);
        pg8::EpiBf16<0> E{(bf16*)(ws + WS_P), DIN, nullptr, 0, 0, 1.f};
        pg8::gemm_phase<pg8::EpiBf16<0>, pg8::StaticOrder, true, true>(lds, g, S, E, tid); }
    if constexpr (PH == PH_STREAM) phase_stream_lr(p, l, lds, tid, lane, wave);
    if constexpr (PH == PH_CHUNK) phase_chunk(p, l, lds, tid, lane, wave);
    if constexpr (PH == PH_SEQ) { if (blockIdx.x >= 128) { const int item = (blockIdx.x - 128) * 8 + wave; if (item < 512) phase_s5_tables(p, l, item, lane); } else phase_seq(p, lds, lane, wave); }
    if constexpr (PH == PH_S5A) phase_s5_end(p, lane, wave);
    if constexpr (PH == PH_S5B) { if (blockIdx.x < 16) phase_s5_carry(p, l, lane, wave); else phase_readout(p, l, lane, wave, (int)blockIdx.x - 16, G - 16); }
    if constexpr (PH == PH_S5C) phase_s5_out(p, l, lds, tid, lane, wave);
    if constexpr (PH == PH_GGLU) {
        const int Mr = l == 0 ? T : NLAT; pg8::Gemm g{(const bf16*)(ws + WS_YG), (const bf16*)(ws + WS_WGLU) + (size_t)l * 512 * 512, Mr, 512, 512, 512}; pg8::StaticOrder S; S.init(Mr, 512, G, (int)blockIdx.x);
        pg8::EpiGLU E{(const bf16*)(ws + WS_YG), (bf16*)(ws + WS_A2), p.in[I_GLUB] + l * 512};
        pg8::gemm_phase<pg8::EpiGLU, pg8::StaticOrder, true, true>(lds, g, S, E, tid); }
    if constexpr (PH == PH_GOUT) {
        { pg8::Gemm g{(const bf16*)(ws + WS_A2), (const bf16*)(ws + WS_WOUT) + (size_t)l * 1024 * 1024, NLAT, 1024, 1024, 1024}; pg8::StaticOrder S; S.init(NLAT, 1024, G, (int)blockIdx.x);
          pg8::EpiRes E{(float*)(ws + WS_X), MODl + 2048, nullptr, 0};
          pg8::gemm_phase<pg8::EpiRes, pg8::StaticOrder, true, true>(lds, g, S, E, tid); }
        if (l == 0) {
            pg8::Gemm g{(const bf16*)(ws + WS_A2), (const bf16*)(ws + WS_WOUT), NCTX, 1024, 256, 1024}; pg8::GroupOrder S;
#pragma unroll
            for (int q = 0; q < 9; ++q) S.toff[q] = q == 0 ? 0 : (1 << 20);
            S.t0 = NLAT / 256; S.a0 = 0; S.o0 = 0; S.nNr = 4; S.kslice = 256; S.init(NCTX, 1024 * 4, G, (int)blockIdx.x);
            pg8::EpiPartF32 E{(float*)(ws + WS_PARTO), NLAT, NCTX, 256};
            pg8::gemm_phase<pg8::EpiPartF32, pg8::GroupOrder, true, true>(lds, g, S, E, tid); }
    }
    if constexpr (PH == PH_NORM2) phase_norm(p, l, 1, false, false, lane, wave, 4, (const float*)(ws + WS_PARTO), (const float*)(ws + WS_MOD) + 2 * 6144 + 2048);
    if constexpr (PH == PH_GFUP) {
        pg8::Gemm g{(const bf16*)(ws + WS_H), (const bf16*)(ws + WS_WFUP), T, 2 * DFF, 1024, 1024}; pg8::StaticOrder S; S.init(T, 2 * DFF, G, (int)blockIdx.x);
        pg8::EpiSwiGLU E{(bf16*)(ws + WS_ACT), DFF};
        pg8::gemm_phase<pg8::EpiSwiGLU, pg8::StaticOrder, true, true>(lds, g, S, E, tid); }
    if constexpr (PH == PH_GFDN) {
        { pg8::Gemm g{(const bf16*)(ws + WS_ACT), (const bf16*)(ws + WS_WFDN), NLAT, 1024, DFF, DFF}; pg8::StaticOrder S; S.init(NLAT, 1024, G, (int)blockIdx.x);
          pg8::EpiRes E{(float*)(ws + WS_X), MODl + 5120, nullptr, 0};
          pg8::gemm_phase<pg8::EpiRes, pg8::StaticOrder, true, true>(lds, g, S, E, tid); }
        {
            pg8::Gemm g{(const bf16*)(ws + WS_ACT), (const bf16*)(ws + WS_WFDN), NCTX, 1024, 256, DFF}; pg8::GroupOrder S;
#pragma unroll
            for (int q = 0; q < 9; ++q) S.toff[q] = q == 0 ? 0 : (1 << 20);
            S.t0 = NLAT / 256; S.a0 = 0; S.o0 = 0; S.nNr = 4; S.kslice = 256; S.init(NCTX, 1024 * 11, G, (int)blockIdx.x);
            pg8::EpiPartF32 E{(float*)(ws + WS_PARTF), NLAT, NCTX, 256};
            pg8::gemm_phase<pg8::EpiPartF32, pg8::GroupOrder, true, true>(lds, g, S, E, tid); }
    }
    if constexpr (PH == PH_NORM2M) { phase_norm2_moe(p, lds, tid, lane, wave); phase_moe_cvt(p, lds, lane, wave); }
    if constexpr (PH == PH_MPREP) phase_moe_prep(p, lds, tid, lane, wave);
    if constexpr (PH == PH_GMUP || PH == PH_GMDN) {
        const int* TOFF = (const int*)(ws + WS_TOFF);
        pg8::GroupOrder S;
#pragma unroll
        for (int q = 0; q < 9; ++q) S.toff[q] = __builtin_amdgcn_readfirstlane(TOFF[q]);
        const int nT = S.toff[8];
        const int t0 = e * MOE_PASS_TILES; int nt = e == 0 ? (nT < 64 ? nT : 64) : (nT > 64 ? nT - 64 : 0);
        S.t0 = t0;
        if constexpr (PH == PH_GMUP) {
            S.a0 = 0; S.o0 = t0; S.nNr = 2 * DFE / 256; S.kslice = 0; S.init(nt * 256, 2 * DFE, G, (int)blockIdx.x);
            pg8::Gemm g{(const bf16*)(ws + WS_APERM) + (size_t)t0 * 256 * 1024, (const bf16*)(ws + WS_WMUP), nt * 256, 2 * DFE, 1024, 1024};
            S.a0 = t0;
            pg8::EpiSwiGLU E{(bf16*)(ws + WS_ACT1), DFE};
            pg8::gemm_phase<pg8::EpiSwiGLU, pg8::GroupOrder, true, true>(lds, g, S, E, tid);
        } else {
            {
                const int ntA = nt < 64 ? nt : 64;
                S.a0 = t0; S.o0 = 0; S.nNr = 4; S.kslice = 0; S.init(ntA * 256, 1024, G, (int)blockIdx.x);
                pg8::Gemm g{(const bf16*)(ws + WS_ACT1), (const bf16*)(ws + WS_WMDN), ntA * 256, 1024, DFE, DFE};
                pg8::EpiBf16<0> E{(bf16*)(ws + WS_APERM), 1024, nullptr, 0, 0, 1.f};
                pg8::gemm_phase<pg8::EpiBf16<0>, pg8::GroupOrder, true, true>(lds, g, S, E, tid); }
            if (e == 1 && nT > 128) {
                S.t0 = 128; S.a0 = 64; S.o0 = 0; S.nNr = 4; S.kslice = DFE / 7; S.init((nT - 128) * 256, 1024 * 7, G, (int)blockIdx.x);
                pg8::Gemm g{(const bf16*)(ws + WS_ACT1), (const bf16*)(ws + WS_WMDN), (nT - 128) * 256, 1024, DFE / 7, DFE};
                pg8::EpiPartBf16 E{(bf16*)(ws + WS_PARTM), 128 * 256, 8 * 256, DFE / 7};
                pg8::gemm_phase<pg8::EpiPartBf16, pg8::GroupOrder, true, true>(lds, g, S, E, tid); }
        }
    }
    if constexpr (PH == PH_FINAL) phase_final(p, lane, wave);
}
template <int PH>
__global__ void __launch_bounds__(512, 2) k_ph(Params p, int l, int e) {
    extern __shared__ __attribute__((aligned(16))) unsigned char lds_raw[];
    LAS unsigned char* lds = (LAS unsigned char*)lds_raw;
    const int tid = threadIdx.x, lane = tid & 63, wave = __builtin_amdgcn_readfirstlane(tid >> 6);
    run_phase<PH>(p, l, e, lds, tid, lane, wave);
}

#ifndef MK_MULTI
#define MK_FUSED 1
#endif
#ifdef MK_FUSED
#ifndef MK_LOOP_L
#define MK_LOOP_L 0
#endif
__global__ void __launch_bounds__(512, 2) fwd_fused(Params p) {
    extern __shared__ __attribute__((aligned(16))) unsigned char lds_raw[];
    LAS unsigned char* lds = (LAS unsigned char*)lds_raw;
    const int tid = threadIdx.x, lane = tid & 63, wave = __builtin_amdgcn_readfirstlane(tid >> 6);
    volatile LAS unsigned* MISC = (volatile LAS unsigned*)(lds + MISC_OFF);
    if (tid < 32) MISC[tid] = 0u;
    __syncthreads();
    XcdBarrier bar = xcd_barrier_post((unsigned*)(p.ws + WS_CTL) + 4096, MISC + 8);
#define PHASE(PH, l, e) do { int t_ = threadIdx.x; asm volatile("" : "+v"(t_)); run_phase<PH>(p, l, e, lds, t_, t_ & 63, __builtin_amdgcn_readfirstlane(t_ >> 6)); xcd_barrier(bar); } while (0)
    PHASE(PH_PRO, 0, 0);
#if MK_LOOP_L
    for (int l = 0; l < 2; ++l) {
        PHASE(PH_NORM1, l, 0); PHASE(PH_GIN, l, 0); PHASE(PH_STREAM, l, 0); PHASE(PH_GLR, l, 0); PHASE(PH_S5A, l, 0); PHASE(PH_S5B, l, 0); PHASE(PH_CHUNK, l, 0); PHASE(PH_SEQ, l, 0); PHASE(PH_S5C, l, 0);
        PHASE(PH_READOUT, l, 0); PHASE(PH_GGLU, l, 0); PHASE(PH_GOUT, l, 0); PHASE(PH_NORM2, l, 0);
        if (l == 0) { PHASE(PH_GFUP, 0, 0); PHASE(PH_GFDN, 0, 0); }
        else { PHASE(PH_MPREP, 1, 0); for (int e = 0; e < 2; ++e) { PHASE(PH_GMUP, 1, e); PHASE(PH_GMDN, 1, e); } }
    }
#else
    PHASE(PH_NORM1, 0, 0); PHASE(PH_GIN, 0, 0); PHASE(PH_STREAM, 0, 0); PHASE(PH_CHUNK, 0, 0); PHASE(PH_SEQ, 0, 0); PHASE(PH_S5A, 0, 0); PHASE(PH_S5B, 0, 0); PHASE(PH_S5C, 0, 0);
    PHASE(PH_GGLU, 0, 0); PHASE(PH_GOUT, 0, 0); PHASE(PH_NORM2, 0, 0); PHASE(PH_GFUP, 0, 0); PHASE(PH_GFDN, 0, 0);
    PHASE(PH_NORM1, 1, 0); PHASE(PH_GIN, 1, 0); PHASE(PH_STREAM, 1, 0); PHASE(PH_CHUNK, 1, 0); PHASE(PH_SEQ, 1, 0); PHASE(PH_S5A, 1, 0); PHASE(PH_S5B, 1, 0); PHASE(PH_S5C, 1, 0);
    PHASE(PH_GGLU, 1, 0); PHASE(PH_GOUT, 1, 0); PHASE(PH_NORM2M, 1, 0); PHASE(PH_MPREP, 1, 0);
    for (int e = 0; e < 2; ++e) { PHASE(PH_GMUP, 1, e); PHASE(PH_GMDN, 1, e); }
#endif
    { int t_ = threadIdx.x; asm volatile("" : "+v"(t_)); run_phase<PH_FINAL>(p, 0, 0, lds, t_, t_ & 63, __builtin_amdgcn_readfirstlane(t_ >> 6)); }
#undef PHASE
}
#endif
}

#ifndef MK_FUSED
template <int PH> static void launch_ph(const mk::Params& a, int l, int e, int grid, hipStream_t stream) {
    static bool attr = false;
    if (!attr) { (void)hipFuncSetAttribute((const void*)mk::k_ph<PH>, hipFuncAttributeMaxDynamicSharedMemorySize, mk::LDS_BYTES); attr = true; }
    hipLaunchKernelGGL((mk::k_ph<PH>), dim3(grid), dim3(512), mk::LDS_BYTES, stream, a, l, e);
}
#endif
extern "C" void kernel_launch(void* const* d_in, const int* in_sizes, int n_in, void* d_out, int out_size, void* d_ws, size_t ws_size, hipStream_t stream) {
    using namespace mk;
    static int grid = 0;
    if (grid == 0) {
        if (n_in != N_IN || in_sizes[0] != NLAT * D || out_size != NLAT * D || ws_size < WS_END) { fprintf(stderr, "kernel_launch: unexpected shapes (n_in %d, ws %zu < %zu?)\n", n_in, ws_size, (size_t)WS_END); grid = -1; return; }
        int dev = 0, cus = 0;
        if (hipGetDevice(&dev) != hipSuccess || hipDeviceGetAttribute(&cus, hipDeviceAttributeMultiprocessorCount, dev) != hipSuccess) { grid = -1; return; }
        grid = cus;
    }
    if (grid < 0) return;
    (void)hipMemsetAsync((char*)d_ws + WS_CTL, 0, CTL_ZERO_BYTES, stream);
    Params a{};
    for (int i = 0; i < N_IN; ++i) a.in[i] = (const float*)d_in[i];
    a.out = (float*)d_out; a.ws = (unsigned char*)d_ws; a.lo = 0; a.hi = 0;
#ifdef MK_FUSED
    { static bool attr = false; if (!attr) { (void)hipFuncSetAttribute((const void*)fwd_fused, hipFuncAttributeMaxDynamicSharedMemorySize, LDS_BYTES); attr = true; }
      hipLaunchKernelGGL(fwd_fused, dim3(grid), dim3(512), LDS_BYTES, stream, a); return; }
#endif
#ifndef MK_FUSED
    launch_ph<PH_PRO>(a, 0, 0, grid, stream);
    for (int l = 0; l < 2; ++l) {
        launch_ph<PH_NORM1>(a, l, 0, grid, stream); launch_ph<PH_GIN>(a, l, 0, grid, stream); launch_ph<PH_STREAM>(a, l, 0, grid, stream);
        launch_ph<PH_CHUNK>(a, l, 0, grid, stream); launch_ph<PH_SEQ>(a, l, 0, grid, stream); launch_ph<PH_S5A>(a, l, 0, grid, stream); launch_ph<PH_S5B>(a, l, 0, grid, stream); launch_ph<PH_S5C>(a, l, 0, grid, stream);
        launch_ph<PH_GGLU>(a, l, 0, grid, stream); launch_ph<PH_GOUT>(a, l, 0, grid, stream); if (l == 0) launch_ph<PH_NORM2>(a, l, 0, grid, stream); else launch_ph<PH_NORM2M>(a, l, 0, grid, stream);
        if (l == 0) { launch_ph<PH_GFUP>(a, l, 0, grid, stream); launch_ph<PH_GFDN>(a, l, 0, grid, stream); }
        else { launch_ph<PH_MPREP>(a, l, 0, grid, stream); for (int e = 0; e < 2; ++e) { launch_ph<PH_GMUP>(a, l, e, grid, stream); launch_ph<PH_GMDN>(a, l, e, grid, stream); } }
    }
    launch_ph<PH_FINAL>(a, 0, 0, grid, stream);
#endif
}
```

```cpp
#include <hip/hip_runtime.h>
#include <cstdio>
#include <cstdint>
namespace pg8 {
#define PG8_LAS __attribute__((address_space(3)))
typedef unsigned short bf16_t;
typedef short bf16x8 __attribute__((ext_vector_type(8)));
typedef float f32x4 __attribute__((ext_vector_type(4)));
typedef unsigned u32x4 __attribute__((ext_vector_type(4)));
constexpr int BM = 256, BK = 64, HALF = 128, HTB = HALF * BK * 2  , STAGE_BYTES = 8 * HTB, NXCD = 8, WGM = 8;

__host__ __device__ __forceinline__ int lds_byte(int r, int c) { const int st = (r >> 4) * 2 + (c >> 5), rr = r & 15, cc = c & 31, ob = rr * 64 + cc * 2; return st * 1024 + (ob ^ (((ob >> 9) & 1) << 5)); }
__host__ __device__ __forceinline__ void stage_rc(int b, int& R, int& C) { const int st = b / 1024, sb = b % 1024, swz = sb ^ (((sb >> 9) & 1) << 5); R = (st >> 1) * 16 + swz / 64; C = (st & 1) * 32 + (swz % 64) / 2; }
__host__ __device__ __forceinline__ int perm32(int rho) { const int n = rho >> 4, i = rho & 15; return 8 * (i >> 2) + 4 * n + (i & 3); }

struct Unit { int pm, pn, pa, pb, po, ko; };
struct Gemm { const bf16_t* A; const bf16_t* Bt; int M, N, K, ld; };

struct StaticOrder {
    int nM, nN, nwg, G, c;
    __host__ __device__ void init(int M, int N, int G_, int c_) { nM = M / BM; nN = N / BM; nwg = nM * nN; G = G_; c = c_; }
    __host__ __device__ bool next(int i, Unit& u) const {
        const long L = (long)i * G + c; if (L >= nwg) return false;
        int wgid = (int)L; { const int q = nwg / NXCD, r = nwg % NXCD, xcd = wgid % NXCD, off = wgid / NXCD; wgid = (xcd < r ? xcd * (q + 1) : r * (q + 1) + (xcd - r) * q) + off; }
        const int nig = WGM * nN, gid = wgid / nig, fm = gid * WGM, gsz = (nM - fm) < WGM ? (nM - fm) : WGM;
        u.pm = fm + ((wgid % nig) % gsz); u.pn = (wgid % nig) / gsz; u.pa = u.pm; u.pb = u.pn; u.po = u.pm; u.ko = 0; return true;
    }
    __device__ __forceinline__ void a_ready(const Unit&) const {}
    __device__ __forceinline__ void done(const Unit&) const {}
};

struct GroupOrder : StaticOrder {
    int t0, a0, o0, nNr, kslice; int toff[9];
    __device__ __forceinline__ bool next(int i, Unit& u) const {
        if (!StaticOrder::next(i, u)) return false;
        u.pm += t0; int e = 0;
#pragma unroll
        for (int q = 1; q < 8; ++q) e += (u.pm >= toff[q]) ? 1 : 0;
        const int ks = u.pn / nNr; u.pn -= ks * nNr; u.ko = ks * kslice;
        u.pa = u.pm - a0; u.po = u.pm - o0; u.pb = e * nNr + u.pn; return true;
    }
};
__device__ __forceinline__ unsigned cvt_pk_bf16(float lo, float hi) { unsigned r; asm volatile("v_cvt_pk_bf16_f32 %0, %1, %2" : "=v"(r) : "v"(lo), "v"(hi)); return r; }
typedef float f32x2 __attribute__((ext_vector_type(2)));
__device__ __forceinline__ f32x2 gelu_pk(f32x2 v) {
    const f32x2 av = __builtin_elementwise_abs(v), d = av * 0.2316418882f + 1.0f;
    f32x2 t; t.x = __builtin_amdgcn_rcpf(d.x); t.y = __builtin_amdgcn_rcpf(d.y);
    f32x2 q = t * 0.5307027145f + (-0.7265760135f); q = q * t + 0.7107068705f; q = q * t + (-0.142248368f); q = q * t + 0.127414796f; q = q * t;
    const f32x2 s = (v * v) * (-0.72134752044f);
    f32x2 e; e.x = __builtin_amdgcn_exp2f(s.x); e.y = __builtin_amdgcn_exp2f(s.y);
    const f32x2 m = v * (q * e), r = v - m;
    f32x2 o; o.x = v.x < 0.f ? m.x : r.x; o.y = v.y < 0.f ? m.y : r.y; return o;
}

template <int ACT  > struct EpiBf16 {
    static constexpr bool PERM = true, AFTER_DRAIN = false; static_assert(ACT == 0 || ACT == 1, "EpiBf16: ACT is 0 (none) or 1 (gelu_pk)");
    bf16_t* O; int ldc; const float* bias; int split_cols; size_t split_stride; float scale0;
    __device__ __forceinline__ void operator()(const f32x4 (&acc)[2][2][4][2], const Unit& u, int wr, int wc, int fr, int fq) const {
        const int row0 = u.pm * BM + wr * 64 + fr; int colt = u.pn * BM; bf16_t* base = O;
        float sc = 1.f; if (split_cols) { const int t = colt / split_cols; base += (size_t)t * split_stride; colt -= t * split_cols; if (t == 0) sc = scale0; }
        const int col0 = colt + wc * 32 + 8 * fq, bcol0 = u.pn * BM + wc * 32 + 8 * fq;
        f32x4 bv[2][2];
#pragma unroll
        for (int bj = 0; bj < 2; ++bj)
#pragma unroll
            for (int n = 0; n < 2; ++n) bv[bj][n] = bias ? *(const f32x4*)(bias + bcol0 + bj * HALF + 4 * n) : (f32x4){0.f, 0.f, 0.f, 0.f};
#pragma unroll
        for (int ai = 0; ai < 2; ++ai)
#pragma unroll
            for (int m = 0; m < 4; ++m) { bf16_t* rowp = base + (size_t)(row0 + ai * HALF + m * 16) * ldc + col0;
#pragma unroll
                for (int bj = 0; bj < 2; ++bj) { f32x4 v0 = acc[ai][bj][m][0] + bv[bj][0], v1 = acc[ai][bj][m][1] + bv[bj][1];
                    if (ACT == 1) { f32x2 a = gelu_pk((f32x2){v0[0], v0[1]}), b = gelu_pk((f32x2){v0[2], v0[3]}), c = gelu_pk((f32x2){v1[0], v1[1]}), d = gelu_pk((f32x2){v1[2], v1[3]});
                        v0 = (f32x4){a.x, a.y, b.x, b.y}; v1 = (f32x4){c.x, c.y, d.x, d.y}; }
                    v0 = v0 * sc; v1 = v1 * sc; u32x4 w; w.x = cvt_pk_bf16(v0[0], v0[1]); w.y = cvt_pk_bf16(v0[2], v0[3]); w.z = cvt_pk_bf16(v1[0], v1[1]); w.w = cvt_pk_bf16(v1[2], v1[3]);
                    *(u32x4*)(rowp + bj * HALF) = w; } }
    }
};

__device__ __forceinline__ float bf_lo(unsigned w) { return __uint_as_float(w << 16); }
__device__ __forceinline__ float bf_hi(unsigned w) { return __uint_as_float(w & 0xffff0000u); }
__device__ __forceinline__ float sigm(float x) { return 1.0f / (1.0f + __expf(-x)); }
constexpr int T_ROWS = 16896, N_LAT = 16384;
struct EpiGLU {
    static constexpr bool PERM = true, AFTER_DRAIN = false;
    const bf16_t* YG; bf16_t* A2; const float* bias;
    __device__ __forceinline__ void operator()(const f32x4 (&acc)[2][2][4][2], const Unit& u, int wr, int wc, int fr, int fq) const {
        const int row0 = u.pm * BM + wr * 64 + fr, cb = u.pn * BM + wc * 32 + 8 * fq;
#pragma unroll
        for (int ai = 0; ai < 2; ++ai)
#pragma unroll
            for (int m = 0; m < 4; ++m) { const int row = row0 + ai * HALF + m * 16;
#pragma unroll
                for (int bj = 0; bj < 2; ++bj) { const int c = cb + bj * HALF; const f32x4 v0 = acc[ai][bj][m][0], v1 = acc[ai][bj][m][1];
                    const float v[8] = {v0[0], v0[1], v0[2], v0[3], v1[0], v1[1], v1[2], v1[3]};
                    const u32x4 y8 = *(const u32x4*)(YG + (size_t)row * 512 + c);
                    const float yf[8] = {bf_lo(y8.x), bf_hi(y8.x), bf_lo(y8.y), bf_hi(y8.y), bf_lo(y8.z), bf_hi(y8.z), bf_lo(y8.w), bf_hi(y8.w)};
                    float s[8];
#pragma unroll
                    for (int j = 0; j < 8; ++j) s[j] = yf[j] * sigm(v[j] + bias[c + j]);
                    u32x4 w1; w1.x = cvt_pk_bf16(s[0], s[1]); w1.y = cvt_pk_bf16(s[2], s[3]); w1.z = cvt_pk_bf16(s[4], s[5]); w1.w = cvt_pk_bf16(s[6], s[7]);
                    *(u32x4*)(A2 + (size_t)row * 1024 + 512 + c) = w1; } }
    }
};
struct EpiRes {
    static constexpr bool PERM = false, AFTER_DRAIN = false;
    float* X; const float* gate; const float* comb; int e;
    __device__ __forceinline__ void operator()(const f32x4 (&acc)[2][2][4][2], const Unit& u, int wr, int wc, int fr, int fq) const {
        const int midx = (u.pm < 64) ? (u.pm >> 5) : 2; const float* gp = gate + midx * 6144;
        const int row0 = u.pm * BM + wr * 64 + fr, col0 = u.pn * BM + wc * 32 + 4 * fq;
        f32x4 gv[2][2];
#pragma unroll
        for (int bj = 0; bj < 2; ++bj)
#pragma unroll
            for (int n = 0; n < 2; ++n) gv[bj][n] = *(const f32x4*)(gp + col0 + bj * HALF + n * 16);
#pragma unroll
        for (int ai = 0; ai < 2; ++ai) {
            f32x4 xv[4][2][2]; float cf4[4];
#pragma unroll
            for (int m = 0; m < 4; ++m) { const int row = row0 + ai * HALF + m * 16; cf4[m] = comb ? comb[(size_t)row * 8 + e] : 1.0f; const float* rowp = X + (size_t)row * 1024 + col0;
#pragma unroll
                for (int bj = 0; bj < 2; ++bj)
#pragma unroll
                    for (int n = 0; n < 2; ++n) xv[m][bj][n] = *(const f32x4*)(rowp + bj * HALF + n * 16); }
#pragma unroll
            for (int m = 0; m < 4; ++m) { const int row = row0 + ai * HALF + m * 16; float* rowp = X + (size_t)row * 1024 + col0;
#pragma unroll
                for (int bj = 0; bj < 2; ++bj)
#pragma unroll
                    for (int n = 0; n < 2; ++n) *(f32x4*)(rowp + bj * HALF + n * 16) = xv[m][bj][n] + gv[bj][n] * acc[ai][bj][m][n] * cf4[m]; }
        }
    }
};
struct EpiSwiGLU {
    static constexpr bool PERM = true, AFTER_DRAIN = false;
    bf16_t* ACT; int ldc;
    __device__ __forceinline__ void operator()(const f32x4 (&acc)[2][2][4][2], const Unit& u, int wr, int wc, int fr, int fq) const {
        const int row0 = u.po * BM + wr * 64 + fr, c = u.pn * HALF + wc * 32 + 8 * fq;
#pragma unroll
        for (int ai = 0; ai < 2; ++ai)
#pragma unroll
            for (int m = 0; m < 4; ++m) { const int row = row0 + ai * HALF + m * 16;
                const f32x4 g0 = acc[ai][0][m][0], g1 = acc[ai][0][m][1], u0 = acc[ai][1][m][0], u1 = acc[ai][1][m][1];
                float s[8];
#pragma unroll
                for (int j = 0; j < 4; ++j) { s[j] = g0[j] * sigm(g0[j]) * u0[j]; s[4 + j] = g1[j] * sigm(g1[j]) * u1[j]; }
                u32x4 w1; w1.x = cvt_pk_bf16(s[0], s[1]); w1.y = cvt_pk_bf16(s[2], s[3]); w1.z = cvt_pk_bf16(s[4], s[5]); w1.w = cvt_pk_bf16(s[6], s[7]);
                *(u32x4*)(ACT + (size_t)row * ldc + c) = w1; }
    }
};


struct EpiPartF32 {
    static constexpr bool PERM = false, AFTER_DRAIN = false;
    float* PART; int row_base, rows, kslice;
    __device__ __forceinline__ void operator()(const f32x4 (&acc)[2][2][4][2], const Unit& u, int wr, int wc, int fr, int fq) const {
        const int ks = u.ko / kslice; float* P0 = PART + (size_t)ks * rows * 1024;
        const int row0 = u.pm * BM - row_base + wr * 64 + fr, col0 = u.pn * BM + wc * 32 + 4 * fq;
#pragma unroll
        for (int ai = 0; ai < 2; ++ai)
#pragma unroll
            for (int m = 0; m < 4; ++m) { float* rowp = P0 + (size_t)(row0 + ai * HALF + m * 16) * 1024 + col0;
#pragma unroll
                for (int bj = 0; bj < 2; ++bj)
#pragma unroll
                    for (int n = 0; n < 2; ++n) *(f32x4*)(rowp + bj * HALF + n * 16) = acc[ai][bj][m][n]; }
    }
};

struct EpiPartBf16 {
    static constexpr bool PERM = true, AFTER_DRAIN = false;
    bf16_t* PART; int row_base, rows, kslice;
    __device__ __forceinline__ void operator()(const f32x4 (&acc)[2][2][4][2], const Unit& u, int wr, int wc, int fr, int fq) const {
        const int ks = u.ko / kslice; bf16_t* P0 = PART + (size_t)ks * rows * 1024;
        const int row0 = u.pm * BM - row_base + wr * 64 + fr, col0 = u.pn * BM + wc * 32 + 8 * fq;
#pragma unroll
        for (int ai = 0; ai < 2; ++ai)
#pragma unroll
            for (int m = 0; m < 4; ++m) { bf16_t* rowp = P0 + (size_t)(row0 + ai * HALF + m * 16) * 1024 + col0;
#pragma unroll
                for (int bj = 0; bj < 2; ++bj) { const f32x4 v0 = acc[ai][bj][m][0], v1 = acc[ai][bj][m][1];
                    u32x4 w; w.x = cvt_pk_bf16(v0[0], v0[1]); w.y = cvt_pk_bf16(v0[2], v0[3]); w.z = cvt_pk_bf16(v1[0], v1[1]); w.w = cvt_pk_bf16(v1[2], v1[3]);
                    *(u32x4*)(rowp + bj * HALF) = w; } }
    }
};
template <class Epi, class Sched, bool ALIGN_EPI = false, bool SP2 = false>
__device__ __forceinline__ void gemm_phase(PG8_LAS unsigned char* lds, const Gemm g, const Sched& S, const Epi& E, const int tid) {
    const int wid = __builtin_amdgcn_readfirstlane(tid >> 6), lane = tid & 63, wr = wid >> 2, wc = wid & 3, fr = lane & 15, fq = lane >> 4;
    const int K = g.ld, nt = g.K / BK;
    unsigned voffA[2], voffB[2];
#pragma unroll
    for (int i = 0; i < 2; ++i) { int R, C; stage_rc(tid * 16 + i * 8192, R, C); const int Rb = Epi::PERM ? ((R & ~31) + perm32(R & 31)) : R;
        voffA[i] = (unsigned)(R * K + C) * 2u; voffB[i] = (unsigned)(Rb * K + C) * 2u; }
    const size_t kstep = (size_t)(BK * 2);
    const size_t hstep = (size_t)HALF * K * 2;
    const size_t tstep = 2 * hstep;
    const unsigned ldsw = (unsigned)wid * 1024u;
    const int aoff = lds_byte(wr * 64 + fr, fq * 8), boff = lds_byte(wc * 32 + fr, fq * 8);
#define PG8_SA(b, h) (((b) * 2 + (h)) * HTB)
#define PG8_SB(b, h) ((4 + (b) * 2 + (h)) * HTB)
#define PG8_STAGE(bufoff, gbase, voff) do { _Pragma("unroll") for (int _i = 0; _i < 2; ++_i) \
        __builtin_amdgcn_global_load_lds((const unsigned*)((const char*)(gbase) + (voff)[_i]), (PG8_LAS unsigned*)(lds + (bufoff) + ldsw + _i * 8192), 16, 0, 0); } while (0)
#define PG8_LDA(dst, b, h) do { _Pragma("unroll") for (int m = 0; m < 4; ++m) _Pragma("unroll") for (int k = 0; k < 2; ++k) dst[m][k] = *(const PG8_LAS bf16x8*)(lds + PG8_SA(b, h) + aoff + m * 2048 + k * 1024); } while (0)
#define PG8_LDB(dst, b, h) do { _Pragma("unroll") for (int n = 0; n < 2; ++n) _Pragma("unroll") for (int k = 0; k < 2; ++k) dst[n][k] = *(const PG8_LAS bf16x8*)(lds + PG8_SB(b, h) + boff + n * 2048 + k * 1024); } while (0)
#define PG8_MMA(ai, bj, At, Bt) do { __builtin_amdgcn_s_setprio(1); _Pragma("unroll") for (int m = 0; m < 4; ++m) _Pragma("unroll") for (int n = 0; n < 2; ++n) _Pragma("unroll") for (int k = 0; k < 2; ++k) \
        acc[ai][bj][m][n] = __builtin_amdgcn_mfma_f32_16x16x32_bf16(Bt[n][k], At[m][k], acc[ai][bj][m][n], 0, 0, 0); __builtin_amdgcn_s_setprio(0); } while (0)
#define PG8_WAIT_V(n) asm volatile("s_waitcnt vmcnt(" #n ")" ::: "memory")
#define PG8_WAIT_L(n) asm volatile("s_waitcnt lgkmcnt(" #n ")" ::: "memory")
#define PG8_BAR __builtin_amdgcn_s_barrier()
#define PG8_SCHED __builtin_amdgcn_sched_barrier(0)
    Unit cur, nxt; int ui = 0;
    if (!S.next(0, cur)) return;
    f32x4 acc[2][2][4][2];
#pragma unroll
    for (int a = 0; a < 2; ++a)
#pragma unroll
        for (int b = 0; b < 2; ++b)
#pragma unroll
            for (int m = 0; m < 4; ++m)
#pragma unroll
                for (int n = 0; n < 2; ++n) acc[a][b][m][n] = (f32x4){0.f, 0.f, 0.f, 0.f};
    bf16x8 At[4][2], B0[2][2], B1[2][2];
    const char* cA = (const char*)g.A + (size_t)cur.pa * tstep + (size_t)cur.ko * 2; const char* cB = (const char*)g.Bt + (size_t)cur.pb * tstep + (size_t)cur.ko * 2;
    S.a_ready(cur);
    if constexpr (SP2) {
        PG8_STAGE(PG8_SB(0, 0), cB, voffB); PG8_STAGE(PG8_SB(0, 1), cB + hstep, voffB); PG8_STAGE(PG8_SA(0, 0), cA, voffA); PG8_STAGE(PG8_SA(0, 1), cA + hstep, voffA);
        if (wr == 1) PG8_BAR;
        PG8_WAIT_V(2); PG8_BAR;
        PG8_STAGE(PG8_SB(1, 0), cB + kstep, voffB); PG8_STAGE(PG8_SA(1, 0), cA + kstep, voffA); PG8_STAGE(PG8_SB(1, 1), cB + hstep + kstep, voffB);
        PG8_WAIT_V(6); PG8_BAR;
    } else {
        PG8_STAGE(PG8_SB(0, 0), cB, voffB); PG8_STAGE(PG8_SA(0, 0), cA, voffA); PG8_STAGE(PG8_SB(0, 1), cB + hstep, voffB); PG8_STAGE(PG8_SA(0, 1), cA + hstep, voffA);
        if (wr == 1) PG8_BAR;
        PG8_WAIT_V(4); PG8_BAR;
        PG8_STAGE(PG8_SB(1, 0), cB + kstep, voffB); PG8_STAGE(PG8_SA(1, 0), cA + kstep, voffA); PG8_STAGE(PG8_SB(1, 1), cB + hstep + kstep, voffB);
        PG8_WAIT_V(6); PG8_BAR;
    }
    for (;;) {
        const bool has_next = S.next(ui + 1, nxt);
        const char* nA = has_next ? (const char*)g.A + (size_t)nxt.pa * tstep + (size_t)nxt.ko * 2 : cA; const char* nB = has_next ? (const char*)g.Bt + (size_t)nxt.pb * tstep + (size_t)nxt.ko * 2 : cB;
        for (int t = 0; t < nt; t += 2) {
            const bool last = (t == nt - 2);
            const char* a1 = cA + (size_t)(t + 1) * kstep;
            const char* a2 = last ? nA : cA + (size_t)(t + 2) * kstep; const char* b2 = last ? nB : cB + (size_t)(t + 2) * kstep;
            const char* a3 = a2 + kstep; const char* b3 = b2 + kstep;
            if (last && has_next) S.a_ready(nxt);
            if constexpr (SP2) {
            PG8_LDB(B0, 0, 0); PG8_LDB(B1, 0, 1); PG8_SCHED; PG8_LDA(At, 0, 0); PG8_STAGE(PG8_SA(1, 1), a1 + hstep, voffA);
            PG8_WAIT_V(8); PG8_WAIT_L(0); PG8_BAR; PG8_MMA(0, 0, At, B0); PG8_MMA(0, 1, At, B1); PG8_BAR; PG8_SCHED;
            PG8_LDA(At, 0, 1); PG8_STAGE(PG8_SB(0, 0), b2, voffB); PG8_STAGE(PG8_SB(0, 1), b2 + hstep, voffB); PG8_STAGE(PG8_SA(0, 0), a2, voffA);
            PG8_WAIT_V(8); PG8_WAIT_L(0); PG8_BAR; PG8_MMA(1, 0, At, B0); PG8_MMA(1, 1, At, B1); PG8_BAR; PG8_SCHED;
            PG8_LDB(B0, 1, 0); PG8_LDB(B1, 1, 1); PG8_SCHED; PG8_LDA(At, 1, 0); PG8_STAGE(PG8_SA(0, 1), a2 + hstep, voffA);
            PG8_WAIT_V(8); PG8_WAIT_L(0); PG8_BAR; PG8_MMA(0, 0, At, B0); PG8_MMA(0, 1, At, B1); PG8_BAR; PG8_SCHED;
            PG8_LDA(At, 1, 1); PG8_STAGE(PG8_SB(1, 0), b3, voffB); PG8_STAGE(PG8_SB(1, 1), b3 + hstep, voffB); PG8_STAGE(PG8_SA(1, 0), a3, voffA);
            PG8_WAIT_V(8); PG8_WAIT_L(0); PG8_BAR; PG8_MMA(1, 0, At, B0); PG8_MMA(1, 1, At, B1); PG8_BAR; PG8_SCHED;
            } else {
            PG8_LDB(B0, 0, 0); PG8_SCHED; PG8_LDA(At, 0, 0); PG8_STAGE(PG8_SA(1, 1), a1 + hstep, voffA);
            PG8_WAIT_L(8); PG8_BAR; PG8_WAIT_L(0); PG8_MMA(0, 0, At, B0); PG8_BAR; PG8_SCHED;
            PG8_LDB(B1, 0, 1); PG8_STAGE(PG8_SB(0, 0), b2, voffB);
            PG8_BAR; PG8_WAIT_L(0); PG8_MMA(0, 1, At, B1); PG8_BAR;
            PG8_LDA(At, 0, 1); PG8_STAGE(PG8_SA(0, 0), a2, voffA);
            PG8_BAR; PG8_WAIT_L(0); PG8_MMA(1, 0, At, B0); PG8_BAR; PG8_SCHED;
            PG8_STAGE(PG8_SB(0, 1), b2 + hstep, voffB);
            PG8_WAIT_V(6); PG8_BAR; PG8_MMA(1, 1, At, B1); PG8_BAR;
            PG8_LDB(B0, 1, 0); PG8_SCHED; PG8_LDA(At, 1, 0); PG8_STAGE(PG8_SA(0, 1), a2 + hstep, voffA);
            PG8_WAIT_L(8); PG8_BAR; PG8_WAIT_L(0); PG8_MMA(0, 0, At, B0); PG8_BAR; PG8_SCHED;
            PG8_LDB(B1, 1, 1); PG8_STAGE(PG8_SB(1, 0), b3, voffB);
            PG8_BAR; PG8_WAIT_L(0); PG8_MMA(0, 1, At, B1); PG8_BAR;
            PG8_LDA(At, 1, 1); PG8_STAGE(PG8_SA(1, 0), a3, voffA);
            PG8_BAR; PG8_WAIT_L(0); PG8_MMA(1, 0, At, B0); PG8_BAR; PG8_SCHED;
            PG8_STAGE(PG8_SB(1, 1), b3 + hstep, voffB);
            PG8_WAIT_V(6); PG8_BAR; PG8_MMA(1, 1, At, B1); PG8_BAR;
            }
        }
        if constexpr (ALIGN_EPI) { if (wr == 0) PG8_BAR; }
        if constexpr (!Epi::AFTER_DRAIN) { E(acc, cur, wr, wc, fr, fq); S.done(cur); }
        if (!has_next) break;
#pragma unroll
        for (int a = 0; a < 2; ++a)
#pragma unroll
            for (int b = 0; b < 2; ++b)
#pragma unroll
                for (int m = 0; m < 4; ++m)
#pragma unroll
                    for (int n = 0; n < 2; ++n) acc[a][b][m][n] = (f32x4){0.f, 0.f, 0.f, 0.f};
        cur = nxt; cA = nA; cB = nB; ++ui;
        if constexpr (ALIGN_EPI) { if (wr == 1) PG8_BAR; }
    }
    PG8_WAIT_V(0);
    if constexpr (!ALIGN_EPI) { if (wr == 0) PG8_BAR; }
    PG8_BAR;
    if constexpr (Epi::AFTER_DRAIN) { E.fused(acc, cur, wr, wc, fr, fq, lds, wid, lane); S.done(cur); }
#undef PG8_SA
#undef PG8_SB
#undef PG8_STAGE
#undef PG8_LDA
#undef PG8_LDB
#undef PG8_MMA
#undef PG8_WAIT_V
#undef PG8_WAIT_L
#undef PG8_BAR
#undef PG8_SCHED
}
}

namespace mk {
typedef unsigned short bf16;
typedef float f32x4 __attribute__((ext_vector_type(4)));
typedef unsigned u32x4 __attribute__((ext_vector_type(4)));
typedef unsigned u32x2 __attribute__((ext_vector_type(2)));
#define LAS __attribute__((address_space(3)))
constexpr int D = 1024, NB = 2, SEQ = 8192, CTXL = 256, NLAT = NB * SEQ, NCTX = NB * CTXL, T = NLAT + NCTX;
constexpr int DIN = 2560, DFF = 2816, NE = 8, DFE = 3584, SPOS = SEQ + CTXL  , NCH = SPOS / 64;
static_assert(T == pg8::T_ROWS && NLAT == pg8::N_LAT, "rows");
enum { I_X = 0, I_C, I_CTX, I_CCTX, I_ADAW, I_ADAB, I_N1G, I_N2G, I_WIN, I_WOUT, I_MU, I_W0, I_WUP, I_A0, I_AUP, I_GUP, I_KK, I_KA, I_RK, I_LNW, I_LNB,
       I_LRE, I_LIM, I_LDT, I_BRE, I_BIM, I_CRE, I_CIM, I_S5D, I_GLUW, I_GLUB, I_FG, I_FU, I_FD, I_ROUT, I_MG, I_MU2, I_MD, I_FING, N_IN };
constexpr size_t MiB = 1u << 20, QMiB = 1u << 18;
constexpr size_t WS_CTL = 0, CTL_ZERO_BYTES = 65536;
constexpr size_t WS_MOD = 1 * MiB;
constexpr size_t WS_COMB = 1 * MiB + 2 * QMiB;
constexpr size_t WS_WIN = 2 * MiB;
constexpr size_t WS_WOUT = 12 * MiB;
constexpr size_t WS_WGLU = 16 * MiB;
constexpr size_t WS_WLR = 17 * MiB;
constexpr size_t WS_WFUP = 23 * MiB;
constexpr size_t WS_WFDN = 34 * MiB;
constexpr size_t WS_X = 40 * MiB;
constexpr size_t WS_H = 106 * MiB;
constexpr size_t WS_LRIN = 106 * MiB;
constexpr size_t WS_U = 122 * MiB + 2 * QMiB;
constexpr size_t WS_P = 370 * MiB;
constexpr size_t WS_LW = 139 * MiB;
constexpr size_t WS_XEND = 205 * MiB;
constexpr size_t WS_CARRY = 213 * MiB + QMiB;
constexpr size_t WS_Y = 139 * MiB;
constexpr size_t WS_YG = 221 * MiB + 2 * QMiB;
constexpr size_t WS_BONUS = 106 * MiB;
constexpr size_t WS_R = 221 * MiB + 2 * QMiB, WS_V = 238 * MiB, WS_KKN = 254 * MiB + 2 * QMiB;
constexpr size_t WS_KT = 271 * MiB, WS_BB = 304 * MiB, WS_GD = 337 * MiB;
constexpr size_t WS_K = 370 * MiB;
constexpr size_t WS_PARTO = 370 * MiB;
constexpr size_t WS_PARTF = 380 * MiB;
constexpr size_t WS_CH = 370 * MiB;
constexpr size_t WS_S5E = 271 * MiB;
constexpr size_t WS_S5BP = 304 * MiB;
constexpr size_t WS_S5K = 287 * MiB;
constexpr size_t WS_A2 = 304 * MiB;
constexpr size_t WS_ACT = 221 * MiB + 2 * QMiB;
constexpr size_t WS_RE = 1 * MiB + 2 * QMiB;
constexpr size_t WS_RP = WS_RE + 65536;
constexpr size_t WS_SEGCNT = WS_RE + 131072;
constexpr size_t WS_PROW = WS_RE + 196608;
constexpr size_t WS_PGW = WS_PROW + 147456;
constexpr size_t WS_TOFF = WS_PGW + 147456;
constexpr size_t WS_PPOS = 1 * MiB + QMiB;
constexpr size_t WS_APERM = 139 * MiB;
constexpr size_t WS_ACT1 = 207 * MiB;
constexpr int MOE_PASS_TILES = 64, MOE_MAX_TILES = 136, MOE_ACT_TILES = 72;
constexpr size_t WS_PARTM = 2 * MiB;
static_assert(WS_TOFF + 64 <= 2 * MiB && WS_APERM + (size_t)MOE_MAX_TILES * 256 * 2048 <= WS_ACT1 && WS_ACT1 + (size_t)MOE_ACT_TILES * 256 * DFE * 2 <= 333 * MiB + 2 * QMiB, "moe ws map");
constexpr size_t WS_WMUP = 333 * MiB + 2 * QMiB;
constexpr size_t WS_WMDN = 445 * MiB + 2 * QMiB;
constexpr size_t WS_END = 502 * MiB;
constexpr int NCC = 2 * NB * NCH * 8;
static_assert(WS_CH + (size_t)NCC * 32768 <= WS_END && WS_WMDN + (size_t)8 * 1024 * 3584 * 2 <= WS_END && WS_ACT + (size_t)NLAT * DFE * 2 <= WS_WMUP && WS_GD + (size_t)2 * T * 512 * 2 <= WS_K, "ws map");
constexpr int LDS_BYTES = 147456, RING_BYTES = 131072, MISC_OFF = LDS_BYTES - 1024, LDS_GC = LDS_BYTES - 2048;

struct Params { const float* in[N_IN]; float* out; unsigned char* ws; int lo, hi; };
static_assert(sizeof(Params) == 8 * N_IN + 24, "no padding");

__device__ __forceinline__ float bf2f(bf16 v) { return __uint_as_float(((unsigned)v) << 16); }
__device__ __forceinline__ unsigned f2bf(float f) { unsigned u = __float_as_uint(f); return (u + 0x7fffu + ((u >> 16) & 1u)) >> 16; }
__device__ __forceinline__ unsigned pk2(float lo, float hi) { return f2bf(lo) | (f2bf(hi) << 16); }
__device__ __forceinline__ float blo(unsigned w) { return __uint_as_float(w << 16); }
__device__ __forceinline__ float bhi(unsigned w) { return __uint_as_float(w & 0xffff0000u); }
__device__ __forceinline__ float sigm(float x) { return 1.0f / (1.0f + __expf(-x)); }
__device__ __forceinline__ float wave_sum(float v) {
#pragma unroll
    for (int o = 1; o < 64; o <<= 1) v += __shfl_xor(v, o);
    return v;
}
#define LDS_WAIT() asm volatile("s_waitcnt lgkmcnt(0)" ::: "memory")
__device__ __forceinline__ int row_of(int b, int d, int s) {
    return s < CTXL ? NLAT + b * CTXL + (d ? CTXL - 1 - s : s) : b * SEQ + (d ? SEQ - 1 - (s - CTXL) : (s - CTXL));
}

#define XB_TMO      128
#define XB_XCNT(j)  (256  + 64 * (j))
#define XB_XSUB(j)  (1280 + 64 * (j))
#define XB_XGEN(j)  (2304 + 64 * (j))
#define XB_TOP      3328
#define XB_TOPGEN   3392
#define XCD_BAR_WORDS 3456
#define XB_SPIN_CAP (1u << 25)
__device__ __forceinline__ unsigned xb_ld(unsigned* p)              { return __hip_atomic_load(p, __ATOMIC_RELAXED, __HIP_MEMORY_SCOPE_AGENT); }
__device__ __forceinline__ unsigned xb_add(unsigned* p, unsigned v) { return __hip_atomic_fetch_add(p, v, __ATOMIC_RELAXED, __HIP_MEMORY_SCOPE_AGENT); }
__device__ __forceinline__ unsigned xb_xcc_id() { return (unsigned)__builtin_amdgcn_s_getreg((3 << 11) | 20) & 0xFu; }
#define XB_SPIN(cond, bar) do { unsigned _sp = 0; while (cond) { __builtin_amdgcn_s_sleep(1); \
    if ((++_sp & 255u) == 0u) { if (xb_ld(&(bar)[XB_TMO])) break; if (_sp > XB_SPIN_CAP) { atomicAdd(&(bar)[XB_TMO], 1u); break; } } } } while (0)
struct XcdBarrier { unsigned* bar; unsigned x; volatile LAS unsigned* st; };
__device__ __forceinline__ XcdBarrier xcd_barrier_post(unsigned* bar, volatile LAS unsigned* st) {
    XcdBarrier b; b.bar = bar; b.x = xb_xcc_id(); b.st = st;
    if (threadIdx.x == 0) (void)xb_add(&bar[XB_XCNT(b.x)], 1u);
    return b;
}
__device__ __forceinline__ void xcd_barrier_complete(unsigned* bar, unsigned x, unsigned& nloc, unsigned& nx) {
    const unsigned G = gridDim.x * gridDim.y * gridDim.z;
    unsigned sum, cnt, mine, sp = 0u;
    for (;;) {
        sum = 0u; cnt = 0u; mine = 0u;
#pragma unroll
        for (unsigned j = 0; j < 16; ++j) { const unsigned c = xb_ld(&bar[XB_XCNT(j)]); sum += c; cnt += (c > 0u) ? 1u : 0u; mine = (j == x) ? c : mine; }
        if (sum == G) break;
        __builtin_amdgcn_s_sleep(1);
        if ((++sp & 255u) == 0u) { if (xb_ld(&bar[XB_TMO])) break; if (sp > XB_SPIN_CAP) { atomicAdd(&bar[XB_TMO], 1u); break; } }
    }
    nloc = mine > 0u ? mine : 1u; nx = cnt > 0u ? cnt : 1u;
}
__device__ __forceinline__ void xcd_barrier(const XcdBarrier& b) {
    asm volatile("s_waitcnt vmcnt(0)" ::: "memory");
    __syncthreads();
    if (threadIdx.x == 0) {
        unsigned* bar = b.bar;
        __builtin_amdgcn_s_waitcnt(0);
        unsigned nloc = b.st[0], nx = b.st[1];
        if (nloc == 0u) { xcd_barrier_complete(bar, b.x, nloc, nx); b.st[0] = nloc; b.st[1] = nx; }
        const unsigned old = xb_add(&bar[XB_XSUB(b.x)], 1u);
        const unsigned gen = old / nloc;
        if (old + 1u == (gen + 1u) * nloc) {
            __builtin_amdgcn_fence(__ATOMIC_RELEASE, "agent");
            asm volatile("s_waitcnt vmcnt(0)" ::: "memory");
            const unsigned og = xb_add(&bar[XB_TOP], 1u);
            const unsigned tg = og / nx;
            if (og + 1u == (tg + 1u) * nx) xb_add(&bar[XB_TOPGEN], 1u);
            else XB_SPIN(xb_ld(&bar[XB_TOPGEN]) == tg, bar);
            __builtin_amdgcn_fence(__ATOMIC_ACQUIRE, "agent");
            xb_add(&bar[XB_XGEN(b.x)], 1u);
            asm volatile("s_waitcnt vmcnt(0)" ::: "memory");
        } else {
            XB_SPIN(xb_ld(&bar[XB_XGEN(b.x)]) == gen, bar);
            __builtin_amdgcn_fence(__ATOMIC_ACQUIRE, "agent");
            asm volatile("s_waitcnt vmcnt(0)" ::: "memory");
        }
    }
    __syncthreads();
}

__device__ __forceinline__ void tr_item(const float* W, int Nsrc, int k0, int n0, bf16* dst, int ldk, int drow0, int dk0, bool zero, LAS float* scr, int lane) {
    if (!zero) {
#pragma unroll 8
        for (int i = 0; i < 32; ++i) { const int kk = 2 * i + (lane >> 5); scr[kk * 33 + (lane & 31)] = W[(size_t)(k0 + kk) * Nsrc + n0 + (lane & 31)]; }
    }
    LDS_WAIT(); asm volatile("" ::: "memory");
    const int c = lane & 7;
#pragma unroll
    for (int j = 0; j < 4; ++j) { const int n = (lane >> 3) + 8 * j; const LAS float* s = scr + (8 * c) * 33 + n;
        u32x4 o = (u32x4){0u, 0u, 0u, 0u};
        if (!zero) { o.x = pk2(s[0 * 33], s[1 * 33]); o.y = pk2(s[2 * 33], s[3 * 33]); o.z = pk2(s[4 * 33], s[5 * 33]); o.w = pk2(s[6 * 33], s[7 * 33]); }
        *(u32x4*)(dst + (size_t)(drow0 + n) * ldk + dk0 + 8 * c) = o; }
    LDS_WAIT(); asm volatile("" ::: "memory");
}

__device__ __forceinline__ void phase_prologue(const Params& p, LAS unsigned char* lds, int tid, int lane, int wave) {
    unsigned char* ws = p.ws;
    const int G = gridDim.x;
    {
        LAS float* act = (LAS float*)lds;
        LAS float* red = (LAS float*)(lds + 12288);
        for (int i = tid; i < 3 * 1024; i += 512) { const float v = i < 2048 ? p.in[I_C][i] : p.in[I_CCTX][i - 2048]; act[i] = v * sigm(v); }
        __syncthreads();
        float* MOD = (float*)(ws + WS_MOD);
        for (int task = blockIdx.x; task < 192; task += G) {
            const int l = task / 96, j = (task % 96) * 64 + lane;
            const float* Wp = p.in[I_ADAW] + (size_t)l * 1024 * 6144 + (size_t)(wave * 128) * 6144 + j;
            float a0 = 0.f, a1 = 0.f, a2 = 0.f;
#pragma unroll 8
            for (int k = 0; k < 128; ++k) { const float w = Wp[(size_t)k * 6144]; const int kk = wave * 128 + k; a0 += act[kk] * w; a1 += act[1024 + kk] * w; a2 += act[2048 + kk] * w; }
            red[(wave * 3 + 0) * 64 + lane] = a0; red[(wave * 3 + 1) * 64 + lane] = a1; red[(wave * 3 + 2) * 64 + lane] = a2;
            __syncthreads();
            if (wave < 3) { float s = p.in[I_ADAB][l * 6144 + j];
#pragma unroll
                for (int w = 0; w < 8; ++w) s += red[(w * 3 + wave) * 64 + lane];
                MOD[(size_t)(l * 3 + wave) * 6144 + j] = s; }
            __syncthreads();
        }
    }
    LAS float* scr = (LAS float*)(lds + 32768 + wave * 8448);
    const int gw = blockIdx.x * 8 + wave, NGW = G * 8;
    constexpr int PL = 1280 + 512 + 128 + 128, NIT = 2 * PL + 3 * 1408;
    for (int it0 = gw; it0 < NIT; it0 += NGW) {
        int it = it0;
        if (it < 2 * PL) {
            const int l = it / PL; it -= l * PL;
            if (it < 1280) { const int kb = it / 80, nb = it % 80; tr_item(p.in[I_WIN] + (size_t)l * 1024 * 2560, 2560, kb * 64, nb * 32, (bf16*)(ws + WS_WIN) + (size_t)l * 2560 * 1024, 1024, nb * 32, kb * 64, false, scr, lane); continue; }
            it -= 1280;
            if (it < 512) { const int kb = it / 32, nb = it % 32; tr_item(p.in[I_WOUT] + (size_t)l * 1024 * 1024, 1024, kb * 64, nb * 32, (bf16*)(ws + WS_WOUT) + (size_t)l * 1024 * 1024, 1024, nb * 32, kb * 64, false, scr, lane); continue; }
            it -= 512;
            if (it < 128) { const int kb = it / 16, nb = it % 16; tr_item(p.in[I_GLUW] + (size_t)l * 512 * 512, 512, kb * 64, nb * 32, (bf16*)(ws + WS_WGLU) + (size_t)l * 512 * 512, 512, nb * 32, kb * 64, false, scr, lane); continue; }
            it -= 128;
            {
                const int d = it / 64, q = it % 64; bf16* dst = (bf16*)(ws + WS_WLR) + (size_t)(l * 2 + d) * 131072;
                if (q < 16) tr_item(p.in[I_WUP] + (size_t)(l * 2 + d) * 64 * 512, 512, 0, q * 32, dst, 64, q * 32, 0, false, scr, lane);
                else if (q < 32) tr_item(p.in[I_AUP] + (size_t)(l * 2 + d) * 64 * 512, 512, 0, (q - 16) * 32, dst + 32768, 64, (q - 16) * 32, 0, false, scr, lane);
                else { const int kb = (q - 32) / 16, nb = (q - 32) % 16; tr_item(p.in[I_GUP] + (size_t)(l * 2 + d) * 128 * 512, 512, kb * 64, nb * 32, dst + 65536, 128, nb * 32, kb * 64, false, scr, lane); }
            }
            continue;
        }
        it -= 2 * PL;
        if (it < 1408) { const int kb = it / 88, nb = it % 88, n0 = nb * 32; tr_item(p.in[I_FG], 2816, kb * 64, n0, (bf16*)(ws + WS_WFUP), 1024, (n0 / 128) * 256 + n0 % 128, kb * 64, false, scr, lane); continue; }
        it -= 1408;
        if (it < 1408) { const int kb = it / 88, nb = it % 88, n0 = nb * 32; tr_item(p.in[I_FU], 2816, kb * 64, n0, (bf16*)(ws + WS_WFUP), 1024, (n0 / 128) * 256 + 128 + n0 % 128, kb * 64, false, scr, lane); continue; }
        it -= 1408;
        { const int kb = it / 32, nb = it % 32; tr_item(p.in[I_FD], 1024, kb * 64, nb * 32, (bf16*)(ws + WS_WFDN), 2816, nb * 32, kb * 64, false, scr, lane); }
    }
}
constexpr int MOE_CVT_ITEMS = 8 * 5376, MOE_CVT_SPLIT = 7 * 5376;
__device__ __forceinline__ void phase_moe_cvt(const Params& p, LAS unsigned char* lds, int lane, int wave, int it_begin, int it_end, int worker, int nworkers) {
    unsigned char* ws = p.ws;
    LAS float* scr = (LAS float*)(lds + 32768 + wave * 8448);
    for (int it0 = it_begin + worker; it0 < it_end; it0 += nworkers) {
        const int e = it0 / 5376; int it = it0 % 5376;
        if (it < 1792) { const int kb = it / 112, nb = it % 112, n0 = nb * 32; tr_item(p.in[I_MG] + (size_t)e * 1024 * 3584, 3584, kb * 64, n0, (bf16*)(ws + WS_WMUP) + (size_t)e * 7168 * 1024, 1024, (n0 / 128) * 256 + n0 % 128, kb * 64, false, scr, lane); continue; }
        it -= 1792;
        if (it < 1792) { const int kb = it / 112, nb = it % 112, n0 = nb * 32; tr_item(p.in[I_MU2] + (size_t)e * 1024 * 3584, 3584, kb * 64, n0, (bf16*)(ws + WS_WMUP) + (size_t)e * 7168 * 1024, 1024, (n0 / 128) * 256 + 128 + n0 % 128, kb * 64, false, scr, lane); continue; }
        it -= 1792;
        { const int kb = it / 32, nb = it % 32; tr_item(p.in[I_MD] + (size_t)e * 3584 * 1024, 1024, kb * 64, nb * 32, (bf16*)(ws + WS_WMDN) + (size_t)e * 1024 * 3584, 3584, nb * 32, kb * 64, false, scr, lane); }
    }
}

__device__ __forceinline__ void phase_norm(const Params& p, int l, int which, bool first, bool router, int lane, int wave, int npart = 0, const float* part = nullptr, const float* pgate = nullptr) {
    unsigned char* ws = p.ws;
    float* X = (float*)(ws + WS_X); bf16* H = (bf16*)(ws + WS_H); const float* MOD = (const float*)(ws + WS_MOD);
    const float* g = p.in[which ? I_N2G : I_N1G] + l * 1024;
    const int gw = blockIdx.x * 8 + wave, NGW = gridDim.x * 8;
    f32x4 gq[4];
#pragma unroll
    for (int j = 0; j < 4; ++j) gq[j] = *(const f32x4*)(g + 4 * lane + 256 * j);
#define NORM_FETCH(r_, V, SH, SC) do { const int rf_ = (r_); \
        const float* src_ = first ? (rf_ < NLAT ? p.in[I_X] + (size_t)rf_ * 1024 : p.in[I_CTX] + (size_t)(rf_ - NLAT) * 1024) : X + (size_t)rf_ * 1024; \
        const float* mp_ = MOD + (size_t)(l * 3 + (rf_ < NLAT ? (rf_ >> 13) : 2)) * 6144 + which * 3072; \
        _Pragma("unroll") for (int j = 0; j < 4; ++j) V[j] = *(const f32x4*)(src_ + 4 * lane + 256 * j); \
        _Pragma("unroll") for (int j = 0; j < 4; ++j) { SH[j] = *(const f32x4*)(mp_ + 4 * lane + 256 * j); SC[j] = *(const f32x4*)(mp_ + 1024 + 4 * lane + 256 * j); } } while (0)
    f32x4 vn[4], shn[4], scn[4];
    if (gw < T) NORM_FETCH(gw, vn, shn, scn);
    for (int row = gw; row < T; row += NGW) {
        f32x4 v[4], shq[4], scq[4]; float ss = 0.f;
#pragma unroll
        for (int j = 0; j < 4; ++j) { v[j] = vn[j]; shq[j] = shn[j]; scq[j] = scn[j]; }
        asm volatile("" ::: "memory");
        NORM_FETCH(row + NGW < T ? row + NGW : row, vn, shn, scn);
        asm volatile("" ::: "memory");
#pragma unroll
        for (int j = 0; j < 4; ++j) ss += (v[j][0] * v[j][0] + v[j][1] * v[j][1]) + (v[j][2] * v[j][2] + v[j][3] * v[j][3]);
        if (first) {
#pragma unroll
            for (int j = 0; j < 4; ++j) *(f32x4*)(X + (size_t)row * 1024 + 4 * lane + 256 * j) = v[j];
        }
        if (npart > 0 && row >= NLAT) {
            ss = 0.f;
#pragma unroll
            for (int j = 0; j < 4; ++j) { const int c = 4 * lane + 256 * j; f32x4 sacc = (f32x4){0.f, 0.f, 0.f, 0.f};
                for (int k = 0; k < npart; ++k) sacc += *(const f32x4*)(part + ((size_t)k * NCTX + (row - NLAT)) * 1024 + c);
                v[j] += *(const f32x4*)(pgate + c) * sacc; *(f32x4*)(X + (size_t)row * 1024 + c) = v[j];
                ss += (v[j][0] * v[j][0] + v[j][1] * v[j][1]) + (v[j][2] * v[j][2] + v[j][3] * v[j][3]); }
        }
        const float inv = rsqrtf(wave_sum(ss) * (1.0f / 1024.0f) + 1e-6f);
        f32x4 h[4];
#pragma unroll
        for (int j = 0; j < 4; ++j) { const int c = 4 * lane + 256 * j; const f32x4 gg = gq[j], sh = shq[j], sc = scq[j];
            h[j] = (v[j] * inv * gg) * (1.0f + sc) + sh;
            u32x2 o; o.x = pk2(h[j][0], h[j][1]); o.y = pk2(h[j][2], h[j][3]); *(u32x2*)(H + (size_t)row * 1024 + c) = o; }
        if (router && row < NLAT) {
            float lg[8] = {0.f, 0.f, 0.f, 0.f, 0.f, 0.f, 0.f, 0.f};
#pragma unroll
            for (int j = 0; j < 4; ++j)
#pragma unroll
                for (int q = 0; q < 4; ++q) { const float* rp = p.in[I_ROUT] + (size_t)(4 * lane + 256 * j + q) * 8; const f32x4 r0 = *(const f32x4*)rp, r1 = *(const f32x4*)(rp + 4); const float hv = h[j][q];
                    lg[0] += hv * r0[0]; lg[1] += hv * r0[1]; lg[2] += hv * r0[2]; lg[3] += hv * r0[3]; lg[4] += hv * r1[0]; lg[5] += hv * r1[1]; lg[6] += hv * r1[2]; lg[7] += hv * r1[3]; }
#pragma unroll
            for (int e = 0; e < 8; ++e) lg[e] = wave_sum(lg[e]);
            int e0 = 0; float v0 = lg[0];
#pragma unroll
            for (int e = 1; e < 8; ++e) if (lg[e] > v0) { v0 = lg[e]; e0 = e; }
            int e1 = -1; float v1 = -3.0e38f;
#pragma unroll
            for (int e = 0; e < 8; ++e) if (e != e0 && lg[e] > v1) { v1 = lg[e]; e1 = e; }
            const float p1 = 1.0f / (1.0f + __expf(v0 - v1)), p0 = 1.0f - p1;
            if (lane < 8) ((float*)(ws + WS_COMB))[(size_t)row * 8 + lane] = lane == e0 ? p0 : (lane == e1 ? p1 : 0.0f);
        }
    }
}
#undef NORM_FETCH
__device__ __forceinline__ void phase_final(const Params& p, int lane, int wave) {
    unsigned char* ws = p.ws;
    const float* X = (const float*)(ws + WS_X); const float* g = p.in[I_FING];
    const bf16* YP = (const bf16*)(ws + WS_APERM); const bf16* PM = (const bf16*)(ws + WS_PARTM); const int* PPOS = (const int*)(ws + WS_PPOS); const float* RP = (const float*)(ws + WS_RP);
    const float* MOD1 = (const float*)(ws + WS_MOD) + (size_t)3 * 6144 + 5120;
    const int gw = blockIdx.x * 8 + wave, NGW = gridDim.x * 8;
    f32x4 gq[4];
#pragma unroll
    for (int j = 0; j < 4; ++j) gq[j] = *(const f32x4*)(g + 4 * lane + 256 * j);
    int s0n = 0, s1n = 0; float p0n = 0.f;
    if (gw < NLAT) { s0n = PPOS[2 * gw]; s1n = PPOS[2 * gw + 1]; p0n = RP[gw]; }
    for (int row = gw; row < NLAT; row += NGW) {
        const int s0 = s0n, s1 = s1n; const float p0 = p0n, p1 = 1.0f - p0;
        { const int rn = row + NGW < NLAT ? row + NGW : row; s0n = PPOS[2 * rn]; s1n = PPOS[2 * rn + 1]; p0n = RP[rn]; }
        const float* gt = MOD1 + (size_t)(row >> 13) * 6144;
        const bool big0 = s0 >= 128 * 256, big1 = s1 >= 128 * 256;
        const bf16* y0p = YP + (size_t)(big0 ? 0 : s0) * 1024; const bf16* y1p = YP + (size_t)(big1 ? 0 : s1) * 1024;
        u32x2 y0r[4], y1r[4]; f32x4 xr[4], gvr[4];
#pragma unroll
        for (int j = 0; j < 4; ++j) { const int c = 4 * lane + 256 * j; y0r[j] = *(const u32x2*)(y0p + c); y1r[j] = *(const u32x2*)(y1p + c); xr[j] = *(const f32x4*)(X + (size_t)row * 1024 + c); gvr[j] = *(const f32x4*)(gt + c); }
        f32x4 v[4]; float ss = 0.f;
#pragma unroll
        for (int j = 0; j < 4; ++j) { const int c = 4 * lane + 256 * j;
            f32x4 e0v = (f32x4){blo(y0r[j].x), bhi(y0r[j].x), blo(y0r[j].y), bhi(y0r[j].y)}, e1v = (f32x4){blo(y1r[j].x), bhi(y1r[j].x), blo(y1r[j].y), bhi(y1r[j].y)};
            if (big0) { e0v = (f32x4){0.f, 0.f, 0.f, 0.f}; for (int k = 0; k < 7; ++k) { const u32x2 y0 = *(const u32x2*)(PM + ((size_t)k * 2048 + (s0 - 128 * 256)) * 1024 + c); e0v += (f32x4){blo(y0.x), bhi(y0.x), blo(y0.y), bhi(y0.y)}; } }
            if (big1) { e1v = (f32x4){0.f, 0.f, 0.f, 0.f}; for (int k = 0; k < 7; ++k) { const u32x2 y1 = *(const u32x2*)(PM + ((size_t)k * 2048 + (s1 - 128 * 256)) * 1024 + c); e1v += (f32x4){blo(y1.x), bhi(y1.x), blo(y1.y), bhi(y1.y)}; } }
            const f32x4 mix = e0v * p0 + e1v * p1;
            v[j] = xr[j] + gvr[j] * mix;
            ss += (v[j][0] * v[j][0] + v[j][1] * v[j][1]) + (v[j][2] * v[j][2] + v[j][3] * v[j][3]); }
        const float inv = rsqrtf(wave_sum(ss) * (1.0f / 1024.0f) + 1e-6f);
#pragma unroll
        for (int j = 0; j < 4; ++j) { const int c = 4 * lane + 256 * j; *(f32x4*)(p.out + (size_t)row * 1024 + c) = v[j] * inv * gq[j]; }
    }
}

__device__ __forceinline__ void phase_norm2_moe(const Params& p, LAS unsigned char* lds, int tid, int lane, int wave) {
    unsigned char* ws = p.ws; const int l = 1;
    const float* X = (const float*)(ws + WS_X); bf16* H = (bf16*)(ws + WS_H); const float* MOD = (const float*)(ws + WS_MOD);
    int* RE = (int*)(ws + WS_RE); float* RP = (float*)(ws + WS_RP); int* SEGCNT = (int*)(ws + WS_SEGCNT);
    const float* g = p.in[I_N2G] + l * 1024;
    LAS int* wc = (LAS int*)lds;
    LAS float* RT = (LAS float*)(lds + 1024);
    for (int ch = tid; ch < 1024; ch += 512) { const f32x4 r0 = *(const f32x4*)(p.in[I_ROUT] + (size_t)ch * 8), r1 = *(const f32x4*)(p.in[I_ROUT] + (size_t)ch * 8 + 4);
        RT[0 * 1024 + ch] = r0[0]; RT[1 * 1024 + ch] = r0[1]; RT[2 * 1024 + ch] = r0[2]; RT[3 * 1024 + ch] = r0[3]; RT[4 * 1024 + ch] = r1[0]; RT[5 * 1024 + ch] = r1[1]; RT[6 * 1024 + ch] = r1[2]; RT[7 * 1024 + ch] = r1[3]; }
    __syncthreads();
    for (int seg = blockIdx.x; seg < NLAT / 64; seg += gridDim.x) {
        int cnt[8] = {0, 0, 0, 0, 0, 0, 0, 0};
        const float* mp = MOD + (size_t)(l * 3 + ((seg * 64) >> 13)) * 6144 + 3072;
        f32x4 gq[4], shq[4], scq[4], vn[4];
#pragma unroll
        for (int j = 0; j < 4; ++j) { const int c = 4 * lane + 256 * j; gq[j] = *(const f32x4*)(g + c); shq[j] = *(const f32x4*)(mp + c); scq[j] = *(const f32x4*)(mp + 1024 + c); }
#pragma unroll
        for (int j = 0; j < 4; ++j) vn[j] = *(const f32x4*)(X + (size_t)(seg * 64 + wave * 8) * 1024 + 4 * lane + 256 * j);
        for (int rr = 0; rr < 8; ++rr) {
            const int row = seg * 64 + wave * 8 + rr;
            asm volatile("" ::: "memory");
            f32x4 v[4]; float ss = 0.f;
#pragma unroll
            for (int j = 0; j < 4; ++j) v[j] = vn[j];
            { const int rn = seg * 64 + wave * 8 + (rr < 7 ? rr + 1 : 7);
#pragma unroll
              for (int j = 0; j < 4; ++j) vn[j] = *(const f32x4*)(X + (size_t)rn * 1024 + 4 * lane + 256 * j); }
#pragma unroll
            for (int j = 0; j < 4; ++j) ss += (v[j][0] * v[j][0] + v[j][1] * v[j][1]) + (v[j][2] * v[j][2] + v[j][3] * v[j][3]);
            const float inv = rsqrtf(wave_sum(ss) * (1.0f / 1024.0f) + 1e-6f);
            float lg[8] = {0.f, 0.f, 0.f, 0.f, 0.f, 0.f, 0.f, 0.f};
#pragma unroll
            for (int j = 0; j < 4; ++j) { const int c = 4 * lane + 256 * j;
                const f32x4 h = (v[j] * inv * gq[j]) * (1.0f + scq[j]) + shq[j];
                u32x2 o; o.x = pk2(h[0], h[1]); o.y = pk2(h[2], h[3]); *(u32x2*)(H + (size_t)row * 1024 + c) = o;
#pragma unroll
                for (int e = 0; e < 8; ++e) { const f32x4 w = *(const LAS f32x4*)(RT + e * 1024 + c); lg[e] += (h[0] * w[0] + h[1] * w[1]) + (h[2] * w[2] + h[3] * w[3]); } }
#pragma unroll
            for (int e = 0; e < 8; ++e) lg[e] = wave_sum(lg[e]);
            int e0 = 0; float v0 = lg[0];
#pragma unroll
            for (int e = 1; e < 8; ++e) if (lg[e] > v0) { v0 = lg[e]; e0 = e; }
            int e1 = -1; float v1 = -3.0e38f;
#pragma unroll
            for (int e = 0; e < 8; ++e) if (e != e0 && lg[e] > v1) { v1 = lg[e]; e1 = e; }
            e0 = __builtin_amdgcn_readfirstlane(e0); e1 = __builtin_amdgcn_readfirstlane(e1);
            const float p1 = 1.0f / (1.0f + __expf(v0 - v1));
            if (lane == 0) { RE[row] = e0 | (e1 << 8); RP[row] = 1.0f - p1; }
#pragma unroll
            for (int e = 0; e < 8; ++e) cnt[e] += (e0 == e ? 1 : 0) + (e1 == e ? 1 : 0);
        }
        if (lane < 8) { int c = 0;
#pragma unroll
            for (int e = 0; e < 8; ++e) c = (lane == e) ? cnt[e] : c;
            wc[wave * 8 + lane] = c; }
        __syncthreads();
        if (tid < 8) { int c = 0;
#pragma unroll
            for (int w = 0; w < 8; ++w) c += wc[w * 8 + tid];
            SEGCNT[seg * 8 + tid] = c; }
        __syncthreads();
    }
}
__device__ __forceinline__ void phase_moe_prep(const Params& p, LAS unsigned char* lds, int tid, int lane, int wave) {
    unsigned char* ws = p.ws;
    const int* RE = (const int*)(ws + WS_RE); const float* RP = (const float*)(ws + WS_RP); const int* SEGCNT = (const int*)(ws + WS_SEGCNT);
    int* PROW = (int*)(ws + WS_PROW); float* PGW = (float*)(ws + WS_PGW); int* TOFF = (int*)(ws + WS_TOFF);
    const bf16* H = (const bf16*)(ws + WS_H); bf16* AP = (bf16*)(ws + WS_APERM);
    LAS int* sc = (LAS int*)lds;
    LAS int* tot = (LAS int*)(lds + 8192);
    LAS int* perm = (LAS int*)(lds + 8192 + 256);
    constexpr int NSEG = NLAT / 64;
    for (int i = tid; i < NSEG * 8; i += 512) sc[i] = SEGCNT[i];
    __syncthreads();
    if (tid < 8) { int t = 0; for (int s2 = 0; s2 < NSEG; ++s2) t += sc[s2 * 8 + tid]; tot[tid] = t; }
    __syncthreads();
    if (tid == 0) { int o = 0; for (int e = 0; e < 8; ++e) { tot[8 + e] = o; o += (tot[e] + 255) >> 8; } tot[16] = o;
        if (blockIdx.x == 0) { for (int e = 0; e <= 8; ++e) TOFF[e] = tot[8 + e]; } }
    __syncthreads();
    for (int seg = blockIdx.x; seg < NSEG; seg += gridDim.x) {
        if (tid < 8) { int bs = 0; for (int s2 = 0; s2 < seg; ++s2) bs += sc[s2 * 8 + tid]; tot[32 + tid] = bs; }
        __syncthreads();
        if (wave == 0) {
            const int row = seg * 64 + lane; const int re = RE[row], e0 = re & 0xff, e1 = re >> 8; const float p0 = RP[row];
            int s0 = 0, s1 = 0;
#pragma unroll
            for (int e = 0; e < 8; ++e) { const bool mine = (e0 == e) || (e1 == e); const unsigned long long m = __ballot(mine);
                const int rank = __popcll(m & ((1ull << lane) - 1ull)); const int slot = (tot[8 + e] << 8) + tot[32 + e] + rank;
                s0 = (e0 == e) ? slot : s0; s1 = (e1 == e) ? slot : s1; }
            PROW[s0] = row; PGW[s0] = p0; PROW[s1] = row; PGW[s1] = 1.0f - p0;
            ((int*)(ws + WS_PPOS))[2 * row] = s0; ((int*)(ws + WS_PPOS))[2 * row + 1] = s1;
            perm[lane * 2] = s0; perm[lane * 2 + 1] = s1;
        }
        __syncthreads();
        for (int rr = 0; rr < 8; ++rr) { const int lr = wave * 8 + rr, row = seg * 64 + lr; const int s0 = perm[lr * 2], s1 = perm[lr * 2 + 1];
            const u32x4 a = *(const u32x4*)(H + (size_t)row * 1024 + lane * 16), b2 = *(const u32x4*)(H + (size_t)row * 1024 + lane * 16 + 8);
            *(u32x4*)(AP + (size_t)s0 * 1024 + lane * 16) = a; *(u32x4*)(AP + (size_t)s0 * 1024 + lane * 16 + 8) = b2;
            *(u32x4*)(AP + (size_t)s1 * 1024 + lane * 16) = a; *(u32x4*)(AP + (size_t)s1 * 1024 + lane * 16 + 8) = b2; }
        __syncthreads();
    }
    for (int e = blockIdx.x; e < 8; e += gridDim.x) {
        const int lo = (tot[8 + e] << 8) + tot[e], hi = tot[9 + e] << 8;
        for (int r = lo + wave; r < hi; r += 8) { if (lane == 0) { PROW[r] = -1; PGW[r] = 0.f; }
            *(u32x4*)(AP + (size_t)r * 1024 + lane * 16) = (u32x4){0u, 0u, 0u, 0u}; *(u32x4*)(AP + (size_t)r * 1024 + lane * 16 + 8) = (u32x4){0u, 0u, 0u, 0u}; }
    }
}

typedef short bf16x8s __attribute__((ext_vector_type(8)));
__device__ __forceinline__ unsigned cvtpk_(float lo, float hi) { typedef float f2_ __attribute__((ext_vector_type(2))); typedef __bf16 b2_ __attribute__((ext_vector_type(2))); f2_ v = {lo, hi}; return __builtin_bit_cast(unsigned, __builtin_convertvector(v, b2_)); }
constexpr int SLR_ROWS = 33, SLR_PITCH = 520;
__device__ __forceinline__ void phase_stream_lr(const Params& p, int l, LAS unsigned char* lds, int tid, int lane, int wave) {
    unsigned char* ws = p.ws;
    const bf16* P = (const bf16*)(ws + WS_P);
    bf16* R = (bf16*)(ws + WS_R); bf16* V = (bf16*)(ws + WS_V); bf16* KKn = (bf16*)(ws + WS_KKN); bf16* U = (bf16*)(ws + WS_U);
    LAS bf16* lrin = (LAS bf16*)lds;
    LAS bf16* kbuf = (LAS bf16*)(lds + 48 * SLR_PITCH * 2);
    LAS bf16* kkbuf = (LAS bf16*)(lds + (48 + SLR_ROWS) * SLR_PITCH * 2);
    const int hrow = tid >> 8, t8 = tid & 255, c8 = 8 * t8;
    float mu8[8]; { const f32x4 m0 = *(const f32x4*)(p.in[I_MU] + l * 2048 + c8), m1 = *(const f32x4*)(p.in[I_MU] + l * 2048 + c8 + 4); mu8[0] = m0[0]; mu8[1] = m0[1]; mu8[2] = m0[2]; mu8[3] = m0[3]; mu8[4] = m1[0]; mu8[5] = m1[1]; mu8[6] = m1[2]; mu8[7] = m1[3]; }
    for (int i = tid; i < 15 * SLR_PITCH / 2; i += 512) ((LAS unsigned*)(lrin + SLR_ROWS * SLR_PITCH))[i] = 0u;
    const int r16 = lane & 15, g4 = lane >> 4;
    for (int tq = blockIdx.x; tq < T / SLR_ROWS; tq += gridDim.x) {
        const int tix = (gridDim.x == 256) ? ((tq & 7) * 64 + ((tq >> 3) & 31) + 32 * (tq >> 8)) : tq;
        const int row0 = tix * SLR_ROWS;
        for (int pr0 = 0; pr0 < 18; pr0 += 3) {
            u32x4 ow3[3], nb3[3][4], uw3[3];
#pragma unroll
            for (int u = 0; u < 3; ++u) { const int lr = 2 * (pr0 + u) + hrow, row = row0 + (lr < SLR_ROWS ? lr : 0); int nr[4];
                if (row < NLAT) { const int t = row & (SEQ - 1), gc = t & 63, gr = t >> 6; nr[0] = gc > 0 ? row - 1 : -1; nr[1] = gc < 63 ? row + 1 : -1; nr[2] = gr > 0 ? row - 64 : -1; nr[3] = gr < 127 ? row + 64 : -1; }
                else { const int t = (row - NLAT) & (CTXL - 1); nr[0] = nr[2] = t > 0 ? row - 1 : -1; nr[1] = nr[3] = t < CTXL - 1 ? row + 1 : -1; }
                ow3[u] = *(const u32x4*)(P + (size_t)row * DIN + c8);
#pragma unroll
                for (int j = 0; j < 4; ++j) nb3[u][j] = nr[j] >= 0 ? *(const u32x4*)(P + (size_t)nr[j] * DIN + c8) : (u32x4){0u, 0u, 0u, 0u};
                if (t8 < 64) uw3[u] = *(const u32x4*)(P + (size_t)row * DIN + 2048 + c8); }
#pragma unroll
            for (int u = 0; u < 3; ++u) { const int lr = 2 * (pr0 + u) + hrow, row = row0 + lr;
              if (lr < SLR_ROWS) {
                const u32x4 ow = ow3[u];
                const float own[8] = {blo(ow.x), bhi(ow.x), blo(ow.y), bhi(ow.y), blo(ow.z), bhi(ow.z), blo(ow.w), bhi(ow.w)};
                const float shv[8] = {blo(nb3[u][0].x), bhi(nb3[u][1].x), blo(nb3[u][2].y), bhi(nb3[u][3].y), blo(nb3[u][0].z), bhi(nb3[u][1].z), blo(nb3[u][2].w), bhi(nb3[u][3].w)};
                float sv[8];
#pragma unroll
                for (int q = 0; q < 8; ++q) sv[q] = own[q] + (shv[q] - own[q]) * mu8[q];
                if (c8 < 512) { u32x4 o; o.x = cvtpk_(sv[0], sv[1]); o.y = cvtpk_(sv[2], sv[3]); o.z = cvtpk_(sv[4], sv[5]); o.w = cvtpk_(sv[6], sv[7]); *(u32x4*)(R + (size_t)row * 512 + c8) = o; }
                else if (c8 < 1024) { const int cc = c8 - 512; u32x4 o; o.x = cvtpk_(sv[0], sv[1]); o.y = cvtpk_(sv[2], sv[3]); o.z = cvtpk_(sv[4], sv[5]); o.w = cvtpk_(sv[6], sv[7]); *(LAS u32x4*)(kbuf + lr * SLR_PITCH + cc) = o;
                    const f32x4 ka_ = *(const f32x4*)(p.in[I_KK] + l * 512 + cc), kb_ = *(const f32x4*)(p.in[I_KK] + l * 512 + cc + 4); const float kkw[8] = {ka_[0], ka_[1], ka_[2], ka_[3], kb_[0], kb_[1], kb_[2], kb_[3]};
                    float q8[8]; float ssq = 0.f;
#pragma unroll
                    for (int q = 0; q < 8; ++q) { q8[q] = sv[q] * kkw[q]; ssq += q8[q] * q8[q]; }
                    ssq += __shfl_xor(ssq, 1); ssq += __shfl_xor(ssq, 2); ssq += __shfl_xor(ssq, 4);
                    const float inv = 1.0f / fmaxf(sqrtf(ssq), 1e-12f);
                    u32x4 o2; o2.x = cvtpk_(q8[0] * inv, q8[1] * inv); o2.y = cvtpk_(q8[2] * inv, q8[3] * inv); o2.z = cvtpk_(q8[4] * inv, q8[5] * inv); o2.w = cvtpk_(q8[6] * inv, q8[7] * inv);
                    *(u32x4*)(KKn + (size_t)row * 512 + cc) = o2; *(LAS u32x4*)(kkbuf + lr * SLR_PITCH + cc) = o2; }
                else if (c8 < 1536) { u32x4 o; o.x = cvtpk_(sv[0], sv[1]); o.y = cvtpk_(sv[2], sv[3]); o.z = cvtpk_(sv[4], sv[5]); o.w = cvtpk_(sv[6], sv[7]); *(u32x4*)(V + (size_t)row * 512 + c8 - 1024) = o; }
                else { const int cc = c8 - 1536; float f[8];
#pragma unroll
                    for (int q = 0; q < 8; ++q) { const float e2 = __expf(2.0f * sv[q]); f[q] = cc < 128 ? 1.0f - 2.0f * __builtin_amdgcn_rcpf(e2 + 1.0f) : (cc < 256 ? sv[q] : sigm(sv[q])); }
                    u32x4 o; o.x = cvtpk_(f[0], f[1]); o.y = cvtpk_(f[2], f[3]); o.z = cvtpk_(f[4], f[5]); o.w = cvtpk_(f[6], f[7]); *(LAS u32x4*)(lrin + lr * SLR_PITCH + cc) = o; }
                if (t8 < 64) { int tbu, ju; if (row < NLAT) { const int bb_ = row >> 13, tt_ = row & (SEQ - 1); tbu = bb_ * NCH + 4 + (tt_ >> 6); ju = tt_ & 63; } else { const int rc = row - NLAT, bb_ = rc >> 8, tt_ = rc & 255; tbu = bb_ * NCH + (tt_ >> 6); ju = tt_ & 63; }
                    *(u32x4*)(U + ((size_t)((c8 >> 4) * 64 + ju) * (2 * NCH) + tbu) * 16 + (c8 & 15)) = uw3[u]; }
              }
            }
        }
        __syncthreads();
#pragma unroll 1
        for (int d = 0; d < 2; ++d) {
            const bf16* Wd = (const bf16*)(ws + WS_WLR) + (size_t)(l * 2 + d) * 131072 + 8 * g4;
            const size_t dT = (size_t)d * T * 512;
#pragma unroll
            for (int sec = 0; sec < 3; ++sec) {
                constexpr int dummy_ = 0; (void)dummy_;
                const int KK_ = sec == 2 ? 128 : 64, NKS = sec == 2 ? 4 : 2, koff = sec == 0 ? d * 64 : (sec == 1 ? 128 + d * 64 : 256 + d * 128);
                const bf16* Ws = Wd + (sec == 0 ? 0 : (sec == 1 ? 32768 : 65536));
#pragma unroll
                for (int i2 = 0; i2 < 4; i2 += 2) {
                bf16x8s wf[2][4];
#pragma unroll
                for (int i = 0; i < 2; ++i)
#pragma unroll
                    for (int ks = 0; ks < 4; ++ks) if (ks < NKS) wf[i][ks] = *(const bf16x8s*)(Ws + (size_t)(16 * (wave + 8 * (i2 + i)) + r16) * KK_ + 32 * ks);
#pragma unroll
                for (int ii = 0; ii < 2; ++ii) { const int i = i2 + ii;
                    const int c = 16 * (wave + 8 * i) + 4 * g4;
                    f32x4 acc[3];
#pragma unroll
                    for (int rt = 0; rt < 3; ++rt) acc[rt] = (f32x4){0.f, 0.f, 0.f, 0.f};
#pragma unroll
                    for (int ks = 0; ks < 4; ++ks) if (ks < NKS) {
#pragma unroll
                        for (int rt = 0; rt < 3; ++rt) { const bf16x8s bq = *(const LAS bf16x8s*)(lrin + (16 * rt + r16) * SLR_PITCH + koff + 32 * ks + 8 * g4);
                            acc[rt] = __builtin_amdgcn_mfma_f32_16x16x32_bf16(wf[ii][ks], bq, acc[rt], 0, 0, 0); } }
                    if (sec == 0) { const f32x4 w0 = *(const f32x4*)(p.in[I_W0] + l * 1024 + d * 512 + c); float* LW = (float*)(ws + WS_LW) + dT;
#pragma unroll
                        for (int rt = 0; rt < 3; ++rt) { const int lr = 16 * rt + r16; if (lr < SLR_ROWS) { f32x4 o;
#pragma unroll
                                for (int q = 0; q < 4; ++q) o[q] = -sigm(w0[q] + acc[rt][q]) * 0.60653065971f;
                                *(f32x4*)(LW + (size_t)(row0 + lr) * 512 + c) = o; } }
                    } else if (sec == 1) { const f32x4 a0 = *(const f32x4*)(p.in[I_A0] + l * 1024 + d * 512 + c), ka = *(const f32x4*)(p.in[I_KA] + l * 512 + c);
                        bf16* KT = (bf16*)(ws + WS_KT) + dT; bf16* BB = (bf16*)(ws + WS_BB) + dT;
#pragma unroll
                        for (int rt = 0; rt < 3; ++rt) { const int lr = 16 * rt + r16; if (lr < SLR_ROWS) {
                                const u32x2 k4 = *(const LAS u32x2*)(kbuf + lr * SLR_PITCH + c), q4 = *(const LAS u32x2*)(kkbuf + lr * SLR_PITCH + c);
                                const float kf[4] = {blo(k4.x), bhi(k4.x), blo(k4.y), bhi(k4.y)}, qf[4] = {blo(q4.x), bhi(q4.x), blo(q4.y), bhi(q4.y)}; float kt[4], bb[4];
#pragma unroll
                                for (int q = 0; q < 4; ++q) { const float a = sigm(a0[q] + acc[rt][q]); kt[q] = kf[q] * (1.0f + (a - 1.0f) * ka[q]); bb[q] = qf[q] * a; }
                                u32x2 o1, o2; o1.x = cvtpk_(kt[0], kt[1]); o1.y = cvtpk_(kt[2], kt[3]); o2.x = cvtpk_(bb[0], bb[1]); o2.y = cvtpk_(bb[2], bb[3]);
                                *(u32x2*)(KT + (size_t)(row0 + lr) * 512 + c) = o1; *(u32x2*)(BB + (size_t)(row0 + lr) * 512 + c) = o2; } }
                    } else { bf16* GD = (bf16*)(ws + WS_GD) + dT;
#pragma unroll
                        for (int rt = 0; rt < 3; ++rt) { const int lr = 16 * rt + r16; if (lr < SLR_ROWS) { u32x2 o; o.x = cvtpk_(acc[rt][0], acc[rt][1]); o.y = cvtpk_(acc[rt][2], acc[rt][3]);
                                *(u32x2*)(GD + (size_t)(row0 + lr) * 512 + c) = o; } }
                    }
                    asm volatile("" ::: "memory");
                }
                }
            }
        }
        __syncthreads();
    }
}

typedef short bf16x8 __attribute__((ext_vector_type(8)));
typedef float f32x2v __attribute__((ext_vector_type(2)));
typedef __bf16 bf16x2v __attribute__((ext_vector_type(2)));
__device__ __forceinline__ unsigned cvtpk(float lo, float hi) { f32x2v v = {lo, hi}; return __builtin_bit_cast(unsigned, __builtin_convertvector(v, bf16x2v)); }
__device__ __forceinline__ int lds_off(int slot, int row, int col) { return slot * 8192 + row * 128 + ((((col >> 3) ^ (row & 7) ^ ((row & 8) ? 7 : 0) ^ ((row >> 3) & 6))) << 4) + (col & 7) * 2; }
struct Acc2 { f32x4 t[2]; };
__device__ __forceinline__ void prod2(LAS unsigned char* lds, int aslot, int btslot, int wave, int lane, Acc2& acc) {
    const int tr = wave >> 1, r = lane & 15, g = lane >> 4;
#pragma unroll
    for (int ks = 0; ks < 2; ++ks) {
        const bf16x8 a = *(const LAS bf16x8*)(lds + lds_off(aslot, 16 * tr + r, 32 * ks + 8 * g));
#pragma unroll
        for (int t = 0; t < 2; ++t) { const int tc = 2 * (wave & 1) + t;
            const bf16x8 bb = *(const LAS bf16x8*)(lds + lds_off(btslot, 16 * tc + r, 32 * ks + 8 * g));
            acc.t[t] = __builtin_amdgcn_mfma_f32_16x16x32_bf16(a, bb, acc.t[t], 0, 0, 0); }
    }
}
__device__ __forceinline__ void wr_tr(LAS unsigned char* lds, int slot, int wave, int lane, const Acc2& acc) {
    const int tr = wave >> 1, r = lane & 15, g = lane >> 4;
#pragma unroll
    for (int t = 0; t < 2; ++t) { const int col = 16 * (2 * (wave & 1) + t) + r;
        u32x2 o; o.x = cvtpk(acc.t[t][0], acc.t[t][1]); o.y = cvtpk(acc.t[t][2], acc.t[t][3]);
        *(LAS u32x2*)(lds + lds_off(slot, col, 16 * tr + 4 * g)) = o; }
}
struct Frag2 { bf16x8 a[2]; bf16x8 b[2][2]; };
__device__ __forceinline__ void prod2_ld(LAS unsigned char* lds, int aslot, int btslot, int wave, int lane, Frag2& f) {
    const int tr = wave >> 1, r = lane & 15, g = lane >> 4;
#pragma unroll
    for (int ks = 0; ks < 2; ++ks) {
        f.a[ks] = *(const LAS bf16x8*)(lds + lds_off(aslot, 16 * tr + r, 32 * ks + 8 * g));
#pragma unroll
        for (int t = 0; t < 2; ++t) f.b[ks][t] = *(const LAS bf16x8*)(lds + lds_off(btslot, 16 * (2 * (wave & 1) + t) + r, 32 * ks + 8 * g)); }
}
__device__ __forceinline__ void prod2_mm(const Frag2& f, Acc2& acc) {
#pragma unroll
    for (int ks = 0; ks < 2; ++ks)
#pragma unroll
        for (int t = 0; t < 2; ++t) acc.t[t] = __builtin_amdgcn_mfma_f32_16x16x32_bf16(f.a[ks], f.b[ks][t], acc.t[t], 0, 0, 0);
}
__device__ __forceinline__ void phase_chunk(const Params& p, int l, LAS unsigned char* lds, int tid, int lane, int wave) {
    unsigned char* ws = p.ws;
    const bf16* R = (const bf16*)(ws + WS_R); const bf16* V = (const bf16*)(ws + WS_V); const bf16* KKn = (const bf16*)(ws + WS_KKN);
    LAS float* Lf = (LAS float*)(lds + 14 * 8192);
    LAS float* segtot = (LAS float*)(lds + 13 * 8192);
    LAS float* gc = (LAS float*)(lds + LDS_GC);
    const int tr = wave >> 1, r16 = lane & 15, g4 = lane >> 4;
    const int pos = tid >> 3, c8 = (tid & 7) * 8;
    u32x4 n_kk8, n_b8, n_kt8, n_r8, n_v8; f32x4 n_l0, n_l1;
#define CHUNK_FETCH(cc_) do { const int h_ = (cc_) & 7, j_ = ((cc_) >> 3) % NCH, db_ = ((cc_) >> 3) / NCH, b_ = db_ & 1, d_ = db_ >> 1; \
        const size_t go_ = (size_t)row_of(b_, d_, j_ * 64 + pos) * 512 + h_ * 64 + c8, do_ = (size_t)d_ * T * 512 + go_; \
        n_kk8 = *(const u32x4*)(KKn + go_); n_b8 = *(const u32x4*)((const bf16*)(ws + WS_BB) + do_); n_kt8 = *(const u32x4*)((const bf16*)(ws + WS_KT) + do_); n_r8 = *(const u32x4*)(R + go_); n_v8 = *(const u32x4*)(V + go_); \
        n_l0 = *(const f32x4*)((const float*)(ws + WS_LW) + do_); n_l1 = *(const f32x4*)((const float*)(ws + WS_LW) + do_ + 4); } while (0)
    if ((int)blockIdx.x < NCC) CHUNK_FETCH((int)blockIdx.x);
    asm volatile("" :: "v"(n_kk8), "v"(n_b8), "v"(n_kt8), "v"(n_r8), "v"(n_v8), "v"(n_l0), "v"(n_l1));
    for (int cc = blockIdx.x; cc < NCC; cc += gridDim.x) {
        const int h = cc & 7, j = (cc >> 3) % NCH, db = (cc >> 3) / NCH, b = db & 1, d = db >> 1;
        bf16* CH = (bf16*)(ws + WS_CH) + (size_t)cc * 16384;
        const int row = row_of(b, d, j * 64 + pos);
        const u32x4 kk8 = n_kk8, b8 = n_b8, kt8 = n_kt8, r8 = n_r8, v8 = n_v8; const f32x4 l0 = n_l0, l1 = n_l1;
        const f32x4 rk0_ = *(const f32x4*)(p.in[I_RK] + l * 512 + h * 64 + c8), rk1_ = *(const f32x4*)(p.in[I_RK] + l * 512 + h * 64 + c8 + 4);
        asm volatile("" ::: "memory");
        { const int ccn = cc + (int)gridDim.x < NCC ? cc + (int)gridDim.x : cc; CHUNK_FETCH(ccn); }
        *(LAS f32x4*)(Lf + pos * 64 + c8) = l0; *(LAS f32x4*)(Lf + pos * 64 + c8 + 4) = l1;
        __syncthreads();
        { const int ch = tid & 63, seg = tid >> 6; float pre[8]; float run = 0.f;
#pragma unroll
          for (int q = 0; q < 8; ++q) { run += Lf[(8 * seg + q) * 64 + ch]; pre[q] = run; }
          segtot[seg * 64 + ch] = run;
          __syncthreads();
          float off = 0.f;
#pragma unroll
          for (int s2 = 0; s2 < 8; ++s2) off += (s2 < seg) ? segtot[s2 * 64 + ch] : 0.f;
#pragma unroll
          for (int q = 0; q < 8; ++q) Lf[(8 * seg + q) * 64 + ch] = pre[q] + off;
          if (seg == 7) gc[ch] = pre[7] + off; }
        __syncthreads();
        {
            const f32x4 g0 = *(const LAS f32x4*)(Lf + pos * 64 + c8), g1 = *(const LAS f32x4*)(Lf + pos * 64 + c8 + 4);
            const f32x4 q0 = *(const LAS f32x4*)(gc + c8), q1 = *(const LAS f32x4*)(gc + c8 + 4);
            const float G[8] = {g0[0], g0[1], g0[2], g0[3], g1[0], g1[1], g1[2], g1[3]}, GC[8] = {q0[0], q0[1], q0[2], q0[3], q1[0], q1[1], q1[2], q1[3]};
            const float Lv[8] = {l0[0], l0[1], l0[2], l0[3], l1[0], l1[1], l1[2], l1[3]};
            const unsigned kkw[4] = {kk8.x, kk8.y, kk8.z, kk8.w}, bw[4] = {b8.x, b8.y, b8.z, b8.w}, ktw[4] = {kt8.x, kt8.y, kt8.z, kt8.w}, rw[4] = {r8.x, r8.y, r8.z, r8.w}, vw[4] = {v8.x, v8.y, v8.z, v8.w};
            float at[8], bt[8], kb[8], qt[8], bg[8], kg[8], vv[8]; float bon = 0.f;
            const float rk[8] = {rk0_[0], rk0_[1], rk0_[2], rk0_[3], rk1_[0], rk1_[1], rk1_[2], rk1_[3]};
#pragma unroll
            for (int q = 0; q < 8; ++q) { const int w2 = q >> 1; const bool hi = q & 1;
                const float kkv = hi ? bhi(kkw[w2]) : blo(kkw[w2]), bv = hi ? bhi(bw[w2]) : blo(bw[w2]), ktv = hi ? bhi(ktw[w2]) : blo(ktw[w2]), rv = hi ? bhi(rw[w2]) : blo(rw[w2]);
                vv[q] = hi ? bhi(vw[w2]) : blo(vw[w2]);
                const float eg = __expf(G[q]), egi = __expf(-G[q]), egp = __expf(G[q] - Lv[q]), egc = __expf(GC[q] - G[q]);
                at[q] = -kkv * egp; bt[q] = bv * egi; kb[q] = ktv * egi; qt[q] = rv * eg; bg[q] = bv * egc; kg[q] = ktv * egc;
                bon += rv * ktv * rk[q]; }
            bon += __shfl_xor(bon, 1); bon += __shfl_xor(bon, 2); bon += __shfl_xor(bon, 4);
            if ((tid & 7) == 0) ((float*)(ws + WS_BONUS))[((size_t)d * T + row) * 8 + h] = bon;
            u32x4 o;
            o.x = cvtpk(at[0], at[1]); o.y = cvtpk(at[2], at[3]); o.z = cvtpk(at[4], at[5]); o.w = cvtpk(at[6], at[7]); *(LAS u32x4*)(lds + lds_off(0, pos, c8)) = o;
            o.x = cvtpk(bt[0], bt[1]); o.y = cvtpk(bt[2], bt[3]); o.z = cvtpk(bt[4], bt[5]); o.w = cvtpk(bt[6], bt[7]); *(LAS u32x4*)(lds + lds_off(2, pos, c8)) = o;
            o.x = cvtpk(kb[0], kb[1]); o.y = cvtpk(kb[2], kb[3]); o.z = cvtpk(kb[4], kb[5]); o.w = cvtpk(kb[6], kb[7]); *(LAS u32x4*)(lds + lds_off(3, pos, c8)) = o;
            o.x = cvtpk(qt[0], qt[1]); o.y = cvtpk(qt[2], qt[3]); o.z = cvtpk(qt[4], qt[5]); o.w = cvtpk(qt[6], qt[7]); *(LAS u32x4*)(lds + lds_off(4, pos, c8)) = o;
            const unsigned atw[4] = {cvtpk(at[0], at[1]), cvtpk(at[2], at[3]), cvtpk(at[4], at[5]), cvtpk(at[6], at[7])};
            const unsigned bgw[4] = {cvtpk(bg[0], bg[1]), cvtpk(bg[2], bg[3]), cvtpk(bg[4], bg[5]), cvtpk(bg[6], bg[7])};
            const unsigned kgw[4] = {cvtpk(kg[0], kg[1]), cvtpk(kg[2], kg[3]), cvtpk(kg[4], kg[5]), cvtpk(kg[6], kg[7])};
#pragma unroll
            for (int q = 0; q < 8; ++q) { const int w2 = q >> 1, sh = (q & 1) * 16;
                *(LAS unsigned short*)(lds + lds_off(1, c8 + q, pos)) = (unsigned short)(atw[w2] >> sh);
                *(LAS unsigned short*)(lds + lds_off(5, c8 + q, pos)) = (unsigned short)(vw[w2] >> sh);
                *(LAS unsigned short*)(lds + lds_off(6, c8 + q, pos)) = (unsigned short)(bgw[w2] >> sh);
                *(LAS unsigned short*)(lds + lds_off(7, c8 + q, pos)) = (unsigned short)(kgw[w2] >> sh); }
        }
        __syncthreads();
        Acc2 accTt;
        { Frag2 f0, f1, f2, f3, f4;
          prod2_ld(lds, 0, 2, wave, lane, f0); prod2_ld(lds, 2, 0, wave, lane, f1); prod2_ld(lds, 3, 0, wave, lane, f2); prod2_ld(lds, 2, 4, wave, lane, f3); prod2_ld(lds, 3, 4, wave, lane, f4);
          Acc2 a0, a1, a2, a3, a4; a0.t[0] = a0.t[1] = a1.t[0] = a1.t[1] = a2.t[0] = a2.t[1] = a3.t[0] = a3.t[1] = a4.t[0] = a4.t[1] = (f32x4){0.f, 0.f, 0.f, 0.f};
          prod2_mm(f0, a0); prod2_mm(f1, a1); prod2_mm(f2, a2); prod2_mm(f3, a3); prod2_mm(f4, a4);
#pragma unroll
          for (int t = 0; t < 2; ++t) { const int col = 16 * (2 * (wave & 1) + t) + r16;
#pragma unroll
              for (int q = 0; q < 4; ++q) { const int rw_ = 16 * tr + 4 * g4 + q;
                  a0.t[t][q] = col < rw_ ? a0.t[t][q] : 0.f;
                  a1.t[t][q] = col > rw_ ? a1.t[t][q] : 0.f; accTt.t[t][q] = a1.t[t][q] + (col == rw_ ? 1.f : 0.f);
                  a2.t[t][q] = col > rw_ ? a2.t[t][q] : 0.f;
                  a3.t[t][q] = col >= rw_ ? a3.t[t][q] : 0.f;
                  a4.t[t][q] = col >= rw_ ? a4.t[t][q] : 0.f; } }
          wr_tr(lds, 9, wave, lane, a0);
          wr_tr(lds, 8, wave, lane, a1); wr_tr(lds, 10, wave, lane, accTt);
          wr_tr(lds, 11, wave, lane, a2);
          wr_tr(lds, 12, wave, lane, a3);
          wr_tr(lds, 13, wave, lane, a4); }
        __syncthreads();
        { Frag2 f1, f2, f3; prod2_ld(lds, 8, 9, wave, lane, f1); prod2_ld(lds, 9, 8, wave, lane, f2); prod2_ld(lds, 11, 5, wave, lane, f3);
          Acc2 a1, a2, a3; a1.t[0] = a1.t[1] = a2.t[0] = a2.t[1] = a3.t[0] = a3.t[1] = (f32x4){0.f, 0.f, 0.f, 0.f};
          prod2_mm(f1, a1); prod2_mm(f2, a2); prod2_mm(f3, a3);
          wr_tr(lds, 3, wave, lane, a1);
          wr_tr(lds, 2, wave, lane, a2);
          wr_tr(lds, 14, wave, lane, a3); }
        __syncthreads();
#pragma unroll
        for (int lvl = 1; lvl <= 4; ++lvl) {
            const int zc = (lvl & 1) ? 2 : 8, zn = (lvl & 1) ? 8 : 2, tc_ = (lvl & 1) ? 10 : 15, tn = (lvl & 1) ? 15 : 10;
            if (lvl < 4) { Frag2 f1, f2, f3; prod2_ld(lds, zc + 1, tc_, wave, lane, f1); prod2_ld(lds, zc, zc + 1, wave, lane, f2); prod2_ld(lds, zc + 1, zc, wave, lane, f3);
                Acc2 a2, a3; a2.t[0] = a2.t[1] = a3.t[0] = a3.t[1] = (f32x4){0.f, 0.f, 0.f, 0.f};
                prod2_mm(f1, accTt); prod2_mm(f2, a2); prod2_mm(f3, a3);
                wr_tr(lds, tn, wave, lane, accTt); wr_tr(lds, zn + 1, wave, lane, a2); wr_tr(lds, zn, wave, lane, a3); }
            else { prod2(lds, zc + 1, tc_, wave, lane, accTt); wr_tr(lds, tn, wave, lane, accTt); }
            __syncthreads();
        }
        { Frag2 f1, f2; prod2_ld(lds, 10, 1, wave, lane, f1); prod2_ld(lds, 10, 14, wave, lane, f2);
          Acc2 a1, a2; a1.t[0] = a1.t[1] = a2.t[0] = a2.t[1] = (f32x4){0.f, 0.f, 0.f, 0.f};
          prod2_mm(f1, a1); prod2_mm(f2, a2);
          wr_tr(lds, 8, wave, lane, a1); wr_tr(lds, 9, wave, lane, a2); }
        __syncthreads();
        { Acc2 a; a.t[0] = a.t[1] = (f32x4){0.f, 0.f, 0.f, 0.f}; prod2(lds, 8, 12, wave, lane, a);
#pragma unroll
          for (int t = 0; t < 2; ++t) { const int col = 16 * (2 * (wave & 1) + t) + r16, r0 = 16 * tr + 4 * g4;
              const u32x2 qq = *(const LAS u32x2*)(lds + lds_off(4, col, r0));
              u32x2 o; o.x = cvtpk(a.t[t][0] + blo(qq.x), a.t[t][1] + bhi(qq.x)); o.y = cvtpk(a.t[t][2] + blo(qq.y), a.t[t][3] + bhi(qq.y));
              *(u32x2*)(CH + 8192 + (((col >> 4) * 2 + (tr >> 1)) * 64 + g4 * 16 + (col & 15)) * 8 + (tr & 1) * 4) = o; } }
        { Acc2 a; a.t[0] = a.t[1] = (f32x4){0.f, 0.f, 0.f, 0.f}; prod2(lds, 12, 9, wave, lane, a); prod2(lds, 13, 5, wave, lane, a);
#pragma unroll
          for (int t = 0; t < 2; ++t) { const int col = 16 * (2 * (wave & 1) + t) + r16, r0 = 16 * tr + 4 * g4;
              u32x2 o; o.x = cvtpk(a.t[t][0], a.t[t][1]); o.y = cvtpk(a.t[t][2], a.t[t][3]); *(u32x2*)(CH + 12288 + (((col >> 4) * 4 + tr) * 64 + g4 * 16 + (col & 15)) * 4) = o; } }
        { Acc2 a; a.t[0] = a.t[1] = (f32x4){0.f, 0.f, 0.f, 0.f}; prod2(lds, 8, 6, wave, lane, a);
#pragma unroll
          for (int t = 0; t < 2; ++t) { const int col = 16 * (2 * (wave & 1) + t) + r16, r0 = 16 * tr + 4 * g4; const float dg = __expf(gc[col]);
#pragma unroll
              for (int q = 0; q < 4; ++q) a.t[t][q] += (r0 + q == col) ? dg : 0.f;
              u32x2 o; o.x = cvtpk(a.t[t][0], a.t[t][1]); o.y = cvtpk(a.t[t][2], a.t[t][3]); *(u32x2*)(CH + (((col >> 4) * 2 + (tr >> 1)) * 64 + g4 * 16 + (col & 15)) * 8 + (tr & 1) * 4) = o; } }
        { Acc2 a; a.t[0] = a.t[1] = (f32x4){0.f, 0.f, 0.f, 0.f}; prod2(lds, 6, 9, wave, lane, a); prod2(lds, 7, 5, wave, lane, a);
#pragma unroll
          for (int t = 0; t < 2; ++t) { const int col = 16 * (2 * (wave & 1) + t) + r16, r0 = 16 * tr + 4 * g4;
              u32x2 o; o.x = cvtpk(a.t[t][0], a.t[t][1]); o.y = cvtpk(a.t[t][2], a.t[t][3]); *(u32x2*)(CH + 4096 + (((col >> 4) * 4 + tr) * 64 + g4 * 16 + (col & 15)) * 4) = o; } }
        __syncthreads();
    }
}
#undef CHUNK_FETCH
struct SeqS { u32x4 mt[4][2]; u32x2 nc[4]; };
struct SeqY { u32x4 qe[4][2]; u32x2 yl[4]; };
__device__ __forceinline__ void seq_load_s(SeqS& B, const bf16* CH, int vs, int lane) {
#pragma unroll
    for (int t = 0; t < 4; ++t) {
#pragma unroll
        for (int s = 0; s < 2; ++s) B.mt[t][s] = *(const u32x4*)(CH + ((t * 2 + s) * 64 + lane) * 8);
        B.nc[t] = *(const u32x2*)(CH + 4096 + ((vs * 4 + t) * 64 + lane) * 4); }
}
__device__ __forceinline__ void seq_load_y(SeqY& B, const bf16* CH, int vs, int lane) {
#pragma unroll
    for (int t = 0; t < 4; ++t) {
#pragma unroll
        for (int s = 0; s < 2; ++s) B.qe[t][s] = *(const u32x4*)(CH + 8192 + ((t * 2 + s) * 64 + lane) * 8);
        B.yl[t] = *(const u32x2*)(CH + 12288 + ((vs * 4 + t) * 64 + lane) * 4); }
}
__device__ __forceinline__ void seq_wait_ge(volatile LAS int* w, int v) { while (*w < v) __builtin_amdgcn_s_sleep(1); asm volatile("" ::: "memory"); }
__device__ __forceinline__ void phase_seq(const Params& p, LAS unsigned char* lds, int lane, int wave) {
    if (blockIdx.x >= 128) return;
    unsigned char* ws = p.ws;
    const int chain = (blockIdx.x & 7) * 4 + (blockIdx.x >> 5), vs = (blockIdx.x >> 3) & 3, db = chain >> 3, h = chain & 7, b = db & 1, d = db >> 1;
    const int r = lane & 15, g = lane >> 4;
    const bf16* CH0 = (const bf16*)(ws + WS_CH) + ((size_t)(db * NCH) * 8 + h) * 16384;
    volatile LAS int* flg = (volatile LAS int*)(lds + 16384);
    LAS u32x4* ring = (LAS u32x4*)lds;
    if (wave == 0 && lane == 0) { flg[0] = 0; flg[1] = 0; }
    __syncthreads();
    if (wave == 0) {
        u32x4 sf[2]; sf[0] = sf[1] = (u32x4){0u, 0u, 0u, 0u};
        SeqS q0, q1, q2, q3;
        seq_load_s(q0, CH0, vs, lane); seq_load_s(q1, CH0 + (size_t)1 * 8 * 16384, vs, lane); seq_load_s(q2, CH0 + (size_t)2 * 8 * 16384, vs, lane);
        seq_load_s(q3, CH0 + (size_t)3 * 8 * 16384, vs, lane);
#define SEQ_USE_S(Q) asm volatile("" :: "v"(Q.mt[0][0]), "v"(Q.mt[0][1]), "v"(Q.mt[1][0]), "v"(Q.mt[1][1]), "v"(Q.mt[2][0]), "v"(Q.mt[2][1]), "v"(Q.mt[3][0]), "v"(Q.mt[3][1]), "v"(Q.nc[0]), "v"(Q.nc[1]), "v"(Q.nc[2]), "v"(Q.nc[3]))
        SEQ_USE_S(q0); SEQ_USE_S(q1); SEQ_USE_S(q2); SEQ_USE_S(q3);
#undef SEQ_USE_S
#define SEQ_S_STEP(Q, jj) do { const int j_ = (jj); \
            if (j_ >= 8) seq_wait_ge(flg + 1, j_ - 7); \
            ring[((j_ & 7) * 2 + 0) * 64 + lane] = sf[0]; ring[((j_ & 7) * 2 + 1) * 64 + lane] = sf[1]; \
            asm volatile("s_waitcnt lgkmcnt(0)" ::: "memory"); if (lane == 0) flg[0] = j_ + 1; \
            f32x4 accS[4]; \
            _Pragma("unroll") for (int t = 0; t < 4; ++t) { f32x4 as = (f32x4){blo(Q.nc[t].x), bhi(Q.nc[t].x), blo(Q.nc[t].y), bhi(Q.nc[t].y)}; \
                _Pragma("unroll") for (int s2 = 0; s2 < 2; ++s2) as = __builtin_amdgcn_mfma_f32_16x16x32_bf16(__builtin_bit_cast(bf16x8, Q.mt[t][s2]), __builtin_bit_cast(bf16x8, sf[s2]), as, 0, 0, 0); \
                accS[t] = as; } \
            _Pragma("unroll") for (int s2 = 0; s2 < 2; ++s2) { sf[s2].x = cvtpk(accS[2 * s2][0], accS[2 * s2][1]); sf[s2].y = cvtpk(accS[2 * s2][2], accS[2 * s2][3]); sf[s2].z = cvtpk(accS[2 * s2 + 1][0], accS[2 * s2 + 1][1]); sf[s2].w = cvtpk(accS[2 * s2 + 1][2], accS[2 * s2 + 1][3]); } \
            { const int jn_ = j_ + 4 < NCH ? j_ + 4 : NCH - 1; seq_load_s(Q, CH0 + (size_t)jn_ * 8 * 16384, vs, lane); } } while (0)
        for (int j = 0; j < NCH; j += 4) { SEQ_S_STEP(q0, j); SEQ_S_STEP(q1, j + 1); SEQ_S_STEP(q2, j + 2); SEQ_S_STEP(q3, j + 3); }
#undef SEQ_S_STEP
    } else if (wave == 1) {
        float* Y = (float*)(ws + WS_Y) + (size_t)d * T * 512 + h * 64 + 16 * vs + r;
        SeqY q0, q1, q2; const int sgs = d ? -1 : 1;
        seq_load_y(q0, CH0, vs, lane); seq_load_y(q1, CH0 + (size_t)1 * 8 * 16384, vs, lane); seq_load_y(q2, CH0 + (size_t)2 * 8 * 16384, vs, lane);
#define SEQ_USE_Y(Q) asm volatile("" :: "v"(Q.qe[0][0]), "v"(Q.qe[0][1]), "v"(Q.qe[1][0]), "v"(Q.qe[1][1]), "v"(Q.qe[2][0]), "v"(Q.qe[2][1]), "v"(Q.qe[3][0]), "v"(Q.qe[3][1]), "v"(Q.yl[0]), "v"(Q.yl[1]), "v"(Q.yl[2]), "v"(Q.yl[3]))
        SEQ_USE_Y(q0); SEQ_USE_Y(q1); SEQ_USE_Y(q2);
#undef SEQ_USE_Y
#define SEQ_Y_STEP(Q, jj) do { const int j_ = (jj); \
            float* Yc_ = Y + ((ptrdiff_t)row_of(b, d, j_ * 64) + (ptrdiff_t)(sgs * 4 * g)) * 512;     \
            seq_wait_ge(flg, j_ + 1); \
            const u32x4 s0_ = ring[((j_ & 7) * 2 + 0) * 64 + lane], s1_ = ring[((j_ & 7) * 2 + 1) * 64 + lane]; \
            asm volatile("s_waitcnt lgkmcnt(0)" ::: "memory"); if (lane == 0) flg[1] = j_ + 1; \
            _Pragma("unroll") for (int t = 0; t < 4; ++t) { f32x4 ay = (f32x4){blo(Q.yl[t].x), bhi(Q.yl[t].x), blo(Q.yl[t].y), bhi(Q.yl[t].y)}; \
                ay = __builtin_amdgcn_mfma_f32_16x16x32_bf16(__builtin_bit_cast(bf16x8, Q.qe[t][0]), __builtin_bit_cast(bf16x8, s0_), ay, 0, 0, 0); \
                ay = __builtin_amdgcn_mfma_f32_16x16x32_bf16(__builtin_bit_cast(bf16x8, Q.qe[t][1]), __builtin_bit_cast(bf16x8, s1_), ay, 0, 0, 0); \
                _Pragma("unroll") for (int qq = 0; qq < 4; ++qq) Yc_[(ptrdiff_t)((16 * t + qq) * sgs) * 512] = ay[qq]; } \
            { const int jn_ = j_ + 3 < NCH ? j_ + 3 : NCH - 1; seq_load_y(Q, CH0 + (size_t)jn_ * 8 * 16384, vs, lane); } } while (0)
        for (int j = 0; j < NCH; j += 3) { SEQ_Y_STEP(q0, j); SEQ_Y_STEP(q1, j + 1); SEQ_Y_STEP(q2, j + 2); }
#undef SEQ_Y_STEP
    }
}

struct S5Disc { float ar, ai; float br[16], bi[16]; };
__device__ __forceinline__ void s5_disc(const Params& p, int l, int d, int g, int lane, S5Disc& q) {
    const int gi = (l * 2 + d) * 32 + g; const size_t pi = (size_t)gi * 64 + lane;
    const float lr = fminf(p.in[I_LRE][pi], -1e-4f), li = p.in[I_LIM][pi], dt = __expf(p.in[I_LDT][gi]);
    const float mag = __expf(lr * dt); float sn, cs; sincosf(li * dt, &sn, &cs);
    q.ar = mag * cs; q.ai = mag * sn;
    const float den = lr * lr + li * li, xr = q.ar - 1.0f, cr = (xr * lr + q.ai * li) / den, ci = (q.ai * lr - xr * li) / den;
    const float* bre = p.in[I_BRE] + pi * 16; const float* bim = p.in[I_BIM] + pi * 16;
#pragma unroll
    for (int c = 0; c < 16; c += 4) { const f32x4 a = *(const f32x4*)(bre + c), b = *(const f32x4*)(bim + c);
#pragma unroll
        for (int j = 0; j < 4; ++j) { q.br[c + j] = cr * a[j] - ci * b[j]; q.bi[c + j] = cr * b[j] + ci * a[j]; } }
}
__device__ __forceinline__ void phase_s5_carry(const Params& p, int l, int lane, int wave) {
    unsigned char* ws = p.ws;
    const float2* XEND = (const float2*)(ws + WS_XEND); float2* CARRY = (float2*)(ws + WS_CARRY);
    const int gw = blockIdx.x * 8 + wave;
    if (gw >= 128) return;
    const int g = gw & 31, b = (gw >> 5) & 1, d = gw >> 6;
    const int gi = (l * 2 + d) * 32 + g; const size_t pi = (size_t)gi * 64 + lane;
    const float lr = fminf(p.in[I_LRE][pi], -1e-4f), li = p.in[I_LIM][pi], dt = __expf(p.in[I_LDT][gi]);
    const float mag = __expf(lr * dt); float sn, cs; sincosf(li * dt, &sn, &cs);
    float ar = mag * cs, ai = mag * sn;
#pragma unroll
    for (int i = 0; i < 6; ++i) { const float nr = ar * ar - ai * ai, ni = 2.0f * ar * ai; ar = nr; ai = ni; }
    const size_t base = ((size_t)((d * 2 + b) * NCH)) * 2048 + g * 64 + lane;
    float xr = 0.f, xi = 0.f;
    for (int j0 = 0; j0 < NCH; j0 += 12) {
        float2 e[12];
#pragma unroll
        for (int i = 0; i < 12; ++i) e[i] = XEND[base + (size_t)(j0 + i) * 2048];
#pragma unroll
        for (int i = 0; i < 12; ++i) { CARRY[base + (size_t)(j0 + i) * 2048] = make_float2(xr, xi); const float nr = ar * xr - ai * xi + e[i].x, ni = ar * xi + ai * xr + e[i].y; xr = nr; xi = ni; }
    }
}

__device__ __forceinline__ void phase_s5_tables(const Params& p, int l, int item, int lane) {
    unsigned char* ws = p.ws;
    const int mr = item & 7, d = (item >> 3) & 1, g = item >> 4;
    const int gi = (l * 2 + d) * 32 + g; const size_t pi = (size_t)gi * 64 + lane;
    const float lr = fminf(p.in[I_LRE][pi], -1e-4f), li = p.in[I_LIM][pi], dt = __expf(p.in[I_LDT][gi]);
    S5Disc q; s5_disc(p, l, d, g, lane, q);
    float cre[16], cim[16];
    { const float* cr_ = p.in[I_CRE] + ((size_t)gi * 16) * 64 + lane; const float* ci_ = p.in[I_CIM] + ((size_t)gi * 16) * 64 + lane;
#pragma unroll
      for (int c = 0; c < 16; ++c) { cre[c] = cr_[c * 64]; cim[c] = ci_[c * 64]; } }
    bf16* Et = (bf16*)(ws + WS_S5E) + (size_t)(g * 2 + d) * 1024 * 128;
    bf16* Kt = (bf16*)(ws + WS_S5K) + (size_t)(g * 2 + d) * 72 * 256;
    if (mr == 0) {
#pragma unroll
        for (int z = 0; z < 8; ++z) *(u32x2*)(Kt + z * 256 + lane * 4) = (u32x2){0u, 0u}; }
    const int m0 = 8 * mr, m1 = (mr == 7) ? 65 : m0 + 8;
    float pr, pim; { const float mg = __expf(lr * dt * (float)m0); float sn, cs; sincosf(li * dt * (float)m0, &sn, &cs); pr = mg * cs; pim = mg * sn; }
    for (int m = m0; m < m1; ++m) {
#pragma unroll 1
        for (int cp = 0; cp < 16; ++cp) {
            float c_r = 0.f, c_i = 0.f;
#pragma unroll
            for (int c = 0; c < 16; ++c) { c_r = (cp == c) ? cre[c] : c_r; c_i = (cp == c) ? cim[c] : c_i; }
            const float car = c_r * pr - c_i * pim, cai = c_r * pim + c_i * pr;
            if (m >= 1) {
                bf16* eb = Et + (size_t)(m - 1) * 4 * 512;
                eb[((lane >> 5) * 64 + ((lane >> 3) & 3) * 16 + cp) * 8 + (lane & 7)] = (bf16)f2bf(car);
                eb[((2 + (lane >> 5)) * 64 + ((lane >> 3) & 3) * 16 + cp) * 8 + (lane & 7)] = (bf16)f2bf(-cai); }
            if (m <= 63) {
                float vals[16];
#pragma unroll
                for (int c = 0; c < 16; ++c) vals[c] = car * q.br[c] - cai * q.bi[c];
                { const bool hi = (lane & 32) != 0;
#pragma unroll
                  for (int i = 0; i < 8; ++i) { const float send = hi ? vals[i] : vals[i + 8], keep = hi ? vals[i + 8] : vals[i]; vals[i] = keep + __shfl_xor(send, 32); } }
                { const bool hi = (lane & 16) != 0;
#pragma unroll
                  for (int i = 0; i < 4; ++i) { const float send = hi ? vals[i] : vals[i + 4], keep = hi ? vals[i + 4] : vals[i]; vals[i] = keep + __shfl_xor(send, 16); } }
                { const bool hi = (lane & 8) != 0;
#pragma unroll
                  for (int i = 0; i < 2; ++i) { const float send = hi ? vals[i] : vals[i + 2], keep = hi ? vals[i + 2] : vals[i]; vals[i] = keep + __shfl_xor(send, 8); } }
                { const bool hi = (lane & 4) != 0; const float send = hi ? vals[0] : vals[1], keep = hi ? vals[1] : vals[0]; vals[0] = keep + __shfl_xor(send, 4); }
                vals[0] += __shfl_xor(vals[0], 2); vals[0] += __shfl_xor(vals[0], 1);
                if ((lane & 3) == 0) Kt[(size_t)(m + 8) * 256 + cp * 16 + (lane >> 2)] = (bf16)f2bf(vals[0]);
            }
        }
        const float nr = pr * q.ar - pim * q.ai, ni = pr * q.ai + pim * q.ar; pr = nr; pim = ni;
    }
    { bf16* BP = (bf16*)(ws + WS_S5BP) + (size_t)(g * 2 + d) * 128 * 1024;
      for (int j = 8 * mr; j < 8 * mr + 8; ++j) { const float pw = (float)(d ? j : 63 - j); const float mg = __expf(lr * dt * pw); float sn, cs; sincosf(li * dt * pw, &sn, &cs); const float xr = mg * cs, xi = mg * sn;
          float re[16], im[16];
#pragma unroll
          for (int c = 0; c < 16; ++c) { re[c] = xr * q.br[c] - xi * q.bi[c]; im[c] = xr * q.bi[c] + xi * q.br[c]; }
          u32x4 o; bf16* fb = BP + (size_t)(j >> 1) * 8 * 512;
          bf16* dr = fb + ((size_t)(lane >> 4) * 64 + ((j & 1) * 2) * 16 + (lane & 15)) * 8; bf16* di = fb + ((size_t)(4 + (lane >> 4)) * 64 + ((j & 1) * 2) * 16 + (lane & 15)) * 8;
          o.x = cvtpk(re[0], re[1]); o.y = cvtpk(re[2], re[3]); o.z = cvtpk(re[4], re[5]); o.w = cvtpk(re[6], re[7]); *(u32x4*)dr = o;
          o.x = cvtpk(re[8], re[9]); o.y = cvtpk(re[10], re[11]); o.z = cvtpk(re[12], re[13]); o.w = cvtpk(re[14], re[15]); *(u32x4*)(dr + 128) = o;
          o.x = cvtpk(im[0], im[1]); o.y = cvtpk(im[2], im[3]); o.z = cvtpk(im[4], im[5]); o.w = cvtpk(im[6], im[7]); *(u32x4*)di = o;
          o.x = cvtpk(im[8], im[9]); o.y = cvtpk(im[10], im[11]); o.z = cvtpk(im[12], im[13]); o.w = cvtpk(im[14], im[15]); *(u32x4*)(di + 128) = o; } }
}
__device__ __forceinline__ int row_tb(int tb, int t) { const int b = tb >= NCH ? 1 : 0, k = tb - b * NCH; return k < 4 ? NLAT + b * CTXL + 64 * k + t : b * SEQ + 64 * (k - 4) + t; }
__device__ __forceinline__ bf16x8 s5_ufrag(const bf16* Ug, int ct, int j0, int r, int g4) { return *(const bf16x8*)(Ug + ((size_t)(j0 + (g4 >> 1)) * (2 * NCH) + 16 * ct + r) * 16 + 8 * (g4 & 1)); }
__device__ __forceinline__ void phase_s5_end(const Params& p, int lane, int wave) {
    unsigned char* ws = p.ws;
    float2* XEND = (float2*)(ws + WS_XEND);
    const int r = lane & 15, g4 = lane >> 4;
    for (int it = blockIdx.x * 8 + wave; it < 32 * 17 * 2; it += gridDim.x * 8) {
        const int d = it & 1, ct = (it >> 1) % 17, g = (it >> 1) / 17;
        const int tb = 16 * ct + r, tbc = tb < 2 * NCH ? tb : 2 * NCH - 1; const bool valid = tb < 2 * NCH;
        const int b = tbc >= NCH ? 1 : 0, k = tbc - b * NCH;
        const bf16* Ug = (const bf16*)(ws + WS_U) + (size_t)g * 64 * (2 * NCH) * 16;
        const bf16* BPf = (const bf16*)(ws + WS_S5BP) + (size_t)(g * 2 + d) * 128 * 1024 + lane * 8;
        f32x4 acc[8];
#pragma unroll
        for (int rt = 0; rt < 8; ++rt) acc[rt] = (f32x4){0.f, 0.f, 0.f, 0.f};
#pragma unroll 1
        for (int kb = 0; kb < 32; kb += 4) {
            bf16x8 bu[4];
#pragma unroll
            for (int i = 0; i < 4; ++i) bu[i] = s5_ufrag(Ug, ct, 2 * (kb + i), r, g4);
            bf16x8 a[4][8];
#pragma unroll
            for (int i = 0; i < 4; ++i)
#pragma unroll
                for (int rt = 0; rt < 8; ++rt) a[i][rt] = *(const bf16x8*)(BPf + ((size_t)(kb + i) * 8 + rt) * 512);
            asm volatile("" : "+v"(acc[0]), "+v"(acc[1]), "+v"(acc[2]), "+v"(acc[3]), "+v"(acc[4]), "+v"(acc[5]), "+v"(acc[6]), "+v"(acc[7]) :: "memory");
#pragma unroll
            for (int i = 0; i < 4; ++i)
#pragma unroll
                for (int rt = 0; rt < 8; ++rt) acc[rt] = __builtin_amdgcn_mfma_f32_16x16x32_bf16(a[i][rt], bu[i], acc[rt], 0, 0, 0);
            asm volatile("" ::: "memory");
        }
        if (valid) { const int js = d ? (k < 4 ? 3 - k : NCH + 3 - k) : k;
            float2* xe = XEND + ((size_t)((d * 2 + b) * NCH + js)) * 2048 + g * 64;
#pragma unroll
            for (int rt = 0; rt < 4; ++rt)
#pragma unroll
                for (int q = 0; q < 4; ++q) xe[16 * rt + 4 * g4 + q] = make_float2(acc[rt][q], acc[rt + 4][q]); }
    }
}
__device__ __forceinline__ void phase_s5_out(const Params& p, int l, LAS unsigned char* lds, int tid, int lane, int wave) {
    unsigned char* ws = p.ws;
    bf16* YG = (bf16*)(ws + WS_YG); const float2* CARRY = (const float2*)(ws + WS_CARRY);
    const int r = lane & 15, g4 = lane >> 4;
    for (int gb = blockIdx.x; gb < 256; gb += gridDim.x) {
        const int g = (gridDim.x == 256) ? ((gb & 7) * 4 + (gb >> 6)) : (gb >> 3), tg = (gridDim.x == 256) ? ((gb >> 3) & 7) : (gb & 7);
        __syncthreads();
        { const u32x4* src = (const u32x4*)((const bf16*)(ws + WS_S5K) + (size_t)g * 2 * 72 * 256);
          { u32x4 tk_[9];
#pragma unroll
            for (int q = 0; q < 9; ++q) tk_[q] = src[tid + 512 * q];
#pragma unroll
            for (int q = 0; q < 9; ++q) ((LAS u32x4*)lds)[tid + 512 * q] = tk_[q]; }
          const u32x4* e0s = (const u32x4*)((const bf16*)(ws + WS_S5E) + (size_t)(g * 2) * 1024 * 128 + (size_t)(8 * tg) * 4 * 512);
          const u32x4* e1s = (const u32x4*)((const bf16*)(ws + WS_S5E) + (size_t)(g * 2 + 1) * 1024 * 128 + (size_t)(56 - 8 * tg) * 4 * 512);
          u32x4 t0_[4], t1_[4];
#pragma unroll
          for (int q = 0; q < 4; ++q) { t0_[q] = e0s[tid + 512 * q]; t1_[q] = e1s[tid + 512 * q]; }
#pragma unroll
          for (int q = 0; q < 4; ++q) { *(LAS u32x4*)(lds + 73728 + (tid + 512 * q) * 16) = t0_[q]; *(LAS u32x4*)(lds + 73728 + 32768 + (tid + 512 * q) * 16) = t1_[q]; } }
        __syncthreads();
        const bf16* Ug = (const bf16*)(ws + WS_U) + (size_t)g * 64 * (2 * NCH) * 16;
        for (int ct = wave; ct < 17; ct += 8) {
            const int tb = 16 * ct + r, tbc = tb < 2 * NCH ? tb : 2 * NCH - 1; const bool valid = tb < 2 * NCH;
            const int b = tbc >= NCH ? 1 : 0, k = tbc - b * NCH;
            bf16x8 xc[2][4];
#pragma unroll
            for (int d = 0; d < 2; ++d) { const int js = d ? (k < 4 ? 3 - k : NCH + 3 - k) : k;
                const float2* cp = CARRY + ((size_t)((d * 2 + b) * NCH + js)) * 2048 + g * 64;
#pragma unroll
                for (int ks = 0; ks < 4; ++ks) { const int p0 = 32 * (ks & 1) + 8 * g4; const f32x4* c4 = (const f32x4*)(cp + p0);
                    const f32x4 a = c4[0], b2 = c4[1], c2 = c4[2], d2 = c4[3]; u32x4 o;
                    if (ks < 2) { o.x = cvtpk(a[0], a[2]); o.y = cvtpk(b2[0], b2[2]); o.z = cvtpk(c2[0], c2[2]); o.w = cvtpk(d2[0], d2[2]); }
                    else { o.x = cvtpk(a[1], a[3]); o.y = cvtpk(b2[1], b2[3]); o.z = cvtpk(c2[1], c2[3]); o.w = cvtpk(d2[1], d2[3]); }
                    xc[d][ks] = __builtin_bit_cast(bf16x8, o); } }
            u32x2 uu8[8];
#pragma unroll
            for (int tt = 0; tt < 8; ++tt) uu8[tt] = *(const u32x2*)(Ug + ((size_t)(8 * tg + tt) * (2 * NCH) + tbc) * 16 + 4 * g4);
            f32x4 acc[8];
#pragma unroll
            for (int tt = 0; tt < 8; ++tt) acc[tt] = (f32x4){0.f, 0.f, 0.f, 0.f};
            bf16x8 bu[4], bn[4];
#pragma unroll
            for (int i = 0; i < 4; ++i) bu[i] = s5_ufrag(Ug, ct, (2 * i) & 63, r, g4);
            for (int jb = 0; jb <= 8 * tg + 6; jb += 8) {
                { const int jn = jb + 8 <= 8 * tg + 6 ? jb + 8 : jb;
#pragma unroll
                  for (int i = 0; i < 4; ++i) bn[i] = s5_ufrag(Ug, ct, (jn + 2 * i) & 63, r, g4); }
#pragma unroll
                for (int i = 0; i < 4; ++i) { const int j = jb + 2 * i + (g4 >> 1);
                    if (jb + 2 * i <= 8 * tg + 6) {
                    const LAS unsigned char* ab = lds + (8 * tg - j + 8) * 512 + r * 32 + (g4 & 1) * 16;
                    bf16x8 a8[8];
#pragma unroll
                    for (int tt = 0; tt < 8; ++tt) a8[tt] = *(const LAS bf16x8*)(ab + tt * 512);
                    asm volatile("" : "+v"(acc[0]), "+v"(acc[1]), "+v"(acc[2]), "+v"(acc[3]), "+v"(acc[4]), "+v"(acc[5]), "+v"(acc[6]), "+v"(acc[7]) :: "memory");
#pragma unroll
                    for (int tt = 0; tt < 8; ++tt) acc[tt] = __builtin_amdgcn_mfma_f32_16x16x32_bf16(a8[tt], bu[i], acc[tt], 0, 0, 0); }
                    asm volatile("" ::: "memory"); }
#pragma unroll
                for (int i = 0; i < 4; ++i) bu[i] = bn[i];
            }
#pragma unroll
            for (int i = 0; i < 4; ++i) bu[i] = s5_ufrag(Ug, ct, 8 * tg + 2 * i, r, g4);
            for (int jb = 8 * tg; jb <= 62; jb += 8) {
                { const int jn = jb + 8 <= 62 ? jb + 8 : jb;
#pragma unroll
                  for (int i = 0; i < 4; ++i) bn[i] = s5_ufrag(Ug, ct, jn + 2 * i, r, g4); }
#pragma unroll
                for (int i = 0; i < 4; ++i) { const int j = jb + 2 * i + (g4 >> 1);
                    if (jb + 2 * i + 1 >= 8 * tg) {
                    const LAS unsigned char* ab = lds + 36864 + (j - 8 * tg + 8) * 512 + r * 32 + (g4 & 1) * 16;
                    bf16x8 a8[8];
#pragma unroll
                    for (int tt = 0; tt < 8; ++tt) a8[tt] = *(const LAS bf16x8*)(ab - tt * 512);
                    asm volatile("" : "+v"(acc[0]), "+v"(acc[1]), "+v"(acc[2]), "+v"(acc[3]), "+v"(acc[4]), "+v"(acc[5]), "+v"(acc[6]), "+v"(acc[7]) :: "memory");
#pragma unroll
                    for (int tt = 0; tt < 8; ++tt) acc[tt] = __builtin_amdgcn_mfma_f32_16x16x32_bf16(a8[tt], bu[i], acc[tt], 0, 0, 0); }
                    asm volatile("" ::: "memory"); }
#pragma unroll
                for (int i = 0; i < 4; ++i) bu[i] = bn[i];
            }
            const f32x4 dsk = *(const f32x4*)(p.in[I_S5D] + l * 512 + g * 16 + 4 * g4);
#pragma unroll
            for (int tt = 0; tt < 8; ++tt) { const int t = 8 * tg + tt;
                const u32x2 uu = uu8[tt];
#pragma unroll
                for (int ks = 0; ks < 4; ++ks) {
                    const bf16x8 e0 = *(const LAS bf16x8*)(lds + 73728 + ((tt * 4 + ks) * 64 + lane) * 16), e1 = *(const LAS bf16x8*)(lds + 73728 + 32768 + (((7 - tt) * 4 + ks) * 64 + lane) * 16);
                    acc[tt] = __builtin_amdgcn_mfma_f32_16x16x32_bf16(e0, xc[0][ks], acc[tt], 0, 0, 0); acc[tt] = __builtin_amdgcn_mfma_f32_16x16x32_bf16(e1, xc[1][ks], acc[tt], 0, 0, 0); }
                const float uf[4] = {blo(uu.x), bhi(uu.x), blo(uu.y), bhi(uu.y)}; float o[4];
#pragma unroll
                for (int q = 0; q < 4; ++q) { const float ys = acc[tt][q] + dsk[q] * uf[q]; o[q] = ys * __builtin_amdgcn_rcpf(1.0f + __expf(-1.5957691216f * (ys + 0.044715f * ys * ys * ys))); }
                if (valid) { u32x2 w2; w2.x = cvtpk(o[0], o[1]); w2.y = cvtpk(o[2], o[3]); *(u32x2*)(YG + (size_t)row_tb(tbc, t) * 512 + g * 16 + 4 * g4) = w2; }
                if (tt & 1) asm volatile("" ::: "memory");
            }
        }
    }
}

__device__ __forceinline__ void phase_readout(const Params& p, int l, int lane, int wave, int blk, int nblk) {
    unsigned char* ws = p.ws;
    const bf16* V = (const bf16*)(ws + WS_V); const bf16* GD = (const bf16*)(ws + WS_GD); const float* BON = (const float*)(ws + WS_BONUS);
    const float* Y = (const float*)(ws + WS_Y);
    bf16* A2 = (bf16*)(ws + WS_A2);
    const int c = lane * 8, h = lane >> 3;
    const f32x4 lw0 = *(const f32x4*)(p.in[I_LNW] + l * 512 + c), lw1 = *(const f32x4*)(p.in[I_LNW] + l * 512 + c + 4), lb0 = *(const f32x4*)(p.in[I_LNB] + l * 512 + c), lb1 = *(const f32x4*)(p.in[I_LNB] + l * 512 + c + 4);
    const float lnw[8] = {lw0[0], lw0[1], lw0[2], lw0[3], lw1[0], lw1[1], lw1[2], lw1[3]}, lnb[8] = {lb0[0], lb0[1], lb0[2], lb0[3], lb1[0], lb1[1], lb1[2], lb1[3]};
    const int gw = blk * 8 + wave, NGW = nblk * 8;
#define RO_FETCH(r_, V8, Y0, Y1, G8, BN) do { const int rf_ = (r_); V8 = *(const u32x4*)(V + (size_t)rf_ * 512 + c); \
        _Pragma("unroll") for (int d = 0; d < 2; ++d) { const size_t o_ = ((size_t)d * T + rf_) * 512 + c; Y0[d] = *(const f32x4*)(Y + o_); Y1[d] = *(const f32x4*)(Y + o_ + 4); G8[d] = *(const u32x4*)(GD + o_); BN[d] = BON[((size_t)d * T + rf_) * 8 + h]; } } while (0)
    u32x4 v8n, g8n[2]; f32x4 y0n[2], y1n[2]; float bnn[2];
    if (gw < T) RO_FETCH(gw, v8n, y0n, y1n, g8n, bnn);
    for (int row = gw; row < T; row += NGW) {
        const u32x4 v8 = v8n; const u32x4 g8c[2] = {g8n[0], g8n[1]}; const f32x4 y0c[2] = {y0n[0], y0n[1]}, y1c[2] = {y1n[0], y1n[1]}; const float bnc[2] = {bnn[0], bnn[1]};
        asm volatile("" ::: "memory");
        RO_FETCH(row + NGW < T ? row + NGW : row, v8n, y0n, y1n, g8n, bnn);
        asm volatile("" ::: "memory");
        const float vf[8] = {blo(v8.x), bhi(v8.x), blo(v8.y), bhi(v8.y), blo(v8.z), bhi(v8.z), blo(v8.w), bhi(v8.w)};
        float out[8] = {0.f, 0.f, 0.f, 0.f, 0.f, 0.f, 0.f, 0.f};
#pragma unroll
        for (int d = 0; d < 2; ++d) {
            const f32x4 y0 = y0c[d], y1 = y1c[d]; const u32x4 g8 = g8c[d];
            const float y[8] = {y0[0], y0[1], y0[2], y0[3], y1[0], y1[1], y1[2], y1[3]};
            const float gf[8] = {blo(g8.x), bhi(g8.x), blo(g8.y), bhi(g8.y), blo(g8.z), bhi(g8.z), blo(g8.w), bhi(g8.w)};
            float sm = ((y[0] + y[1]) + (y[2] + y[3])) + ((y[4] + y[5]) + (y[6] + y[7]));
            sm += __shfl_xor(sm, 1); sm += __shfl_xor(sm, 2); sm += __shfl_xor(sm, 4);
            const float mean = sm * (1.0f / 64.0f); float q = 0.f;
#pragma unroll
            for (int i = 0; i < 8; ++i) { const float dv = y[i] - mean; q += dv * dv; }
            q += __shfl_xor(q, 1); q += __shfl_xor(q, 2); q += __shfl_xor(q, 4);
            const float rs = rsqrtf(q * (1.0f / 64.0f) + 64e-5f), bon = bnc[d];
#pragma unroll
            for (int i = 0; i < 8; ++i) out[i] += ((y[i] - mean) * rs * lnw[i] + lnb[i] + bon * vf[i]) * gf[i]; }
        u32x4 w; w.x = cvtpk(out[0], out[1]); w.y = cvtpk(out[2], out[3]); w.z = cvtpk(out[4], out[5]); w.w = cvtpk(out[6], out[7]);
        *(u32x4*)(A2 + (size_t)row * 1024 + c) = w;
    }
#undef RO_FETCH
}

enum { PH_PRO = 0, PH_NORM1, PH_GIN, PH_STREAM, PH_GLR, PH_S5A, PH_S5B, PH_CHUNK, PH_SEQ, PH_S5C, PH_READOUT, PH_GGLU, PH_GOUT, PH_NORM2, PH_GFUP, PH_GFDN, PH_NORM2M, PH_MPREP, PH_GMUP, PH_GMDN, PH_FINAL, N_PH };
template <int PH>
__device__ __forceinline__ void run_phase(const Params& p, int l, int e, LAS unsigned char* lds, int tid, int lane, int wave) {
    unsigned char* ws = p.ws; const int G = gridDim.x;
    const float* MODl = (const float*)(ws + WS_MOD) + (size_t)l * 3 * 6144;
    if constexpr (PH == PH_PRO) phase_prologue(p, lds, tid, lane, wave);
    if constexpr (PH == PH_NORM1) { if (l == 0) phase_norm(p, l, 0, true, false, lane, wave); else phase_norm(p, l, 0, false, false, lane, wave, 11, (const float*)(ws + WS_PARTF), (const float*)(ws + WS_MOD) + 2 * 6144 + 5120); }
    if constexpr (PH == PH_GIN) {
        pg8::Gemm g{(const bf16*)(ws + WS_H), (const bf16*)(ws + WS_WIN) + (size_t)l * DIN * 1024, T, DIN, 1024, 1024}; pg8::StaticOrder S; S.init(T, DIN, G, (int)blockIdx.x);
        pg8::EpiBf16<0> E{(bf16*)(ws + WS_P), DIN, nullptr, 0, 0, 1.f};
        pg8::gemm_phase<pg8::EpiBf16<0>, pg8::StaticOrder, true, true>(lds, g, S, E, tid); }
    if constexpr (PH == PH_STREAM) phase_stream_lr(p, l, lds, tid, lane, wave);
    if constexpr (PH == PH_CHUNK) phase_chunk(p, l, lds, tid, lane, wave);
    if constexpr (PH == PH_SEQ) { if (blockIdx.x >= 128) { const int item = (blockIdx.x - 128) * 8 + wave; if (item < 512) phase_s5_tables(p, l, item, lane); } else phase_seq(p, lds, lane, wave); }
    if constexpr (PH == PH_S5A) phase_s5_end(p, lane, wave);
    if constexpr (PH == PH_S5B) { if (blockIdx.x < 16) phase_s5_carry(p, l, lane, wave); else phase_readout(p, l, lane, wave, (int)blockIdx.x - 16, G - 16); }
    if constexpr (PH == PH_S5C) phase_s5_out(p, l, lds, tid, lane, wave);
    if constexpr (PH == PH_GGLU) {
        const int Mr = l == 0 ? T : NLAT; pg8::Gemm g{(const bf16*)(ws + WS_YG), (const bf16*)(ws + WS_WGLU) + (size_t)l * 512 * 512, Mr, 512, 512, 512}; pg8::StaticOrder S; S.init(Mr, 512, G, (int)blockIdx.x);
        pg8::EpiGLU E{(const bf16*)(ws + WS_YG), (bf16*)(ws + WS_A2), p.in[I_GLUB] + l * 512};
        pg8::gemm_phase<pg8::EpiGLU, pg8::StaticOrder, true, true>(lds, g, S, E, tid);
        if (l == 1 && G > 128 && (int)blockIdx.x >= 128) phase_moe_cvt(p, lds, lane, wave, MOE_CVT_SPLIT, MOE_CVT_ITEMS, ((int)blockIdx.x - 128) * 8 + wave, (G - 128) * 8); }
    if constexpr (PH == PH_GOUT) {
        { pg8::Gemm g{(const bf16*)(ws + WS_A2), (const bf16*)(ws + WS_WOUT) + (size_t)l * 1024 * 1024, NLAT, 1024, 1024, 1024}; pg8::StaticOrder S; S.init(NLAT, 1024, G, (int)blockIdx.x);
          pg8::EpiRes E{(float*)(ws + WS_X), MODl + 2048, nullptr, 0};
          pg8::gemm_phase<pg8::EpiRes, pg8::StaticOrder, true, true>(lds, g, S, E, tid); }
        if (l == 0) {
            pg8::Gemm g{(const bf16*)(ws + WS_A2), (const bf16*)(ws + WS_WOUT), NCTX, 1024, 256, 1024}; pg8::GroupOrder S;
#pragma unroll
            for (int q = 0; q < 9; ++q) S.toff[q] = q == 0 ? 0 : (1 << 20);
            S.t0 = NLAT / 256; S.a0 = 0; S.o0 = 0; S.nNr = 4; S.kslice = 256; S.init(NCTX, 1024 * 4, G, (int)blockIdx.x);
            pg8::EpiPartF32 E{(float*)(ws + WS_PARTO), NLAT, NCTX, 256};
            pg8::gemm_phase<pg8::EpiPartF32, pg8::GroupOrder, true, true>(lds, g, S, E, tid); }
    }
    if constexpr (PH == PH_NORM2) phase_norm(p, l, 1, false, false, lane, wave, 4, (const float*)(ws + WS_PARTO), (const float*)(ws + WS_MOD) + 2 * 6144 + 2048);
    if constexpr (PH == PH_GFUP) {
        pg8::Gemm g{(const bf16*)(ws + WS_H), (const bf16*)(ws + WS_WFUP), T, 2 * DFF, 1024, 1024}; pg8::StaticOrder S; S.init(T, 2 * DFF, G, (int)blockIdx.x);
        pg8::EpiSwiGLU E{(bf16*)(ws + WS_ACT), DFF};
        pg8::gemm_phase<pg8::EpiSwiGLU, pg8::StaticOrder, true, true>(lds, g, S, E, tid); }
    if constexpr (PH == PH_GFDN) {
        { pg8::Gemm g{(const bf16*)(ws + WS_ACT), (const bf16*)(ws + WS_WFDN), NLAT, 1024, DFF, DFF}; pg8::StaticOrder S; S.init(NLAT, 1024, G, (int)blockIdx.x);
          pg8::EpiRes E{(float*)(ws + WS_X), MODl + 5120, nullptr, 0};
          pg8::gemm_phase<pg8::EpiRes, pg8::StaticOrder, true, true>(lds, g, S, E, tid); }
        {
            pg8::Gemm g{(const bf16*)(ws + WS_ACT), (const bf16*)(ws + WS_WFDN), NCTX, 1024, 256, DFF}; pg8::GroupOrder S;
#pragma unroll
            for (int q = 0; q < 9; ++q) S.toff[q] = q == 0 ? 0 : (1 << 20);
            S.t0 = NLAT / 256; S.a0 = 0; S.o0 = 0; S.nNr = 4; S.kslice = 256; S.init(NCTX, 1024 * 11, G, (int)blockIdx.x);
            pg8::EpiPartF32 E{(float*)(ws + WS_PARTF), NLAT, NCTX, 256};
            pg8::gemm_phase<pg8::EpiPartF32, pg8::GroupOrder, true, true>(lds, g, S, E, tid); }
    }
    if constexpr (PH == PH_NORM2M) { phase_norm2_moe(p, lds, tid, lane, wave); phase_moe_cvt(p, lds, lane, wave, 0, G > 128 ? MOE_CVT_SPLIT : MOE_CVT_ITEMS, (int)blockIdx.x * 8 + wave, G * 8); }
    if constexpr (PH == PH_MPREP) phase_moe_prep(p, lds, tid, lane, wave);
    if constexpr (PH == PH_GMUP || PH == PH_GMDN) {
        const int* TOFF = (const int*)(ws + WS_TOFF);
        pg8::GroupOrder S;
#pragma unroll
        for (int q = 0; q < 9; ++q) S.toff[q] = __builtin_amdgcn_readfirstlane(TOFF[q]);
        const int nT = S.toff[8];
        const int t0 = e * MOE_PASS_TILES; int nt = e == 0 ? (nT < 64 ? nT : 64) : (nT > 64 ? nT - 64 : 0);
        S.t0 = t0;
        if constexpr (PH == PH_GMUP) {
            S.a0 = 0; S.o0 = t0; S.nNr = 2 * DFE / 256; S.kslice = 0; S.init(nt * 256, 2 * DFE, G, (int)blockIdx.x);
            pg8::Gemm g{(const bf16*)(ws + WS_APERM) + (size_t)t0 * 256 * 1024, (const bf16*)(ws + WS_WMUP), nt * 256, 2 * DFE, 1024, 1024};
            S.a0 = t0;
            pg8::EpiSwiGLU E{(bf16*)(ws + WS_ACT1), DFE};
            pg8::gemm_phase<pg8::EpiSwiGLU, pg8::GroupOrder, true, true>(lds, g, S, E, tid);
        } else {
            {
                const int ntA = nt < 64 ? nt : 64;
                S.a0 = t0; S.o0 = 0; S.nNr = 4; S.kslice = 0; S.init(ntA * 256, 1024, G, (int)blockIdx.x);
                pg8::Gemm g{(const bf16*)(ws + WS_ACT1), (const bf16*)(ws + WS_WMDN), ntA * 256, 1024, DFE, DFE};
                pg8::EpiBf16<0> E{(bf16*)(ws + WS_APERM), 1024, nullptr, 0, 0, 1.f};
                pg8::gemm_phase<pg8::EpiBf16<0>, pg8::GroupOrder, true, true>(lds, g, S, E, tid); }
            if (e == 1 && nT > 128) {
                S.t0 = 128; S.a0 = 64; S.o0 = 0; S.nNr = 4; S.kslice = DFE / 7; S.init((nT - 128) * 256, 1024 * 7, G, (int)blockIdx.x);
                pg8::Gemm g{(const bf16*)(ws + WS_ACT1), (const bf16*)(ws + WS_WMDN), (nT - 128) * 256, 1024, DFE / 7, DFE};
                pg8::EpiPartBf16 E{(bf16*)(ws + WS_PARTM), 128 * 256, 8 * 256, DFE / 7};
                pg8::gemm_phase<pg8::EpiPartBf16, pg8::GroupOrder, true, true>(lds, g, S, E, tid); }
        }
    }
    if constexpr (PH == PH_FINAL) phase_final(p, lane, wave);
}
template <int PH>
__global__ void __launch_bounds__(512, 2) k_ph(Params p, int l, int e) {
    extern __shared__ __attribute__((aligned(16))) unsigned char lds_raw[];
    LAS unsigned char* lds = (LAS unsigned char*)lds_raw;
    const int tid = threadIdx.x, lane = tid & 63, wave = __builtin_amdgcn_readfirstlane(tid >> 6);
    run_phase<PH>(p, l, e, lds, tid, lane, wave);
}

#ifndef MK_MULTI
#define MK_FUSED 1
#endif
#ifdef MK_FUSED
#ifndef MK_LOOP_L
#define MK_LOOP_L 0
#endif
__global__ void __launch_bounds__(512, 2) fwd_fused(Params p) {
    extern __shared__ __attribute__((aligned(16))) unsigned char lds_raw[];
    LAS unsigned char* lds = (LAS unsigned char*)lds_raw;
    const int tid = threadIdx.x, lane = tid & 63, wave = __builtin_amdgcn_readfirstlane(tid >> 6);
    volatile LAS unsigned* MISC = (volatile LAS unsigned*)(lds + MISC_OFF);
    if (tid < 32) MISC[tid] = 0u;
    __syncthreads();
    XcdBarrier bar = xcd_barrier_post((unsigned*)(p.ws + WS_CTL) + 4096, MISC + 8);
#define PHASE(PH, l, e) do { int t_ = threadIdx.x; asm volatile("" : "+v"(t_)); run_phase<PH>(p, l, e, lds, t_, t_ & 63, __builtin_amdgcn_readfirstlane(t_ >> 6)); xcd_barrier(bar); } while (0)
    PHASE(PH_PRO, 0, 0);
#if MK_LOOP_L
    for (int l = 0; l < 2; ++l) {
        PHASE(PH_NORM1, l, 0); PHASE(PH_GIN, l, 0); PHASE(PH_STREAM, l, 0); PHASE(PH_GLR, l, 0); PHASE(PH_S5A, l, 0); PHASE(PH_S5B, l, 0); PHASE(PH_CHUNK, l, 0); PHASE(PH_SEQ, l, 0); PHASE(PH_S5C, l, 0);
        PHASE(PH_READOUT, l, 0); PHASE(PH_GGLU, l, 0); PHASE(PH_GOUT, l, 0); PHASE(PH_NORM2, l, 0);
        if (l == 0) { PHASE(PH_GFUP, 0, 0); PHASE(PH_GFDN, 0, 0); }
        else { PHASE(PH_MPREP, 1, 0); for (int e = 0; e < 2; ++e) { PHASE(PH_GMUP, 1, e); PHASE(PH_GMDN, 1, e); } }
    }
#else
    PHASE(PH_NORM1, 0, 0); PHASE(PH_GIN, 0, 0); PHASE(PH_STREAM, 0, 0); PHASE(PH_CHUNK, 0, 0); PHASE(PH_SEQ, 0, 0); PHASE(PH_S5A, 0, 0); PHASE(PH_S5B, 0, 0); PHASE(PH_S5C, 0, 0);
    PHASE(PH_GGLU, 0, 0); PHASE(PH_GOUT, 0, 0); PHASE(PH_NORM2, 0, 0); PHASE(PH_GFUP, 0, 0); PHASE(PH_GFDN, 0, 0);
    PHASE(PH_NORM1, 1, 0); PHASE(PH_GIN, 1, 0); PHASE(PH_STREAM, 1, 0); PHASE(PH_CHUNK, 1, 0); PHASE(PH_SEQ, 1, 0); PHASE(PH_S5A, 1, 0); PHASE(PH_S5B, 1, 0); PHASE(PH_S5C, 1, 0);
    PHASE(PH_GGLU, 1, 0); PHASE(PH_GOUT, 1, 0); PHASE(PH_NORM2M, 1, 0); PHASE(PH_MPREP, 1, 0);
    for (int e = 0; e < 2; ++e) { PHASE(PH_GMUP, 1, e); PHASE(PH_GMDN, 1, e); }
#endif
    { int t_ = threadIdx.x; asm volatile("" : "+v"(t_)); run_phase<PH_FINAL>(p, 0, 0, lds, t_, t_ & 63, __builtin_amdgcn_readfirstlane(t_ >> 6)); }
#undef PHASE
}
#endif
}

#ifndef MK_FUSED
template <int PH> static void launch_ph(const mk::Params& a, int l, int e, int grid, hipStream_t stream) {
    static bool attr = false;
    if (!attr) { (void)hipFuncSetAttribute((const void*)mk::k_ph<PH>, hipFuncAttributeMaxDynamicSharedMemorySize, mk::LDS_BYTES); attr = true; }
    hipLaunchKernelGGL((mk::k_ph<PH>), dim3(grid), dim3(512), mk::LDS_BYTES, stream, a, l, e);
}
#endif
extern "C" void kernel_launch(void* const* d_in, const int* in_sizes, int n_in, void* d_out, int out_size, void* d_ws, size_t ws_size, hipStream_t stream) {
    using namespace mk;
    static int grid = 0;
    if (grid == 0) {
        if (n_in != N_IN || in_sizes[0] != NLAT * D || out_size != NLAT * D || ws_size < WS_END) { fprintf(stderr, "kernel_launch: unexpected shapes (n_in %d, ws %zu < %zu?)\n", n_in, ws_size, (size_t)WS_END); grid = -1; return; }
        int dev = 0, cus = 0;
        if (hipGetDevice(&dev) != hipSuccess || hipDeviceGetAttribute(&cus, hipDeviceAttributeMultiprocessorCount, dev) != hipSuccess) { grid = -1; return; }
        grid = cus;
    }
    if (grid < 0) return;
    (void)hipMemsetAsync((char*)d_ws + WS_CTL, 0, CTL_ZERO_BYTES, stream);
    Params a{};
    for (int i = 0; i < N_IN; ++i) a.in[i] = (const float*)d_in[i];
    a.out = (float*)d_out; a.ws = (unsigned char*)d_ws; a.lo = 0; a.hi = 0;
#ifdef MK_FUSED
    { static bool attr = false; if (!attr) { (void)hipFuncSetAttribute((const void*)fwd_fused, hipFuncAttributeMaxDynamicSharedMemorySize, LDS_BYTES); attr = true; }
      hipLaunchKernelGGL(fwd_fused, dim3(grid), dim3(512), LDS_BYTES, stream, a); return; }
#endif
#ifndef MK_FUSED
    launch_ph<PH_PRO>(a, 0, 0, grid, stream);
    for (int l = 0; l < 2; ++l) {
        launch_ph<PH_NORM1>(a, l, 0, grid, stream); launch_ph<PH_GIN>(a, l, 0, grid, stream); launch_ph<PH_STREAM>(a, l, 0, grid, stream);
        launch_ph<PH_CHUNK>(a, l, 0, grid, stream); launch_ph<PH_SEQ>(a, l, 0, grid, stream); launch_ph<PH_S5A>(a, l, 0, grid, stream); launch_ph<PH_S5B>(a, l, 0, grid, stream); launch_ph<PH_S5C>(a, l, 0, grid, stream);
        launch_ph<PH_GGLU>(a, l, 0, grid, stream); launch_ph<PH_GOUT>(a, l, 0, grid, stream); if (l == 0) launch_ph<PH_NORM2>(a, l, 0, grid, stream); else launch_ph<PH_NORM2M>(a, l, 0, grid, stream);
        if (l == 0) { launch_ph<PH_GFUP>(a, l, 0, grid, stream); launch_ph<PH_GFDN>(a, l, 0, grid, stream); }
        else { launch_ph<PH_MPREP>(a, l, 0, grid, stream); for (int e = 0; e < 2; ++e) { launch_ph<PH_GMUP>(a, l, e, grid, stream); launch_ph<PH_GMDN>(a, l, e, grid, stream); } }
    }
    launch_ph<PH_FINAL>(a, 0, 0, grid, stream);
#endif
}
```

```cpp
#include <hip/hip_runtime.h>
#include <cstdio>
#include <cstdint>
namespace pg8 {
#define PG8_LAS __attribute__((address_space(3)))
typedef unsigned short bf16_t;
typedef short bf16x8 __attribute__((ext_vector_type(8)));
typedef float f32x4 __attribute__((ext_vector_type(4)));
typedef unsigned u32x4 __attribute__((ext_vector_type(4)));
constexpr int BM = 256, BK = 64, HALF = 128, HTB = HALF * BK * 2  , STAGE_BYTES = 8 * HTB, NXCD = 8, WGM = 8;

__host__ __device__ __forceinline__ int lds_byte(int r, int c) { const int st = (r >> 4) * 2 + (c >> 5), rr = r & 15, cc = c & 31, ob = rr * 64 + cc * 2; return st * 1024 + (ob ^ (((ob >> 9) & 1) << 5)); }
__host__ __device__ __forceinline__ void stage_rc(int b, int& R, int& C) { const int st = b / 1024, sb = b % 1024, swz = sb ^ (((sb >> 9) & 1) << 5); R = (st >> 1) * 16 + swz / 64; C = (st & 1) * 32 + (swz % 64) / 2; }
__host__ __device__ __forceinline__ int perm32(int rho) { const int n = rho >> 4, i = rho & 15; return 8 * (i >> 2) + 4 * n + (i & 3); }

struct Unit { int pm, pn, pa, pb, po, ko; };
struct Gemm { const bf16_t* A; const bf16_t* Bt; int M, N, K, ld; };

struct StaticOrder {
    int nM, nN, nwg, G, c;
    __host__ __device__ void init(int M, int N, int G_, int c_) { nM = M / BM; nN = N / BM; nwg = nM * nN; G = G_; c = c_; }
    __host__ __device__ bool next(int i, Unit& u) const {
        const long L = (long)i * G + c; if (L >= nwg) return false;
        int wgid = (int)L; { const int q = nwg / NXCD, r = nwg % NXCD, xcd = wgid % NXCD, off = wgid / NXCD; wgid = (xcd < r ? xcd * (q + 1) : r * (q + 1) + (xcd - r) * q) + off; }
        const int nig = WGM * nN, gid = wgid / nig, fm = gid * WGM, gsz = (nM - fm) < WGM ? (nM - fm) : WGM;
        u.pm = fm + ((wgid % nig) % gsz); u.pn = (wgid % nig) / gsz; u.pa = u.pm; u.pb = u.pn; u.po = u.pm; u.ko = 0; return true;
    }
    __device__ __forceinline__ void a_ready(const Unit&) const {}
    __device__ __forceinline__ void done(const Unit&) const {}
};

struct GroupOrder : StaticOrder {
    int t0, a0, o0, nNr, kslice; int toff[9];
    __device__ __forceinline__ bool next(int i, Unit& u) const {
        if (!StaticOrder::next(i, u)) return false;
        u.pm += t0; int e = 0;
#pragma unroll
        for (int q = 1; q < 8; ++q) e += (u.pm >= toff[q]) ? 1 : 0;
        const int ks = u.pn / nNr; u.pn -= ks * nNr; u.ko = ks * kslice;
        u.pa = u.pm - a0; u.po = u.pm - o0; u.pb = e * nNr + u.pn; return true;
    }
};
__device__ __forceinline__ unsigned cvt_pk_bf16(float lo, float hi) { unsigned r; asm volatile("v_cvt_pk_bf16_f32 %0, %1, %2" : "=v"(r) : "v"(lo), "v"(hi)); return r; }
typedef float f32x2 __attribute__((ext_vector_type(2)));
__device__ __forceinline__ f32x2 gelu_pk(f32x2 v) {
    const f32x2 av = __builtin_elementwise_abs(v), d = av * 0.2316418882f + 1.0f;
    f32x2 t; t.x = __builtin_amdgcn_rcpf(d.x); t.y = __builtin_amdgcn_rcpf(d.y);
    f32x2 q = t * 0.5307027145f + (-0.7265760135f); q = q * t + 0.7107068705f; q = q * t + (-0.142248368f); q = q * t + 0.127414796f; q = q * t;
    const f32x2 s = (v * v) * (-0.72134752044f);
    f32x2 e; e.x = __builtin_amdgcn_exp2f(s.x); e.y = __builtin_amdgcn_exp2f(s.y);
    const f32x2 m = v * (q * e), r = v - m;
    f32x2 o; o.x = v.x < 0.f ? m.x : r.x; o.y = v.y < 0.f ? m.y : r.y; return o;
}

template <int ACT  > struct EpiBf16 {
    static constexpr bool PERM = true, AFTER_DRAIN = false; static_assert(ACT == 0 || ACT == 1, "EpiBf16: ACT is 0 (none) or 1 (gelu_pk)");
    bf16_t* O; int ldc; const float* bias; int split_cols; size_t split_stride; float scale0;
    __device__ __forceinline__ void operator()(const f32x4 (&acc)[2][2][4][2], const Unit& u, int wr, int wc, int fr, int fq) const {
        const int row0 = u.pm * BM + wr * 64 + fr; int colt = u.pn * BM; bf16_t* base = O;
        float sc = 1.f; if (split_cols) { const int t = colt / split_cols; base += (size_t)t * split_stride; colt -= t * split_cols; if (t == 0) sc = scale0; }
        const int col0 = colt + wc * 32 + 8 * fq, bcol0 = u.pn * BM + wc * 32 + 8 * fq;
        f32x4 bv[2][2];
#pragma unroll
        for (int bj = 0; bj < 2; ++bj)
#pragma unroll
            for (int n = 0; n < 2; ++n) bv[bj][n] = bias ? *(const f32x4*)(bias + bcol0 + bj * HALF + 4 * n) : (f32x4){0.f, 0.f, 0.f, 0.f};
#pragma unroll
        for (int ai = 0; ai < 2; ++ai)
#pragma unroll
            for (int m = 0; m < 4; ++m) { bf16_t* rowp = base + (size_t)(row0 + ai * HALF + m * 16) * ldc + col0;
#pragma unroll
                for (int bj = 0; bj < 2; ++bj) { f32x4 v0 = acc[ai][bj][m][0] + bv[bj][0], v1 = acc[ai][bj][m][1] + bv[bj][1];
                    if (ACT == 1) { f32x2 a = gelu_pk((f32x2){v0[0], v0[1]}), b = gelu_pk((f32x2){v0[2], v0[3]}), c = gelu_pk((f32x2){v1[0], v1[1]}), d = gelu_pk((f32x2){v1[2], v1[3]});
                        v0 = (f32x4){a.x, a.y, b.x, b.y}; v1 = (f32x4){c.x, c.y, d.x, d.y}; }
                    v0 = v0 * sc; v1 = v1 * sc; u32x4 w; w.x = cvt_pk_bf16(v0[0], v0[1]); w.y = cvt_pk_bf16(v0[2], v0[3]); w.z = cvt_pk_bf16(v1[0], v1[1]); w.w = cvt_pk_bf16(v1[2], v1[3]);
                    *(u32x4*)(rowp + bj * HALF) = w; } }
    }
};

__device__ __forceinline__ float bf_lo(unsigned w) { return __uint_as_float(w << 16); }
__device__ __forceinline__ float bf_hi(unsigned w) { return __uint_as_float(w & 0xffff0000u); }
__device__ __forceinline__ float sigm(float x) { return 1.0f / (1.0f + __expf(-x)); }
constexpr int T_ROWS = 16896, N_LAT = 16384;
struct EpiGLU {
    static constexpr bool PERM = true, AFTER_DRAIN = false;
    const bf16_t* YG; bf16_t* A2; const float* bias;
    __device__ __forceinline__ void operator()(const f32x4 (&acc)[2][2][4][2], const Unit& u, int wr, int wc, int fr, int fq) const {
        const int row0 = u.pm * BM + wr * 64 + fr, cb = u.pn * BM + wc * 32 + 8 * fq;
#pragma unroll
        for (int ai = 0; ai < 2; ++ai)
#pragma unroll
            for (int m = 0; m < 4; ++m) { const int row = row0 + ai * HALF + m * 16;
#pragma unroll
                for (int bj = 0; bj < 2; ++bj) { const int c = cb + bj * HALF; const f32x4 v0 = acc[ai][bj][m][0], v1 = acc[ai][bj][m][1];
                    const float v[8] = {v0[0], v0[1], v0[2], v0[3], v1[0], v1[1], v1[2], v1[3]};
                    const u32x4 y8 = *(const u32x4*)(YG + (size_t)row * 512 + c);
                    const float yf[8] = {bf_lo(y8.x), bf_hi(y8.x), bf_lo(y8.y), bf_hi(y8.y), bf_lo(y8.z), bf_hi(y8.z), bf_lo(y8.w), bf_hi(y8.w)};
                    float s[8];
#pragma unroll
                    for (int j = 0; j < 8; ++j) s[j] = yf[j] * sigm(v[j] + bias[c + j]);
                    u32x4 w1; w1.x = cvt_pk_bf16(s[0], s[1]); w1.y = cvt_pk_bf16(s[2], s[3]); w1.z = cvt_pk_bf16(s[4], s[5]); w1.w = cvt_pk_bf16(s[6], s[7]);
                    *(u32x4*)(A2 + (size_t)row * 1024 + 512 + c) = w1; } }
    }
};
struct EpiRes {
    static constexpr bool PERM = false, AFTER_DRAIN = false;
    float* X; const float* gate; const float* comb; int e;
    __device__ __forceinline__ void operator()(const f32x4 (&acc)[2][2][4][2], const Unit& u, int wr, int wc, int fr, int fq) const {
        const int midx = (u.pm < 64) ? (u.pm >> 5) : 2; const float* gp = gate + midx * 6144;
        const int row0 = u.pm * BM + wr * 64 + fr, col0 = u.pn * BM + wc * 32 + 4 * fq;
        f32x4 gv[2][2];
#pragma unroll
        for (int bj = 0; bj < 2; ++bj)
#pragma unroll
            for (int n = 0; n < 2; ++n) gv[bj][n] = *(const f32x4*)(gp + col0 + bj * HALF + n * 16);
#pragma unroll
        for (int ai = 0; ai < 2; ++ai) {
            f32x4 xv[4][2][2]; float cf4[4];
#pragma unroll
            for (int m = 0; m < 4; ++m) { const int row = row0 + ai * HALF + m * 16; cf4[m] = comb ? comb[(size_t)row * 8 + e] : 1.0f; const float* rowp = X + (size_t)row * 1024 + col0;
#pragma unroll
                for (int bj = 0; bj < 2; ++bj)
#pragma unroll
                    for (int n = 0; n < 2; ++n) xv[m][bj][n] = *(const f32x4*)(rowp + bj * HALF + n * 16); }
#pragma unroll
            for (int m = 0; m < 4; ++m) { const int row = row0 + ai * HALF + m * 16; float* rowp = X + (size_t)row * 1024 + col0;
#pragma unroll
                for (int bj = 0; bj < 2; ++bj)
#pragma unroll
                    for (int n = 0; n < 2; ++n) *(f32x4*)(rowp + bj * HALF + n * 16) = xv[m][bj][n] + gv[bj][n] * acc[ai][bj][m][n] * cf4[m]; }
        }
    }
};
struct EpiSwiGLU {
    static constexpr bool PERM = true, AFTER_DRAIN = false;
    bf16_t* ACT; int ldc;
    __device__ __forceinline__ void operator()(const f32x4 (&acc)[2][2][4][2], const Unit& u, int wr, int wc, int fr, int fq) const {
        const int row0 = u.po * BM + wr * 64 + fr, c = u.pn * HALF + wc * 32 + 8 * fq;
#pragma unroll
        for (int ai = 0; ai < 2; ++ai)
#pragma unroll
            for (int m = 0; m < 4; ++m) { const int row = row0 + ai * HALF + m * 16;
                const f32x4 g0 = acc[ai][0][m][0], g1 = acc[ai][0][m][1], u0 = acc[ai][1][m][0], u1 = acc[ai][1][m][1];
                float s[8];
#pragma unroll
                for (int j = 0; j < 4; ++j) { s[j] = g0[j] * sigm(g0[j]) * u0[j]; s[4 + j] = g1[j] * sigm(g1[j]) * u1[j]; }
                u32x4 w1; w1.x = cvt_pk_bf16(s[0], s[1]); w1.y = cvt_pk_bf16(s[2], s[3]); w1.z = cvt_pk_bf16(s[4], s[5]); w1.w = cvt_pk_bf16(s[6], s[7]);
                *(u32x4*)(ACT + (size_t)row * ldc + c) = w1; }
    }
};


struct EpiPartF32 {
    static constexpr bool PERM = false, AFTER_DRAIN = false;
    float* PART; int row_base, rows, kslice;
    __device__ __forceinline__ void operator()(const f32x4 (&acc)[2][2][4][2], const Unit& u, int wr, int wc, int fr, int fq) const {
        const int ks = u.ko / kslice; float* P0 = PART + (size_t)ks * rows * 1024;
        const int row0 = u.pm * BM - row_base + wr * 64 + fr, col0 = u.pn * BM + wc * 32 + 4 * fq;
#pragma unroll
        for (int ai = 0; ai < 2; ++ai)
#pragma unroll
            for (int m = 0; m < 4; ++m) { float* rowp = P0 + (size_t)(row0 + ai * HALF + m * 16) * 1024 + col0;
#pragma unroll
                for (int bj = 0; bj < 2; ++bj)
#pragma unroll
                    for (int n = 0; n < 2; ++n) *(f32x4*)(rowp + bj * HALF + n * 16) = acc[ai][bj][m][n]; }
    }
};

struct EpiPartBf16 {
    static constexpr bool PERM = true, AFTER_DRAIN = false;
    bf16_t* PART; int row_base, rows, kslice;
    __device__ __forceinline__ void operator()(const f32x4 (&acc)[2][2][4][2], const Unit& u, int wr, int wc, int fr, int fq) const {
        const int ks = u.ko / kslice; bf16_t* P0 = PART + (size_t)ks * rows * 1024;
        const int row0 = u.pm * BM - row_base + wr * 64 + fr, col0 = u.pn * BM + wc * 32 + 8 * fq;
#pragma unroll
        for (int ai = 0; ai < 2; ++ai)
#pragma unroll
            for (int m = 0; m < 4; ++m) { bf16_t* rowp = P0 + (size_t)(row0 + ai * HALF + m * 16) * 1024 + col0;
#pragma unroll
                for (int bj = 0; bj < 2; ++bj) { const f32x4 v0 = acc[ai][bj][m][0], v1 = acc[ai][bj][m][1];
                    u32x4 w; w.x = cvt_pk_bf16(v0[0], v0[1]); w.y = cvt_pk_bf16(v0[2], v0[3]); w.z = cvt_pk_bf16(v1[0], v1[1]); w.w = cvt_pk_bf16(v1[2], v1[3]);
                    *(u32x4*)(rowp + bj * HALF) = w; } }
    }
};
template <class Epi, class Sched, bool ALIGN_EPI = false, bool SP2 = false>
__device__ __forceinline__ void gemm_phase(PG8_LAS unsigned char* lds, const Gemm g, const Sched& S, const Epi& E, const int tid) {
    const int wid = __builtin_amdgcn_readfirstlane(tid >> 6), lane = tid & 63, wr = wid >> 2, wc = wid & 3, fr = lane & 15, fq = lane >> 4;
    const int K = g.ld, nt = g.K / BK;
    unsigned voffA[2], voffB[2];
#pragma unroll
    for (int i = 0; i < 2; ++i) { int R, C; stage_rc(tid * 16 + i * 8192, R, C); const int Rb = Epi::PERM ? ((R & ~31) + perm32(R & 31)) : R;
        voffA[i] = (unsigned)(R * K + C) * 2u; voffB[i] = (unsigned)(Rb * K + C) * 2u; }
    const size_t kstep = (size_t)(BK * 2);
    const size_t hstep = (size_t)HALF * K * 2;
    const size_t tstep = 2 * hstep;
    const unsigned ldsw = (unsigned)wid * 1024u;
    const int aoff = lds_byte(wr * 64 + fr, fq * 8), boff = lds_byte(wc * 32 + fr, fq * 8);
#define PG8_SA(b, h) (((b) * 2 + (h)) * HTB)
#define PG8_SB(b, h) ((4 + (b) * 2 + (h)) * HTB)
#define PG8_STAGE(bufoff, gbase, voff) do { _Pragma("unroll") for (int _i = 0; _i < 2; ++_i) \
        __builtin_amdgcn_global_load_lds((const unsigned*)((const char*)(gbase) + (voff)[_i]), (PG8_LAS unsigned*)(lds + (bufoff) + ldsw + _i * 8192), 16, 0, 0); } while (0)
#define PG8_LDA(dst, b, h) do { _Pragma("unroll") for (int m = 0; m < 4; ++m) _Pragma("unroll") for (int k = 0; k < 2; ++k) dst[m][k] = *(const PG8_LAS bf16x8*)(lds + PG8_SA(b, h) + aoff + m * 2048 + k * 1024); } while (0)
#define PG8_LDB(dst, b, h) do { _Pragma("unroll") for (int n = 0; n < 2; ++n) _Pragma("unroll") for (int k = 0; k < 2; ++k) dst[n][k] = *(const PG8_LAS bf16x8*)(lds + PG8_SB(b, h) + boff + n * 2048 + k * 1024); } while (0)
#define PG8_MMA(ai, bj, At, Bt) do { __builtin_amdgcn_s_setprio(1); _Pragma("unroll") for (int m = 0; m < 4; ++m) _Pragma("unroll") for (int n = 0; n < 2; ++n) _Pragma("unroll") for (int k = 0; k < 2; ++k) \
        acc[ai][bj][m][n] = __builtin_amdgcn_mfma_f32_16x16x32_bf16(Bt[n][k], At[m][k], acc[ai][bj][m][n], 0, 0, 0); __builtin_amdgcn_s_setprio(0); } while (0)
#define PG8_WAIT_V(n) asm volatile("s_waitcnt vmcnt(" #n ")" ::: "memory")
#define PG8_WAIT_L(n) asm volatile("s_waitcnt lgkmcnt(" #n ")" ::: "memory")
#define PG8_BAR __builtin_amdgcn_s_barrier()
#define PG8_SCHED __builtin_amdgcn_sched_barrier(0)
    Unit cur, nxt; int ui = 0;
    if (!S.next(0, cur)) return;
    f32x4 acc[2][2][4][2];
#pragma unroll
    for (int a = 0; a < 2; ++a)
#pragma unroll
        for (int b = 0; b < 2; ++b)
#pragma unroll
            for (int m = 0; m < 4; ++m)
#pragma unroll
                for (int n = 0; n < 2; ++n) acc[a][b][m][n] = (f32x4){0.f, 0.f, 0.f, 0.f};
    bf16x8 At[4][2], B0[2][2], B1[2][2];
    const char* cA = (const char*)g.A + (size_t)cur.pa * tstep + (size_t)cur.ko * 2; const char* cB = (const char*)g.Bt + (size_t)cur.pb * tstep + (size_t)cur.ko * 2;
    S.a_ready(cur);
    if constexpr (SP2) {
        PG8_STAGE(PG8_SB(0, 0), cB, voffB); PG8_STAGE(PG8_SB(0, 1), cB + hstep, voffB); PG8_STAGE(PG8_SA(0, 0), cA, voffA); PG8_STAGE(PG8_SA(0, 1), cA + hstep, voffA);
        if (wr == 1) PG8_BAR;
        PG8_WAIT_V(2); PG8_BAR;
        PG8_STAGE(PG8_SB(1, 0), cB + kstep, voffB); PG8_STAGE(PG8_SA(1, 0), cA + kstep, voffA); PG8_STAGE(PG8_SB(1, 1), cB + hstep + kstep, voffB);
        PG8_WAIT_V(6); PG8_BAR;
    } else {
        PG8_STAGE(PG8_SB(0, 0), cB, voffB); PG8_STAGE(PG8_SA(0, 0), cA, voffA); PG8_STAGE(PG8_SB(0, 1), cB + hstep, voffB); PG8_STAGE(PG8_SA(0, 1), cA + hstep, voffA);
        if (wr == 1) PG8_BAR;
        PG8_WAIT_V(4); PG8_BAR;
        PG8_STAGE(PG8_SB(1, 0), cB + kstep, voffB); PG8_STAGE(PG8_SA(1, 0), cA + kstep, voffA); PG8_STAGE(PG8_SB(1, 1), cB + hstep + kstep, voffB);
        PG8_WAIT_V(6); PG8_BAR;
    }
    for (;;) {
        const bool has_next = S.next(ui + 1, nxt);
        const char* nA = has_next ? (const char*)g.A + (size_t)nxt.pa * tstep + (size_t)nxt.ko * 2 : cA; const char* nB = has_next ? (const char*)g.Bt + (size_t)nxt.pb * tstep + (size_t)nxt.ko * 2 : cB;
        for (int t = 0; t < nt; t += 2) {
            const bool last = (t == nt - 2);
            const char* a1 = cA + (size_t)(t + 1) * kstep;
            const char* a2 = last ? nA : cA + (size_t)(t + 2) * kstep; const char* b2 = last ? nB : cB + (size_t)(t + 2) * kstep;
            const char* a3 = a2 + kstep; const char* b3 = b2 + kstep;
            if (last && has_next) S.a_ready(nxt);
            if constexpr (SP2) {
            PG8_LDB(B0, 0, 0); PG8_LDB(B1, 0, 1); PG8_SCHED; PG8_LDA(At, 0, 0); PG8_STAGE(PG8_SA(1, 1), a1 + hstep, voffA);
            PG8_WAIT_V(8); PG8_WAIT_L(0); PG8_BAR; PG8_MMA(0, 0, At, B0); PG8_MMA(0, 1, At, B1); PG8_BAR; PG8_SCHED;
            PG8_LDA(At, 0, 1); PG8_STAGE(PG8_SB(0, 0), b2, voffB); PG8_STAGE(PG8_SB(0, 1), b2 + hstep, voffB); PG8_STAGE(PG8_SA(0, 0), a2, voffA);
            PG8_WAIT_V(8); PG8_WAIT_L(0); PG8_BAR; PG8_MMA(1, 0, At, B0); PG8_MMA(1, 1, At, B1); PG8_BAR; PG8_SCHED;
            PG8_LDB(B0, 1, 0); PG8_LDB(B1, 1, 1); PG8_SCHED; PG8_LDA(At, 1, 0); PG8_STAGE(PG8_SA(0, 1), a2 + hstep, voffA);
            PG8_WAIT_V(8); PG8_WAIT_L(0); PG8_BAR; PG8_MMA(0, 0, At, B0); PG8_MMA(0, 1, At, B1); PG8_BAR; PG8_SCHED;
            PG8_LDA(At, 1, 1); PG8_STAGE(PG8_SB(1, 0), b3, voffB); PG8_STAGE(PG8_SB(1, 1), b3 + hstep, voffB); PG8_STAGE(PG8_SA(1, 0), a3, voffA);
            PG8_WAIT_V(8); PG8_WAIT_L(0); PG8_BAR; PG8_MMA(1, 0, At, B0); PG8_MMA(1, 1, At, B1); PG8_BAR; PG8_SCHED;
            } else {
            PG8_LDB(B0, 0, 0); PG8_SCHED; PG8_LDA(At, 0, 0); PG8_STAGE(PG8_SA(1, 1), a1 + hstep, voffA);
            PG8_WAIT_L(8); PG8_BAR; PG8_WAIT_L(0); PG8_MMA(0, 0, At, B0); PG8_BAR; PG8_SCHED;
            PG8_LDB(B1, 0, 1); PG8_STAGE(PG8_SB(0, 0), b2, voffB);
            PG8_BAR; PG8_WAIT_L(0); PG8_MMA(0, 1, At, B1); PG8_BAR;
            PG8_LDA(At, 0, 1); PG8_STAGE(PG8_SA(0, 0), a2, voffA);
            PG8_BAR; PG8_WAIT_L(0); PG8_MMA(1, 0, At, B0); PG8_BAR; PG8_SCHED;
            PG8_STAGE(PG8_SB(0, 1), b2 + hstep, voffB);
            PG8_WAIT_V(6); PG8_BAR; PG8_MMA(1, 1, At, B1); PG8_BAR;
            PG8_LDB(B0, 1, 0); PG8_SCHED; PG8_LDA(At, 1, 0); PG8_STAGE(PG8_SA(0, 1), a2 + hstep, voffA);
            PG8_WAIT_L(8); PG8_BAR; PG8_WAIT_L(0); PG8_MMA(0, 0, At, B0); PG8_BAR; PG8_SCHED;
            PG8_LDB(B1, 1, 1); PG8_STAGE(PG8_SB(1, 0), b3, voffB);
            PG8_BAR; PG8_WAIT_L(0); PG8_MMA(0, 1, At, B1); PG8_BAR;
            PG8_LDA(At, 1, 1); PG8_STAGE(PG8_SA(1, 0), a3, voffA);
            PG8_BAR; PG8_WAIT_L(0); PG8_MMA(1, 0, At, B0); PG8_BAR; PG8_SCHED;
            PG8_STAGE(PG8_SB(1, 1), b3 + hstep, voffB);
            PG8_WAIT_V(6); PG8_BAR; PG8_MMA(1, 1, At, B1); PG8_BAR;
            }
        }
        if constexpr (ALIGN_EPI) { if (wr == 0) PG8_BAR; }
        if constexpr (!Epi::AFTER_DRAIN) { E(acc, cur, wr, wc, fr, fq); S.done(cur); }
        if (!has_next) break;
#pragma unroll
        for (int a = 0; a < 2; ++a)
#pragma unroll
            for (int b = 0; b < 2; ++b)
#pragma unroll
                for (int m = 0; m < 4; ++m)
#pragma unroll
                    for (int n = 0; n < 2; ++n) acc[a][b][m][n] = (f32x4){0.f, 0.f, 0.f, 0.f};
        cur = nxt; cA = nA; cB = nB; ++ui;
        if constexpr (ALIGN_EPI) { if (wr == 1) PG8_BAR; }
    }
    PG8_WAIT_V(0);
    if constexpr (!ALIGN_EPI) { if (wr == 0) PG8_BAR; }
    PG8_BAR;
    if constexpr (Epi::AFTER_DRAIN) { E.fused(acc, cur, wr, wc, fr, fq, lds, wid, lane); S.done(cur); }
#undef PG8_SA
#undef PG8_SB
#undef PG8_STAGE
#undef PG8_LDA
#undef PG8_LDB
#undef PG8_MMA
#undef PG8_WAIT_V
#undef PG8_WAIT_L
#undef PG8_BAR
#undef PG8_SCHED
}
}

namespace mk {
typedef unsigned short bf16;
typedef float f32x4 __attribute__((ext_vector_type(4)));
typedef unsigned u32x4 __attribute__((ext_vector_type(4)));
typedef unsigned u32x2 __attribute__((ext_vector_type(2)));
#define LAS __attribute__((address_space(3)))
constexpr int D = 1024, NB = 2, SEQ = 8192, CTXL = 256, NLAT = NB * SEQ, NCTX = NB * CTXL, T = NLAT + NCTX;
constexpr int DIN = 2560, DFF = 2816, NE = 8, DFE = 3584, SPOS = SEQ + CTXL  , NCH = SPOS / 64;
static_assert(T == pg8::T_ROWS && NLAT == pg8::N_LAT, "rows");
enum { I_X = 0, I_C, I_CTX, I_CCTX, I_ADAW, I_ADAB, I_N1G, I_N2G, I_WIN, I_WOUT, I_MU, I_W0, I_WUP, I_A0, I_AUP, I_GUP, I_KK, I_KA, I_RK, I_LNW, I_LNB,
       I_LRE, I_LIM, I_LDT, I_BRE, I_BIM, I_CRE, I_CIM, I_S5D, I_GLUW, I_GLUB, I_FG, I_FU, I_FD, I_ROUT, I_MG, I_MU2, I_MD, I_FING, N_IN };
constexpr size_t MiB = 1u << 20, QMiB = 1u << 18;
constexpr size_t WS_CTL = 0, CTL_ZERO_BYTES = 65536;
constexpr size_t WS_MOD = 1 * MiB;
constexpr size_t WS_COMB = 1 * MiB + 2 * QMiB;
constexpr size_t WS_WIN = 2 * MiB;
constexpr size_t WS_WOUT = 12 * MiB;
constexpr size_t WS_WGLU = 16 * MiB;
constexpr size_t WS_WLR = 17 * MiB;
constexpr size_t WS_WFUP = 23 * MiB;
constexpr size_t WS_WFDN = 34 * MiB;
constexpr size_t WS_X = 40 * MiB;
constexpr size_t WS_H = 106 * MiB;
constexpr size_t WS_LRIN = 106 * MiB;
constexpr size_t WS_U = 122 * MiB + 2 * QMiB;
constexpr size_t WS_P = 370 * MiB;
constexpr size_t WS_LW = 139 * MiB;
constexpr size_t WS_XEND = 205 * MiB;
constexpr size_t WS_CARRY = 213 * MiB + QMiB;
constexpr size_t WS_Y = 139 * MiB;
constexpr size_t WS_YG = 221 * MiB + 2 * QMiB;
constexpr size_t WS_BONUS = 106 * MiB;
constexpr size_t WS_R = 221 * MiB + 2 * QMiB, WS_V = 238 * MiB, WS_KKN = 254 * MiB + 2 * QMiB;
constexpr size_t WS_KT = 271 * MiB, WS_BB = 304 * MiB, WS_GD = 337 * MiB;
constexpr size_t WS_K = 370 * MiB;
constexpr size_t WS_PARTO = 370 * MiB;
constexpr size_t WS_PARTF = 380 * MiB;
constexpr size_t WS_CH = 370 * MiB;
constexpr size_t WS_S5E = 271 * MiB;
constexpr size_t WS_S5BP = 304 * MiB;
constexpr size_t WS_S5K = 287 * MiB;
constexpr size_t WS_A2 = 304 * MiB;
constexpr size_t WS_ACT = 221 * MiB + 2 * QMiB;
constexpr size_t WS_RE = 1 * MiB + 2 * QMiB;
constexpr size_t WS_RP = WS_RE + 65536;
constexpr size_t WS_SEGCNT = WS_RE + 131072;
constexpr size_t WS_PROW = WS_RE + 196608;
constexpr size_t WS_PGW = WS_PROW + 147456;
constexpr size_t WS_TOFF = WS_PGW + 147456;
constexpr size_t WS_PPOS = 1 * MiB + QMiB;
constexpr size_t WS_APERM = 139 * MiB;
constexpr size_t WS_ACT1 = 207 * MiB;
constexpr int MOE_PASS_TILES = 64, MOE_MAX_TILES = 136, MOE_ACT_TILES = 72;
constexpr size_t WS_PARTM = 2 * MiB;
static_assert(WS_TOFF + 64 <= 2 * MiB && WS_APERM + (size_t)MOE_MAX_TILES * 256 * 2048 <= WS_ACT1 && WS_ACT1 + (size_t)MOE_ACT_TILES * 256 * DFE * 2 <= 333 * MiB + 2 * QMiB, "moe ws map");
constexpr size_t WS_WMUP = 333 * MiB + 2 * QMiB;
constexpr size_t WS_WMDN = 445 * MiB + 2 * QMiB;
constexpr size_t WS_END = 502 * MiB;
constexpr int NCC = 2 * NB * NCH * 8;
static_assert(WS_CH + (size_t)NCC * 32768 <= WS_END && WS_WMDN + (size_t)8 * 1024 * 3584 * 2 <= WS_END && WS_ACT + (size_t)NLAT * DFE * 2 <= WS_WMUP && WS_GD + (size_t)2 * T * 512 * 2 <= WS_K, "ws map");
constexpr int LDS_BYTES = 147456, RING_BYTES = 131072, MISC_OFF = LDS_BYTES - 1024, LDS_GC = LDS_BYTES - 2048;

struct Params { const float* in[N_IN]; float* out; unsigned char* ws; int lo, hi; };
static_assert(sizeof(Params) == 8 * N_IN + 24, "no padding");

__device__ __forceinline__ float bf2f(bf16 v) { return __uint_as_float(((unsigned)v) << 16); }
__device__ __forceinline__ unsigned f2bf(float f) { unsigned u = __float_as_uint(f); return (u + 0x7fffu + ((u >> 16) & 1u)) >> 16; }
__device__ __forceinline__ unsigned pk2(float lo, float hi) { return f2bf(lo) | (f2bf(hi) << 16); }
__device__ __forceinline__ float blo(unsigned w) { return __uint_as_float(w << 16); }
__device__ __forceinline__ float bhi(unsigned w) { return __uint_as_float(w & 0xffff0000u); }
__device__ __forceinline__ float sigm(float x) { return 1.0f / (1.0f + __expf(-x)); }
__device__ __forceinline__ float wave_sum(float v) {
#pragma unroll
    for (int o = 1; o < 64; o <<= 1) v += __shfl_xor(v, o);
    return v;
}
#define LDS_WAIT() asm volatile("s_waitcnt lgkmcnt(0)" ::: "memory")
__device__ __forceinline__ int row_of(int b, int d, int s) {
    return s < CTXL ? NLAT + b * CTXL + (d ? CTXL - 1 - s : s) : b * SEQ + (d ? SEQ - 1 - (s - CTXL) : (s - CTXL));
}

#define XB_TMO      128
#define XB_XCNT(j)  (256  + 64 * (j))
#define XB_XSUB(j)  (1280 + 64 * (j))
#define XB_XGEN(j)  (2304 + 64 * (j))
#define XB_TOP      3328
#define XB_TOPGEN   3392
#define XCD_BAR_WORDS 3456
#define XB_SPIN_CAP (1u << 25)
__device__ __forceinline__ unsigned xb_ld(unsigned* p)              { return __hip_atomic_load(p, __ATOMIC_RELAXED, __HIP_MEMORY_SCOPE_AGENT); }
__device__ __forceinline__ unsigned xb_add(unsigned* p, unsigned v) { return __hip_atomic_fetch_add(p, v, __ATOMIC_RELAXED, __HIP_MEMORY_SCOPE_AGENT); }
__device__ __forceinline__ unsigned xb_xcc_id() { return (unsigned)__builtin_amdgcn_s_getreg((3 << 11) | 20) & 0xFu; }
#define XB_SPIN(cond, bar) do { unsigned _sp = 0; while (cond) { __builtin_amdgcn_s_sleep(1); \
    if ((++_sp & 255u) == 0u) { if (xb_ld(&(bar)[XB_TMO])) break; if (_sp > XB_SPIN_CAP) { atomicAdd(&(bar)[XB_TMO], 1u); break; } } } } while (0)
struct XcdBarrier { unsigned* bar; unsigned x; volatile LAS unsigned* st; };
__device__ __forceinline__ XcdBarrier xcd_barrier_post(unsigned* bar, volatile LAS unsigned* st) {
    XcdBarrier b; b.bar = bar; b.x = xb_xcc_id(); b.st = st;
    if (threadIdx.x == 0) (void)xb_add(&bar[XB_XCNT(b.x)], 1u);
    return b;
}
__device__ __forceinline__ void xcd_barrier_complete(unsigned* bar, unsigned x, unsigned& nloc, unsigned& nx) {
    const unsigned G = gridDim.x * gridDim.y * gridDim.z;
    unsigned sum, cnt, mine, sp = 0u;
    for (;;) {
        sum = 0u; cnt = 0u; mine = 0u;
#pragma unroll
        for (unsigned j = 0; j < 16; ++j) { const unsigned c = xb_ld(&bar[XB_XCNT(j)]); sum += c; cnt += (c > 0u) ? 1u : 0u; mine = (j == x) ? c : mine; }
        if (sum == G) break;
        __builtin_amdgcn_s_sleep(1);
        if ((++sp & 255u) == 0u) { if (xb_ld(&bar[XB_TMO])) break; if (sp > XB_SPIN_CAP) { atomicAdd(&bar[XB_TMO], 1u); break; } }
    }
    nloc = mine > 0u ? mine : 1u; nx = cnt > 0u ? cnt : 1u;
}
__device__ __forceinline__ void xcd_barrier(const XcdBarrier& b) {
    asm volatile("s_waitcnt vmcnt(0)" ::: "memory");
    __syncthreads();
    if (threadIdx.x == 0) {
        unsigned* bar = b.bar;
        __builtin_amdgcn_s_waitcnt(0);
        unsigned nloc = b.st[0], nx = b.st[1];
        if (nloc == 0u) { xcd_barrier_complete(bar, b.x, nloc, nx); b.st[0] = nloc; b.st[1] = nx; }
        const unsigned old = xb_add(&bar[XB_XSUB(b.x)], 1u);
        const unsigned gen = old / nloc;
        if (old + 1u == (gen + 1u) * nloc) {
            __builtin_amdgcn_fence(__ATOMIC_RELEASE, "agent");
            asm volatile("s_waitcnt vmcnt(0)" ::: "memory");
            const unsigned og = xb_add(&bar[XB_TOP], 1u);
            const unsigned tg = og / nx;
            if (og + 1u == (tg + 1u) * nx) xb_add(&bar[XB_TOPGEN], 1u);
            else XB_SPIN(xb_ld(&bar[XB_TOPGEN]) == tg, bar);
            __builtin_amdgcn_fence(__ATOMIC_ACQUIRE, "agent");
            xb_add(&bar[XB_XGEN(b.x)], 1u);
            asm volatile("s_waitcnt vmcnt(0)" ::: "memory");
        } else {
            XB_SPIN(xb_ld(&bar[XB_XGEN(b.x)]) == gen, bar);
            __builtin_amdgcn_fence(__ATOMIC_ACQUIRE, "agent");
            asm volatile("s_waitcnt vmcnt(0)" ::: "memory");
        }
    }
    __syncthreads();
}

__device__ __forceinline__ void tr_item(const float* W, int Nsrc, int k0, int n0, bf16* dst, int ldk, int drow0, int dk0, bool zero, LAS float* scr, int lane) {
    if (!zero) {
#pragma unroll 8
        for (int i = 0; i < 32; ++i) { const int kk = 2 * i + (lane >> 5); scr[kk * 33 + (lane & 31)] = W[(size_t)(k0 + kk) * Nsrc + n0 + (lane & 31)]; }
    }
    LDS_WAIT(); asm volatile("" ::: "memory");
    const int c = lane & 7;
#pragma unroll
    for (int j = 0; j < 4; ++j) { const int n = (lane >> 3) + 8 * j; const LAS float* s = scr + (8 * c) * 33 + n;
        u32x4 o = (u32x4){0u, 0u, 0u, 0u};
        if (!zero) { o.x = pk2(s[0 * 33], s[1 * 33]); o.y = pk2(s[2 * 33], s[3 * 33]); o.z = pk2(s[4 * 33], s[5 * 33]); o.w = pk2(s[6 * 33], s[7 * 33]); }
        *(u32x4*)(dst + (size_t)(drow0 + n) * ldk + dk0 + 8 * c) = o; }
    LDS_WAIT(); asm volatile("" ::: "memory");
}

__device__ __forceinline__ void phase_prologue(const Params& p, LAS unsigned char* lds, int tid, int lane, int wave) {
    unsigned char* ws = p.ws;
    const int G = gridDim.x;
    {
        LAS float* act = (LAS float*)lds;
        LAS float* red = (LAS float*)(lds + 12288);
        for (int i = tid; i < 3 * 1024; i += 512) { const float v = i < 2048 ? p.in[I_C][i] : p.in[I_CCTX][i - 2048]; act[i] = v * sigm(v); }
        __syncthreads();
        float* MOD = (float*)(ws + WS_MOD);
        for (int task = blockIdx.x; task < 192; task += G) {
            const int l = task / 96, j = (task % 96) * 64 + lane;
            const float* Wp = p.in[I_ADAW] + (size_t)l * 1024 * 6144 + (size_t)(wave * 128) * 6144 + j;
            float a0 = 0.f, a1 = 0.f, a2 = 0.f;
#pragma unroll 8
            for (int k = 0; k < 128; ++k) { const float w = Wp[(size_t)k * 6144]; const int kk = wave * 128 + k; a0 += act[kk] * w; a1 += act[1024 + kk] * w; a2 += act[2048 + kk] * w; }
            red[(wave * 3 + 0) * 64 + lane] = a0; red[(wave * 3 + 1) * 64 + lane] = a1; red[(wave * 3 + 2) * 64 + lane] = a2;
            __syncthreads();
            if (wave < 3) { float s = p.in[I_ADAB][l * 6144 + j];
#pragma unroll
                for (int w = 0; w < 8; ++w) s += red[(w * 3 + wave) * 64 + lane];
                MOD[(size_t)(l * 3 + wave) * 6144 + j] = s; }
            __syncthreads();
        }
    }
    LAS float* scr = (LAS float*)(lds + 32768 + wave * 8448);
    const int gw = blockIdx.x * 8 + wave, NGW = G * 8;
    constexpr int PL = 1280 + 512 + 128 + 128, NIT = 2 * PL + 3 * 1408;
    for (int it0 = gw; it0 < NIT; it0 += NGW) {
        int it = it0;
        if (it < 2 * PL) {
            const int l = it / PL; it -= l * PL;
            if (it < 1280) { const int kb = it / 80, nb = it % 80; tr_item(p.in[I_WIN] + (size_t)l * 1024 * 2560, 2560, kb * 64, nb * 32, (bf16*)(ws + WS_WIN) + (size_t)l * 2560 * 1024, 1024, nb * 32, kb * 64, false, scr, lane); continue; }
            it -= 1280;
            if (it < 512) { const int kb = it / 32, nb = it % 32; tr_item(p.in[I_WOUT] + (size_t)l * 1024 * 1024, 1024, kb * 64, nb * 32, (bf16*)(ws + WS_WOUT) + (size_t)l * 1024 * 1024, 1024, nb * 32, kb * 64, false, scr, lane); continue; }
            it -= 512;
            if (it < 128) { const int kb = it / 16, nb = it % 16; tr_item(p.in[I_GLUW] + (size_t)l * 512 * 512, 512, kb * 64, nb * 32, (bf16*)(ws + WS_WGLU) + (size_t)l * 512 * 512, 512, nb * 32, kb * 64, false, scr, lane); continue; }
            it -= 128;
            {
                const int d = it / 64, q = it % 64; bf16* dst = (bf16*)(ws + WS_WLR) + (size_t)(l * 2 + d) * 131072;
                if (q < 16) tr_item(p.in[I_WUP] + (size_t)(l * 2 + d) * 64 * 512, 512, 0, q * 32, dst, 64, q * 32, 0, false, scr, lane);
                else if (q < 32) tr_item(p.in[I_AUP] + (size_t)(l * 2 + d) * 64 * 512, 512, 0, (q - 16) * 32, dst + 32768, 64, (q - 16) * 32, 0, false, scr, lane);
                else { const int kb = (q - 32) / 16, nb = (q - 32) % 16; tr_item(p.in[I_GUP] + (size_t)(l * 2 + d) * 128 * 512, 512, kb * 64, nb * 32, dst + 65536, 128, nb * 32, kb * 64, false, scr, lane); }
            }
            continue;
        }
        it -= 2 * PL;
        if (it < 1408) { const int kb = it / 88, nb = it % 88, n0 = nb * 32; tr_item(p.in[I_FG], 2816, kb * 64, n0, (bf16*)(ws + WS_WFUP), 1024, (n0 / 128) * 256 + n0 % 128, kb * 64, false, scr, lane); continue; }
        it -= 1408;
        if (it < 1408) { const int kb = it / 88, nb = it % 88, n0 = nb * 32; tr_item(p.in[I_FU], 2816, kb * 64, n0, (bf16*)(ws + WS_WFUP), 1024, (n0 / 128) * 256 + 128 + n0 % 128, kb * 64, false, scr, lane); continue; }
        it -= 1408;
        { const int kb = it / 32, nb = it % 32; tr_item(p.in[I_FD], 1024, kb * 64, nb * 32, (bf16*)(ws + WS_WFDN), 2816, nb * 32, kb * 64, false, scr, lane); }
    }
}
constexpr int MOE_CVT_ITEMS = 8 * 5376, MOE_CVT_SPLIT = 7 * 5376;
__device__ __forceinline__ void phase_moe_cvt(const Params& p, LAS unsigned char* lds, int lane, int wave, int it_begin, int it_end, int worker, int nworkers) {
    unsigned char* ws = p.ws;
    LAS float* scr = (LAS float*)(lds + 32768 + wave * 8448);
    for (int it0 = it_begin + worker; it0 < it_end; it0 += nworkers) {
        const int e = it0 / 5376; int it = it0 % 5376;
        if (it < 1792) { const int kb = it / 112, nb = it % 112, n0 = nb * 32; tr_item(p.in[I_MG] + (size_t)e * 1024 * 3584, 3584, kb * 64, n0, (bf16*)(ws + WS_WMUP) + (size_t)e * 7168 * 1024, 1024, (n0 / 128) * 256 + n0 % 128, kb * 64, false, scr, lane); continue; }
        it -= 1792;
        if (it < 1792) { const int kb = it / 112, nb = it % 112, n0 = nb * 32; tr_item(p.in[I_MU2] + (size_t)e * 1024 * 3584, 3584, kb * 64, n0, (bf16*)(ws + WS_WMUP) + (size_t)e * 7168 * 1024, 1024, (n0 / 128) * 256 + 128 + n0 % 128, kb * 64, false, scr, lane); continue; }
        it -= 1792;
        { const int kb = it / 32, nb = it % 32; tr_item(p.in[I_MD] + (size_t)e * 3584 * 1024, 1024, kb * 64, nb * 32, (bf16*)(ws + WS_WMDN) + (size_t)e * 1024 * 3584, 3584, nb * 32, kb * 64, false, scr, lane); }
    }
}

__device__ __forceinline__ void phase_norm(const Params& p, int l, int which, bool first, bool router, int lane, int wave, int npart = 0, const float* part = nullptr, const float* pgate = nullptr) {
    unsigned char* ws = p.ws;
    float* X = (float*)(ws + WS_X); bf16* H = (bf16*)(ws + WS_H); const float* MOD = (const float*)(ws + WS_MOD);
    const float* g = p.in[which ? I_N2G : I_N1G] + l * 1024;
    const int gw = blockIdx.x * 8 + wave, NGW = gridDim.x * 8;
    f32x4 gq[4];
#pragma unroll
    for (int j = 0; j < 4; ++j) gq[j] = *(const f32x4*)(g + 4 * lane + 256 * j);
#define NORM_FETCH(r_, V, SH, SC) do { const int rf_ = (r_); \
        const float* src_ = first ? (rf_ < NLAT ? p.in[I_X] + (size_t)rf_ * 1024 : p.in[I_CTX] + (size_t)(rf_ - NLAT) * 1024) : X + (size_t)rf_ * 1024; \
        const float* mp_ = MOD + (size_t)(l * 3 + (rf_ < NLAT ? (rf_ >> 13) : 2)) * 6144 + which * 3072; \
        _Pragma("unroll") for (int j = 0; j < 4; ++j) V[j] = *(const f32x4*)(src_ + 4 * lane + 256 * j); \
        _Pragma("unroll") for (int j = 0; j < 4; ++j) { SH[j] = *(const f32x4*)(mp_ + 4 * lane + 256 * j); SC[j] = *(const f32x4*)(mp_ + 1024 + 4 * lane + 256 * j); } } while (0)
    f32x4 vn[4], shn[4], scn[4];
    if (gw < T) NORM_FETCH(gw, vn, shn, scn);
    for (int row = gw; row < T; row += NGW) {
        f32x4 v[4], shq[4], scq[4]; float ss = 0.f;
#pragma unroll
        for (int j = 0; j < 4; ++j) { v[j] = vn[j]; shq[j] = shn[j]; scq[j] = scn[j]; }
        asm volatile("" ::: "memory");
        NORM_FETCH(row + NGW < T ? row + NGW : row, vn, shn, scn);
        asm volatile("" ::: "memory");
#pragma unroll
        for (int j = 0; j < 4; ++j) ss += (v[j][0] * v[j][0] + v[j][1] * v[j][1]) + (v[j][2] * v[j][2] + v[j][3] * v[j][3]);
        if (first) {
#pragma unroll
            for (int j = 0; j < 4; ++j) *(f32x4*)(X + (size_t)row * 1024 + 4 * lane + 256 * j) = v[j];
        }
        if (npart > 0 && row >= NLAT) {
            ss = 0.f;
#pragma unroll
            for (int j = 0; j < 4; ++j) { const int c = 4 * lane + 256 * j; f32x4 sacc = (f32x4){0.f, 0.f, 0.f, 0.f};
                for (int k = 0; k < npart; ++k) sacc += *(const f32x4*)(part + ((size_t)k * NCTX + (row - NLAT)) * 1024 + c);
                v[j] += *(const f32x4*)(pgate + c) * sacc; *(f32x4*)(X + (size_t)row * 1024 + c) = v[j];
                ss += (v[j][0] * v[j][0] + v[j][1] * v[j][1]) + (v[j][2] * v[j][2] + v[j][3] * v[j][3]); }
        }
        const float inv = rsqrtf(wave_sum(ss) * (1.0f / 1024.0f) + 1e-6f);
        f32x4 h[4];
#pragma unroll
        for (int j = 0; j < 4; ++j) { const int c = 4 * lane + 256 * j; const f32x4 gg = gq[j], sh = shq[j], sc = scq[j];
            h[j] = (v[j] * inv * gg) * (1.0f + sc) + sh;
            u32x2 o; o.x = pk2(h[j][0], h[j][1]); o.y = pk2(h[j][2], h[j][3]); *(u32x2*)(H + (size_t)row * 1024 + c) = o; }
        if (router && row < NLAT) {
            float lg[8] = {0.f, 0.f, 0.f, 0.f, 0.f, 0.f, 0.f, 0.f};
#pragma unroll
            for (int j = 0; j < 4; ++j)
#pragma unroll
                for (int q = 0; q < 4; ++q) { const float* rp = p.in[I_ROUT] + (size_t)(4 * lane + 256 * j + q) * 8; const f32x4 r0 = *(const f32x4*)rp, r1 = *(const f32x4*)(rp + 4); const float hv = h[j][q];
                    lg[0] += hv * r0[0]; lg[1] += hv * r0[1]; lg[2] += hv * r0[2]; lg[3] += hv * r0[3]; lg[4] += hv * r1[0]; lg[5] += hv * r1[1]; lg[6] += hv * r1[2]; lg[7] += hv * r1[3]; }
#pragma unroll
            for (int e = 0; e < 8; ++e) lg[e] = wave_sum(lg[e]);
            int e0 = 0; float v0 = lg[0];
#pragma unroll
            for (int e = 1; e < 8; ++e) if (lg[e] > v0) { v0 = lg[e]; e0 = e; }
            int e1 = -1; float v1 = -3.0e38f;
#pragma unroll
            for (int e = 0; e < 8; ++e) if (e != e0 && lg[e] > v1) { v1 = lg[e]; e1 = e; }
            const float p1 = 1.0f / (1.0f + __expf(v0 - v1)), p0 = 1.0f - p1;
            if (lane < 8) ((float*)(ws + WS_COMB))[(size_t)row * 8 + lane] = lane == e0 ? p0 : (lane == e1 ? p1 : 0.0f);
        }
    }
}
#undef NORM_FETCH
__device__ __forceinline__ void phase_final(const Params& p, int lane, int wave) {
    unsigned char* ws = p.ws;
    const float* X = (const float*)(ws + WS_X); const float* g = p.in[I_FING];
    const bf16* YP = (const bf16*)(ws + WS_APERM); const bf16* PM = (const bf16*)(ws + WS_PARTM); const int* PPOS = (const int*)(ws + WS_PPOS); const float* RP = (const float*)(ws + WS_RP);
    const float* MOD1 = (const float*)(ws + WS_MOD) + (size_t)3 * 6144 + 5120;
    const int gw = blockIdx.x * 8 + wave, NGW = gridDim.x * 8;
    f32x4 gq[4];
#pragma unroll
    for (int j = 0; j < 4; ++j) gq[j] = *(const f32x4*)(g + 4 * lane + 256 * j);
    int s0n = 0, s1n = 0; float p0n = 0.f;
    if (gw < NLAT) { s0n = PPOS[2 * gw]; s1n = PPOS[2 * gw + 1]; p0n = RP[gw]; }
    for (int row = gw; row < NLAT; row += NGW) {
        const int s0 = s0n, s1 = s1n; const float p0 = p0n, p1 = 1.0f - p0;
        { const int rn = row + NGW < NLAT ? row + NGW : row; s0n = PPOS[2 * rn]; s1n = PPOS[2 * rn + 1]; p0n = RP[rn]; }
        const float* gt = MOD1 + (size_t)(row >> 13) * 6144;
        const bool big0 = s0 >= 128 * 256, big1 = s1 >= 128 * 256;
        const bf16* y0p = YP + (size_t)(big0 ? 0 : s0) * 1024; const bf16* y1p = YP + (size_t)(big1 ? 0 : s1) * 1024;
        u32x2 y0r[4], y1r[4]; f32x4 xr[4], gvr[4];
#pragma unroll
        for (int j = 0; j < 4; ++j) { const int c = 4 * lane + 256 * j; y0r[j] = *(const u32x2*)(y0p + c); y1r[j] = *(const u32x2*)(y1p + c); xr[j] = *(const f32x4*)(X + (size_t)row * 1024 + c); gvr[j] = *(const f32x4*)(gt + c); }
        f32x4 v[4]; float ss = 0.f;
#pragma unroll
        for (int j = 0; j < 4; ++j) { const int c = 4 * lane + 256 * j;
            f32x4 e0v = (f32x4){blo(y0r[j].x), bhi(y0r[j].x), blo(y0r[j].y), bhi(y0r[j].y)}, e1v = (f32x4){blo(y1r[j].x), bhi(y1r[j].x), blo(y1r[j].y), bhi(y1r[j].y)};
            if (big0) { e0v = (f32x4){0.f, 0.f, 0.f, 0.f}; for (int k = 0; k < 7; ++k) { const u32x2 y0 = *(const u32x2*)(PM + ((size_t)k * 2048 + (s0 - 128 * 256)) * 1024 + c); e0v += (f32x4){blo(y0.x), bhi(y0.x), blo(y0.y), bhi(y0.y)}; } }
            if (big1) { e1v = (f32x4){0.f, 0.f, 0.f, 0.f}; for (int k = 0; k < 7; ++k) { const u32x2 y1 = *(const u32x2*)(PM + ((size_t)k * 2048 + (s1 - 128 * 256)) * 1024 + c); e1v += (f32x4){blo(y1.x), bhi(y1.x), blo(y1.y), bhi(y1.y)}; } }
            const f32x4 mix = e0v * p0 + e1v * p1;
            v[j] = xr[j] + gvr[j] * mix;
            ss += (v[j][0] * v[j][0] + v[j][1] * v[j][1]) + (v[j][2] * v[j][2] + v[j][3] * v[j][3]); }
        const float inv = rsqrtf(wave_sum(ss) * (1.0f / 1024.0f) + 1e-6f);
#pragma unroll
        for (int j = 0; j < 4; ++j) { const int c = 4 * lane + 256 * j; *(f32x4*)(p.out + (size_t)row * 1024 + c) = v[j] * inv * gq[j]; }
    }
}

__device__ __forceinline__ void phase_norm2_moe(const Params& p, LAS unsigned char* lds, int tid, int lane, int wave) {
    unsigned char* ws = p.ws; const int l = 1;
    const float* X = (const float*)(ws + WS_X); bf16* H = (bf16*)(ws + WS_H); const float* MOD = (const float*)(ws + WS_MOD);
    int* RE = (int*)(ws + WS_RE); float* RP = (float*)(ws + WS_RP); int* SEGCNT = (int*)(ws + WS_SEGCNT);
    const float* g = p.in[I_N2G] + l * 1024;
    LAS int* wc = (LAS int*)lds;
    LAS float* RT = (LAS float*)(lds + 1024);
    for (int ch = tid; ch < 1024; ch += 512) { const f32x4 r0 = *(const f32x4*)(p.in[I_ROUT] + (size_t)ch * 8), r1 = *(const f32x4*)(p.in[I_ROUT] + (size_t)ch * 8 + 4);
        RT[0 * 1024 + ch] = r0[0]; RT[1 * 1024 + ch] = r0[1]; RT[2 * 1024 + ch] = r0[2]; RT[3 * 1024 + ch] = r0[3]; RT[4 * 1024 + ch] = r1[0]; RT[5 * 1024 + ch] = r1[1]; RT[6 * 1024 + ch] = r1[2]; RT[7 * 1024 + ch] = r1[3]; }
    __syncthreads();
    for (int seg = blockIdx.x; seg < NLAT / 64; seg += gridDim.x) {
        int cnt[8] = {0, 0, 0, 0, 0, 0, 0, 0};
        const float* mp = MOD + (size_t)(l * 3 + ((seg * 64) >> 13)) * 6144 + 3072;
        f32x4 gq[4], shq[4], scq[4], vn[4];
#pragma unroll
        for (int j = 0; j < 4; ++j) { const int c = 4 * lane + 256 * j; gq[j] = *(const f32x4*)(g + c); shq[j] = *(const f32x4*)(mp + c); scq[j] = *(const f32x4*)(mp + 1024 + c); }
#pragma unroll
        for (int j = 0; j < 4; ++j) vn[j] = *(const f32x4*)(X + (size_t)(seg * 64 + wave * 8) * 1024 + 4 * lane + 256 * j);
        for (int rr = 0; rr < 8; ++rr) {
            const int row = seg * 64 + wave * 8 + rr;
            asm volatile("" ::: "memory");
            f32x4 v[4]; float ss = 0.f;
#pragma unroll
            for (int j = 0; j < 4; ++j) v[j] = vn[j];
            { const int rn = seg * 64 + wave * 8 + (rr < 7 ? rr + 1 : 7);
#pragma unroll
              for (int j = 0; j < 4; ++j) vn[j] = *(const f32x4*)(X + (size_t)rn * 1024 + 4 * lane + 256 * j); }
#pragma unroll
            for (int j = 0; j < 4; ++j) ss += (v[j][0] * v[j][0] + v[j][1] * v[j][1]) + (v[j][2] * v[j][2] + v[j][3] * v[j][3]);
            const float inv = rsqrtf(wave_sum(ss) * (1.0f / 1024.0f) + 1e-6f);
            float lg[8] = {0.f, 0.f, 0.f, 0.f, 0.f, 0.f, 0.f, 0.f};
#pragma unroll
            for (int j = 0; j < 4; ++j) { const int c = 4 * lane + 256 * j;
                const f32x4 h = (v[j] * inv * gq[j]) * (1.0f + scq[j]) + shq[j];
                u32x2 o; o.x = pk2(h[0], h[1]); o.y = pk2(h[2], h[3]); *(u32x2*)(H + (size_t)row * 1024 + c) = o;
#pragma unroll
                for (int e = 0; e < 8; ++e) { const f32x4 w = *(const LAS f32x4*)(RT + e * 1024 + c); lg[e] += (h[0] * w[0] + h[1] * w[1]) + (h[2] * w[2] + h[3] * w[3]); } }
#pragma unroll
            for (int e = 0; e < 8; ++e) lg[e] = wave_sum(lg[e]);
            int e0 = 0; float v0 = lg[0];
#pragma unroll
            for (int e = 1; e < 8; ++e) if (lg[e] > v0) { v0 = lg[e]; e0 = e; }
            int e1 = -1; float v1 = -3.0e38f;
#pragma unroll
            for (int e = 0; e < 8; ++e) if (e != e0 && lg[e] > v1) { v1 = lg[e]; e1 = e; }
            e0 = __builtin_amdgcn_readfirstlane(e0); e1 = __builtin_amdgcn_readfirstlane(e1);
            const float p1 = 1.0f / (1.0f + __expf(v0 - v1));
            if (lane == 0) { RE[row] = e0 | (e1 << 8); RP[row] = 1.0f - p1; }
#pragma unroll
            for (int e = 0; e < 8; ++e) cnt[e] += (e0 == e ? 1 : 0) + (e1 == e ? 1 : 0);
        }
        if (lane < 8) { int c = 0;
#pragma unroll
            for (int e = 0; e < 8; ++e) c = (lane == e) ? cnt[e] : c;
            wc[wave * 8 + lane] = c; }
        __syncthreads();
        if (tid < 8) { int c = 0;
#pragma unroll
            for (int w = 0; w < 8; ++w) c += wc[w * 8 + tid];
            SEGCNT[seg * 8 + tid] = c; }
        __syncthreads();
    }
}
__device__ __forceinline__ void phase_moe_prep(const Params& p, LAS unsigned char* lds, int tid, int lane, int wave) {
    unsigned char* ws = p.ws;
    const int* RE = (const int*)(ws + WS_RE); const float* RP = (const float*)(ws + WS_RP); const int* SEGCNT = (const int*)(ws + WS_SEGCNT);
    int* PROW = (int*)(ws + WS_PROW); float* PGW = (float*)(ws + WS_PGW); int* TOFF = (int*)(ws + WS_TOFF);
    const bf16* H = (const bf16*)(ws + WS_H); bf16* AP = (bf16*)(ws + WS_APERM);
    LAS int* sc = (LAS int*)lds;
    LAS int* tot = (LAS int*)(lds + 8192);
    LAS int* perm = (LAS int*)(lds + 8192 + 256);
    constexpr int NSEG = NLAT / 64;
    for (int i = tid; i < NSEG * 8; i += 512) sc[i] = SEGCNT[i];
    __syncthreads();
    if (tid < 8) { int t = 0; for (int s2 = 0; s2 < NSEG; ++s2) t += sc[s2 * 8 + tid]; tot[tid] = t; }
    __syncthreads();
    if (tid == 0) { int o = 0; for (int e = 0; e < 8; ++e) { tot[8 + e] = o; o += (tot[e] + 255) >> 8; } tot[16] = o;
        if (blockIdx.x == 0) { for (int e = 0; e <= 8; ++e) TOFF[e] = tot[8 + e]; } }
    __syncthreads();
    for (int seg = blockIdx.x; seg < NSEG; seg += gridDim.x) {
        if (tid < 8) { int bs = 0; for (int s2 = 0; s2 < seg; ++s2) bs += sc[s2 * 8 + tid]; tot[32 + tid] = bs; }
        __syncthreads();
        if (wave == 0) {
            const int row = seg * 64 + lane; const int re = RE[row], e0 = re & 0xff, e1 = re >> 8; const float p0 = RP[row];
            int s0 = 0, s1 = 0;
#pragma unroll
            for (int e = 0; e < 8; ++e) { const bool mine = (e0 == e) || (e1 == e); const unsigned long long m = __ballot(mine);
                const int rank = __popcll(m & ((1ull << lane) - 1ull)); const int slot = (tot[8 + e] << 8) + tot[32 + e] + rank;
                s0 = (e0 == e) ? slot : s0; s1 = (e1 == e) ? slot : s1; }
            PROW[s0] = row; PGW[s0] = p0; PROW[s1] = row; PGW[s1] = 1.0f - p0;
            ((int*)(ws + WS_PPOS))[2 * row] = s0; ((int*)(ws + WS_PPOS))[2 * row + 1] = s1;
            perm[lane * 2] = s0; perm[lane * 2 + 1] = s1;
        }
        __syncthreads();
        for (int rr = 0; rr < 8; ++rr) { const int lr = wave * 8 + rr, row = seg * 64 + lr; const int s0 = perm[lr * 2], s1 = perm[lr * 2 + 1];
            const u32x4 a = *(const u32x4*)(H + (size_t)row * 1024 + lane * 16), b2 = *(const u32x4*)(H + (size_t)row * 1024 + lane * 16 + 8);
            *(u32x4*)(AP + (size_t)s0 * 1024 + lane * 16) = a; *(u32x4*)(AP + (size_t)s0 * 1024 + lane * 16 + 8) = b2;
            *(u32x4*)(AP + (size_t)s1 * 1024 + lane * 16) = a; *(u32x4*)(AP + (size_t)s1 * 1024 + lane * 16 + 8) = b2; }
        __syncthreads();
    }
    for (int e = blockIdx.x; e < 8; e += gridDim.x) {
        const int lo = (tot[8 + e] << 8) + tot[e], hi = tot[9 + e] << 8;
        for (int r = lo + wave; r < hi; r += 8) { if (lane == 0) { PROW[r] = -1; PGW[r] = 0.f; }
            *(u32x4*)(AP + (size_t)r * 1024 + lane * 16) = (u32x4){0u, 0u, 0u, 0u}; *(u32x4*)(AP + (size_t)r * 1024 + lane * 16 + 8) = (u32x4){0u, 0u, 0u, 0u}; }
    }
}

typedef short bf16x8s __attribute__((ext_vector_type(8)));
__device__ __forceinline__ unsigned cvtpk_(float lo, float hi) { typedef float f2_ __attribute__((ext_vector_type(2))); typedef __bf16 b2_ __attribute__((ext_vector_type(2))); f2_ v = {lo, hi}; return __builtin_bit_cast(unsigned, __builtin_convertvector(v, b2_)); }
constexpr int SLR_ROWS = 33, SLR_PITCH = 520;
__device__ __forceinline__ void phase_stream_lr(const Params& p, int l, LAS unsigned char* lds, int tid, int lane, int wave) {
    unsigned char* ws = p.ws;
    const bf16* P = (const bf16*)(ws + WS_P);
    bf16* R = (bf16*)(ws + WS_R); bf16* V = (bf16*)(ws + WS_V); bf16* KKn = (bf16*)(ws + WS_KKN); bf16* U = (bf16*)(ws + WS_U);
    LAS bf16* lrin = (LAS bf16*)lds;
    LAS bf16* kbuf = (LAS bf16*)(lds + 48 * SLR_PITCH * 2);
    LAS bf16* kkbuf = (LAS bf16*)(lds + (48 + SLR_ROWS) * SLR_PITCH * 2);
    const int hrow = tid >> 8, t8 = tid & 255, c8 = 8 * t8;
    float mu8[8]; { const f32x4 m0 = *(const f32x4*)(p.in[I_MU] + l * 2048 + c8), m1 = *(const f32x4*)(p.in[I_MU] + l * 2048 + c8 + 4); mu8[0] = m0[0]; mu8[1] = m0[1]; mu8[2] = m0[2]; mu8[3] = m0[3]; mu8[4] = m1[0]; mu8[5] = m1[1]; mu8[6] = m1[2]; mu8[7] = m1[3]; }
    for (int i = tid; i < 15 * SLR_PITCH / 2; i += 512) ((LAS unsigned*)(lrin + SLR_ROWS * SLR_PITCH))[i] = 0u;
    const int r16 = lane & 15, g4 = lane >> 4;
    for (int tq = blockIdx.x; tq < T / SLR_ROWS; tq += gridDim.x) {
        const int tix = (gridDim.x == 256) ? ((tq & 7) * 64 + ((tq >> 3) & 31) + 32 * (tq >> 8)) : tq;
        const int row0 = tix * SLR_ROWS;
        for (int pr0 = 0; pr0 < 18; pr0 += 3) {
            u32x4 ow3[3], nb3[3][4], uw3[3];
#pragma unroll
            for (int u = 0; u < 3; ++u) { const int lr = 2 * (pr0 + u) + hrow, row = row0 + (lr < SLR_ROWS ? lr : 0); int nr[4];
                if (row < NLAT) { const int t = row & (SEQ - 1), gc = t & 63, gr = t >> 6; nr[0] = gc > 0 ? row - 1 : -1; nr[1] = gc < 63 ? row + 1 : -1; nr[2] = gr > 0 ? row - 64 : -1; nr[3] = gr < 127 ? row + 64 : -1; }
                else { const int t = (row - NLAT) & (CTXL - 1); nr[0] = nr[2] = t > 0 ? row - 1 : -1; nr[1] = nr[3] = t < CTXL - 1 ? row + 1 : -1; }
                ow3[u] = *(const u32x4*)(P + (size_t)row * DIN + c8);
#pragma unroll
                for (int j = 0; j < 4; ++j) nb3[u][j] = nr[j] >= 0 ? *(const u32x4*)(P + (size_t)nr[j] * DIN + c8) : (u32x4){0u, 0u, 0u, 0u};
                if (t8 < 64) uw3[u] = *(const u32x4*)(P + (size_t)row * DIN + 2048 + c8); }
#pragma unroll
            for (int u = 0; u < 3; ++u) { const int lr = 2 * (pr0 + u) + hrow, row = row0 + lr;
              if (lr < SLR_ROWS) {
                const u32x4 ow = ow3[u];
                const float own[8] = {blo(ow.x), bhi(ow.x), blo(ow.y), bhi(ow.y), blo(ow.z), bhi(ow.z), blo(ow.w), bhi(ow.w)};
                const float shv[8] = {blo(nb3[u][0].x), bhi(nb3[u][1].x), blo(nb3[u][2].y), bhi(nb3[u][3].y), blo(nb3[u][0].z), bhi(nb3[u][1].z), blo(nb3[u][2].w), bhi(nb3[u][3].w)};
                float sv[8];
#pragma unroll
                for (int q = 0; q < 8; ++q) sv[q] = own[q] + (shv[q] - own[q]) * mu8[q];
                if (c8 < 512) { u32x4 o; o.x = cvtpk_(sv[0], sv[1]); o.y = cvtpk_(sv[2], sv[3]); o.z = cvtpk_(sv[4], sv[5]); o.w = cvtpk_(sv[6], sv[7]); *(u32x4*)(R + (size_t)row * 512 + c8) = o; }
                else if (c8 < 1024) { const int cc = c8 - 512; u32x4 o; o.x = cvtpk_(sv[0], sv[1]); o.y = cvtpk_(sv[2], sv[3]); o.z = cvtpk_(sv[4], sv[5]); o.w = cvtpk_(sv[6], sv[7]); *(LAS u32x4*)(kbuf + lr * SLR_PITCH + cc) = o;
                    const f32x4 ka_ = *(const f32x4*)(p.in[I_KK] + l * 512 + cc), kb_ = *(const f32x4*)(p.in[I_KK] + l * 512 + cc + 4); const float kkw[8] = {ka_[0], ka_[1], ka_[2], ka_[3], kb_[0], kb_[1], kb_[2], kb_[3]};
                    float q8[8]; float ssq = 0.f;
#pragma unroll
                    for (int q = 0; q < 8; ++q) { q8[q] = sv[q] * kkw[q]; ssq += q8[q] * q8[q]; }
                    ssq += __shfl_xor(ssq, 1); ssq += __shfl_xor(ssq, 2); ssq += __shfl_xor(ssq, 4);
                    const float inv = 1.0f / fmaxf(sqrtf(ssq), 1e-12f);
                    u32x4 o2; o2.x = cvtpk_(q8[0] * inv, q8[1] * inv); o2.y = cvtpk_(q8[2] * inv, q8[3] * inv); o2.z = cvtpk_(q8[4] * inv, q8[5] * inv); o2.w = cvtpk_(q8[6] * inv, q8[7] * inv);
                    *(u32x4*)(KKn + (size_t)row * 512 + cc) = o2; *(LAS u32x4*)(kkbuf + lr * SLR_PITCH + cc) = o2; }
                else if (c8 < 1536) { u32x4 o; o.x = cvtpk_(sv[0], sv[1]); o.y = cvtpk_(sv[2], sv[3]); o.z = cvtpk_(sv[4], sv[5]); o.w = cvtpk_(sv[6], sv[7]); *(u32x4*)(V + (size_t)row * 512 + c8 - 1024) = o; }
                else { const int cc = c8 - 1536; float f[8];
#pragma unroll
                    for (int q = 0; q < 8; ++q) { const float e2 = __expf(2.0f * sv[q]); f[q] = cc < 128 ? 1.0f - 2.0f * __builtin_amdgcn_rcpf(e2 + 1.0f) : (cc < 256 ? sv[q] : sigm(sv[q])); }
                    u32x4 o; o.x = cvtpk_(f[0], f[1]); o.y = cvtpk_(f[2], f[3]); o.z = cvtpk_(f[4], f[5]); o.w = cvtpk_(f[6], f[7]); *(LAS u32x4*)(lrin + lr * SLR_PITCH + cc) = o; }
                if (t8 < 64) { int tbu, ju; if (row < NLAT) { const int bb_ = row >> 13, tt_ = row & (SEQ - 1); tbu = bb_ * NCH + 4 + (tt_ >> 6); ju = tt_ & 63; } else { const int rc = row - NLAT, bb_ = rc >> 8, tt_ = rc & 255; tbu = bb_ * NCH + (tt_ >> 6); ju = tt_ & 63; }
                    *(u32x4*)(U + ((size_t)((c8 >> 4) * 64 + ju) * (2 * NCH) + tbu) * 16 + (c8 & 15)) = uw3[u]; }
              }
            }
        }
        __syncthreads();
#pragma unroll 1
        for (int d = 0; d < 2; ++d) {
            const bf16* Wd = (const bf16*)(ws + WS_WLR) + (size_t)(l * 2 + d) * 131072 + 8 * g4;
            const size_t dT = (size_t)d * T * 512;
#pragma unroll
            for (int sec = 0; sec < 3; ++sec) {
                constexpr int dummy_ = 0; (void)dummy_;
                const int KK_ = sec == 2 ? 128 : 64, NKS = sec == 2 ? 4 : 2, koff = sec == 0 ? d * 64 : (sec == 1 ? 128 + d * 64 : 256 + d * 128);
                const bf16* Ws = Wd + (sec == 0 ? 0 : (sec == 1 ? 32768 : 65536));
#pragma unroll
                for (int i2 = 0; i2 < 4; i2 += 2) {
                bf16x8s wf[2][4];
#pragma unroll
                for (int i = 0; i < 2; ++i)
#pragma unroll
                    for (int ks = 0; ks < 4; ++ks) if (ks < NKS) wf[i][ks] = *(const bf16x8s*)(Ws + (size_t)(16 * (wave + 8 * (i2 + i)) + r16) * KK_ + 32 * ks);
#pragma unroll
                for (int ii = 0; ii < 2; ++ii) { const int i = i2 + ii;
                    const int c = 16 * (wave + 8 * i) + 4 * g4;
                    f32x4 acc[3];
#pragma unroll
                    for (int rt = 0; rt < 3; ++rt) acc[rt] = (f32x4){0.f, 0.f, 0.f, 0.f};
#pragma unroll
                    for (int ks = 0; ks < 4; ++ks) if (ks < NKS) {
#pragma unroll
                        for (int rt = 0; rt < 3; ++rt) { const bf16x8s bq = *(const LAS bf16x8s*)(lrin + (16 * rt + r16) * SLR_PITCH + koff + 32 * ks + 8 * g4);
                            acc[rt] = __builtin_amdgcn_mfma_f32_16x16x32_bf16(wf[ii][ks], bq, acc[rt], 0, 0, 0); } }
                    if (sec == 0) { const f32x4 w0 = *(const f32x4*)(p.in[I_W0] + l * 1024 + d * 512 + c); float* LW = (float*)(ws + WS_LW) + dT;
#pragma unroll
                        for (int rt = 0; rt < 3; ++rt) { const int lr = 16 * rt + r16; if (lr < SLR_ROWS) { f32x4 o;
#pragma unroll
                                for (int q = 0; q < 4; ++q) o[q] = -sigm(w0[q] + acc[rt][q]) * 0.60653065971f;
                                *(f32x4*)(LW + (size_t)(row0 + lr) * 512 + c) = o; } }
                    } else if (sec == 1) { const f32x4 a0 = *(const f32x4*)(p.in[I_A0] + l * 1024 + d * 512 + c), ka = *(const f32x4*)(p.in[I_KA] + l * 512 + c);
                        bf16* KT = (bf16*)(ws + WS_KT) + dT; bf16* BB = (bf16*)(ws + WS_BB) + dT;
#pragma unroll
                        for (int rt = 0; rt < 3; ++rt) { const int lr = 16 * rt + r16; if (lr < SLR_ROWS) {
                                const u32x2 k4 = *(const LAS u32x2*)(kbuf + lr * SLR_PITCH + c), q4 = *(const LAS u32x2*)(kkbuf + lr * SLR_PITCH + c);
                                const float kf[4] = {blo(k4.x), bhi(k4.x), blo(k4.y), bhi(k4.y)}, qf[4] = {blo(q4.x), bhi(q4.x), blo(q4.y), bhi(q4.y)}; float kt[4], bb[4];
#pragma unroll
                                for (int q = 0; q < 4; ++q) { const float a = sigm(a0[q] + acc[rt][q]); kt[q] = kf[q] * (1.0f + (a - 1.0f) * ka[q]); bb[q] = qf[q] * a; }
                                u32x2 o1, o2; o1.x = cvtpk_(kt[0], kt[1]); o1.y = cvtpk_(kt[2], kt[3]); o2.x = cvtpk_(bb[0], bb[1]); o2.y = cvtpk_(bb[2], bb[3]);
                                *(u32x2*)(KT + (size_t)(row0 + lr) * 512 + c) = o1; *(u32x2*)(BB + (size_t)(row0 + lr) * 512 + c) = o2; } }
                    } else { bf16* GD = (bf16*)(ws + WS_GD) + dT;
#pragma unroll
                        for (int rt = 0; rt < 3; ++rt) { const int lr = 16 * rt + r16; if (lr < SLR_ROWS) { u32x2 o; o.x = cvtpk_(acc[rt][0], acc[rt][1]); o.y = cvtpk_(acc[rt][2], acc[rt][3]);
                                *(u32x2*)(GD + (size_t)(row0 + lr) * 512 + c) = o; } }
                    }
                    asm volatile("" ::: "memory");
                }
                }
            }
        }
        __syncthreads();
    }
}

typedef short bf16x8 __attribute__((ext_vector_type(8)));
typedef float f32x2v __attribute__((ext_vector_type(2)));
typedef __bf16 bf16x2v __attribute__((ext_vector_type(2)));
__device__ __forceinline__ unsigned cvtpk(float lo, float hi) { f32x2v v = {lo, hi}; return __builtin_bit_cast(unsigned, __builtin_convertvector(v, bf16x2v)); }
__device__ __forceinline__ int lds_off(int slot, int row, int col) { return slot * 8192 + row * 128 + ((((col >> 3) ^ (row & 7) ^ ((row & 8) ? 7 : 0) ^ ((row >> 3) & 6))) << 4) + (col & 7) * 2; }
struct Acc2 { f32x4 t[2]; };
__device__ __forceinline__ void prod2(LAS unsigned char* lds, int aslot, int btslot, int wave, int lane, Acc2& acc) {
    const int tr = wave >> 1, r = lane & 15, g = lane >> 4;
#pragma unroll
    for (int ks = 0; ks < 2; ++ks) {
        const bf16x8 a = *(const LAS bf16x8*)(lds + lds_off(aslot, 16 * tr + r, 32 * ks + 8 * g));
#pragma unroll
        for (int t = 0; t < 2; ++t) { const int tc = 2 * (wave & 1) + t;
            const bf16x8 bb = *(const LAS bf16x8*)(lds + lds_off(btslot, 16 * tc + r, 32 * ks + 8 * g));
            acc.t[t] = __builtin_amdgcn_mfma_f32_16x16x32_bf16(a, bb, acc.t[t], 0, 0, 0); }
    }
}
__device__ __forceinline__ void wr_tr(LAS unsigned char* lds, int slot, int wave, int lane, const Acc2& acc) {
    const int tr = wave >> 1, r = lane & 15, g = lane >> 4;
#pragma unroll
    for (int t = 0; t < 2; ++t) { const int col = 16 * (2 * (wave & 1) + t) + r;
        u32x2 o; o.x = cvtpk(acc.t[t][0], acc.t[t][1]); o.y = cvtpk(acc.t[t][2], acc.t[t][3]);
        *(LAS u32x2*)(lds + lds_off(slot, col, 16 * tr + 4 * g)) = o; }
}
struct Frag2 { bf16x8 a[2]; bf16x8 b[2][2]; };
__device__ __forceinline__ void prod2_ld(LAS unsigned char* lds, int aslot, int btslot, int wave, int lane, Frag2& f) {
    const int tr = wave >> 1, r = lane & 15, g = lane >> 4;
#pragma unroll
    for (int ks = 0; ks < 2; ++ks) {
        f.a[ks] = *(const LAS bf16x8*)(lds + lds_off(aslot, 16 * tr + r, 32 * ks + 8 * g));
#pragma unroll
        for (int t = 0; t < 2; ++t) f.b[ks][t] = *(const LAS bf16x8*)(lds + lds_off(btslot, 16 * (2 * (wave & 1) + t) + r, 32 * ks + 8 * g)); }
}
__device__ __forceinline__ void prod2_mm(const Frag2& f, Acc2& acc) {
#pragma unroll
    for (int ks = 0; ks < 2; ++ks)
#pragma unroll
        for (int t = 0; t < 2; ++t) acc.t[t] = __builtin_amdgcn_mfma_f32_16x16x32_bf16(f.a[ks], f.b[ks][t], acc.t[t], 0, 0, 0);
}
__device__ __forceinline__ void phase_chunk(const Params& p, int l, LAS unsigned char* lds, int tid, int lane, int wave) {
    unsigned char* ws = p.ws;
    const bf16* R = (const bf16*)(ws + WS_R); const bf16* V = (const bf16*)(ws + WS_V); const bf16* KKn = (const bf16*)(ws + WS_KKN);
    LAS float* Lf = (LAS float*)(lds + 14 * 8192);
    LAS float* segtot = (LAS float*)(lds + 13 * 8192);
    LAS float* gc = (LAS float*)(lds + LDS_GC);
    const int tr = wave >> 1, r16 = lane & 15, g4 = lane >> 4;
    const int pos = tid >> 3, c8 = (tid & 7) * 8;
    u32x4 n_kk8, n_b8, n_kt8, n_r8, n_v8; f32x4 n_l0, n_l1;
#define CHUNK_FETCH(cc_) do { const int h_ = (cc_) & 7, j_ = ((cc_) >> 3) % NCH, db_ = ((cc_) >> 3) / NCH, b_ = db_ & 1, d_ = db_ >> 1; \
        const size_t go_ = (size_t)row_of(b_, d_, j_ * 64 + pos) * 512 + h_ * 64 + c8, do_ = (size_t)d_ * T * 512 + go_; \
        n_kk8 = *(const u32x4*)(KKn + go_); n_b8 = *(const u32x4*)((const bf16*)(ws + WS_BB) + do_); n_kt8 = *(const u32x4*)((const bf16*)(ws + WS_KT) + do_); n_r8 = *(const u32x4*)(R + go_); n_v8 = *(const u32x4*)(V + go_); \
        n_l0 = *(const f32x4*)((const float*)(ws + WS_LW) + do_); n_l1 = *(const f32x4*)((const float*)(ws + WS_LW) + do_ + 4); } while (0)
    if ((int)blockIdx.x < NCC) CHUNK_FETCH((int)blockIdx.x);
    asm volatile("" :: "v"(n_kk8), "v"(n_b8), "v"(n_kt8), "v"(n_r8), "v"(n_v8), "v"(n_l0), "v"(n_l1));
    for (int cc = blockIdx.x; cc < NCC; cc += gridDim.x) {
        const int h = cc & 7, j = (cc >> 3) % NCH, db = (cc >> 3) / NCH, b = db & 1, d = db >> 1;
        bf16* CH = (bf16*)(ws + WS_CH) + (size_t)cc * 16384;
        const int row = row_of(b, d, j * 64 + pos);
        const u32x4 kk8 = n_kk8, b8 = n_b8, kt8 = n_kt8, r8 = n_r8, v8 = n_v8; const f32x4 l0 = n_l0, l1 = n_l1;
        const f32x4 rk0_ = *(const f32x4*)(p.in[I_RK] + l * 512 + h * 64 + c8), rk1_ = *(const f32x4*)(p.in[I_RK] + l * 512 + h * 64 + c8 + 4);
        asm volatile("" ::: "memory");
        { const int ccn = cc + (int)gridDim.x < NCC ? cc + (int)gridDim.x : cc; CHUNK_FETCH(ccn); }
        *(LAS f32x4*)(Lf + pos * 64 + c8) = l0; *(LAS f32x4*)(Lf + pos * 64 + c8 + 4) = l1;
        __syncthreads();
        { const int ch = tid & 63, seg = tid >> 6; float pre[8]; float run = 0.f;
#pragma unroll
          for (int q = 0; q < 8; ++q) { run += Lf[(8 * seg + q) * 64 + ch]; pre[q] = run; }
          segtot[seg * 64 + ch] = run;
          __syncthreads();
          float off = 0.f;
#pragma unroll
          for (int s2 = 0; s2 < 8; ++s2) off += (s2 < seg) ? segtot[s2 * 64 + ch] : 0.f;
#pragma unroll
          for (int q = 0; q < 8; ++q) Lf[(8 * seg + q) * 64 + ch] = pre[q] + off;
          if (seg == 7) gc[ch] = pre[7] + off; }
        __syncthreads();
        {
            const f32x4 g0 = *(const LAS f32x4*)(Lf + pos * 64 + c8), g1 = *(const LAS f32x4*)(Lf + pos * 64 + c8 + 4);
            const f32x4 q0 = *(const LAS f32x4*)(gc + c8), q1 = *(const LAS f32x4*)(gc + c8 + 4);
            const float G[8] = {g0[0], g0[1], g0[2], g0[3], g1[0], g1[1], g1[2], g1[3]}, GC[8] = {q0[0], q0[1], q0[2], q0[3], q1[0], q1[1], q1[2], q1[3]};
            const float Lv[8] = {l0[0], l0[1], l0[2], l0[3], l1[0], l1[1], l1[2], l1[3]};
            const unsigned kkw[4] = {kk8.x, kk8.y, kk8.z, kk8.w}, bw[4] = {b8.x, b8.y, b8.z, b8.w}, ktw[4] = {kt8.x, kt8.y, kt8.z, kt8.w}, rw[4] = {r8.x, r8.y, r8.z, r8.w}, vw[4] = {v8.x, v8.y, v8.z, v8.w};
            float at[8], bt[8], kb[8], qt[8], bg[8], kg[8], vv[8]; float bon = 0.f;
            const float rk[8] = {rk0_[0], rk0_[1], rk0_[2], rk0_[3], rk1_[0], rk1_[1], rk1_[2], rk1_[3]};
#pragma unroll
            for (int q = 0; q < 8; ++q) { const int w2 = q >> 1; const bool hi = q & 1;
                const float kkv = hi ? bhi(kkw[w2]) : blo(kkw[w2]), bv = hi ? bhi(bw[w2]) : blo(bw[w2]), ktv = hi ? bhi(ktw[w2]) : blo(ktw[w2]), rv = hi ? bhi(rw[w2]) : blo(rw[w2]);
                vv[q] = hi ? bhi(vw[w2]) : blo(vw[w2]);
                const float eg = __expf(G[q]), egi = __expf(-G[q]), egp = __expf(G[q] - Lv[q]), egc = __expf(GC[q] - G[q]);
                at[q] = -kkv * egp; bt[q] = bv * egi; kb[q] = ktv * egi; qt[q] = rv * eg; bg[q] = bv * egc; kg[q] = ktv * egc;
                bon += rv * ktv * rk[q]; }
            bon += __shfl_xor(bon, 1); bon += __shfl_xor(bon, 2); bon += __shfl_xor(bon, 4);
            if ((tid & 7) == 0) ((float*)(ws + WS_BONUS))[((size_t)d * T + row) * 8 + h] = bon;
            u32x4 o;
            o.x = cvtpk(at[0], at[1]); o.y = cvtpk(at[2], at[3]); o.z = cvtpk(at[4], at[5]); o.w = cvtpk(at[6], at[7]); *(LAS u32x4*)(lds + lds_off(0, pos, c8)) = o;
            o.x = cvtpk(bt[0], bt[1]); o.y = cvtpk(bt[2], bt[3]); o.z = cvtpk(bt[4], bt[5]); o.w = cvtpk(bt[6], bt[7]); *(LAS u32x4*)(lds + lds_off(2, pos, c8)) = o;
            o.x = cvtpk(kb[0], kb[1]); o.y = cvtpk(kb[2], kb[3]); o.z = cvtpk(kb[4], kb[5]); o.w = cvtpk(kb[6], kb[7]); *(LAS u32x4*)(lds + lds_off(3, pos, c8)) = o;
            o.x = cvtpk(qt[0], qt[1]); o.y = cvtpk(qt[2], qt[3]); o.z = cvtpk(qt[4], qt[5]); o.w = cvtpk(qt[6], qt[7]); *(LAS u32x4*)(lds + lds_off(4, pos, c8)) = o;
            const unsigned atw[4] = {cvtpk(at[0], at[1]), cvtpk(at[2], at[3]), cvtpk(at[4], at[5]), cvtpk(at[6], at[7])};
            const unsigned bgw[4] = {cvtpk(bg[0], bg[1]), cvtpk(bg[2], bg[3]), cvtpk(bg[4], bg[5]), cvtpk(bg[6], bg[7])};
            const unsigned kgw[4] = {cvtpk(kg[0], kg[1]), cvtpk(kg[2], kg[3]), cvtpk(kg[4], kg[5]), cvtpk(kg[6], kg[7])};
#pragma unroll
            for (int q = 0; q < 8; ++q) { const int w2 = q >> 1, sh = (q & 1) * 16;
                *(LAS unsigned short*)(lds + lds_off(1, c8 + q, pos)) = (unsigned short)(atw[w2] >> sh);
                *(LAS unsigned short*)(lds + lds_off(5, c8 + q, pos)) = (unsigned short)(vw[w2] >> sh);
                *(LAS unsigned short*)(lds + lds_off(6, c8 + q, pos)) = (unsigned short)(bgw[w2] >> sh);
                *(LAS unsigned short*)(lds + lds_off(7, c8 + q, pos)) = (unsigned short)(kgw[w2] >> sh); }
        }
        __syncthreads();
        Acc2 accTt;
        { Frag2 f0, f1, f2, f3, f4;
          prod2_ld(lds, 0, 2, wave, lane, f0); prod2_ld(lds, 2, 0, wave, lane, f1); prod2_ld(lds, 3, 0, wave, lane, f2); prod2_ld(lds, 2, 4, wave, lane, f3); prod2_ld(lds, 3, 4, wave, lane, f4);
          Acc2 a0, a1, a2, a3, a4; a0.t[0] = a0.t[1] = a1.t[0] = a1.t[1] = a2.t[0] = a2.t[1] = a3.t[0] = a3.t[1] = a4.t[0] = a4.t[1] = (f32x4){0.f, 0.f, 0.f, 0.f};
          prod2_mm(f0, a0); prod2_mm(f1, a1); prod2_mm(f2, a2); prod2_mm(f3, a3); prod2_mm(f4, a4);
#pragma unroll
          for (int t = 0; t < 2; ++t) { const int col = 16 * (2 * (wave & 1) + t) + r16;
#pragma unroll
              for (int q = 0; q < 4; ++q) { const int rw_ = 16 * tr + 4 * g4 + q;
                  a0.t[t][q] = col < rw_ ? a0.t[t][q] : 0.f;
                  a1.t[t][q] = col > rw_ ? a1.t[t][q] : 0.f; accTt.t[t][q] = a1.t[t][q] + (col == rw_ ? 1.f : 0.f);
                  a2.t[t][q] = col > rw_ ? a2.t[t][q] : 0.f;
                  a3.t[t][q] = col >= rw_ ? a3.t[t][q] : 0.f;
                  a4.t[t][q] = col >= rw_ ? a4.t[t][q] : 0.f; } }
          wr_tr(lds, 9, wave, lane, a0);
          wr_tr(lds, 8, wave, lane, a1); wr_tr(lds, 10, wave, lane, accTt);
          wr_tr(lds, 11, wave, lane, a2);
          wr_tr(lds, 12, wave, lane, a3);
          wr_tr(lds, 13, wave, lane, a4); }
        __syncthreads();
        { Frag2 f1, f2, f3; prod2_ld(lds, 8, 9, wave, lane, f1); prod2_ld(lds, 9, 8, wave, lane, f2); prod2_ld(lds, 11, 5, wave, lane, f3);
          Acc2 a1, a2, a3; a1.t[0] = a1.t[1] = a2.t[0] = a2.t[1] = a3.t[0] = a3.t[1] = (f32x4){0.f, 0.f, 0.f, 0.f};
          prod2_mm(f1, a1); prod2_mm(f2, a2); prod2_mm(f3, a3);
          wr_tr(lds, 3, wave, lane, a1);
          wr_tr(lds, 2, wave, lane, a2);
          wr_tr(lds, 14, wave, lane, a3); }
        __syncthreads();
#pragma unroll
        for (int lvl = 1; lvl <= 4; ++lvl) {
            const int zc = (lvl & 1) ? 2 : 8, zn = (lvl & 1) ? 8 : 2, tc_ = (lvl & 1) ? 10 : 15, tn = (lvl & 1) ? 15 : 10;
            if (lvl < 4) { Frag2 f1, f2, f3; prod2_ld(lds, zc + 1, tc_, wave, lane, f1); prod2_ld(lds, zc, zc + 1, wave, lane, f2); prod2_ld(lds, zc + 1, zc, wave, lane, f3);
                Acc2 a2, a3; a2.t[0] = a2.t[1] = a3.t[0] = a3.t[1] = (f32x4){0.f, 0.f, 0.f, 0.f};
                prod2_mm(f1, accTt); prod2_mm(f2, a2); prod2_mm(f3, a3);
                wr_tr(lds, tn, wave, lane, accTt); wr_tr(lds, zn + 1, wave, lane, a2); wr_tr(lds, zn, wave, lane, a3); }
            else { prod2(lds, zc + 1, tc_, wave, lane, accTt); wr_tr(lds, tn, wave, lane, accTt); }
            __syncthreads();
        }
        { Frag2 f1, f2; prod2_ld(lds, 10, 1, wave, lane, f1); prod2_ld(lds, 10, 14, wave, lane, f2);
          Acc2 a1, a2; a1.t[0] = a1.t[1] = a2.t[0] = a2.t[1] = (f32x4){0.f, 0.f, 0.f, 0.f};
          prod2_mm(f1, a1); prod2_mm(f2, a2);
          wr_tr(lds, 8, wave, lane, a1); wr_tr(lds, 9, wave, lane, a2); }
        __syncthreads();
        { Acc2 a; a.t[0] = a.t[1] = (f32x4){0.f, 0.f, 0.f, 0.f}; prod2(lds, 8, 12, wave, lane, a);
#pragma unroll
          for (int t = 0; t < 2; ++t) { const int col = 16 * (2 * (wave & 1) + t) + r16, r0 = 16 * tr + 4 * g4;
              const u32x2 qq = *(const LAS u32x2*)(lds + lds_off(4, col, r0));
              u32x2 o; o.x = cvtpk(a.t[t][0] + blo(qq.x), a.t[t][1] + bhi(qq.x)); o.y = cvtpk(a.t[t][2] + blo(qq.y), a.t[t][3] + bhi(qq.y));
              *(u32x2*)(CH + 8192 + (((col >> 4) * 2 + (tr >> 1)) * 64 + g4 * 16 + (col & 15)) * 8 + (tr & 1) * 4) = o; } }
        { Acc2 a; a.t[0] = a.t[1] = (f32x4){0.f, 0.f, 0.f, 0.f}; prod2(lds, 12, 9, wave, lane, a); prod2(lds, 13, 5, wave, lane, a);
#pragma unroll
          for (int t = 0; t < 2; ++t) { const int col = 16 * (2 * (wave & 1) + t) + r16, r0 = 16 * tr + 4 * g4;
              u32x2 o; o.x = cvtpk(a.t[t][0], a.t[t][1]); o.y = cvtpk(a.t[t][2], a.t[t][3]); *(u32x2*)(CH + 12288 + (((col >> 4) * 4 + tr) * 64 + g4 * 16 + (col & 15)) * 4) = o; } }
        { Acc2 a; a.t[0] = a.t[1] = (f32x4){0.f, 0.f, 0.f, 0.f}; prod2(lds, 8, 6, wave, lane, a);
#pragma unroll
          for (int t = 0; t < 2; ++t) { const int col = 16 * (2 * (wave & 1) + t) + r16, r0 = 16 * tr + 4 * g4; const float dg = __expf(gc[col]);
#pragma unroll
              for (int q = 0; q < 4; ++q) a.t[t][q] += (r0 + q == col) ? dg : 0.f;
              u32x2 o; o.x = cvtpk(a.t[t][0], a.t[t][1]); o.y = cvtpk(a.t[t][2], a.t[t][3]); *(u32x2*)(CH + (((col >> 4) * 2 + (tr >> 1)) * 64 + g4 * 16 + (col & 15)) * 8 + (tr & 1) * 4) = o; } }
        { Acc2 a; a.t[0] = a.t[1] = (f32x4){0.f, 0.f, 0.f, 0.f}; prod2(lds, 6, 9, wave, lane, a); prod2(lds, 7, 5, wave, lane, a);
#pragma unroll
          for (int t = 0; t < 2; ++t) { const int col = 16 * (2 * (wave & 1) + t) + r16, r0 = 16 * tr + 4 * g4;
              u32x2 o; o.x = cvtpk(a.t[t][0], a.t[t][1]); o.y = cvtpk(a.t[t][2], a.t[t][3]); *(u32x2*)(CH + 4096 + (((col >> 4) * 4 + tr) * 64 + g4 * 16 + (col & 15)) * 4) = o; } }
        __syncthreads();
    }
}
#undef CHUNK_FETCH
struct SeqS { u32x4 mt[4][2]; u32x2 nc[4]; };
struct SeqY { u32x4 qe[4][2]; u32x2 yl[4]; };
__device__ __forceinline__ void seq_load_s(SeqS& B, const bf16* CH, int vs, int lane) {
#pragma unroll
    for (int t = 0; t < 4; ++t) {
#pragma unroll
        for (int s = 0; s < 2; ++s) B.mt[t][s] = *(const u32x4*)(CH + ((t * 2 + s) * 64 + lane) * 8);
        B.nc[t] = *(const u32x2*)(CH + 4096 + ((vs * 4 + t) * 64 + lane) * 4); }
}
__device__ __forceinline__ void seq_load_y(SeqY& B, const bf16* CH, int vs, int lane) {
#pragma unroll
    for (int t = 0; t < 4; ++t) {
#pragma unroll
        for (int s = 0; s < 2; ++s) B.qe[t][s] = *(const u32x4*)(CH + 8192 + ((t * 2 + s) * 64 + lane) * 8);
        B.yl[t] = *(const u32x2*)(CH + 12288 + ((vs * 4 + t) * 64 + lane) * 4); }
}
__device__ __forceinline__ void seq_wait_ge(volatile LAS int* w, int v) { while (*w < v) __builtin_amdgcn_s_sleep(1); asm volatile("" ::: "memory"); }
__device__ __forceinline__ void phase_seq(const Params& p, LAS unsigned char* lds, int lane, int wave) {
    if (blockIdx.x >= 128) return;
    unsigned char* ws = p.ws;
    const int chain = (blockIdx.x & 7) * 4 + (blockIdx.x >> 5), vs = (blockIdx.x >> 3) & 3, db = chain >> 3, h = chain & 7, b = db & 1, d = db >> 1;
    const int r = lane & 15, g = lane >> 4;
    const bf16* CH0 = (const bf16*)(ws + WS_CH) + ((size_t)(db * NCH) * 8 + h) * 16384;
    volatile LAS int* flg = (volatile LAS int*)(lds + 16384);
    LAS u32x4* ring = (LAS u32x4*)lds;
    if (wave == 0 && lane == 0) { flg[0] = 0; flg[1] = 0; }
    __syncthreads();
    if (wave == 0) {
        u32x4 sf[2]; sf[0] = sf[1] = (u32x4){0u, 0u, 0u, 0u};
        SeqS q0, q1, q2, q3;
        seq_load_s(q0, CH0, vs, lane); seq_load_s(q1, CH0 + (size_t)1 * 8 * 16384, vs, lane); seq_load_s(q2, CH0 + (size_t)2 * 8 * 16384, vs, lane);
        seq_load_s(q3, CH0 + (size_t)3 * 8 * 16384, vs, lane);
#define SEQ_USE_S(Q) asm volatile("" :: "v"(Q.mt[0][0]), "v"(Q.mt[0][1]), "v"(Q.mt[1][0]), "v"(Q.mt[1][1]), "v"(Q.mt[2][0]), "v"(Q.mt[2][1]), "v"(Q.mt[3][0]), "v"(Q.mt[3][1]), "v"(Q.nc[0]), "v"(Q.nc[1]), "v"(Q.nc[2]), "v"(Q.nc[3]))
        SEQ_USE_S(q0); SEQ_USE_S(q1); SEQ_USE_S(q2); SEQ_USE_S(q3);
#undef SEQ_USE_S
#define SEQ_S_STEP(Q, jj) do { const int j_ = (jj); \
            if (j_ >= 8) seq_wait_ge(flg + 1, j_ - 7); \
            ring[((j_ & 7) * 2 + 0) * 64 + lane] = sf[0]; ring[((j_ & 7) * 2 + 1) * 64 + lane] = sf[1]; \
            asm volatile("s_waitcnt lgkmcnt(0)" ::: "memory"); if (lane == 0) flg[0] = j_ + 1; \
            f32x4 accS[4]; \
            _Pragma("unroll") for (int t = 0; t < 4; ++t) { f32x4 as = (f32x4){blo(Q.nc[t].x), bhi(Q.nc[t].x), blo(Q.nc[t].y), bhi(Q.nc[t].y)}; \
                _Pragma("unroll") for (int s2 = 0; s2 < 2; ++s2) as = __builtin_amdgcn_mfma_f32_16x16x32_bf16(__builtin_bit_cast(bf16x8, Q.mt[t][s2]), __builtin_bit_cast(bf16x8, sf[s2]), as, 0, 0, 0); \
                accS[t] = as; } \
            _Pragma("unroll") for (int s2 = 0; s2 < 2; ++s2) { sf[s2].x = cvtpk(accS[2 * s2][0], accS[2 * s2][1]); sf[s2].y = cvtpk(accS[2 * s2][2], accS[2 * s2][3]); sf[s2].z = cvtpk(accS[2 * s2 + 1][0], accS[2 * s2 + 1][1]); sf[s2].w = cvtpk(accS[2 * s2 + 1][2], accS[2 * s2 + 1][3]); } \
            { const int jn_ = j_ + 4 < NCH ? j_ + 4 : NCH - 1; seq_load_s(Q, CH0 + (size_t)jn_ * 8 * 16384, vs, lane); } } while (0)
        for (int j = 0; j < NCH; j += 4) { SEQ_S_STEP(q0, j); SEQ_S_STEP(q1, j + 1); SEQ_S_STEP(q2, j + 2); SEQ_S_STEP(q3, j + 3); }
#undef SEQ_S_STEP
    } else if (wave == 1) {
        float* Y = (float*)(ws + WS_Y) + (size_t)d * T * 512 + h * 64 + 16 * vs + r;
        SeqY q0, q1, q2; const int sgs = d ? -1 : 1;
        seq_load_y(q0, CH0, vs, lane); seq_load_y(q1, CH0 + (size_t)1 * 8 * 16384, vs, lane); seq_load_y(q2, CH0 + (size_t)2 * 8 * 16384, vs, lane);
#define SEQ_USE_Y(Q) asm volatile("" :: "v"(Q.qe[0][0]), "v"(Q.qe[0][1]), "v"(Q.qe[1][0]), "v"(Q.qe[1][1]), "v"(Q.qe[2][0]), "v"(Q.qe[2][1]), "v"(Q.qe[3][0]), "v"(Q.qe[3][1]), "v"(Q.yl[0]), "v"(Q.yl[1]), "v"(Q.yl[2]), "v"(Q.yl[3]))
        SEQ_USE_Y(q0); SEQ_USE_Y(q1); SEQ_USE_Y(q2);
#undef SEQ_USE_Y
#define SEQ_Y_STEP(Q, jj) do { const int j_ = (jj); \
            float* Yc_ = Y + ((ptrdiff_t)row_of(b, d, j_ * 64) + (ptrdiff_t)(sgs * 4 * g)) * 512;     \
            seq_wait_ge(flg, j_ + 1); \
            const u32x4 s0_ = ring[((j_ & 7) * 2 + 0) * 64 + lane], s1_ = ring[((j_ & 7) * 2 + 1) * 64 + lane]; \
            asm volatile("s_waitcnt lgkmcnt(0)" ::: "memory"); if (lane == 0) flg[1] = j_ + 1; \
            _Pragma("unroll") for (int t = 0; t < 4; ++t) { f32x4 ay = (f32x4){blo(Q.yl[t].x), bhi(Q.yl[t].x), blo(Q.yl[t].y), bhi(Q.yl[t].y)}; \
                ay = __builtin_amdgcn_mfma_f32_16x16x32_bf16(__builtin_bit_cast(bf16x8, Q.qe[t][0]), __builtin_bit_cast(bf16x8, s0_), ay, 0, 0, 0); \
                ay = __builtin_amdgcn_mfma_f32_16x16x32_bf16(__builtin_bit_cast(bf16x8, Q.qe[t][1]), __builtin_bit_cast(bf16x8, s1_), ay, 0, 0, 0); \
                _Pragma("unroll") for (int qq = 0; qq < 4; ++qq) Yc_[(ptrdiff_t)((16 * t + qq) * sgs) * 512] = ay[qq]; } \
            { const int jn_ = j_ + 3 < NCH ? j_ + 3 : NCH - 1; seq_load_y(Q, CH0 + (size_t)jn_ * 8 * 16384, vs, lane); } } while (0)
        for (int j = 0; j < NCH; j += 3) { SEQ_Y_STEP(q0, j); SEQ_Y_STEP(q1, j + 1); SEQ_Y_STEP(q2, j + 2); }
#undef SEQ_Y_STEP
    }
}

struct S5Disc { float ar, ai; float br[16], bi[16]; };
__device__ __forceinline__ void s5_disc(const Params& p, int l, int d, int g, int lane, S5Disc& q) {
    const int gi = (l * 2 + d) * 32 + g; const size_t pi = (size_t)gi * 64 + lane;
    const float lr = fminf(p.in[I_LRE][pi], -1e-4f), li = p.in[I_LIM][pi], dt = __expf(p.in[I_LDT][gi]);
    const float mag = __expf(lr * dt); float sn, cs; sincosf(li * dt, &sn, &cs);
    q.ar = mag * cs; q.ai = mag * sn;
    const float den = lr * lr + li * li, xr = q.ar - 1.0f, cr = (xr * lr + q.ai * li) / den, ci = (q.ai * lr - xr * li) / den;
    const float* bre = p.in[I_BRE] + pi * 16; const float* bim = p.in[I_BIM] + pi * 16;
#pragma unroll
    for (int c = 0; c < 16; c += 4) { const f32x4 a = *(const f32x4*)(bre + c), b = *(const f32x4*)(bim + c);
#pragma unroll
        for (int j = 0; j < 4; ++j) { q.br[c + j] = cr * a[j] - ci * b[j]; q.bi[c + j] = cr * b[j] + ci * a[j]; } }
}
__device__ __forceinline__ void phase_s5_carry(const Params& p, int l, int lane, int wave) {
    unsigned char* ws = p.ws;
    const float2* XEND = (const float2*)(ws + WS_XEND); float2* CARRY = (float2*)(ws + WS_CARRY);
    const int gw = blockIdx.x * 8 + wave;
    if (gw >= 128) return;
    const int g = gw & 31, b = (gw >> 5) & 1, d = gw >> 6;
    const int gi = (l * 2 + d) * 32 + g; const size_t pi = (size_t)gi * 64 + lane;
    const float lr = fminf(p.in[I_LRE][pi], -1e-4f), li = p.in[I_LIM][pi], dt = __expf(p.in[I_LDT][gi]);
    const float mag = __expf(lr * dt); float sn, cs; sincosf(li * dt, &sn, &cs);
    float ar = mag * cs, ai = mag * sn;
#pragma unroll
    for (int i = 0; i < 6; ++i) { const float nr = ar * ar - ai * ai, ni = 2.0f * ar * ai; ar = nr; ai = ni; }
    const size_t base = ((size_t)((d * 2 + b) * NCH)) * 2048 + g * 64 + lane;
    float xr = 0.f, xi = 0.f;
    for (int j0 = 0; j0 < NCH; j0 += 12) {
        float2 e[12];
#pragma unroll
        for (int i = 0; i < 12; ++i) e[i] = XEND[base + (size_t)(j0 + i) * 2048];
#pragma unroll
        for (int i = 0; i < 12; ++i) { CARRY[base + (size_t)(j0 + i) * 2048] = make_float2(xr, xi); const float nr = ar * xr - ai * xi + e[i].x, ni = ar * xi + ai * xr + e[i].y; xr = nr; xi = ni; }
    }
}

__device__ __forceinline__ void phase_s5_tables(const Params& p, int l, int item2, int lane) {
    unsigned char* ws = p.ws;
    const int hm = item2 & 1, item = item2 >> 1;
    const int mr = item & 7, d = (item >> 3) & 1, g = item >> 4;
    const int gi = (l * 2 + d) * 32 + g; const size_t pi = (size_t)gi * 64 + lane;
    const float lr = fminf(p.in[I_LRE][pi], -1e-4f), li = p.in[I_LIM][pi], dt = __expf(p.in[I_LDT][gi]);
    S5Disc q; s5_disc(p, l, d, g, lane, q);
    float cre[16], cim[16];
    { const float* cr_ = p.in[I_CRE] + ((size_t)gi * 16) * 64 + lane; const float* ci_ = p.in[I_CIM] + ((size_t)gi * 16) * 64 + lane;
#pragma unroll
      for (int c = 0; c < 16; ++c) { cre[c] = cr_[c * 64]; cim[c] = ci_[c * 64]; } }
    bf16* Et = (bf16*)(ws + WS_S5E) + (size_t)(g * 2 + d) * 1024 * 128;
    bf16* Kt = (bf16*)(ws + WS_S5K) + (size_t)(g * 2 + d) * 72 * 256;
    if (mr == 0 && hm == 0) {
#pragma unroll
        for (int z = 0; z < 8; ++z) *(u32x2*)(Kt + z * 256 + lane * 4) = (u32x2){0u, 0u}; }
    const int m0 = 8 * mr + 4 * hm, m1 = (mr == 7 && hm == 1) ? 65 : m0 + 4;
    float pr, pim; { const float mg = __expf(lr * dt * (float)m0); float sn, cs; sincosf(li * dt * (float)m0, &sn, &cs); pr = mg * cs; pim = mg * sn; }
    for (int m = m0; m < m1; ++m) {
#pragma unroll 1
        for (int cp = 0; cp < 16; ++cp) {
            float c_r = 0.f, c_i = 0.f;
#pragma unroll
            for (int c = 0; c < 16; ++c) { c_r = (cp == c) ? cre[c] : c_r; c_i = (cp == c) ? cim[c] : c_i; }
            const float car = c_r * pr - c_i * pim, cai = c_r * pim + c_i * pr;
            if (m >= 1) {
                bf16* eb = Et + (size_t)(m - 1) * 4 * 512;
                eb[((lane >> 5) * 64 + ((lane >> 3) & 3) * 16 + cp) * 8 + (lane & 7)] = (bf16)f2bf(car);
                eb[((2 + (lane >> 5)) * 64 + ((lane >> 3) & 3) * 16 + cp) * 8 + (lane & 7)] = (bf16)f2bf(-cai); }
            if (m <= 63) {
                float vals[16];
#pragma unroll
                for (int c = 0; c < 16; ++c) vals[c] = car * q.br[c] - cai * q.bi[c];
                { const bool hi = (lane & 32) != 0;
#pragma unroll
                  for (int i = 0; i < 8; ++i) { const float send = hi ? vals[i] : vals[i + 8], keep = hi ? vals[i + 8] : vals[i]; vals[i] = keep + __shfl_xor(send, 32); } }
                { const bool hi = (lane & 16) != 0;
#pragma unroll
                  for (int i = 0; i < 4; ++i) { const float send = hi ? vals[i] : vals[i + 4], keep = hi ? vals[i + 4] : vals[i]; vals[i] = keep + __shfl_xor(send, 16); } }
                { const bool hi = (lane & 8) != 0;
#pragma unroll
                  for (int i = 0; i < 2; ++i) { const float send = hi ? vals[i] : vals[i + 2], keep = hi ? vals[i + 2] : vals[i]; vals[i] = keep + __shfl_xor(send, 8); } }
                { const bool hi = (lane & 4) != 0; const float send = hi ? vals[0] : vals[1], keep = hi ? vals[1] : vals[0]; vals[0] = keep + __shfl_xor(send, 4); }
                vals[0] += __shfl_xor(vals[0], 2); vals[0] += __shfl_xor(vals[0], 1);
                if ((lane & 3) == 0) Kt[(size_t)(m + 8) * 256 + cp * 16 + (lane >> 2)] = (bf16)f2bf(vals[0]);
            }
        }
        const float nr = pr * q.ar - pim * q.ai, ni = pr * q.ai + pim * q.ar; pr = nr; pim = ni;
    }
    { bf16* BP = (bf16*)(ws + WS_S5BP) + (size_t)(g * 2 + d) * 128 * 1024;
      for (int j = 8 * mr + 4 * hm; j < 8 * mr + 4 * hm + 4; ++j) { const float pw = (float)(d ? j : 63 - j); const float mg = __expf(lr * dt * pw); float sn, cs; sincosf(li * dt * pw, &sn, &cs); const float xr = mg * cs, xi = mg * sn;
          float re[16], im[16];
#pragma unroll
          for (int c = 0; c < 16; ++c) { re[c] = xr * q.br[c] - xi * q.bi[c]; im[c] = xr * q.bi[c] + xi * q.br[c]; }
          u32x4 o; bf16* fb = BP + (size_t)(j >> 1) * 8 * 512;
          bf16* dr = fb + ((size_t)(lane >> 4) * 64 + ((j & 1) * 2) * 16 + (lane & 15)) * 8; bf16* di = fb + ((size_t)(4 + (lane >> 4)) * 64 + ((j & 1) * 2) * 16 + (lane & 15)) * 8;
          o.x = cvtpk(re[0], re[1]); o.y = cvtpk(re[2], re[3]); o.z = cvtpk(re[4], re[5]); o.w = cvtpk(re[6], re[7]); *(u32x4*)dr = o;
          o.x = cvtpk(re[8], re[9]); o.y = cvtpk(re[10], re[11]); o.z = cvtpk(re[12], re[13]); o.w = cvtpk(re[14], re[15]); *(u32x4*)(dr + 128) = o;
          o.x = cvtpk(im[0], im[1]); o.y = cvtpk(im[2], im[3]); o.z = cvtpk(im[4], im[5]); o.w = cvtpk(im[6], im[7]); *(u32x4*)di = o;
          o.x = cvtpk(im[8], im[9]); o.y = cvtpk(im[10], im[11]); o.z = cvtpk(im[12], im[13]); o.w = cvtpk(im[14], im[15]); *(u32x4*)(di + 128) = o; } }
}
__device__ __forceinline__ int row_tb(int tb, int t) { const int b = tb >= NCH ? 1 : 0, k = tb - b * NCH; return k < 4 ? NLAT + b * CTXL + 64 * k + t : b * SEQ + 64 * (k - 4) + t; }
__device__ __forceinline__ bf16x8 s5_ufrag(const bf16* Ug, int ct, int j0, int r, int g4) { return *(const bf16x8*)(Ug + ((size_t)(j0 + (g4 >> 1)) * (2 * NCH) + 16 * ct + r) * 16 + 8 * (g4 & 1)); }
__device__ __forceinline__ void phase_s5_end(const Params& p, int lane, int wave) {
    unsigned char* ws = p.ws;
    float2* XEND = (float2*)(ws + WS_XEND);
    const int r = lane & 15, g4 = lane >> 4;
    for (int it = blockIdx.x * 8 + wave; it < 32 * 17 * 2; it += gridDim.x * 8) {
        const int d = it & 1, ct = (it >> 1) % 17, g = (it >> 1) / 17;
        const int tb = 16 * ct + r, tbc = tb < 2 * NCH ? tb : 2 * NCH - 1; const bool valid = tb < 2 * NCH;
        const int b = tbc >= NCH ? 1 : 0, k = tbc - b * NCH;
        const bf16* Ug = (const bf16*)(ws + WS_U) + (size_t)g * 64 * (2 * NCH) * 16;
        const bf16* BPf = (const bf16*)(ws + WS_S5BP) + (size_t)(g * 2 + d) * 128 * 1024 + lane * 8;
        f32x4 acc[8];
#pragma unroll
        for (int rt = 0; rt < 8; ++rt) acc[rt] = (f32x4){0.f, 0.f, 0.f, 0.f};
#pragma unroll 1
        for (int kb = 0; kb < 32; kb += 4) {
            bf16x8 bu[4];
#pragma unroll
            for (int i = 0; i < 4; ++i) bu[i] = s5_ufrag(Ug, ct, 2 * (kb + i), r, g4);
            bf16x8 a[4][8];
#pragma unroll
            for (int i = 0; i < 4; ++i)
#pragma unroll
                for (int rt = 0; rt < 8; ++rt) a[i][rt] = *(const bf16x8*)(BPf + ((size_t)(kb + i) * 8 + rt) * 512);
            asm volatile("" : "+v"(acc[0]), "+v"(acc[1]), "+v"(acc[2]), "+v"(acc[3]), "+v"(acc[4]), "+v"(acc[5]), "+v"(acc[6]), "+v"(acc[7]) :: "memory");
#pragma unroll
            for (int i = 0; i < 4; ++i)
#pragma unroll
                for (int rt = 0; rt < 8; ++rt) acc[rt] = __builtin_amdgcn_mfma_f32_16x16x32_bf16(a[i][rt], bu[i], acc[rt], 0, 0, 0);
            asm volatile("" ::: "memory");
        }
        if (valid) { const int js = d ? (k < 4 ? 3 - k : NCH + 3 - k) : k;
            float2* xe = XEND + ((size_t)((d * 2 + b) * NCH + js)) * 2048 + g * 64;
#pragma unroll
            for (int rt = 0; rt < 4; ++rt)
#pragma unroll
                for (int q = 0; q < 4; ++q) xe[16 * rt + 4 * g4 + q] = make_float2(acc[rt][q], acc[rt + 4][q]); }
    }
}
__device__ __forceinline__ void phase_s5_out(const Params& p, int l, LAS unsigned char* lds, int tid, int lane, int wave) {
    unsigned char* ws = p.ws;
    bf16* YG = (bf16*)(ws + WS_YG); const float2* CARRY = (const float2*)(ws + WS_CARRY);
    const int r = lane & 15, g4 = lane >> 4;
    for (int gb = blockIdx.x; gb < 256; gb += gridDim.x) {
        const int g = (gridDim.x == 256) ? ((gb & 7) * 4 + (gb >> 6)) : (gb >> 3), tg = (gridDim.x == 256) ? ((gb >> 3) & 7) : (gb & 7);
        __syncthreads();
        { const u32x4* src = (const u32x4*)((const bf16*)(ws + WS_S5K) + (size_t)g * 2 * 72 * 256);
          { u32x4 tk_[9];
#pragma unroll
            for (int q = 0; q < 9; ++q) tk_[q] = src[tid + 512 * q];
#pragma unroll
            for (int q = 0; q < 9; ++q) ((LAS u32x4*)lds)[tid + 512 * q] = tk_[q]; }
          const u32x4* e0s = (const u32x4*)((const bf16*)(ws + WS_S5E) + (size_t)(g * 2) * 1024 * 128 + (size_t)(8 * tg) * 4 * 512);
          const u32x4* e1s = (const u32x4*)((const bf16*)(ws + WS_S5E) + (size_t)(g * 2 + 1) * 1024 * 128 + (size_t)(56 - 8 * tg) * 4 * 512);
          u32x4 t0_[4], t1_[4];
#pragma unroll
          for (int q = 0; q < 4; ++q) { t0_[q] = e0s[tid + 512 * q]; t1_[q] = e1s[tid + 512 * q]; }
#pragma unroll
          for (int q = 0; q < 4; ++q) { *(LAS u32x4*)(lds + 73728 + (tid + 512 * q) * 16) = t0_[q]; *(LAS u32x4*)(lds + 73728 + 32768 + (tid + 512 * q) * 16) = t1_[q]; } }
        __syncthreads();
        const bf16* Ug = (const bf16*)(ws + WS_U) + (size_t)g * 64 * (2 * NCH) * 16;
        for (int ct = wave; ct < 17; ct += 8) {
            const int tb = 16 * ct + r, tbc = tb < 2 * NCH ? tb : 2 * NCH - 1; const bool valid = tb < 2 * NCH;
            const int b = tbc >= NCH ? 1 : 0, k = tbc - b * NCH;
            bf16x8 xc[2][4];
#pragma unroll
            for (int d = 0; d < 2; ++d) { const int js = d ? (k < 4 ? 3 - k : NCH + 3 - k) : k;
                const float2* cp = CARRY + ((size_t)((d * 2 + b) * NCH + js)) * 2048 + g * 64;
#pragma unroll
                for (int ks = 0; ks < 4; ++ks) { const int p0 = 32 * (ks & 1) + 8 * g4; const f32x4* c4 = (const f32x4*)(cp + p0);
                    const f32x4 a = c4[0], b2 = c4[1], c2 = c4[2], d2 = c4[3]; u32x4 o;
                    if (ks < 2) { o.x = cvtpk(a[0], a[2]); o.y = cvtpk(b2[0], b2[2]); o.z = cvtpk(c2[0], c2[2]); o.w = cvtpk(d2[0], d2[2]); }
                    else { o.x = cvtpk(a[1], a[3]); o.y = cvtpk(b2[1], b2[3]); o.z = cvtpk(c2[1], c2[3]); o.w = cvtpk(d2[1], d2[3]); }
                    xc[d][ks] = __builtin_bit_cast(bf16x8, o); } }
            u32x2 uu8[8];
#pragma unroll
            for (int tt = 0; tt < 8; ++tt) uu8[tt] = *(const u32x2*)(Ug + ((size_t)(8 * tg + tt) * (2 * NCH) + tbc) * 16 + 4 * g4);
            f32x4 acc[8];
#pragma unroll
            for (int tt = 0; tt < 8; ++tt) acc[tt] = (f32x4){0.f, 0.f, 0.f, 0.f};
            bf16x8 bu[4], bn[4];
#pragma unroll
            for (int i = 0; i < 4; ++i) bu[i] = s5_ufrag(Ug, ct, (2 * i) & 63, r, g4);
            for (int jb = 0; jb <= 8 * tg + 6; jb += 8) {
                { const int jn = jb + 8 <= 8 * tg + 6 ? jb + 8 : jb;
#pragma unroll
                  for (int i = 0; i < 4; ++i) bn[i] = s5_ufrag(Ug, ct, (jn + 2 * i) & 63, r, g4); }
#pragma unroll
                for (int i = 0; i < 4; ++i) { const int j = jb + 2 * i + (g4 >> 1);
                    if (jb + 2 * i <= 8 * tg + 6) {
                    const LAS unsigned char* ab = lds + (8 * tg - j + 8) * 512 + r * 32 + (g4 & 1) * 16;
                    bf16x8 a8[8];
#pragma unroll
                    for (int tt = 0; tt < 8; ++tt) a8[tt] = *(const LAS bf16x8*)(ab + tt * 512);
                    asm volatile("" : "+v"(acc[0]), "+v"(acc[1]), "+v"(acc[2]), "+v"(acc[3]), "+v"(acc[4]), "+v"(acc[5]), "+v"(acc[6]), "+v"(acc[7]) :: "memory");
#pragma unroll
                    for (int tt = 0; tt < 8; ++tt) acc[tt] = __builtin_amdgcn_mfma_f32_16x16x32_bf16(a8[tt], bu[i], acc[tt], 0, 0, 0); }
                    asm volatile("" ::: "memory"); }
#pragma unroll
                for (int i = 0; i < 4; ++i) bu[i] = bn[i];
            }
#pragma unroll
            for (int i = 0; i < 4; ++i) bu[i] = s5_ufrag(Ug, ct, 8 * tg + 2 * i, r, g4);
            for (int jb = 8 * tg; jb <= 62; jb += 8) {
                { const int jn = jb + 8 <= 62 ? jb + 8 : jb;
#pragma unroll
                  for (int i = 0; i < 4; ++i) bn[i] = s5_ufrag(Ug, ct, jn + 2 * i, r, g4); }
#pragma unroll
                for (int i = 0; i < 4; ++i) { const int j = jb + 2 * i + (g4 >> 1);
                    if (jb + 2 * i + 1 >= 8 * tg) {
                    const LAS unsigned char* ab = lds + 36864 + (j - 8 * tg + 8) * 512 + r * 32 + (g4 & 1) * 16;
                    bf16x8 a8[8];
#pragma unroll
                    for (int tt = 0; tt < 8; ++tt) a8[tt] = *(const LAS bf16x8*)(ab - tt * 512);
                    asm volatile("" : "+v"(acc[0]), "+v"(acc[1]), "+v"(acc[2]), "+v"(acc[3]), "+v"(acc[4]), "+v"(acc[5]), "+v"(acc[6]), "+v"(acc[7]) :: "memory");
#pragma unroll
                    for (int tt = 0; tt < 8; ++tt) acc[tt] = __builtin_amdgcn_mfma_f32_16x16x32_bf16(a8[tt], bu[i], acc[tt], 0, 0, 0); }
                    asm volatile("" ::: "memory"); }
#pragma unroll
                for (int i = 0; i < 4; ++i) bu[i] = bn[i];
            }
            const f32x4 dsk = *(const f32x4*)(p.in[I_S5D] + l * 512 + g * 16 + 4 * g4);
#pragma unroll
            for (int tt = 0; tt < 8; ++tt) { const int t = 8 * tg + tt;
                const u32x2 uu = uu8[tt];
#pragma unroll
                for (int ks = 0; ks < 4; ++ks) {
                    const bf16x8 e0 = *(const LAS bf16x8*)(lds + 73728 + ((tt * 4 + ks) * 64 + lane) * 16), e1 = *(const LAS bf16x8*)(lds + 73728 + 32768 + (((7 - tt) * 4 + ks) * 64 + lane) * 16);
                    acc[tt] = __builtin_amdgcn_mfma_f32_16x16x32_bf16(e0, xc[0][ks], acc[tt], 0, 0, 0); acc[tt] = __builtin_amdgcn_mfma_f32_16x16x32_bf16(e1, xc[1][ks], acc[tt], 0, 0, 0); }
                const float uf[4] = {blo(uu.x), bhi(uu.x), blo(uu.y), bhi(uu.y)}; float o[4];
#pragma unroll
                for (int q = 0; q < 4; ++q) { const float ys = acc[tt][q] + dsk[q] * uf[q]; o[q] = ys * __builtin_amdgcn_rcpf(1.0f + __expf(-1.5957691216f * (ys + 0.044715f * ys * ys * ys))); }
                if (valid) { u32x2 w2; w2.x = cvtpk(o[0], o[1]); w2.y = cvtpk(o[2], o[3]); *(u32x2*)(YG + (size_t)row_tb(tbc, t) * 512 + g * 16 + 4 * g4) = w2; }
                if (tt & 1) asm volatile("" ::: "memory");
            }
        }
    }
}

__device__ __forceinline__ void phase_readout(const Params& p, int l, int lane, int wave, int blk, int nblk) {
    unsigned char* ws = p.ws;
    const bf16* V = (const bf16*)(ws + WS_V); const bf16* GD = (const bf16*)(ws + WS_GD); const float* BON = (const float*)(ws + WS_BONUS);
    const float* Y = (const float*)(ws + WS_Y);
    bf16* A2 = (bf16*)(ws + WS_A2);
    const int c = lane * 8, h = lane >> 3;
    const f32x4 lw0 = *(const f32x4*)(p.in[I_LNW] + l * 512 + c), lw1 = *(const f32x4*)(p.in[I_LNW] + l * 512 + c + 4), lb0 = *(const f32x4*)(p.in[I_LNB] + l * 512 + c), lb1 = *(const f32x4*)(p.in[I_LNB] + l * 512 + c + 4);
    const float lnw[8] = {lw0[0], lw0[1], lw0[2], lw0[3], lw1[0], lw1[1], lw1[2], lw1[3]}, lnb[8] = {lb0[0], lb0[1], lb0[2], lb0[3], lb1[0], lb1[1], lb1[2], lb1[3]};
    const int gw = blk * 8 + wave, NGW = nblk * 8;
#define RO_FETCH(r_, V8, Y0, Y1, G8, BN) do { const int rf_ = (r_); V8 = *(const u32x4*)(V + (size_t)rf_ * 512 + c); \
        _Pragma("unroll") for (int d = 0; d < 2; ++d) { const size_t o_ = ((size_t)d * T + rf_) * 512 + c; Y0[d] = *(const f32x4*)(Y + o_); Y1[d] = *(const f32x4*)(Y + o_ + 4); G8[d] = *(const u32x4*)(GD + o_); BN[d] = BON[((size_t)d * T + rf_) * 8 + h]; } } while (0)
    u32x4 v8n, g8n[2]; f32x4 y0n[2], y1n[2]; float bnn[2];
    if (gw < T) RO_FETCH(gw, v8n, y0n, y1n, g8n, bnn);
    for (int row = gw; row < T; row += NGW) {
        const u32x4 v8 = v8n; const u32x4 g8c[2] = {g8n[0], g8n[1]}; const f32x4 y0c[2] = {y0n[0], y0n[1]}, y1c[2] = {y1n[0], y1n[1]}; const float bnc[2] = {bnn[0], bnn[1]};
        asm volatile("" ::: "memory");
        RO_FETCH(row + NGW < T ? row + NGW : row, v8n, y0n, y1n, g8n, bnn);
        asm volatile("" ::: "memory");
        const float vf[8] = {blo(v8.x), bhi(v8.x), blo(v8.y), bhi(v8.y), blo(v8.z), bhi(v8.z), blo(v8.w), bhi(v8.w)};
        float out[8] = {0.f, 0.f, 0.f, 0.f, 0.f, 0.f, 0.f, 0.f};
#pragma unroll
        for (int d = 0; d < 2; ++d) {
            const f32x4 y0 = y0c[d], y1 = y1c[d]; const u32x4 g8 = g8c[d];
            const float y[8] = {y0[0], y0[1], y0[2], y0[3], y1[0], y1[1], y1[2], y1[3]};
            const float gf[8] = {blo(g8.x), bhi(g8.x), blo(g8.y), bhi(g8.y), blo(g8.z), bhi(g8.z), blo(g8.w), bhi(g8.w)};
            float sm = ((y[0] + y[1]) + (y[2] + y[3])) + ((y[4] + y[5]) + (y[6] + y[7]));
            sm += __shfl_xor(sm, 1); sm += __shfl_xor(sm, 2); sm += __shfl_xor(sm, 4);
            const float mean = sm * (1.0f / 64.0f); float q = 0.f;
#pragma unroll
            for (int i = 0; i < 8; ++i) { const float dv = y[i] - mean; q += dv * dv; }
            q += __shfl_xor(q, 1); q += __shfl_xor(q, 2); q += __shfl_xor(q, 4);
            const float rs = rsqrtf(q * (1.0f / 64.0f) + 64e-5f), bon = bnc[d];
#pragma unroll
            for (int i = 0; i < 8; ++i) out[i] += ((y[i] - mean) * rs * lnw[i] + lnb[i] + bon * vf[i]) * gf[i]; }
        u32x4 w; w.x = cvtpk(out[0], out[1]); w.y = cvtpk(out[2], out[3]); w.z = cvtpk(out[4], out[5]); w.w = cvtpk(out[6], out[7]);
        *(u32x4*)(A2 + (size_t)row * 1024 + c) = w;
    }
#undef RO_FETCH
}

enum { PH_PRO = 0, PH_NORM1, PH_GIN, PH_STREAM, PH_GLR, PH_S5A, PH_S5B, PH_CHUNK, PH_SEQ, PH_S5C, PH_READOUT, PH_GGLU, PH_GOUT, PH_NORM2, PH_GFUP, PH_GFDN, PH_NORM2M, PH_MPREP, PH_GMUP, PH_GMDN, PH_FINAL, N_PH };
template <int PH>
__device__ __forceinline__ void run_phase(const Params& p, int l, int e, LAS unsigned char* lds, int tid, int lane, int wave) {
    unsigned char* ws = p.ws; const int G = gridDim.x;
    const float* MODl = (const float*)(ws + WS_MOD) + (size_t)l * 3 * 6144;
    if constexpr (PH == PH_PRO) phase_prologue(p, lds, tid, lane, wave);
    if constexpr (PH == PH_NORM1) { if (l == 0) phase_norm(p, l, 0, true, false, lane, wave); else phase_norm(p, l, 0, false, false, lane, wave, 11, (const float*)(ws + WS_PARTF), (const float*)(ws + WS_MOD) + 2 * 6144 + 5120); }
    if constexpr (PH == PH_GIN) {
        pg8::Gemm g{(const bf16*)(ws + WS_H), (const bf16*)(ws + WS_WIN) + (size_t)l * DIN * 1024, T, DIN, 1024, 1024}; pg8::StaticOrder S; S.init(T, DIN, G, (int)blockIdx.x);
        pg8::EpiBf16<0> E{(bf16*)(ws + WS_P), DIN, nullptr, 0, 0, 1.f};
        pg8::gemm_phase<pg8::EpiBf16<0>, pg8::StaticOrder, true, true>(lds, g, S, E, tid); }
    if constexpr (PH == PH_STREAM) phase_stream_lr(p, l, lds, tid, lane, wave);
    if constexpr (PH == PH_CHUNK) phase_chunk(p, l, lds, tid, lane, wave);
    if constexpr (PH == PH_SEQ) { if (blockIdx.x >= 128) { const int item = (blockIdx.x - 128) * 8 + wave; for (int it2 = item; it2 < 1024; it2 += (G - 128) * 8) phase_s5_tables(p, l, it2, lane); } else phase_seq(p, lds, lane, wave); }
    if constexpr (PH == PH_S5A) phase_s5_end(p, lane, wave);
    if constexpr (PH == PH_S5B) { if (blockIdx.x < 16) phase_s5_carry(p, l, lane, wave); else phase_readout(p, l, lane, wave, (int)blockIdx.x - 16, G - 16); }
    if constexpr (PH == PH_S5C) phase_s5_out(p, l, lds, tid, lane, wave);
    if constexpr (PH == PH_GGLU) {
        const int Mr = l == 0 ? T : NLAT; pg8::Gemm g{(const bf16*)(ws + WS_YG), (const bf16*)(ws + WS_WGLU) + (size_t)l * 512 * 512, Mr, 512, 512, 512}; pg8::StaticOrder S; S.init(Mr, 512, G, (int)blockIdx.x);
        pg8::EpiGLU E{(const bf16*)(ws + WS_YG), (bf16*)(ws + WS_A2), p.in[I_GLUB] + l * 512};
        pg8::gemm_phase<pg8::EpiGLU, pg8::StaticOrder, true, true>(lds, g, S, E, tid);
        if (l == 1 && G > 128 && (int)blockIdx.x >= 128) phase_moe_cvt(p, lds, lane, wave, MOE_CVT_SPLIT, MOE_CVT_ITEMS, ((int)blockIdx.x - 128) * 8 + wave, (G - 128) * 8); }
    if constexpr (PH == PH_GOUT) {
        { pg8::Gemm g{(const bf16*)(ws + WS_A2), (const bf16*)(ws + WS_WOUT) + (size_t)l * 1024 * 1024, NLAT, 1024, 1024, 1024}; pg8::StaticOrder S; S.init(NLAT, 1024, G, (int)blockIdx.x);
          pg8::EpiRes E{(float*)(ws + WS_X), MODl + 2048, nullptr, 0};
          pg8::gemm_phase<pg8::EpiRes, pg8::StaticOrder, true, true>(lds, g, S, E, tid); }
        if (l == 0) {
            pg8::Gemm g{(const bf16*)(ws + WS_A2), (const bf16*)(ws + WS_WOUT), NCTX, 1024, 256, 1024}; pg8::GroupOrder S;
#pragma unroll
            for (int q = 0; q < 9; ++q) S.toff[q] = q == 0 ? 0 : (1 << 20);
            S.t0 = NLAT / 256; S.a0 = 0; S.o0 = 0; S.nNr = 4; S.kslice = 256; S.init(NCTX, 1024 * 4, G, (int)blockIdx.x);
            pg8::EpiPartF32 E{(float*)(ws + WS_PARTO), NLAT, NCTX, 256};
            pg8::gemm_phase<pg8::EpiPartF32, pg8::GroupOrder, true, true>(lds, g, S, E, tid); }
    }
    if constexpr (PH == PH_NORM2) phase_norm(p, l, 1, false, false, lane, wave, 4, (const float*)(ws + WS_PARTO), (const float*)(ws + WS_MOD) + 2 * 6144 + 2048);
    if constexpr (PH == PH_GFUP) {
        pg8::Gemm g{(const bf16*)(ws + WS_H), (const bf16*)(ws + WS_WFUP), T, 2 * DFF, 1024, 1024}; pg8::StaticOrder S; S.init(T, 2 * DFF, G, (int)blockIdx.x);
        pg8::EpiSwiGLU E{(bf16*)(ws + WS_ACT), DFF};
        pg8::gemm_phase<pg8::EpiSwiGLU, pg8::StaticOrder, true, true>(lds, g, S, E, tid); }
    if constexpr (PH == PH_GFDN) {
        { pg8::Gemm g{(const bf16*)(ws + WS_ACT), (const bf16*)(ws + WS_WFDN), NLAT, 1024, DFF, DFF}; pg8::StaticOrder S; S.init(NLAT, 1024, G, (int)blockIdx.x);
          pg8::EpiRes E{(float*)(ws + WS_X), MODl + 5120, nullptr, 0};
          pg8::gemm_phase<pg8::EpiRes, pg8::StaticOrder, true, true>(lds, g, S, E, tid); }
        {
            pg8::Gemm g{(const bf16*)(ws + WS_ACT), (const bf16*)(ws + WS_WFDN), NCTX, 1024, 256, DFF}; pg8::GroupOrder S;
#pragma unroll
            for (int q = 0; q < 9; ++q) S.toff[q] = q == 0 ? 0 : (1 << 20);
            S.t0 = NLAT / 256; S.a0 = 0; S.o0 = 0; S.nNr = 4; S.kslice = 256; S.init(NCTX, 1024 * 11, G, (int)blockIdx.x);
            pg8::EpiPartF32 E{(float*)(ws + WS_PARTF), NLAT, NCTX, 256};
            pg8::gemm_phase<pg8::EpiPartF32, pg8::GroupOrder, true, true>(lds, g, S, E, tid); }
    }
    if constexpr (PH == PH_NORM2M) { phase_norm2_moe(p, lds, tid, lane, wave); phase_moe_cvt(p, lds, lane, wave, 0, G > 128 ? MOE_CVT_SPLIT : MOE_CVT_ITEMS, (int)blockIdx.x * 8 + wave, G * 8); }
    if constexpr (PH == PH_MPREP) phase_moe_prep(p, lds, tid, lane, wave);
    if constexpr (PH == PH_GMUP || PH == PH_GMDN) {
        const int* TOFF = (const int*)(ws + WS_TOFF);
        pg8::GroupOrder S;
#pragma unroll
        for (int q = 0; q < 9; ++q) S.toff[q] = __builtin_amdgcn_readfirstlane(TOFF[q]);
        const int nT = S.toff[8];
        const int t0 = e * MOE_PASS_TILES; int nt = e == 0 ? (nT < 64 ? nT : 64) : (nT > 64 ? nT - 64 : 0);
        S.t0 = t0;
        if constexpr (PH == PH_GMUP) {
            S.a0 = 0; S.o0 = t0; S.nNr = 2 * DFE / 256; S.kslice = 0; S.init(nt * 256, 2 * DFE, G, (int)blockIdx.x);
            pg8::Gemm g{(const bf16*)(ws + WS_APERM) + (size_t)t0 * 256 * 1024, (const bf16*)(ws + WS_WMUP), nt * 256, 2 * DFE, 1024, 1024};
            S.a0 = t0;
            pg8::EpiSwiGLU E{(bf16*)(ws + WS_ACT1), DFE};
            pg8::gemm_phase<pg8::EpiSwiGLU, pg8::GroupOrder, true, true>(lds, g, S, E, tid);
        } else {
            {
                const int ntA = nt < 64 ? nt : 64;
                S.a0 = t0; S.o0 = 0; S.nNr = 4; S.kslice = 0; S.init(ntA * 256, 1024, G, (int)blockIdx.x);
                pg8::Gemm g{(const bf16*)(ws + WS_ACT1), (const bf16*)(ws + WS_WMDN), ntA * 256, 1024, DFE, DFE};
                pg8::EpiBf16<0> E{(bf16*)(ws + WS_APERM), 1024, nullptr, 0, 0, 1.f};
                pg8::gemm_phase<pg8::EpiBf16<0>, pg8::GroupOrder, true, true>(lds, g, S, E, tid); }
            if (e == 1 && nT > 128) {
                S.t0 = 128; S.a0 = 64; S.o0 = 0; S.nNr = 4; S.kslice = DFE / 7; S.init((nT - 128) * 256, 1024 * 7, G, (int)blockIdx.x);
                pg8::Gemm g{(const bf16*)(ws + WS_ACT1), (const bf16*)(ws + WS_WMDN), (nT - 128) * 256, 1024, DFE / 7, DFE};
                pg8::EpiPartBf16 E{(bf16*)(ws + WS_PARTM), 128 * 256, 8 * 256, DFE / 7};
                pg8::gemm_phase<pg8::EpiPartBf16, pg8::GroupOrder, true, true>(lds, g, S, E, tid); }
        }
    }
    if constexpr (PH == PH_FINAL) phase_final(p, lane, wave);
}
template <int PH>
__global__ void __launch_bounds__(512, 2) k_ph(Params p, int l, int e) {
    extern __shared__ __attribute__((aligned(16))) unsigned char lds_raw[];
    LAS unsigned char* lds = (LAS unsigned char*)lds_raw;
    const int tid = threadIdx.x, lane = tid & 63, wave = __builtin_amdgcn_readfirstlane(tid >> 6);
    run_phase<PH>(p, l, e, lds, tid, lane, wave);
}

#ifndef MK_MULTI
#define MK_FUSED 1
#endif
#ifdef MK_FUSED
#ifndef MK_LOOP_L
#define MK_LOOP_L 0
#endif
__global__ void __launch_bounds__(512, 2) fwd_fused(Params p) {
    extern __shared__ __attribute__((aligned(16))) unsigned char lds_raw[];
    LAS unsigned char* lds = (LAS unsigned char*)lds_raw;
    const int tid = threadIdx.x, lane = tid & 63, wave = __builtin_amdgcn_readfirstlane(tid >> 6);
    volatile LAS unsigned* MISC = (volatile LAS unsigned*)(lds + MISC_OFF);
    if (tid < 32) MISC[tid] = 0u;
    __syncthreads();
    XcdBarrier bar = xcd_barrier_post((unsigned*)(p.ws + WS_CTL) + 4096, MISC + 8);
#define PHASE(PH, l, e) do { int t_ = threadIdx.x; asm volatile("" : "+v"(t_)); run_phase<PH>(p, l, e, lds, t_, t_ & 63, __builtin_amdgcn_readfirstlane(t_ >> 6)); xcd_barrier(bar); } while (0)
    PHASE(PH_PRO, 0, 0);
#if MK_LOOP_L
    for (int l = 0; l < 2; ++l) {
        PHASE(PH_NORM1, l, 0); PHASE(PH_GIN, l, 0); PHASE(PH_STREAM, l, 0); PHASE(PH_GLR, l, 0); PHASE(PH_S5A, l, 0); PHASE(PH_S5B, l, 0); PHASE(PH_CHUNK, l, 0); PHASE(PH_SEQ, l, 0); PHASE(PH_S5C, l, 0);
        PHASE(PH_READOUT, l, 0); PHASE(PH_GGLU, l, 0); PHASE(PH_GOUT, l, 0); PHASE(PH_NORM2, l, 0);
        if (l == 0) { PHASE(PH_GFUP, 0, 0); PHASE(PH_GFDN, 0, 0); }
        else { PHASE(PH_MPREP, 1, 0); for (int e = 0; e < 2; ++e) { PHASE(PH_GMUP, 1, e); PHASE(PH_GMDN, 1, e); } }
    }
#else
    PHASE(PH_NORM1, 0, 0); PHASE(PH_GIN, 0, 0); PHASE(PH_STREAM, 0, 0); PHASE(PH_CHUNK, 0, 0); PHASE(PH_SEQ, 0, 0); PHASE(PH_S5A, 0, 0); PHASE(PH_S5B, 0, 0); PHASE(PH_S5C, 0, 0);
    PHASE(PH_GGLU, 0, 0); PHASE(PH_GOUT, 0, 0); PHASE(PH_NORM2, 0, 0); PHASE(PH_GFUP, 0, 0); PHASE(PH_GFDN, 0, 0);
    PHASE(PH_NORM1, 1, 0); PHASE(PH_GIN, 1, 0); PHASE(PH_STREAM, 1, 0); PHASE(PH_CHUNK, 1, 0); PHASE(PH_SEQ, 1, 0); PHASE(PH_S5A, 1, 0); PHASE(PH_S5B, 1, 0); PHASE(PH_S5C, 1, 0);
    PHASE(PH_GGLU, 1, 0); PHASE(PH_GOUT, 1, 0); PHASE(PH_NORM2M, 1, 0); PHASE(PH_MPREP, 1, 0);
    for (int e = 0; e < 2; ++e) { PHASE(PH_GMUP, 1, e); PHASE(PH_GMDN, 1, e); }
#endif
    { int t_ = threadIdx.x; asm volatile("" : "+v"(t_)); run_phase<PH_FINAL>(p, 0, 0, lds, t_, t_ & 63, __builtin_amdgcn_readfirstlane(t_ >> 6)); }
#undef PHASE
}
#endif
}

#ifndef MK_FUSED
template <int PH> static void launch_ph(const mk::Params& a, int l, int e, int grid, hipStream_t stream) {
    static bool attr = false;
    if (!attr) { (void)hipFuncSetAttribute((const void*)mk::k_ph<PH>, hipFuncAttributeMaxDynamicSharedMemorySize, mk::LDS_BYTES); attr = true; }
    hipLaunchKernelGGL((mk::k_ph<PH>), dim3(grid), dim3(512), mk::LDS_BYTES, stream, a, l, e);
}
#endif
extern "C" void kernel_launch(void* const* d_in, const int* in_sizes, int n_in, void* d_out, int out_size, void* d_ws, size_t ws_size, hipStream_t stream) {
    using namespace mk;
    static int grid = 0;
    if (grid == 0) {
        if (n_in != N_IN || in_sizes[0] != NLAT * D || out_size != NLAT * D || ws_size < WS_END) { fprintf(stderr, "kernel_launch: unexpected shapes (n_in %d, ws %zu < %zu?)\n", n_in, ws_size, (size_t)WS_END); grid = -1; return; }
        int dev = 0, cus = 0;
        if (hipGetDevice(&dev) != hipSuccess || hipDeviceGetAttribute(&cus, hipDeviceAttributeMultiprocessorCount, dev) != hipSuccess) { grid = -1; return; }
        grid = cus;
    }
    if (grid < 0) return;
    (void)hipMemsetAsync((char*)d_ws + WS_CTL, 0, CTL_ZERO_BYTES, stream);
    Params a{};
    for (int i = 0; i < N_IN; ++i) a.in[i] = (const float*)d_in[i];
    a.out = (float*)d_out; a.ws = (unsigned char*)d_ws; a.lo = 0; a.hi = 0;
#ifdef MK_FUSED
    { static bool attr = false; if (!attr) { (void)hipFuncSetAttribute((const void*)fwd_fused, hipFuncAttributeMaxDynamicSharedMemorySize, LDS_BYTES); attr = true; }
      hipLaunchKernelGGL(fwd_fused, dim3(grid), dim3(512), LDS_BYTES, stream, a); return; }
#endif
#ifndef MK_FUSED
    launch_ph<PH_PRO>(a, 0, 0, grid, stream);
    for (int l = 0; l < 2; ++l) {
        launch_ph<PH_NORM1>(a, l, 0, grid, stream); launch_ph<PH_GIN>(a, l, 0, grid, stream); launch_ph<PH_STREAM>(a, l, 0, grid, stream);
        launch_ph<PH_CHUNK>(a, l, 0, grid, stream); launch_ph<PH_SEQ>(a, l, 0, grid, stream); launch_ph<PH_S5A>(a, l, 0, grid, stream); launch_ph<PH_S5B>(a, l, 0, grid, stream); launch_ph<PH_S5C>(a, l, 0, grid, stream);
        launch_ph<PH_GGLU>(a, l, 0, grid, stream); launch_ph<PH_GOUT>(a, l, 0, grid, stream); if (l == 0) launch_ph<PH_NORM2>(a, l, 0, grid, stream); else launch_ph<PH_NORM2M>(a, l, 0, grid, stream);
        if (l == 0) { launch_ph<PH_GFUP>(a, l, 0, grid, stream); launch_ph<PH_GFDN>(a, l, 0, grid, stream); }
        else { launch_ph<PH_MPREP>(a, l, 0, grid, stream); for (int e = 0; e < 2; ++e) { launch_ph<PH_GMUP>(a, l, e, grid, stream); launch_ph<PH_GMDN>(a, l, e, grid, stream); } }
    }
    launch_ph<PH_FINAL>(a, 0, 0, grid, stream);
#endif
}
```

```cpp
#include <hip/hip_runtime.h>
#include <cstdio>
#include <cstdint>
namespace pg8 {
#define PG8_LAS __attribute__((address_space(3)))
typedef unsigned short bf16_t;
typedef short bf16x8 __attribute__((ext_vector_type(8)));
typedef float f32x4 __attribute__((ext_vector_type(4)));
typedef unsigned u32x4 __attribute__((ext_vector_type(4)));
constexpr int BM = 256, BK = 64, HALF = 128, HTB = HALF * BK * 2  , STAGE_BYTES = 8 * HTB, NXCD = 8, WGM = 8;

__host__ __device__ __forceinline__ int lds_byte(int r, int c) { const int st = (r >> 4) * 2 + (c >> 5), rr = r & 15, cc = c & 31, ob = rr * 64 + cc * 2; return st * 1024 + (ob ^ (((ob >> 9) & 1) << 5)); }
__host__ __device__ __forceinline__ void stage_rc(int b, int& R, int& C) { const int st = b / 1024, sb = b % 1024, swz = sb ^ (((sb >> 9) & 1) << 5); R = (st >> 1) * 16 + swz / 64; C = (st & 1) * 32 + (swz % 64) / 2; }
__host__ __device__ __forceinline__ int perm32(int rho) { const int n = rho >> 4, i = rho & 15; return 8 * (i >> 2) + 4 * n + (i & 3); }

struct Unit { int pm, pn, pa, pb, po, ko; };
struct Gemm { const bf16_t* A; const bf16_t* Bt; int M, N, K, ld; };

struct StaticOrder {
    int nM, nN, nwg, G, c;
    __host__ __device__ void init(int M, int N, int G_, int c_) { nM = M / BM; nN = N / BM; nwg = nM * nN; G = G_; c = c_; }
    __host__ __device__ bool next(int i, Unit& u) const {
        const long L = (long)i * G + c; if (L >= nwg) return false;
        int wgid = (int)L; { const int q = nwg / NXCD, r = nwg % NXCD, xcd = wgid % NXCD, off = wgid / NXCD; wgid = (xcd < r ? xcd * (q + 1) : r * (q + 1) + (xcd - r) * q) + off; }
        const int nig = WGM * nN, gid = wgid / nig, fm = gid * WGM, gsz = (nM - fm) < WGM ? (nM - fm) : WGM;
        u.pm = fm + ((wgid % nig) % gsz); u.pn = (wgid % nig) / gsz; u.pa = u.pm; u.pb = u.pn; u.po = u.pm; u.ko = 0; return true;
    }
    __device__ __forceinline__ void a_ready(const Unit&) const {}
    __device__ __forceinline__ void done(const Unit&) const {}
};

struct GroupOrder : StaticOrder {
    int t0, a0, o0, nNr, kslice; int toff[9];
    __device__ __forceinline__ bool next(int i, Unit& u) const {
        if (!StaticOrder::next(i, u)) return false;
        u.pm += t0; int e = 0;
#pragma unroll
        for (int q = 1; q < 8; ++q) e += (u.pm >= toff[q]) ? 1 : 0;
        const int ks = u.pn / nNr; u.pn -= ks * nNr; u.ko = ks * kslice;
        u.pa = u.pm - a0; u.po = u.pm - o0; u.pb = e * nNr + u.pn; return true;
    }
};
__device__ __forceinline__ unsigned cvt_pk_bf16(float lo, float hi) { unsigned r; asm volatile("v_cvt_pk_bf16_f32 %0, %1, %2" : "=v"(r) : "v"(lo), "v"(hi)); return r; }
typedef float f32x2 __attribute__((ext_vector_type(2)));
__device__ __forceinline__ f32x2 gelu_pk(f32x2 v) {
    const f32x2 av = __builtin_elementwise_abs(v), d = av * 0.2316418882f + 1.0f;
    f32x2 t; t.x = __builtin_amdgcn_rcpf(d.x); t.y = __builtin_amdgcn_rcpf(d.y);
    f32x2 q = t * 0.5307027145f + (-0.7265760135f); q = q * t + 0.7107068705f; q = q * t + (-0.142248368f); q = q * t + 0.127414796f; q = q * t;
    const f32x2 s = (v * v) * (-0.72134752044f);
    f32x2 e; e.x = __builtin_amdgcn_exp2f(s.x); e.y = __builtin_amdgcn_exp2f(s.y);
    const f32x2 m = v * (q * e), r = v - m;
    f32x2 o; o.x = v.x < 0.f ? m.x : r.x; o.y = v.y < 0.f ? m.y : r.y; return o;
}

template <int ACT  > struct EpiBf16 {
    static constexpr bool PERM = true, AFTER_DRAIN = false; static_assert(ACT == 0 || ACT == 1, "EpiBf16: ACT is 0 (none) or 1 (gelu_pk)");
    bf16_t* O; int ldc; const float* bias; int split_cols; size_t split_stride; float scale0;
    __device__ __forceinline__ void operator()(const f32x4 (&acc)[2][2][4][2], const Unit& u, int wr, int wc, int fr, int fq) const {
        const int row0 = u.pm * BM + wr * 64 + fr; int colt = u.pn * BM; bf16_t* base = O;
        float sc = 1.f; if (split_cols) { const int t = colt / split_cols; base += (size_t)t * split_stride; colt -= t * split_cols; if (t == 0) sc = scale0; }
        const int col0 = colt + wc * 32 + 8 * fq, bcol0 = u.pn * BM + wc * 32 + 8 * fq;
        f32x4 bv[2][2];
#pragma unroll
        for (int bj = 0; bj < 2; ++bj)
#pragma unroll
            for (int n = 0; n < 2; ++n) bv[bj][n] = bias ? *(const f32x4*)(bias + bcol0 + bj * HALF + 4 * n) : (f32x4){0.f, 0.f, 0.f, 0.f};
#pragma unroll
        for (int ai = 0; ai < 2; ++ai)
#pragma unroll
            for (int m = 0; m < 4; ++m) { bf16_t* rowp = base + (size_t)(row0 + ai * HALF + m * 16) * ldc + col0;
#pragma unroll
                for (int bj = 0; bj < 2; ++bj) { f32x4 v0 = acc[ai][bj][m][0] + bv[bj][0], v1 = acc[ai][bj][m][1] + bv[bj][1];
                    if (ACT == 1) { f32x2 a = gelu_pk((f32x2){v0[0], v0[1]}), b = gelu_pk((f32x2){v0[2], v0[3]}), c = gelu_pk((f32x2){v1[0], v1[1]}), d = gelu_pk((f32x2){v1[2], v1[3]});
                        v0 = (f32x4){a.x, a.y, b.x, b.y}; v1 = (f32x4){c.x, c.y, d.x, d.y}; }
                    v0 = v0 * sc; v1 = v1 * sc; u32x4 w; w.x = cvt_pk_bf16(v0[0], v0[1]); w.y = cvt_pk_bf16(v0[2], v0[3]); w.z = cvt_pk_bf16(v1[0], v1[1]); w.w = cvt_pk_bf16(v1[2], v1[3]);
                    *(u32x4*)(rowp + bj * HALF) = w; } }
    }
};

__device__ __forceinline__ float bf_lo(unsigned w) { return __uint_as_float(w << 16); }
__device__ __forceinline__ float bf_hi(unsigned w) { return __uint_as_float(w & 0xffff0000u); }
__device__ __forceinline__ float sigm(float x) { return 1.0f / (1.0f + __expf(-x)); }
constexpr int T_ROWS = 16896, N_LAT = 16384;
struct EpiGLU {
    static constexpr bool PERM = true, AFTER_DRAIN = false;
    const bf16_t* YG; bf16_t* A2; const float* bias;
    __device__ __forceinline__ void operator()(const f32x4 (&acc)[2][2][4][2], const Unit& u, int wr, int wc, int fr, int fq) const {
        const int row0 = u.pm * BM + wr * 64 + fr, cb = u.pn * BM + wc * 32 + 8 * fq;
#pragma unroll
        for (int ai = 0; ai < 2; ++ai)
#pragma unroll
            for (int m = 0; m < 4; ++m) { const int row = row0 + ai * HALF + m * 16;
#pragma unroll
                for (int bj = 0; bj < 2; ++bj) { const int c = cb + bj * HALF; const f32x4 v0 = acc[ai][bj][m][0], v1 = acc[ai][bj][m][1];
                    const float v[8] = {v0[0], v0[1], v0[2], v0[3], v1[0], v1[1], v1[2], v1[3]};
                    const u32x4 y8 = *(const u32x4*)(YG + (size_t)row * 512 + c);
                    const float yf[8] = {bf_lo(y8.x), bf_hi(y8.x), bf_lo(y8.y), bf_hi(y8.y), bf_lo(y8.z), bf_hi(y8.z), bf_lo(y8.w), bf_hi(y8.w)};
                    float s[8];
#pragma unroll
                    for (int j = 0; j < 8; ++j) s[j] = yf[j] * sigm(v[j] + bias[c + j]);
                    u32x4 w1; w1.x = cvt_pk_bf16(s[0], s[1]); w1.y = cvt_pk_bf16(s[2], s[3]); w1.z = cvt_pk_bf16(s[4], s[5]); w1.w = cvt_pk_bf16(s[6], s[7]);
                    *(u32x4*)(A2 + (size_t)row * 1024 + 512 + c) = w1; } }
    }
};
struct EpiRes {
    static constexpr bool PERM = false, AFTER_DRAIN = false;
    float* X; const float* gate; const float* comb; int e;
    __device__ __forceinline__ void operator()(const f32x4 (&acc)[2][2][4][2], const Unit& u, int wr, int wc, int fr, int fq) const {
        const int midx = (u.pm < 64) ? (u.pm >> 5) : 2; const float* gp = gate + midx * 6144;
        const int row0 = u.pm * BM + wr * 64 + fr, col0 = u.pn * BM + wc * 32 + 4 * fq;
        f32x4 gv[2][2];
#pragma unroll
        for (int bj = 0; bj < 2; ++bj)
#pragma unroll
            for (int n = 0; n < 2; ++n) gv[bj][n] = *(const f32x4*)(gp + col0 + bj * HALF + n * 16);
#pragma unroll
        for (int ai = 0; ai < 2; ++ai) {
            f32x4 xv[4][2][2]; float cf4[4];
#pragma unroll
            for (int m = 0; m < 4; ++m) { const int row = row0 + ai * HALF + m * 16; cf4[m] = comb ? comb[(size_t)row * 8 + e] : 1.0f; const float* rowp = X + (size_t)row * 1024 + col0;
#pragma unroll
                for (int bj = 0; bj < 2; ++bj)
#pragma unroll
                    for (int n = 0; n < 2; ++n) xv[m][bj][n] = *(const f32x4*)(rowp + bj * HALF + n * 16); }
#pragma unroll
            for (int m = 0; m < 4; ++m) { const int row = row0 + ai * HALF + m * 16; float* rowp = X + (size_t)row * 1024 + col0;
#pragma unroll
                for (int bj = 0; bj < 2; ++bj)
#pragma unroll
                    for (int n = 0; n < 2; ++n) *(f32x4*)(rowp + bj * HALF + n * 16) = xv[m][bj][n] + gv[bj][n] * acc[ai][bj][m][n] * cf4[m]; }
        }
    }
};
struct EpiSwiGLU {
    static constexpr bool PERM = true, AFTER_DRAIN = false;
    bf16_t* ACT; int ldc;
    __device__ __forceinline__ void operator()(const f32x4 (&acc)[2][2][4][2], const Unit& u, int wr, int wc, int fr, int fq) const {
        const int row0 = u.po * BM + wr * 64 + fr, c = u.pn * HALF + wc * 32 + 8 * fq;
#pragma unroll
        for (int ai = 0; ai < 2; ++ai)
#pragma unroll
            for (int m = 0; m < 4; ++m) { const int row = row0 + ai * HALF + m * 16;
                const f32x4 g0 = acc[ai][0][m][0], g1 = acc[ai][0][m][1], u0 = acc[ai][1][m][0], u1 = acc[ai][1][m][1];
                float s[8];
#pragma unroll
                for (int j = 0; j < 4; ++j) { s[j] = g0[j] * sigm(g0[j]) * u0[j]; s[4 + j] = g1[j] * sigm(g1[j]) * u1[j]; }
                u32x4 w1; w1.x = cvt_pk_bf16(s[0], s[1]); w1.y = cvt_pk_bf16(s[2], s[3]); w1.z = cvt_pk_bf16(s[4], s[5]); w1.w = cvt_pk_bf16(s[6], s[7]);
                *(u32x4*)(ACT + (size_t)row * ldc + c) = w1; }
    }
};


struct EpiPartF32 {
    static constexpr bool PERM = false, AFTER_DRAIN = false;
    float* PART; int row_base, rows, kslice;
    __device__ __forceinline__ void operator()(const f32x4 (&acc)[2][2][4][2], const Unit& u, int wr, int wc, int fr, int fq) const {
        const int ks = u.ko / kslice; float* P0 = PART + (size_t)ks * rows * 1024;
        const int row0 = u.pm * BM - row_base + wr * 64 + fr, col0 = u.pn * BM + wc * 32 + 4 * fq;
#pragma unroll
        for (int ai = 0; ai < 2; ++ai)
#pragma unroll
            for (int m = 0; m < 4; ++m) { float* rowp = P0 + (size_t)(row0 + ai * HALF + m * 16) * 1024 + col0;
#pragma unroll
                for (int bj = 0; bj < 2; ++bj)
#pragma unroll
                    for (int n = 0; n < 2; ++n) *(f32x4*)(rowp + bj * HALF + n * 16) = acc[ai][bj][m][n]; }
    }
};

struct EpiPartBf16 {
    static constexpr bool PERM = true, AFTER_DRAIN = false;
    bf16_t* PART; int row_base, rows, kslice;
    __device__ __forceinline__ void operator()(const f32x4 (&acc)[2][2][4][2], const Unit& u, int wr, int wc, int fr, int fq) const {
        const int ks = u.ko / kslice; bf16_t* P0 = PART + (size_t)ks * rows * 1024;
        const int row0 = u.pm * BM - row_base + wr * 64 + fr, col0 = u.pn * BM + wc * 32 + 8 * fq;
#pragma unroll
        for (int ai = 0; ai < 2; ++ai)
#pragma unroll
            for (int m = 0; m < 4; ++m) { bf16_t* rowp = P0 + (size_t)(row0 + ai * HALF + m * 16) * 1024 + col0;
#pragma unroll
                for (int bj = 0; bj < 2; ++bj) { const f32x4 v0 = acc[ai][bj][m][0], v1 = acc[ai][bj][m][1];
                    u32x4 w; w.x = cvt_pk_bf16(v0[0], v0[1]); w.y = cvt_pk_bf16(v0[2], v0[3]); w.z = cvt_pk_bf16(v1[0], v1[1]); w.w = cvt_pk_bf16(v1[2], v1[3]);
                    *(u32x4*)(rowp + bj * HALF) = w; } }
    }
};
template <class Epi, class Sched, bool ALIGN_EPI = false, bool SP2 = false>
__device__ __forceinline__ void gemm_phase(PG8_LAS unsigned char* lds, const Gemm g, const Sched& S, const Epi& E, const int tid) {
    const int wid = __builtin_amdgcn_readfirstlane(tid >> 6), lane = tid & 63, wr = wid >> 2, wc = wid & 3, fr = lane & 15, fq = lane >> 4;
    const int K = g.ld, nt = g.K / BK;
    unsigned voffA[2], voffB[2];
#pragma unroll
    for (int i = 0; i < 2; ++i) { int R, C; stage_rc(tid * 16 + i * 8192, R, C); const int Rb = Epi::PERM ? ((R & ~31) + perm32(R & 31)) : R;
        voffA[i] = (unsigned)(R * K + C) * 2u; voffB[i] = (unsigned)(Rb * K + C) * 2u; }
    const size_t kstep = (size_t)(BK * 2);
    const size_t hstep = (size_t)HALF * K * 2;
    const size_t tstep = 2 * hstep;
    const unsigned ldsw = (unsigned)wid * 1024u;
    const int aoff = lds_byte(wr * 64 + fr, fq * 8), boff = lds_byte(wc * 32 + fr, fq * 8);
#define PG8_SA(b, h) (((b) * 2 + (h)) * HTB)
#define PG8_SB(b, h) ((4 + (b) * 2 + (h)) * HTB)
#define PG8_STAGE(bufoff, gbase, voff) do { _Pragma("unroll") for (int _i = 0; _i < 2; ++_i) \
        __builtin_amdgcn_global_load_lds((const unsigned*)((const char*)(gbase) + (voff)[_i]), (PG8_LAS unsigned*)(lds + (bufoff) + ldsw + _i * 8192), 16, 0, 0); } while (0)
#define PG8_LDA(dst, b, h) do { _Pragma("unroll") for (int m = 0; m < 4; ++m) _Pragma("unroll") for (int k = 0; k < 2; ++k) dst[m][k] = *(const PG8_LAS bf16x8*)(lds + PG8_SA(b, h) + aoff + m * 2048 + k * 1024); } while (0)
#define PG8_LDB(dst, b, h) do { _Pragma("unroll") for (int n = 0; n < 2; ++n) _Pragma("unroll") for (int k = 0; k < 2; ++k) dst[n][k] = *(const PG8_LAS bf16x8*)(lds + PG8_SB(b, h) + boff + n * 2048 + k * 1024); } while (0)
#define PG8_MMA(ai, bj, At, Bt) do { __builtin_amdgcn_s_setprio(1); _Pragma("unroll") for (int m = 0; m < 4; ++m) _Pragma("unroll") for (int n = 0; n < 2; ++n) _Pragma("unroll") for (int k = 0; k < 2; ++k) \
        acc[ai][bj][m][n] = __builtin_amdgcn_mfma_f32_16x16x32_bf16(Bt[n][k], At[m][k], acc[ai][bj][m][n], 0, 0, 0); __builtin_amdgcn_s_setprio(0); } while (0)
#define PG8_WAIT_V(n) asm volatile("s_waitcnt vmcnt(" #n ")" ::: "memory")
#define PG8_WAIT_L(n) asm volatile("s_waitcnt lgkmcnt(" #n ")" ::: "memory")
#define PG8_BAR __builtin_amdgcn_s_barrier()
#define PG8_SCHED __builtin_amdgcn_sched_barrier(0)
    Unit cur, nxt; int ui = 0;
    if (!S.next(0, cur)) return;
    f32x4 acc[2][2][4][2];
#pragma unroll
    for (int a = 0; a < 2; ++a)
#pragma unroll
        for (int b = 0; b < 2; ++b)
#pragma unroll
            for (int m = 0; m < 4; ++m)
#pragma unroll
                for (int n = 0; n < 2; ++n) acc[a][b][m][n] = (f32x4){0.f, 0.f, 0.f, 0.f};
    bf16x8 At[4][2], B0[2][2], B1[2][2];
    const char* cA = (const char*)g.A + (size_t)cur.pa * tstep + (size_t)cur.ko * 2; const char* cB = (const char*)g.Bt + (size_t)cur.pb * tstep + (size_t)cur.ko * 2;
    S.a_ready(cur);
    if constexpr (SP2) {
        PG8_STAGE(PG8_SB(0, 0), cB, voffB); PG8_STAGE(PG8_SB(0, 1), cB + hstep, voffB); PG8_STAGE(PG8_SA(0, 0), cA, voffA); PG8_STAGE(PG8_SA(0, 1), cA + hstep, voffA);
        if (wr == 1) PG8_BAR;
        PG8_WAIT_V(2); PG8_BAR;
        PG8_STAGE(PG8_SB(1, 0), cB + kstep, voffB); PG8_STAGE(PG8_SA(1, 0), cA + kstep, voffA); PG8_STAGE(PG8_SB(1, 1), cB + hstep + kstep, voffB);
        PG8_WAIT_V(6); PG8_BAR;
    } else {
        PG8_STAGE(PG8_SB(0, 0), cB, voffB); PG8_STAGE(PG8_SA(0, 0), cA, voffA); PG8_STAGE(PG8_SB(0, 1), cB + hstep, voffB); PG8_STAGE(PG8_SA(0, 1), cA + hstep, voffA);
        if (wr == 1) PG8_BAR;
        PG8_WAIT_V(4); PG8_BAR;
        PG8_STAGE(PG8_SB(1, 0), cB + kstep, voffB); PG8_STAGE(PG8_SA(1, 0), cA + kstep, voffA); PG8_STAGE(PG8_SB(1, 1), cB + hstep + kstep, voffB);
        PG8_WAIT_V(6); PG8_BAR;
    }
    for (;;) {
        const bool has_next = S.next(ui + 1, nxt);
        const char* nA = has_next ? (const char*)g.A + (size_t)nxt.pa * tstep + (size_t)nxt.ko * 2 : cA; const char* nB = has_next ? (const char*)g.Bt + (size_t)nxt.pb * tstep + (size_t)nxt.ko * 2 : cB;
        for (int t = 0; t < nt; t += 2) {
            const bool last = (t == nt - 2);
            const char* a1 = cA + (size_t)(t + 1) * kstep;
            const char* a2 = last ? nA : cA + (size_t)(t + 2) * kstep; const char* b2 = last ? nB : cB + (size_t)(t + 2) * kstep;
            const char* a3 = a2 + kstep; const char* b3 = b2 + kstep;
            if (last && has_next) S.a_ready(nxt);
            if constexpr (SP2) {
            PG8_LDB(B0, 0, 0); PG8_LDB(B1, 0, 1); PG8_SCHED; PG8_LDA(At, 0, 0); PG8_STAGE(PG8_SA(1, 1), a1 + hstep, voffA);
            PG8_WAIT_V(8); PG8_WAIT_L(0); PG8_BAR; PG8_MMA(0, 0, At, B0); PG8_MMA(0, 1, At, B1); PG8_BAR; PG8_SCHED;
            PG8_LDA(At, 0, 1); PG8_STAGE(PG8_SB(0, 0), b2, voffB); PG8_STAGE(PG8_SB(0, 1), b2 + hstep, voffB); PG8_STAGE(PG8_SA(0, 0), a2, voffA);
            PG8_WAIT_V(8); PG8_WAIT_L(0); PG8_BAR; PG8_MMA(1, 0, At, B0); PG8_MMA(1, 1, At, B1); PG8_BAR; PG8_SCHED;
            PG8_LDB(B0, 1, 0); PG8_LDB(B1, 1, 1); PG8_SCHED; PG8_LDA(At, 1, 0); PG8_STAGE(PG8_SA(0, 1), a2 + hstep, voffA);
            PG8_WAIT_V(8); PG8_WAIT_L(0); PG8_BAR; PG8_MMA(0, 0, At, B0); PG8_MMA(0, 1, At, B1); PG8_BAR; PG8_SCHED;
            PG8_LDA(At, 1, 1); PG8_STAGE(PG8_SB(1, 0), b3, voffB); PG8_STAGE(PG8_SB(1, 1), b3 + hstep, voffB); PG8_STAGE(PG8_SA(1, 0), a3, voffA);
            PG8_WAIT_V(8); PG8_WAIT_L(0); PG8_BAR; PG8_MMA(1, 0, At, B0); PG8_MMA(1, 1, At, B1); PG8_BAR; PG8_SCHED;
            } else {
            PG8_LDB(B0, 0, 0); PG8_SCHED; PG8_LDA(At, 0, 0); PG8_STAGE(PG8_SA(1, 1), a1 + hstep, voffA);
            PG8_WAIT_L(8); PG8_BAR; PG8_WAIT_L(0); PG8_MMA(0, 0, At, B0); PG8_BAR; PG8_SCHED;
            PG8_LDB(B1, 0, 1); PG8_STAGE(PG8_SB(0, 0), b2, voffB);
            PG8_BAR; PG8_WAIT_L(0); PG8_MMA(0, 1, At, B1); PG8_BAR;
            PG8_LDA(At, 0, 1); PG8_STAGE(PG8_SA(0, 0), a2, voffA);
            PG8_BAR; PG8_WAIT_L(0); PG8_MMA(1, 0, At, B0); PG8_BAR; PG8_SCHED;
            PG8_STAGE(PG8_SB(0, 1), b2 + hstep, voffB);
            PG8_WAIT_V(6); PG8_BAR; PG8_MMA(1, 1, At, B1); PG8_BAR;
            PG8_LDB(B0, 1, 0); PG8_SCHED; PG8_LDA(At, 1, 0); PG8_STAGE(PG8_SA(0, 1), a2 + hstep, voffA);
            PG8_WAIT_L(8); PG8_BAR; PG8_WAIT_L(0); PG8_MMA(0, 0, At, B0); PG8_BAR; PG8_SCHED;
            PG8_LDB(B1, 1, 1); PG8_STAGE(PG8_SB(1, 0), b3, voffB);
            PG8_BAR; PG8_WAIT_L(0); PG8_MMA(0, 1, At, B1); PG8_BAR;
            PG8_LDA(At, 1, 1); PG8_STAGE(PG8_SA(1, 0), a3, voffA);
            PG8_BAR; PG8_WAIT_L(0); PG8_MMA(1, 0, At, B0); PG8_BAR; PG8_SCHED;
            PG8_STAGE(PG8_SB(1, 1), b3 + hstep, voffB);
            PG8_WAIT_V(6); PG8_BAR; PG8_MMA(1, 1, At, B1); PG8_BAR;
            }
        }
        if constexpr (ALIGN_EPI) { if (wr == 0) PG8_BAR; }
        if constexpr (!Epi::AFTER_DRAIN) { E(acc, cur, wr, wc, fr, fq); S.done(cur); }
        if (!has_next) break;
#pragma unroll
        for (int a = 0; a < 2; ++a)
#pragma unroll
            for (int b = 0; b < 2; ++b)
#pragma unroll
                for (int m = 0; m < 4; ++m)
#pragma unroll
                    for (int n = 0; n < 2; ++n) acc[a][b][m][n] = (f32x4){0.f, 0.f, 0.f, 0.f};
        cur = nxt; cA = nA; cB = nB; ++ui;
        if constexpr (ALIGN_EPI) { if (wr == 1) PG8_BAR; }
    }
    PG8_WAIT_V(0);
    if constexpr (!ALIGN_EPI) { if (wr == 0) PG8_BAR; }
    PG8_BAR;
    if constexpr (Epi::AFTER_DRAIN) { E.fused(acc, cur, wr, wc, fr, fq, lds, wid, lane); S.done(cur); }
#undef PG8_SA
#undef PG8_SB
#undef PG8_STAGE
#undef PG8_LDA
#undef PG8_LDB
#undef PG8_MMA
#undef PG8_WAIT_V
#undef PG8_WAIT_L
#undef PG8_BAR
#undef PG8_SCHED
}
}

namespace mk {
typedef unsigned short bf16;
typedef float f32x4 __attribute__((ext_vector_type(4)));
typedef unsigned u32x4 __attribute__((ext_vector_type(4)));
typedef unsigned u32x2 __attribute__((ext_vector_type(2)));
#define LAS __attribute__((address_space(3)))
constexpr int D = 1024, NB = 2, SEQ = 8192, CTXL = 256, NLAT = NB * SEQ, NCTX = NB * CTXL, T = NLAT + NCTX;
constexpr int DIN = 2560, DFF = 2816, NE = 8, DFE = 3584, SPOS = SEQ + CTXL  , NCH = SPOS / 64;
static_assert(T == pg8::T_ROWS && NLAT == pg8::N_LAT, "rows");
enum { I_X = 0, I_C, I_CTX, I_CCTX, I_ADAW, I_ADAB, I_N1G, I_N2G, I_WIN, I_WOUT, I_MU, I_W0, I_WUP, I_A0, I_AUP, I_GUP, I_KK, I_KA, I_RK, I_LNW, I_LNB,
       I_LRE, I_LIM, I_LDT, I_BRE, I_BIM, I_CRE, I_CIM, I_S5D, I_GLUW, I_GLUB, I_FG, I_FU, I_FD, I_ROUT, I_MG, I_MU2, I_MD, I_FING, N_IN };
constexpr size_t MiB = 1u << 20, QMiB = 1u << 18;
constexpr size_t WS_CTL = 0, CTL_ZERO_BYTES = 65536;
constexpr size_t WS_MOD = 1 * MiB;
constexpr size_t WS_COMB = 1 * MiB + 2 * QMiB;
constexpr size_t WS_WIN = 2 * MiB;
constexpr size_t WS_WOUT = 12 * MiB;
constexpr size_t WS_WGLU = 16 * MiB;
constexpr size_t WS_WLR = 17 * MiB;
constexpr size_t WS_WFUP = 23 * MiB;
constexpr size_t WS_WFDN = 34 * MiB;
constexpr size_t WS_X = 40 * MiB;
constexpr size_t WS_H = 106 * MiB;
constexpr size_t WS_LRIN = 106 * MiB;
constexpr size_t WS_U = 122 * MiB + 2 * QMiB;
constexpr size_t WS_P = 370 * MiB;
constexpr size_t WS_LW = 139 * MiB;
constexpr size_t WS_XEND = 205 * MiB;
constexpr size_t WS_CARRY = 213 * MiB + QMiB;
constexpr size_t WS_Y = 139 * MiB;
constexpr size_t WS_YG = 221 * MiB + 2 * QMiB;
constexpr size_t WS_BONUS = 106 * MiB;
constexpr size_t WS_R = 221 * MiB + 2 * QMiB, WS_V = 238 * MiB, WS_KKN = 254 * MiB + 2 * QMiB;
constexpr size_t WS_KT = 271 * MiB, WS_BB = 304 * MiB, WS_GD = 337 * MiB;
constexpr size_t WS_K = 370 * MiB;
constexpr size_t WS_PARTO = 370 * MiB;
constexpr size_t WS_PARTF = 380 * MiB;
constexpr size_t WS_CH = 370 * MiB;
constexpr size_t WS_S5E = 271 * MiB;
constexpr size_t WS_S5BP = 304 * MiB;
constexpr size_t WS_S5K = 287 * MiB;
constexpr size_t WS_A2 = 304 * MiB;
constexpr size_t WS_ACT = 221 * MiB + 2 * QMiB;
constexpr size_t WS_RE = 1 * MiB + 2 * QMiB;
constexpr size_t WS_RP = WS_RE + 65536;
constexpr size_t WS_SEGCNT = WS_RE + 131072;
constexpr size_t WS_PROW = WS_RE + 196608;
constexpr size_t WS_PGW = WS_PROW + 147456;
constexpr size_t WS_TOFF = WS_PGW + 147456;
constexpr size_t WS_PPOS = 1 * MiB + QMiB;
constexpr size_t WS_APERM = 139 * MiB;
constexpr size_t WS_ACT1 = 207 * MiB;
constexpr int MOE_PASS_TILES = 64, MOE_MAX_TILES = 136, MOE_ACT_TILES = 72;
constexpr size_t WS_PARTM = 2 * MiB;
static_assert(WS_TOFF + 64 <= 2 * MiB && WS_APERM + (size_t)MOE_MAX_TILES * 256 * 2048 <= WS_ACT1 && WS_ACT1 + (size_t)MOE_ACT_TILES * 256 * DFE * 2 <= 333 * MiB + 2 * QMiB, "moe ws map");
constexpr size_t WS_WMUP = 333 * MiB + 2 * QMiB;
constexpr size_t WS_WMDN = 445 * MiB + 2 * QMiB;
constexpr size_t WS_END = 502 * MiB;
constexpr int NCC = 2 * NB * NCH * 8;
static_assert(WS_CH + (size_t)NCC * 32768 <= WS_END && WS_WMDN + (size_t)8 * 1024 * 3584 * 2 <= WS_END && WS_ACT + (size_t)NLAT * DFE * 2 <= WS_WMUP && WS_GD + (size_t)2 * T * 512 * 2 <= WS_K, "ws map");
constexpr int LDS_BYTES = 147456, RING_BYTES = 131072, MISC_OFF = LDS_BYTES - 1024, LDS_GC = LDS_BYTES - 2048;

struct Params { const float* in[N_IN]; float* out; unsigned char* ws; int lo, hi; };
static_assert(sizeof(Params) == 8 * N_IN + 24, "no padding");

__device__ __forceinline__ float bf2f(bf16 v) { return __uint_as_float(((unsigned)v) << 16); }
__device__ __forceinline__ unsigned f2bf(float f) { unsigned u = __float_as_uint(f); return (u + 0x7fffu + ((u >> 16) & 1u)) >> 16; }
__device__ __forceinline__ unsigned pk2(float lo, float hi) { return f2bf(lo) | (f2bf(hi) << 16); }
__device__ __forceinline__ float blo(unsigned w) { return __uint_as_float(w << 16); }
__device__ __forceinline__ float bhi(unsigned w) { return __uint_as_float(w & 0xffff0000u); }
__device__ __forceinline__ float sigm(float x) { return 1.0f / (1.0f + __expf(-x)); }
__device__ __forceinline__ float wave_sum(float v) {
#pragma unroll
    for (int o = 1; o < 64; o <<= 1) v += __shfl_xor(v, o);
    return v;
}
#define LDS_WAIT() asm volatile("s_waitcnt lgkmcnt(0)" ::: "memory")
__device__ __forceinline__ int row_of(int b, int d, int s) {
    return s < CTXL ? NLAT + b * CTXL + (d ? CTXL - 1 - s : s) : b * SEQ + (d ? SEQ - 1 - (s - CTXL) : (s - CTXL));
}

#define XB_TMO      128
#define XB_XCNT(j)  (256  + 64 * (j))
#define XB_XSUB(j)  (1280 + 64 * (j))
#define XB_XGEN(j)  (2304 + 64 * (j))
#define XB_TOP      3328
#define XB_TOPGEN   3392
#define XCD_BAR_WORDS 3456
#define XB_SPIN_CAP (1u << 25)
__device__ __forceinline__ unsigned xb_ld(unsigned* p)              { return __hip_atomic_load(p, __ATOMIC_RELAXED, __HIP_MEMORY_SCOPE_AGENT); }
__device__ __forceinline__ unsigned xb_add(unsigned* p, unsigned v) { return __hip_atomic_fetch_add(p, v, __ATOMIC_RELAXED, __HIP_MEMORY_SCOPE_AGENT); }
__device__ __forceinline__ unsigned xb_xcc_id() { return (unsigned)__builtin_amdgcn_s_getreg((3 << 11) | 20) & 0xFu; }
#define XB_SPIN(cond, bar) do { unsigned _sp = 0; while (cond) { __builtin_amdgcn_s_sleep(1); \
    if ((++_sp & 255u) == 0u) { if (xb_ld(&(bar)[XB_TMO])) break; if (_sp > XB_SPIN_CAP) { atomicAdd(&(bar)[XB_TMO], 1u); break; } } } } while (0)
struct XcdBarrier { unsigned* bar; unsigned x; volatile LAS unsigned* st; };
__device__ __forceinline__ XcdBarrier xcd_barrier_post(unsigned* bar, volatile LAS unsigned* st) {
    XcdBarrier b; b.bar = bar; b.x = xb_xcc_id(); b.st = st;
    if (threadIdx.x == 0) (void)xb_add(&bar[XB_XCNT(b.x)], 1u);
    return b;
}
__device__ __forceinline__ void xcd_barrier_complete(unsigned* bar, unsigned x, unsigned& nloc, unsigned& nx) {
    const unsigned G = gridDim.x * gridDim.y * gridDim.z;
    unsigned sum, cnt, mine, sp = 0u;
    for (;;) {
        sum = 0u; cnt = 0u; mine = 0u;
#pragma unroll
        for (unsigned j = 0; j < 16; ++j) { const unsigned c = xb_ld(&bar[XB_XCNT(j)]); sum += c; cnt += (c > 0u) ? 1u : 0u; mine = (j == x) ? c : mine; }
        if (sum == G) break;
        __builtin_amdgcn_s_sleep(1);
        if ((++sp & 255u) == 0u) { if (xb_ld(&bar[XB_TMO])) break; if (sp > XB_SPIN_CAP) { atomicAdd(&bar[XB_TMO], 1u); break; } }
    }
    nloc = mine > 0u ? mine : 1u; nx = cnt > 0u ? cnt : 1u;
}
__device__ __forceinline__ void xcd_barrier(const XcdBarrier& b) {
    asm volatile("s_waitcnt vmcnt(0)" ::: "memory");
    __syncthreads();
    if (threadIdx.x == 0) {
        unsigned* bar = b.bar;
        __builtin_amdgcn_s_waitcnt(0);
        unsigned nloc = b.st[0], nx = b.st[1];
        if (nloc == 0u) { xcd_barrier_complete(bar, b.x, nloc, nx); b.st[0] = nloc; b.st[1] = nx; }
        const unsigned old = xb_add(&bar[XB_XSUB(b.x)], 1u);
        const unsigned gen = old / nloc;
        if (old + 1u == (gen + 1u) * nloc) {
            __builtin_amdgcn_fence(__ATOMIC_RELEASE, "agent");
            asm volatile("s_waitcnt vmcnt(0)" ::: "memory");
            const unsigned og = xb_add(&bar[XB_TOP], 1u);
            const unsigned tg = og / nx;
            if (og + 1u == (tg + 1u) * nx) xb_add(&bar[XB_TOPGEN], 1u);
            else XB_SPIN(xb_ld(&bar[XB_TOPGEN]) == tg, bar);
            __builtin_amdgcn_fence(__ATOMIC_ACQUIRE, "agent");
            xb_add(&bar[XB_XGEN(b.x)], 1u);
            asm volatile("s_waitcnt vmcnt(0)" ::: "memory");
        } else {
            XB_SPIN(xb_ld(&bar[XB_XGEN(b.x)]) == gen, bar);
            __builtin_amdgcn_fence(__ATOMIC_ACQUIRE, "agent");
            asm volatile("s_waitcnt vmcnt(0)" ::: "memory");
        }
    }
    __syncthreads();
}

__device__ __forceinline__ void tr_item(const float* W, int Nsrc, int k0, int n0, bf16* dst, int ldk, int drow0, int dk0, bool zero, LAS float* scr, int lane) {
    if (!zero) {
#pragma unroll 8
        for (int i = 0; i < 32; ++i) { const int kk = 2 * i + (lane >> 5); scr[kk * 33 + (lane & 31)] = W[(size_t)(k0 + kk) * Nsrc + n0 + (lane & 31)]; }
    }
    LDS_WAIT(); asm volatile("" ::: "memory");
    const int c = lane & 7;
#pragma unroll
    for (int j = 0; j < 4; ++j) { const int n = (lane >> 3) + 8 * j; const LAS float* s = scr + (8 * c) * 33 + n;
        u32x4 o = (u32x4){0u, 0u, 0u, 0u};
        if (!zero) { o.x = pk2(s[0 * 33], s[1 * 33]); o.y = pk2(s[2 * 33], s[3 * 33]); o.z = pk2(s[4 * 33], s[5 * 33]); o.w = pk2(s[6 * 33], s[7 * 33]); }
        *(u32x4*)(dst + (size_t)(drow0 + n) * ldk + dk0 + 8 * c) = o; }
    LDS_WAIT(); asm volatile("" ::: "memory");
}

__device__ __forceinline__ void phase_prologue(const Params& p, LAS unsigned char* lds, int tid, int lane, int wave) {
    unsigned char* ws = p.ws;
    const int G = gridDim.x;
    {
        LAS float* act = (LAS float*)lds;
        LAS float* red = (LAS float*)(lds + 12288);
        for (int i = tid; i < 3 * 1024; i += 512) { const float v = i < 2048 ? p.in[I_C][i] : p.in[I_CCTX][i - 2048]; act[i] = v * sigm(v); }
        __syncthreads();
        float* MOD = (float*)(ws + WS_MOD);
        for (int task = blockIdx.x; task < 192; task += G) {
            const int l = task / 96, j = (task % 96) * 64 + lane;
            const float* Wp = p.in[I_ADAW] + (size_t)l * 1024 * 6144 + (size_t)(wave * 128) * 6144 + j;
            float a0 = 0.f, a1 = 0.f, a2 = 0.f;
#pragma unroll 8
            for (int k = 0; k < 128; ++k) { const float w = Wp[(size_t)k * 6144]; const int kk = wave * 128 + k; a0 += act[kk] * w; a1 += act[1024 + kk] * w; a2 += act[2048 + kk] * w; }
            red[(wave * 3 + 0) * 64 + lane] = a0; red[(wave * 3 + 1) * 64 + lane] = a1; red[(wave * 3 + 2) * 64 + lane] = a2;
            __syncthreads();
            if (wave < 3) { float s = p.in[I_ADAB][l * 6144 + j];
#pragma unroll
                for (int w = 0; w < 8; ++w) s += red[(w * 3 + wave) * 64 + lane];
                MOD[(size_t)(l * 3 + wave) * 6144 + j] = s; }
            __syncthreads();
        }
    }
    LAS float* scr = (LAS float*)(lds + 32768 + wave * 8448);
    const int gw = blockIdx.x * 8 + wave, NGW = G * 8;
    constexpr int PL = 1280 + 512 + 128 + 128, NIT = 2 * PL + 3 * 1408;
    for (int it0 = gw; it0 < NIT; it0 += NGW) {
        int it = it0;
        if (it < 2 * PL) {
            const int l = it / PL; it -= l * PL;
            if (it < 1280) { const int kb = it / 80, nb = it % 80; tr_item(p.in[I_WIN] + (size_t)l * 1024 * 2560, 2560, kb * 64, nb * 32, (bf16*)(ws + WS_WIN) + (size_t)l * 2560 * 1024, 1024, nb * 32, kb * 64, false, scr, lane); continue; }
            it -= 1280;
            if (it < 512) { const int kb = it / 32, nb = it % 32; tr_item(p.in[I_WOUT] + (size_t)l * 1024 * 1024, 1024, kb * 64, nb * 32, (bf16*)(ws + WS_WOUT) + (size_t)l * 1024 * 1024, 1024, nb * 32, kb * 64, false, scr, lane); continue; }
            it -= 512;
            if (it < 128) { const int kb = it / 16, nb = it % 16; tr_item(p.in[I_GLUW] + (size_t)l * 512 * 512, 512, kb * 64, nb * 32, (bf16*)(ws + WS_WGLU) + (size_t)l * 512 * 512, 512, nb * 32, kb * 64, false, scr, lane); continue; }
            it -= 128;
            {
                const int d = it / 64, q = it % 64; bf16* dst = (bf16*)(ws + WS_WLR) + (size_t)(l * 2 + d) * 131072;
                if (q < 16) tr_item(p.in[I_WUP] + (size_t)(l * 2 + d) * 64 * 512, 512, 0, q * 32, dst, 64, q * 32, 0, false, scr, lane);
                else if (q < 32) tr_item(p.in[I_AUP] + (size_t)(l * 2 + d) * 64 * 512, 512, 0, (q - 16) * 32, dst + 32768, 64, (q - 16) * 32, 0, false, scr, lane);
                else { const int kb = (q - 32) / 16, nb = (q - 32) % 16; tr_item(p.in[I_GUP] + (size_t)(l * 2 + d) * 128 * 512, 512, kb * 64, nb * 32, dst + 65536, 128, nb * 32, kb * 64, false, scr, lane); }
            }
            continue;
        }
        it -= 2 * PL;
        if (it < 1408) { const int kb = it / 88, nb = it % 88, n0 = nb * 32; tr_item(p.in[I_FG], 2816, kb * 64, n0, (bf16*)(ws + WS_WFUP), 1024, (n0 / 128) * 256 + n0 % 128, kb * 64, false, scr, lane); continue; }
        it -= 1408;
        if (it < 1408) { const int kb = it / 88, nb = it % 88, n0 = nb * 32; tr_item(p.in[I_FU], 2816, kb * 64, n0, (bf16*)(ws + WS_WFUP), 1024, (n0 / 128) * 256 + 128 + n0 % 128, kb * 64, false, scr, lane); continue; }
        it -= 1408;
        { const int kb = it / 32, nb = it % 32; tr_item(p.in[I_FD], 1024, kb * 64, nb * 32, (bf16*)(ws + WS_WFDN), 2816, nb * 32, kb * 64, false, scr, lane); }
    }
}
constexpr int MOE_CVT_ITEMS = 8 * 5376, MOE_CVT_SPLIT = 7 * 5376;
__device__ __forceinline__ void phase_moe_cvt(const Params& p, LAS unsigned char* lds, int lane, int wave, int it_begin, int it_end, int worker, int nworkers) {
    unsigned char* ws = p.ws;
    LAS float* scr = (LAS float*)(lds + 32768 + wave * 8448);
    for (int it0 = it_begin + worker; it0 < it_end; it0 += nworkers) {
        const int e = it0 / 5376; int it = it0 % 5376;
        if (it < 1792) { const int kb = it / 112, nb = it % 112, n0 = nb * 32; tr_item(p.in[I_MG] + (size_t)e * 1024 * 3584, 3584, kb * 64, n0, (bf16*)(ws + WS_WMUP) + (size_t)e * 7168 * 1024, 1024, (n0 / 128) * 256 + n0 % 128, kb * 64, false, scr, lane); continue; }
        it -= 1792;
        if (it < 1792) { const int kb = it / 112, nb = it % 112, n0 = nb * 32; tr_item(p.in[I_MU2] + (size_t)e * 1024 * 3584, 3584, kb * 64, n0, (bf16*)(ws + WS_WMUP) + (size_t)e * 7168 * 1024, 1024, (n0 / 128) * 256 + 128 + n0 % 128, kb * 64, false, scr, lane); continue; }
        it -= 1792;
        { const int kb = it / 32, nb = it % 32; tr_item(p.in[I_MD] + (size_t)e * 3584 * 1024, 1024, kb * 64, nb * 32, (bf16*)(ws + WS_WMDN) + (size_t)e * 1024 * 3584, 3584, nb * 32, kb * 64, false, scr, lane); }
    }
}

__device__ __forceinline__ void phase_norm(const Params& p, int l, int which, bool first, bool router, int lane, int wave, int npart = 0, const float* part = nullptr, const float* pgate = nullptr) {
    unsigned char* ws = p.ws;
    float* X = (float*)(ws + WS_X); bf16* H = (bf16*)(ws + WS_H); const float* MOD = (const float*)(ws + WS_MOD);
    const float* g = p.in[which ? I_N2G : I_N1G] + l * 1024;
    const int gw = blockIdx.x * 8 + wave, NGW = gridDim.x * 8;
    f32x4 gq[4];
#pragma unroll
    for (int j = 0; j < 4; ++j) gq[j] = *(const f32x4*)(g + 4 * lane + 256 * j);
#define NORM_FETCH(r_, V, SH, SC) do { const int rf_ = (r_); \
        const float* src_ = first ? (rf_ < NLAT ? p.in[I_X] + (size_t)rf_ * 1024 : p.in[I_CTX] + (size_t)(rf_ - NLAT) * 1024) : X + (size_t)rf_ * 1024; \
        const float* mp_ = MOD + (size_t)(l * 3 + (rf_ < NLAT ? (rf_ >> 13) : 2)) * 6144 + which * 3072; \
        _Pragma("unroll") for (int j = 0; j < 4; ++j) V[j] = *(const f32x4*)(src_ + 4 * lane + 256 * j); \
        _Pragma("unroll") for (int j = 0; j < 4; ++j) { SH[j] = *(const f32x4*)(mp_ + 4 * lane + 256 * j); SC[j] = *(const f32x4*)(mp_ + 1024 + 4 * lane + 256 * j); } } while (0)
    f32x4 vn[4], shn[4], scn[4];
    if (gw < T) NORM_FETCH(gw, vn, shn, scn);
    for (int row = gw; row < T; row += NGW) {
        f32x4 v[4], shq[4], scq[4]; float ss = 0.f;
#pragma unroll
        for (int j = 0; j < 4; ++j) { v[j] = vn[j]; shq[j] = shn[j]; scq[j] = scn[j]; }
        asm volatile("" ::: "memory");
        NORM_FETCH(row + NGW < T ? row + NGW : row, vn, shn, scn);
        asm volatile("" ::: "memory");
#pragma unroll
        for (int j = 0; j < 4; ++j) ss += (v[j][0] * v[j][0] + v[j][1] * v[j][1]) + (v[j][2] * v[j][2] + v[j][3] * v[j][3]);
        if (first) {
#pragma unroll
            for (int j = 0; j < 4; ++j) *(f32x4*)(X + (size_t)row * 1024 + 4 * lane + 256 * j) = v[j];
        }
        if (npart > 0 && row >= NLAT) {
            ss = 0.f;
#pragma unroll
            for (int j = 0; j < 4; ++j) { const int c = 4 * lane + 256 * j; f32x4 sacc = (f32x4){0.f, 0.f, 0.f, 0.f};
                for (int k = 0; k < npart; ++k) sacc += *(const f32x4*)(part + ((size_t)k * NCTX + (row - NLAT)) * 1024 + c);
                v[j] += *(const f32x4*)(pgate + c) * sacc; *(f32x4*)(X + (size_t)row * 1024 + c) = v[j];
                ss += (v[j][0] * v[j][0] + v[j][1] * v[j][1]) + (v[j][2] * v[j][2] + v[j][3] * v[j][3]); }
        }
        const float inv = rsqrtf(wave_sum(ss) * (1.0f / 1024.0f) + 1e-6f);
        f32x4 h[4];
#pragma unroll
        for (int j = 0; j < 4; ++j) { const int c = 4 * lane + 256 * j; const f32x4 gg = gq[j], sh = shq[j], sc = scq[j];
            h[j] = (v[j] * inv * gg) * (1.0f + sc) + sh;
            u32x2 o; o.x = pk2(h[j][0], h[j][1]); o.y = pk2(h[j][2], h[j][3]); *(u32x2*)(H + (size_t)row * 1024 + c) = o; }
        if (router && row < NLAT) {
            float lg[8] = {0.f, 0.f, 0.f, 0.f, 0.f, 0.f, 0.f, 0.f};
#pragma unroll
            for (int j = 0; j < 4; ++j)
#pragma unroll
                for (int q = 0; q < 4; ++q) { const float* rp = p.in[I_ROUT] + (size_t)(4 * lane + 256 * j + q) * 8; const f32x4 r0 = *(const f32x4*)rp, r1 = *(const f32x4*)(rp + 4); const float hv = h[j][q];
                    lg[0] += hv * r0[0]; lg[1] += hv * r0[1]; lg[2] += hv * r0[2]; lg[3] += hv * r0[3]; lg[4] += hv * r1[0]; lg[5] += hv * r1[1]; lg[6] += hv * r1[2]; lg[7] += hv * r1[3]; }
#pragma unroll
            for (int e = 0; e < 8; ++e) lg[e] = wave_sum(lg[e]);
            int e0 = 0; float v0 = lg[0];
#pragma unroll
            for (int e = 1; e < 8; ++e) if (lg[e] > v0) { v0 = lg[e]; e0 = e; }
            int e1 = -1; float v1 = -3.0e38f;
#pragma unroll
            for (int e = 0; e < 8; ++e) if (e != e0 && lg[e] > v1) { v1 = lg[e]; e1 = e; }
            const float p1 = 1.0f / (1.0f + __expf(v0 - v1)), p0 = 1.0f - p1;
            if (lane < 8) ((float*)(ws + WS_COMB))[(size_t)row * 8 + lane] = lane == e0 ? p0 : (lane == e1 ? p1 : 0.0f);
        }
    }
}
#undef NORM_FETCH
__device__ __forceinline__ void phase_final(const Params& p, int lane, int wave) {
    unsigned char* ws = p.ws;
    const float* X = (const float*)(ws + WS_X); const float* g = p.in[I_FING];
    const bf16* YP = (const bf16*)(ws + WS_APERM); const bf16* PM = (const bf16*)(ws + WS_PARTM); const int* PPOS = (const int*)(ws + WS_PPOS); const float* RP = (const float*)(ws + WS_RP);
    const float* MOD1 = (const float*)(ws + WS_MOD) + (size_t)3 * 6144 + 5120;
    const int gw = blockIdx.x * 8 + wave, NGW = gridDim.x * 8;
    f32x4 gq[4];
#pragma unroll
    for (int j = 0; j < 4; ++j) gq[j] = *(const f32x4*)(g + 4 * lane + 256 * j);
    int s0n = 0, s1n = 0; float p0n = 0.f;
    if (gw < NLAT) { s0n = PPOS[2 * gw]; s1n = PPOS[2 * gw + 1]; p0n = RP[gw]; }
    for (int row = gw; row < NLAT; row += NGW) {
        const int s0 = s0n, s1 = s1n; const float p0 = p0n, p1 = 1.0f - p0;
        { const int rn = row + NGW < NLAT ? row + NGW : row; s0n = PPOS[2 * rn]; s1n = PPOS[2 * rn + 1]; p0n = RP[rn]; }
        const float* gt = MOD1 + (size_t)(row >> 13) * 6144;
        const bool big0 = s0 >= 128 * 256, big1 = s1 >= 128 * 256;
        const bf16* y0p = YP + (size_t)(big0 ? 0 : s0) * 1024; const bf16* y1p = YP + (size_t)(big1 ? 0 : s1) * 1024;
        u32x2 y0r[4], y1r[4]; f32x4 xr[4], gvr[4];
#pragma unroll
        for (int j = 0; j < 4; ++j) { const int c = 4 * lane + 256 * j; y0r[j] = *(const u32x2*)(y0p + c); y1r[j] = *(const u32x2*)(y1p + c); xr[j] = *(const f32x4*)(X + (size_t)row * 1024 + c); gvr[j] = *(const f32x4*)(gt + c); }
        f32x4 v[4]; float ss = 0.f;
#pragma unroll
        for (int j = 0; j < 4; ++j) { const int c = 4 * lane + 256 * j;
            f32x4 e0v = (f32x4){blo(y0r[j].x), bhi(y0r[j].x), blo(y0r[j].y), bhi(y0r[j].y)}, e1v = (f32x4){blo(y1r[j].x), bhi(y1r[j].x), blo(y1r[j].y), bhi(y1r[j].y)};
            if (big0) { e0v = (f32x4){0.f, 0.f, 0.f, 0.f}; for (int k = 0; k < 7; ++k) { const u32x2 y0 = *(const u32x2*)(PM + ((size_t)k * 2048 + (s0 - 128 * 256)) * 1024 + c); e0v += (f32x4){blo(y0.x), bhi(y0.x), blo(y0.y), bhi(y0.y)}; } }
            if (big1) { e1v = (f32x4){0.f, 0.f, 0.f, 0.f}; for (int k = 0; k < 7; ++k) { const u32x2 y1 = *(const u32x2*)(PM + ((size_t)k * 2048 + (s1 - 128 * 256)) * 1024 + c); e1v += (f32x4){blo(y1.x), bhi(y1.x), blo(y1.y), bhi(y1.y)}; } }
            const f32x4 mix = e0v * p0 + e1v * p1;
            v[j] = xr[j] + gvr[j] * mix;
            ss += (v[j][0] * v[j][0] + v[j][1] * v[j][1]) + (v[j][2] * v[j][2] + v[j][3] * v[j][3]); }
        const float inv = rsqrtf(wave_sum(ss) * (1.0f / 1024.0f) + 1e-6f);
#pragma unroll
        for (int j = 0; j < 4; ++j) { const int c = 4 * lane + 256 * j; *(f32x4*)(p.out + (size_t)row * 1024 + c) = v[j] * inv * gq[j]; }
    }
}

__device__ __forceinline__ void phase_norm2_moe(const Params& p, LAS unsigned char* lds, int tid, int lane, int wave) {
    unsigned char* ws = p.ws; const int l = 1;
    const float* X = (const float*)(ws + WS_X); bf16* H = (bf16*)(ws + WS_H); const float* MOD = (const float*)(ws + WS_MOD);
    int* RE = (int*)(ws + WS_RE); float* RP = (float*)(ws + WS_RP); int* SEGCNT = (int*)(ws + WS_SEGCNT);
    const float* g = p.in[I_N2G] + l * 1024;
    LAS int* wc = (LAS int*)lds;
    LAS float* RT = (LAS float*)(lds + 1024);
    for (int ch = tid; ch < 1024; ch += 512) { const f32x4 r0 = *(const f32x4*)(p.in[I_ROUT] + (size_t)ch * 8), r1 = *(const f32x4*)(p.in[I_ROUT] + (size_t)ch * 8 + 4);
        RT[0 * 1024 + ch] = r0[0]; RT[1 * 1024 + ch] = r0[1]; RT[2 * 1024 + ch] = r0[2]; RT[3 * 1024 + ch] = r0[3]; RT[4 * 1024 + ch] = r1[0]; RT[5 * 1024 + ch] = r1[1]; RT[6 * 1024 + ch] = r1[2]; RT[7 * 1024 + ch] = r1[3]; }
    __syncthreads();
    for (int seg = blockIdx.x; seg < NLAT / 64; seg += gridDim.x) {
        int cnt[8] = {0, 0, 0, 0, 0, 0, 0, 0};
        const float* mp = MOD + (size_t)(l * 3 + ((seg * 64) >> 13)) * 6144 + 3072;
        f32x4 gq[4], shq[4], scq[4], vn[4];
#pragma unroll
        for (int j = 0; j < 4; ++j) { const int c = 4 * lane + 256 * j; gq[j] = *(const f32x4*)(g + c); shq[j] = *(const f32x4*)(mp + c); scq[j] = *(const f32x4*)(mp + 1024 + c); }
#pragma unroll
        for (int j = 0; j < 4; ++j) vn[j] = *(const f32x4*)(X + (size_t)(seg * 64 + wave * 8) * 1024 + 4 * lane + 256 * j);
        for (int rr = 0; rr < 8; ++rr) {
            const int row = seg * 64 + wave * 8 + rr;
            asm volatile("" ::: "memory");
            f32x4 v[4]; float ss = 0.f;
#pragma unroll
            for (int j = 0; j < 4; ++j) v[j] = vn[j];
            { const int rn = seg * 64 + wave * 8 + (rr < 7 ? rr + 1 : 7);
#pragma unroll
              for (int j = 0; j < 4; ++j) vn[j] = *(const f32x4*)(X + (size_t)rn * 1024 + 4 * lane + 256 * j); }
#pragma unroll
            for (int j = 0; j < 4; ++j) ss += (v[j][0] * v[j][0] + v[j][1] * v[j][1]) + (v[j][2] * v[j][2] + v[j][3] * v[j][3]);
            const float inv = rsqrtf(wave_sum(ss) * (1.0f / 1024.0f) + 1e-6f);
            float lg[8] = {0.f, 0.f, 0.f, 0.f, 0.f, 0.f, 0.f, 0.f};
#pragma unroll
            for (int j = 0; j < 4; ++j) { const int c = 4 * lane + 256 * j;
                const f32x4 h = (v[j] * inv * gq[j]) * (1.0f + scq[j]) + shq[j];
                u32x2 o; o.x = pk2(h[0], h[1]); o.y = pk2(h[2], h[3]); *(u32x2*)(H + (size_t)row * 1024 + c) = o;
#pragma unroll
                for (int e = 0; e < 8; ++e) { const f32x4 w = *(const LAS f32x4*)(RT + e * 1024 + c); lg[e] += (h[0] * w[0] + h[1] * w[1]) + (h[2] * w[2] + h[3] * w[3]); } }
#pragma unroll
            for (int e = 0; e < 8; ++e) lg[e] = wave_sum(lg[e]);
            int e0 = 0; float v0 = lg[0];
#pragma unroll
            for (int e = 1; e < 8; ++e) if (lg[e] > v0) { v0 = lg[e]; e0 = e; }
            int e1 = -1; float v1 = -3.0e38f;
#pragma unroll
            for (int e = 0; e < 8; ++e) if (e != e0 && lg[e] > v1) { v1 = lg[e]; e1 = e; }
            e0 = __builtin_amdgcn_readfirstlane(e0); e1 = __builtin_amdgcn_readfirstlane(e1);
            const float p1 = 1.0f / (1.0f + __expf(v0 - v1));
            if (lane == 0) { RE[row] = e0 | (e1 << 8); RP[row] = 1.0f - p1; }
#pragma unroll
            for (int e = 0; e < 8; ++e) cnt[e] += (e0 == e ? 1 : 0) + (e1 == e ? 1 : 0);
        }
        if (lane < 8) { int c = 0;
#pragma unroll
            for (int e = 0; e < 8; ++e) c = (lane == e) ? cnt[e] : c;
            wc[wave * 8 + lane] = c; }
        __syncthreads();
        if (tid < 8) { int c = 0;
#pragma unroll
            for (int w = 0; w < 8; ++w) c += wc[w * 8 + tid];
            SEGCNT[seg * 8 + tid] = c; }
        __syncthreads();
    }
}
__device__ __forceinline__ void phase_moe_prep(const Params& p, LAS unsigned char* lds, int tid, int lane, int wave) {
    unsigned char* ws = p.ws;
    const int* RE = (const int*)(ws + WS_RE); const float* RP = (const float*)(ws + WS_RP); const int* SEGCNT = (const int*)(ws + WS_SEGCNT);
    int* PROW = (int*)(ws + WS_PROW); float* PGW = (float*)(ws + WS_PGW); int* TOFF = (int*)(ws + WS_TOFF);
    const bf16* H = (const bf16*)(ws + WS_H); bf16* AP = (bf16*)(ws + WS_APERM);
    LAS int* sc = (LAS int*)lds;
    LAS int* tot = (LAS int*)(lds + 8192);
    LAS int* perm = (LAS int*)(lds + 8192 + 256);
    constexpr int NSEG = NLAT / 64;
    for (int i = tid; i < NSEG * 8; i += 512) sc[i] = SEGCNT[i];
    __syncthreads();
    if (tid < 8) { int t = 0; for (int s2 = 0; s2 < NSEG; ++s2) t += sc[s2 * 8 + tid]; tot[tid] = t; }
    __syncthreads();
    if (tid == 0) { int o = 0; for (int e = 0; e < 8; ++e) { tot[8 + e] = o; o += (tot[e] + 255) >> 8; } tot[16] = o;
        if (blockIdx.x == 0) { for (int e = 0; e <= 8; ++e) TOFF[e] = tot[8 + e]; } }
    __syncthreads();
    for (int seg = blockIdx.x; seg < NSEG; seg += gridDim.x) {
        if (tid < 8) { int bs = 0; for (int s2 = 0; s2 < seg; ++s2) bs += sc[s2 * 8 + tid]; tot[32 + tid] = bs; }
        __syncthreads();
        if (wave == 0) {
            const int row = seg * 64 + lane; const int re = RE[row], e0 = re & 0xff, e1 = re >> 8; const float p0 = RP[row];
            int s0 = 0, s1 = 0;
#pragma unroll
            for (int e = 0; e < 8; ++e) { const bool mine = (e0 == e) || (e1 == e); const unsigned long long m = __ballot(mine);
                const int rank = __popcll(m & ((1ull << lane) - 1ull)); const int slot = (tot[8 + e] << 8) + tot[32 + e] + rank;
                s0 = (e0 == e) ? slot : s0; s1 = (e1 == e) ? slot : s1; }
            PROW[s0] = row; PGW[s0] = p0; PROW[s1] = row; PGW[s1] = 1.0f - p0;
            ((int*)(ws + WS_PPOS))[2 * row] = s0; ((int*)(ws + WS_PPOS))[2 * row + 1] = s1;
            perm[lane * 2] = s0; perm[lane * 2 + 1] = s1;
        }
        __syncthreads();
        for (int rr = 0; rr < 8; ++rr) { const int lr = wave * 8 + rr, row = seg * 64 + lr; const int s0 = perm[lr * 2], s1 = perm[lr * 2 + 1];
            const u32x4 a = *(const u32x4*)(H + (size_t)row * 1024 + lane * 16), b2 = *(const u32x4*)(H + (size_t)row * 1024 + lane * 16 + 8);
            *(u32x4*)(AP + (size_t)s0 * 1024 + lane * 16) = a; *(u32x4*)(AP + (size_t)s0 * 1024 + lane * 16 + 8) = b2;
            *(u32x4*)(AP + (size_t)s1 * 1024 + lane * 16) = a; *(u32x4*)(AP + (size_t)s1 * 1024 + lane * 16 + 8) = b2; }
        __syncthreads();
    }
    for (int e = blockIdx.x; e < 8; e += gridDim.x) {
        const int lo = (tot[8 + e] << 8) + tot[e], hi = tot[9 + e] << 8;
        for (int r = lo + wave; r < hi; r += 8) { if (lane == 0) { PROW[r] = -1; PGW[r] = 0.f; }
            *(u32x4*)(AP + (size_t)r * 1024 + lane * 16) = (u32x4){0u, 0u, 0u, 0u}; *(u32x4*)(AP + (size_t)r * 1024 + lane * 16 + 8) = (u32x4){0u, 0u, 0u, 0u}; }
    }
}

typedef short bf16x8s __attribute__((ext_vector_type(8)));
__device__ __forceinline__ unsigned cvtpk_(float lo, float hi) { typedef float f2_ __attribute__((ext_vector_type(2))); typedef __bf16 b2_ __attribute__((ext_vector_type(2))); f2_ v = {lo, hi}; return __builtin_bit_cast(unsigned, __builtin_convertvector(v, b2_)); }
constexpr int SLR_ROWS = 33, SLR_PITCH = 520;
__device__ __forceinline__ void phase_stream_lr(const Params& p, int l, LAS unsigned char* lds, int tid, int lane, int wave) {
    unsigned char* ws = p.ws;
    const bf16* P = (const bf16*)(ws + WS_P);
    bf16* R = (bf16*)(ws + WS_R); bf16* V = (bf16*)(ws + WS_V); bf16* KKn = (bf16*)(ws + WS_KKN); bf16* U = (bf16*)(ws + WS_U);
    LAS bf16* lrin = (LAS bf16*)lds;
    LAS bf16* kbuf = (LAS bf16*)(lds + 48 * SLR_PITCH * 2);
    LAS bf16* kkbuf = (LAS bf16*)(lds + (48 + SLR_ROWS) * SLR_PITCH * 2);
    const int hrow = tid >> 8, t8 = tid & 255, c8 = 8 * t8;
    float mu8[8]; { const f32x4 m0 = *(const f32x4*)(p.in[I_MU] + l * 2048 + c8), m1 = *(const f32x4*)(p.in[I_MU] + l * 2048 + c8 + 4); mu8[0] = m0[0]; mu8[1] = m0[1]; mu8[2] = m0[2]; mu8[3] = m0[3]; mu8[4] = m1[0]; mu8[5] = m1[1]; mu8[6] = m1[2]; mu8[7] = m1[3]; }
    for (int i = tid; i < 15 * SLR_PITCH / 2; i += 512) ((LAS unsigned*)(lrin + SLR_ROWS * SLR_PITCH))[i] = 0u;
    const int r16 = lane & 15, g4 = lane >> 4;
    for (int tq = blockIdx.x; tq < T / SLR_ROWS; tq += gridDim.x) {
        const int tix = (gridDim.x == 256) ? ((tq & 7) * 64 + ((tq >> 3) & 31) + 32 * (tq >> 8)) : tq;
        const int row0 = tix * SLR_ROWS;
        for (int pr0 = 0; pr0 < 18; pr0 += 3) {
            u32x4 ow3[3], nb3[3][4], uw3[3];
#pragma unroll
            for (int u = 0; u < 3; ++u) { const int lr = 2 * (pr0 + u) + hrow, row = row0 + (lr < SLR_ROWS ? lr : 0); int nr[4];
                if (row < NLAT) { const int t = row & (SEQ - 1), gc = t & 63, gr = t >> 6; nr[0] = gc > 0 ? row - 1 : -1; nr[1] = gc < 63 ? row + 1 : -1; nr[2] = gr > 0 ? row - 64 : -1; nr[3] = gr < 127 ? row + 64 : -1; }
                else { const int t = (row - NLAT) & (CTXL - 1); nr[0] = nr[2] = t > 0 ? row - 1 : -1; nr[1] = nr[3] = t < CTXL - 1 ? row + 1 : -1; }
                ow3[u] = *(const u32x4*)(P + (size_t)row * DIN + c8);
#pragma unroll
                for (int j = 0; j < 4; ++j) nb3[u][j] = nr[j] >= 0 ? *(const u32x4*)(P + (size_t)nr[j] * DIN + c8) : (u32x4){0u, 0u, 0u, 0u};
                if (t8 < 64) uw3[u] = *(const u32x4*)(P + (size_t)row * DIN + 2048 + c8); }
#pragma unroll
            for (int u = 0; u < 3; ++u) { const int lr = 2 * (pr0 + u) + hrow, row = row0 + lr;
              if (lr < SLR_ROWS) {
                const u32x4 ow = ow3[u];
                const float own[8] = {blo(ow.x), bhi(ow.x), blo(ow.y), bhi(ow.y), blo(ow.z), bhi(ow.z), blo(ow.w), bhi(ow.w)};
                const float shv[8] = {blo(nb3[u][0].x), bhi(nb3[u][1].x), blo(nb3[u][2].y), bhi(nb3[u][3].y), blo(nb3[u][0].z), bhi(nb3[u][1].z), blo(nb3[u][2].w), bhi(nb3[u][3].w)};
                float sv[8];
#pragma unroll
                for (int q = 0; q < 8; ++q) sv[q] = own[q] + (shv[q] - own[q]) * mu8[q];
                if (c8 < 512) { u32x4 o; o.x = cvtpk_(sv[0], sv[1]); o.y = cvtpk_(sv[2], sv[3]); o.z = cvtpk_(sv[4], sv[5]); o.w = cvtpk_(sv[6], sv[7]); *(u32x4*)(R + (size_t)row * 512 + c8) = o; }
                else if (c8 < 1024) { const int cc = c8 - 512; u32x4 o; o.x = cvtpk_(sv[0], sv[1]); o.y = cvtpk_(sv[2], sv[3]); o.z = cvtpk_(sv[4], sv[5]); o.w = cvtpk_(sv[6], sv[7]); *(LAS u32x4*)(kbuf + lr * SLR_PITCH + cc) = o;
                    const f32x4 ka_ = *(const f32x4*)(p.in[I_KK] + l * 512 + cc), kb_ = *(const f32x4*)(p.in[I_KK] + l * 512 + cc + 4); const float kkw[8] = {ka_[0], ka_[1], ka_[2], ka_[3], kb_[0], kb_[1], kb_[2], kb_[3]};
                    float q8[8]; float ssq = 0.f;
#pragma unroll
                    for (int q = 0; q < 8; ++q) { q8[q] = sv[q] * kkw[q]; ssq += q8[q] * q8[q]; }
                    ssq += __shfl_xor(ssq, 1); ssq += __shfl_xor(ssq, 2); ssq += __shfl_xor(ssq, 4);
                    const float inv = 1.0f / fmaxf(sqrtf(ssq), 1e-12f);
                    u32x4 o2; o2.x = cvtpk_(q8[0] * inv, q8[1] * inv); o2.y = cvtpk_(q8[2] * inv, q8[3] * inv); o2.z = cvtpk_(q8[4] * inv, q8[5] * inv); o2.w = cvtpk_(q8[6] * inv, q8[7] * inv);
                    *(u32x4*)(KKn + (size_t)row * 512 + cc) = o2; *(LAS u32x4*)(kkbuf + lr * SLR_PITCH + cc) = o2; }
                else if (c8 < 1536) { u32x4 o; o.x = cvtpk_(sv[0], sv[1]); o.y = cvtpk_(sv[2], sv[3]); o.z = cvtpk_(sv[4], sv[5]); o.w = cvtpk_(sv[6], sv[7]); *(u32x4*)(V + (size_t)row * 512 + c8 - 1024) = o; }
                else { const int cc = c8 - 1536; float f[8];
#pragma unroll
                    for (int q = 0; q < 8; ++q) { const float e2 = __expf(2.0f * sv[q]); f[q] = cc < 128 ? 1.0f - 2.0f * __builtin_amdgcn_rcpf(e2 + 1.0f) : (cc < 256 ? sv[q] : sigm(sv[q])); }
                    u32x4 o; o.x = cvtpk_(f[0], f[1]); o.y = cvtpk_(f[2], f[3]); o.z = cvtpk_(f[4], f[5]); o.w = cvtpk_(f[6], f[7]); *(LAS u32x4*)(lrin + lr * SLR_PITCH + cc) = o; }
                if (t8 < 64) { int tbu, ju; if (row < NLAT) { const int bb_ = row >> 13, tt_ = row & (SEQ - 1); tbu = bb_ * NCH + 4 + (tt_ >> 6); ju = tt_ & 63; } else { const int rc = row - NLAT, bb_ = rc >> 8, tt_ = rc & 255; tbu = bb_ * NCH + (tt_ >> 6); ju = tt_ & 63; }
                    *(u32x4*)(U + ((size_t)((c8 >> 4) * 64 + ju) * (2 * NCH) + tbu) * 16 + (c8 & 15)) = uw3[u]; }
              }
            }
        }
        __syncthreads();
#pragma unroll 1
        for (int d = 0; d < 2; ++d) {
            const bf16* Wd = (const bf16*)(ws + WS_WLR) + (size_t)(l * 2 + d) * 131072 + 8 * g4;
            const size_t dT = (size_t)d * T * 512;
#pragma unroll
            for (int sec = 0; sec < 3; ++sec) {
                constexpr int dummy_ = 0; (void)dummy_;
                const int KK_ = sec == 2 ? 128 : 64, NKS = sec == 2 ? 4 : 2, koff = sec == 0 ? d * 64 : (sec == 1 ? 128 + d * 64 : 256 + d * 128);
                const bf16* Ws = Wd + (sec == 0 ? 0 : (sec == 1 ? 32768 : 65536));
#pragma unroll
                for (int i2 = 0; i2 < 4; i2 += 2) {
                bf16x8s wf[2][4];
#pragma unroll
                for (int i = 0; i < 2; ++i)
#pragma unroll
                    for (int ks = 0; ks < 4; ++ks) if (ks < NKS) wf[i][ks] = *(const bf16x8s*)(Ws + (size_t)(16 * (wave + 8 * (i2 + i)) + r16) * KK_ + 32 * ks);
#pragma unroll
                for (int ii = 0; ii < 2; ++ii) { const int i = i2 + ii;
                    const int c = 16 * (wave + 8 * i) + 4 * g4;
                    f32x4 acc[3];
#pragma unroll
                    for (int rt = 0; rt < 3; ++rt) acc[rt] = (f32x4){0.f, 0.f, 0.f, 0.f};
#pragma unroll
                    for (int ks = 0; ks < 4; ++ks) if (ks < NKS) {
#pragma unroll
                        for (int rt = 0; rt < 3; ++rt) { const bf16x8s bq = *(const LAS bf16x8s*)(lrin + (16 * rt + r16) * SLR_PITCH + koff + 32 * ks + 8 * g4);
                            acc[rt] = __builtin_amdgcn_mfma_f32_16x16x32_bf16(wf[ii][ks], bq, acc[rt], 0, 0, 0); } }
                    if (sec == 0) { const f32x4 w0 = *(const f32x4*)(p.in[I_W0] + l * 1024 + d * 512 + c); float* LW = (float*)(ws + WS_LW) + dT;
#pragma unroll
                        for (int rt = 0; rt < 3; ++rt) { const int lr = 16 * rt + r16; if (lr < SLR_ROWS) { f32x4 o;
#pragma unroll
                                for (int q = 0; q < 4; ++q) o[q] = -sigm(w0[q] + acc[rt][q]) * 0.60653065971f;
                                *(f32x4*)(LW + (size_t)(row0 + lr) * 512 + c) = o; } }
                    } else if (sec == 1) { const f32x4 a0 = *(const f32x4*)(p.in[I_A0] + l * 1024 + d * 512 + c), ka = *(const f32x4*)(p.in[I_KA] + l * 512 + c);
                        bf16* KT = (bf16*)(ws + WS_KT) + dT; bf16* BB = (bf16*)(ws + WS_BB) + dT;
#pragma unroll
                        for (int rt = 0; rt < 3; ++rt) { const int lr = 16 * rt + r16; if (lr < SLR_ROWS) {
                                const u32x2 k4 = *(const LAS u32x2*)(kbuf + lr * SLR_PITCH + c), q4 = *(const LAS u32x2*)(kkbuf + lr * SLR_PITCH + c);
                                const float kf[4] = {blo(k4.x), bhi(k4.x), blo(k4.y), bhi(k4.y)}, qf[4] = {blo(q4.x), bhi(q4.x), blo(q4.y), bhi(q4.y)}; float kt[4], bb[4];
#pragma unroll
                                for (int q = 0; q < 4; ++q) { const float a = sigm(a0[q] + acc[rt][q]); kt[q] = kf[q] * (1.0f + (a - 1.0f) * ka[q]); bb[q] = qf[q] * a; }
                                u32x2 o1, o2; o1.x = cvtpk_(kt[0], kt[1]); o1.y = cvtpk_(kt[2], kt[3]); o2.x = cvtpk_(bb[0], bb[1]); o2.y = cvtpk_(bb[2], bb[3]);
                                *(u32x2*)(KT + (size_t)(row0 + lr) * 512 + c) = o1; *(u32x2*)(BB + (size_t)(row0 + lr) * 512 + c) = o2; } }
                    } else { bf16* GD = (bf16*)(ws + WS_GD) + dT;
#pragma unroll
                        for (int rt = 0; rt < 3; ++rt) { const int lr = 16 * rt + r16; if (lr < SLR_ROWS) { u32x2 o; o.x = cvtpk_(acc[rt][0], acc[rt][1]); o.y = cvtpk_(acc[rt][2], acc[rt][3]);
                                *(u32x2*)(GD + (size_t)(row0 + lr) * 512 + c) = o; } }
                    }
                    asm volatile("" ::: "memory");
                }
                }
            }
        }
        __syncthreads();
    }
}

typedef short bf16x8 __attribute__((ext_vector_type(8)));
typedef float f32x2v __attribute__((ext_vector_type(2)));
typedef __bf16 bf16x2v __attribute__((ext_vector_type(2)));
__device__ __forceinline__ unsigned cvtpk(float lo, float hi) { f32x2v v = {lo, hi}; return __builtin_bit_cast(unsigned, __builtin_convertvector(v, bf16x2v)); }
__device__ __forceinline__ int lds_off(int slot, int row, int col) { return slot * 8192 + row * 128 + ((((col >> 3) ^ (row & 7) ^ ((row & 8) ? 7 : 0) ^ ((row >> 3) & 6))) << 4) + (col & 7) * 2; }
struct Acc2 { f32x4 t[2]; };
__device__ __forceinline__ void prod2(LAS unsigned char* lds, int aslot, int btslot, int wave, int lane, Acc2& acc) {
    const int tr = wave >> 1, r = lane & 15, g = lane >> 4;
#pragma unroll
    for (int ks = 0; ks < 2; ++ks) {
        const bf16x8 a = *(const LAS bf16x8*)(lds + lds_off(aslot, 16 * tr + r, 32 * ks + 8 * g));
#pragma unroll
        for (int t = 0; t < 2; ++t) { const int tc = 2 * (wave & 1) + t;
            const bf16x8 bb = *(const LAS bf16x8*)(lds + lds_off(btslot, 16 * tc + r, 32 * ks + 8 * g));
            acc.t[t] = __builtin_amdgcn_mfma_f32_16x16x32_bf16(a, bb, acc.t[t], 0, 0, 0); }
    }
}
__device__ __forceinline__ void wr_tr(LAS unsigned char* lds, int slot, int wave, int lane, const Acc2& acc) {
    const int tr = wave >> 1, r = lane & 15, g = lane >> 4;
#pragma unroll
    for (int t = 0; t < 2; ++t) { const int col = 16 * (2 * (wave & 1) + t) + r;
        u32x2 o; o.x = cvtpk(acc.t[t][0], acc.t[t][1]); o.y = cvtpk(acc.t[t][2], acc.t[t][3]);
        *(LAS u32x2*)(lds + lds_off(slot, col, 16 * tr + 4 * g)) = o; }
}
struct Frag2 { bf16x8 a[2]; bf16x8 b[2][2]; };
__device__ __forceinline__ void prod2_ld(LAS unsigned char* lds, int aslot, int btslot, int wave, int lane, Frag2& f) {
    const int tr = wave >> 1, r = lane & 15, g = lane >> 4;
#pragma unroll
    for (int ks = 0; ks < 2; ++ks) {
        f.a[ks] = *(const LAS bf16x8*)(lds + lds_off(aslot, 16 * tr + r, 32 * ks + 8 * g));
#pragma unroll
        for (int t = 0; t < 2; ++t) f.b[ks][t] = *(const LAS bf16x8*)(lds + lds_off(btslot, 16 * (2 * (wave & 1) + t) + r, 32 * ks + 8 * g)); }
}
__device__ __forceinline__ void prod2_mm(const Frag2& f, Acc2& acc) {
#pragma unroll
    for (int ks = 0; ks < 2; ++ks)
#pragma unroll
        for (int t = 0; t < 2; ++t) acc.t[t] = __builtin_amdgcn_mfma_f32_16x16x32_bf16(f.a[ks], f.b[ks][t], acc.t[t], 0, 0, 0);
}
__device__ __forceinline__ void phase_chunk(const Params& p, int l, LAS unsigned char* lds, int tid, int lane, int wave) {
    unsigned char* ws = p.ws;
    const bf16* R = (const bf16*)(ws + WS_R); const bf16* V = (const bf16*)(ws + WS_V); const bf16* KKn = (const bf16*)(ws + WS_KKN);
    LAS float* Lf = (LAS float*)(lds + 14 * 8192);
    LAS float* segtot = (LAS float*)(lds + 13 * 8192);
    LAS float* gc = (LAS float*)(lds + LDS_GC);
    const int tr = wave >> 1, r16 = lane & 15, g4 = lane >> 4;
    const int pos = tid >> 3, c8 = (tid & 7) * 8;
    u32x4 n_kk8, n_b8, n_kt8, n_r8, n_v8; f32x4 n_l0, n_l1;
#define CHUNK_FETCH(cc_) do { const int h_ = (cc_) & 7, j_ = ((cc_) >> 3) % NCH, db_ = ((cc_) >> 3) / NCH, b_ = db_ & 1, d_ = db_ >> 1; \
        const size_t go_ = (size_t)row_of(b_, d_, j_ * 64 + pos) * 512 + h_ * 64 + c8, do_ = (size_t)d_ * T * 512 + go_; \
        n_kk8 = *(const u32x4*)(KKn + go_); n_b8 = *(const u32x4*)((const bf16*)(ws + WS_BB) + do_); n_kt8 = *(const u32x4*)((const bf16*)(ws + WS_KT) + do_); n_r8 = *(const u32x4*)(R + go_); n_v8 = *(const u32x4*)(V + go_); \
        n_l0 = *(const f32x4*)((const float*)(ws + WS_LW) + do_); n_l1 = *(const f32x4*)((const float*)(ws + WS_LW) + do_ + 4); } while (0)
    if ((int)blockIdx.x < NCC) CHUNK_FETCH((int)blockIdx.x);
    asm volatile("" :: "v"(n_kk8), "v"(n_b8), "v"(n_kt8), "v"(n_r8), "v"(n_v8), "v"(n_l0), "v"(n_l1));
    for (int cc = blockIdx.x; cc < NCC; cc += gridDim.x) {
        const int h = cc & 7, j = (cc >> 3) % NCH, db = (cc >> 3) / NCH, b = db & 1, d = db >> 1;
        bf16* CH = (bf16*)(ws + WS_CH) + (size_t)cc * 16384;
        const int row = row_of(b, d, j * 64 + pos);
        const u32x4 kk8 = n_kk8, b8 = n_b8, kt8 = n_kt8, r8 = n_r8, v8 = n_v8; const f32x4 l0 = n_l0, l1 = n_l1;
        const f32x4 rk0_ = *(const f32x4*)(p.in[I_RK] + l * 512 + h * 64 + c8), rk1_ = *(const f32x4*)(p.in[I_RK] + l * 512 + h * 64 + c8 + 4);
        asm volatile("" ::: "memory");
        { const int ccn = cc + (int)gridDim.x < NCC ? cc + (int)gridDim.x : cc; CHUNK_FETCH(ccn); }
        *(LAS f32x4*)(Lf + pos * 64 + c8) = l0; *(LAS f32x4*)(Lf + pos * 64 + c8 + 4) = l1;
        __syncthreads();
        { const int ch = tid & 63, seg = tid >> 6; float pre[8]; float run = 0.f;
#pragma unroll
          for (int q = 0; q < 8; ++q) { run += Lf[(8 * seg + q) * 64 + ch]; pre[q] = run; }
          segtot[seg * 64 + ch] = run;
          __syncthreads();
          float off = 0.f;
#pragma unroll
          for (int s2 = 0; s2 < 8; ++s2) off += (s2 < seg) ? segtot[s2 * 64 + ch] : 0.f;
#pragma unroll
          for (int q = 0; q < 8; ++q) Lf[(8 * seg + q) * 64 + ch] = pre[q] + off;
          if (seg == 7) gc[ch] = pre[7] + off; }
        __syncthreads();
        {
            const f32x4 g0 = *(const LAS f32x4*)(Lf + pos * 64 + c8), g1 = *(const LAS f32x4*)(Lf + pos * 64 + c8 + 4);
            const f32x4 q0 = *(const LAS f32x4*)(gc + c8), q1 = *(const LAS f32x4*)(gc + c8 + 4);
            const float G[8] = {g0[0], g0[1], g0[2], g0[3], g1[0], g1[1], g1[2], g1[3]}, GC[8] = {q0[0], q0[1], q0[2], q0[3], q1[0], q1[1], q1[2], q1[3]};
            const float Lv[8] = {l0[0], l0[1], l0[2], l0[3], l1[0], l1[1], l1[2], l1[3]};
            const unsigned kkw[4] = {kk8.x, kk8.y, kk8.z, kk8.w}, bw[4] = {b8.x, b8.y, b8.z, b8.w}, ktw[4] = {kt8.x, kt8.y, kt8.z, kt8.w}, rw[4] = {r8.x, r8.y, r8.z, r8.w}, vw[4] = {v8.x, v8.y, v8.z, v8.w};
            float at[8], bt[8], kb[8], qt[8], bg[8], kg[8], vv[8]; float bon = 0.f;
            const float rk[8] = {rk0_[0], rk0_[1], rk0_[2], rk0_[3], rk1_[0], rk1_[1], rk1_[2], rk1_[3]};
#pragma unroll
            for (int q = 0; q < 8; ++q) { const int w2 = q >> 1; const bool hi = q & 1;
                const float kkv = hi ? bhi(kkw[w2]) : blo(kkw[w2]), bv = hi ? bhi(bw[w2]) : blo(bw[w2]), ktv = hi ? bhi(ktw[w2]) : blo(ktw[w2]), rv = hi ? bhi(rw[w2]) : blo(rw[w2]);
                vv[q] = hi ? bhi(vw[w2]) : blo(vw[w2]);
                const float eg = __expf(G[q]), egi = __expf(-G[q]), egp = __expf(G[q] - Lv[q]), egc = __expf(GC[q] - G[q]);
                at[q] = -kkv * egp; bt[q] = bv * egi; kb[q] = ktv * egi; qt[q] = rv * eg; bg[q] = bv * egc; kg[q] = ktv * egc;
                bon += rv * ktv * rk[q]; }
            bon += __shfl_xor(bon, 1); bon += __shfl_xor(bon, 2); bon += __shfl_xor(bon, 4);
            if ((tid & 7) == 0) ((float*)(ws + WS_BONUS))[((size_t)d * T + row) * 8 + h] = bon;
            u32x4 o;
            o.x = cvtpk(at[0], at[1]); o.y = cvtpk(at[2], at[3]); o.z = cvtpk(at[4], at[5]); o.w = cvtpk(at[6], at[7]); *(LAS u32x4*)(lds + lds_off(0, pos, c8)) = o;
            o.x = cvtpk(bt[0], bt[1]); o.y = cvtpk(bt[2], bt[3]); o.z = cvtpk(bt[4], bt[5]); o.w = cvtpk(bt[6], bt[7]); *(LAS u32x4*)(lds + lds_off(2, pos, c8)) = o;
            o.x = cvtpk(kb[0], kb[1]); o.y = cvtpk(kb[2], kb[3]); o.z = cvtpk(kb[4], kb[5]); o.w = cvtpk(kb[6], kb[7]); *(LAS u32x4*)(lds + lds_off(3, pos, c8)) = o;
            o.x = cvtpk(qt[0], qt[1]); o.y = cvtpk(qt[2], qt[3]); o.z = cvtpk(qt[4], qt[5]); o.w = cvtpk(qt[6], qt[7]); *(LAS u32x4*)(lds + lds_off(4, pos, c8)) = o;
            const unsigned atw[4] = {cvtpk(at[0], at[1]), cvtpk(at[2], at[3]), cvtpk(at[4], at[5]), cvtpk(at[6], at[7])};
            const unsigned bgw[4] = {cvtpk(bg[0], bg[1]), cvtpk(bg[2], bg[3]), cvtpk(bg[4], bg[5]), cvtpk(bg[6], bg[7])};
            const unsigned kgw[4] = {cvtpk(kg[0], kg[1]), cvtpk(kg[2], kg[3]), cvtpk(kg[4], kg[5]), cvtpk(kg[6], kg[7])};
#pragma unroll
            for (int q = 0; q < 8; ++q) { const int w2 = q >> 1, sh = (q & 1) * 16;
                *(LAS unsigned short*)(lds + lds_off(1, c8 + q, pos)) = (unsigned short)(atw[w2] >> sh);
                *(LAS unsigned short*)(lds + lds_off(5, c8 + q, pos)) = (unsigned short)(vw[w2] >> sh);
                *(LAS unsigned short*)(lds + lds_off(6, c8 + q, pos)) = (unsigned short)(bgw[w2] >> sh);
                *(LAS unsigned short*)(lds + lds_off(7, c8 + q, pos)) = (unsigned short)(kgw[w2] >> sh); }
        }
        __syncthreads();
        Acc2 accTt;
        { Frag2 f0, f1, f2, f3, f4;
          prod2_ld(lds, 0, 2, wave, lane, f0); prod2_ld(lds, 2, 0, wave, lane, f1); prod2_ld(lds, 3, 0, wave, lane, f2); prod2_ld(lds, 2, 4, wave, lane, f3); prod2_ld(lds, 3, 4, wave, lane, f4);
          Acc2 a0, a1, a2, a3, a4; a0.t[0] = a0.t[1] = a1.t[0] = a1.t[1] = a2.t[0] = a2.t[1] = a3.t[0] = a3.t[1] = a4.t[0] = a4.t[1] = (f32x4){0.f, 0.f, 0.f, 0.f};
          prod2_mm(f0, a0); prod2_mm(f1, a1); prod2_mm(f2, a2); prod2_mm(f3, a3); prod2_mm(f4, a4);
#pragma unroll
          for (int t = 0; t < 2; ++t) { const int col = 16 * (2 * (wave & 1) + t) + r16;
#pragma unroll
              for (int q = 0; q < 4; ++q) { const int rw_ = 16 * tr + 4 * g4 + q;
                  a0.t[t][q] = col < rw_ ? a0.t[t][q] : 0.f;
                  a1.t[t][q] = col > rw_ ? a1.t[t][q] : 0.f; accTt.t[t][q] = a1.t[t][q] + (col == rw_ ? 1.f : 0.f);
                  a2.t[t][q] = col > rw_ ? a2.t[t][q] : 0.f;
                  a3.t[t][q] = col >= rw_ ? a3.t[t][q] : 0.f;
                  a4.t[t][q] = col >= rw_ ? a4.t[t][q] : 0.f; } }
          wr_tr(lds, 9, wave, lane, a0);
          wr_tr(lds, 8, wave, lane, a1); wr_tr(lds, 10, wave, lane, accTt);
          wr_tr(lds, 11, wave, lane, a2);
          wr_tr(lds, 12, wave, lane, a3);
          wr_tr(lds, 13, wave, lane, a4); }
        __syncthreads();
        { Frag2 f1, f2, f3; prod2_ld(lds, 8, 9, wave, lane, f1); prod2_ld(lds, 9, 8, wave, lane, f2); prod2_ld(lds, 11, 5, wave, lane, f3);
          Acc2 a1, a2, a3; a1.t[0] = a1.t[1] = a2.t[0] = a2.t[1] = a3.t[0] = a3.t[1] = (f32x4){0.f, 0.f, 0.f, 0.f};
          prod2_mm(f1, a1); prod2_mm(f2, a2); prod2_mm(f3, a3);
          wr_tr(lds, 3, wave, lane, a1);
          wr_tr(lds, 2, wave, lane, a2);
          wr_tr(lds, 14, wave, lane, a3); }
        __syncthreads();
#pragma unroll
        for (int lvl = 1; lvl <= 4; ++lvl) {
            const int zc = (lvl & 1) ? 2 : 8, zn = (lvl & 1) ? 8 : 2, tc_ = (lvl & 1) ? 10 : 15, tn = (lvl & 1) ? 15 : 10;
            if (lvl < 4) { Frag2 f1, f2, f3; prod2_ld(lds, zc + 1, tc_, wave, lane, f1); prod2_ld(lds, zc, zc + 1, wave, lane, f2); prod2_ld(lds, zc + 1, zc, wave, lane, f3);
                Acc2 a2, a3; a2.t[0] = a2.t[1] = a3.t[0] = a3.t[1] = (f32x4){0.f, 0.f, 0.f, 0.f};
                prod2_mm(f1, accTt); prod2_mm(f2, a2); prod2_mm(f3, a3);
                wr_tr(lds, tn, wave, lane, accTt); wr_tr(lds, zn + 1, wave, lane, a2); wr_tr(lds, zn, wave, lane, a3); }
            else { prod2(lds, zc + 1, tc_, wave, lane, accTt); wr_tr(lds, tn, wave, lane, accTt); }
            __syncthreads();
        }
        { Frag2 f1, f2; prod2_ld(lds, 10, 1, wave, lane, f1); prod2_ld(lds, 10, 14, wave, lane, f2);
          Acc2 a1, a2; a1.t[0] = a1.t[1] = a2.t[0] = a2.t[1] = (f32x4){0.f, 0.f, 0.f, 0.f};
          prod2_mm(f1, a1); prod2_mm(f2, a2);
          wr_tr(lds, 8, wave, lane, a1); wr_tr(lds, 9, wave, lane, a2); }
        __syncthreads();
        { Acc2 a; a.t[0] = a.t[1] = (f32x4){0.f, 0.f, 0.f, 0.f}; prod2(lds, 8, 12, wave, lane, a);
#pragma unroll
          for (int t = 0; t < 2; ++t) { const int col = 16 * (2 * (wave & 1) + t) + r16, r0 = 16 * tr + 4 * g4;
              const u32x2 qq = *(const LAS u32x2*)(lds + lds_off(4, col, r0));
              u32x2 o; o.x = cvtpk(a.t[t][0] + blo(qq.x), a.t[t][1] + bhi(qq.x)); o.y = cvtpk(a.t[t][2] + blo(qq.y), a.t[t][3] + bhi(qq.y));
              *(u32x2*)(CH + 8192 + (((col >> 4) * 2 + (tr >> 1)) * 64 + g4 * 16 + (col & 15)) * 8 + (tr & 1) * 4) = o; } }
        { Acc2 a; a.t[0] = a.t[1] = (f32x4){0.f, 0.f, 0.f, 0.f}; prod2(lds, 12, 9, wave, lane, a); prod2(lds, 13, 5, wave, lane, a);
#pragma unroll
          for (int t = 0; t < 2; ++t) { const int col = 16 * (2 * (wave & 1) + t) + r16, r0 = 16 * tr + 4 * g4;
              u32x2 o; o.x = cvtpk(a.t[t][0], a.t[t][1]); o.y = cvtpk(a.t[t][2], a.t[t][3]); *(u32x2*)(CH + 12288 + (((col >> 4) * 4 + tr) * 64 + g4 * 16 + (col & 15)) * 4) = o; } }
        { Acc2 a; a.t[0] = a.t[1] = (f32x4){0.f, 0.f, 0.f, 0.f}; prod2(lds, 8, 6, wave, lane, a);
#pragma unroll
          for (int t = 0; t < 2; ++t) { const int col = 16 * (2 * (wave & 1) + t) + r16, r0 = 16 * tr + 4 * g4; const float dg = __expf(gc[col]);
#pragma unroll
              for (int q = 0; q < 4; ++q) a.t[t][q] += (r0 + q == col) ? dg : 0.f;
              u32x2 o; o.x = cvtpk(a.t[t][0], a.t[t][1]); o.y = cvtpk(a.t[t][2], a.t[t][3]); *(u32x2*)(CH + (((col >> 4) * 2 + (tr >> 1)) * 64 + g4 * 16 + (col & 15)) * 8 + (tr & 1) * 4) = o; } }
        { Acc2 a; a.t[0] = a.t[1] = (f32x4){0.f, 0.f, 0.f, 0.f}; prod2(lds, 6, 9, wave, lane, a); prod2(lds, 7, 5, wave, lane, a);
#pragma unroll
          for (int t = 0; t < 2; ++t) { const int col = 16 * (2 * (wave & 1) + t) + r16, r0 = 16 * tr + 4 * g4;
              u32x2 o; o.x = cvtpk(a.t[t][0], a.t[t][1]); o.y = cvtpk(a.t[t][2], a.t[t][3]); *(u32x2*)(CH + 4096 + (((col >> 4) * 4 + tr) * 64 + g4 * 16 + (col & 15)) * 4) = o; } }
        __syncthreads();
    }
}
#undef CHUNK_FETCH
struct SeqS { u32x4 mt[4][2]; u32x2 nc[4]; };
struct SeqY { u32x4 qe[4][2]; u32x2 yl[4]; };
__device__ __forceinline__ void seq_load_s(SeqS& B, const bf16* CH, int vs, int lane) {
#pragma unroll
    for (int t = 0; t < 4; ++t) {
#pragma unroll
        for (int s = 0; s < 2; ++s) B.mt[t][s] = *(const u32x4*)(CH + ((t * 2 + s) * 64 + lane) * 8);
        B.nc[t] = *(const u32x2*)(CH + 4096 + ((vs * 4 + t) * 64 + lane) * 4); }
}
__device__ __forceinline__ void seq_load_y(SeqY& B, const bf16* CH, int vs, int lane) {
#pragma unroll
    for (int t = 0; t < 4; ++t) {
#pragma unroll
        for (int s = 0; s < 2; ++s) B.qe[t][s] = *(const u32x4*)(CH + 8192 + ((t * 2 + s) * 64 + lane) * 8);
        B.yl[t] = *(const u32x2*)(CH + 12288 + ((vs * 4 + t) * 64 + lane) * 4); }
}
__device__ __forceinline__ void seq_wait_ge(volatile LAS int* w, int v) { while (*w < v) __builtin_amdgcn_s_sleep(1); asm volatile("" ::: "memory"); }
__device__ __forceinline__ void phase_seq(const Params& p, LAS unsigned char* lds, int lane, int wave) {
    if (blockIdx.x >= 128) return;
    unsigned char* ws = p.ws;
    const int chain = (blockIdx.x & 7) * 4 + (blockIdx.x >> 5), vs = (blockIdx.x >> 3) & 3, db = chain >> 3, h = chain & 7, b = db & 1, d = db >> 1;
    const int r = lane & 15, g = lane >> 4;
    const bf16* CH0 = (const bf16*)(ws + WS_CH) + ((size_t)(db * NCH) * 8 + h) * 16384;
    volatile LAS int* flg = (volatile LAS int*)(lds + 16384);
    LAS u32x4* ring = (LAS u32x4*)lds;
    if (wave == 0 && lane == 0) { flg[0] = 0; flg[1] = 0; }
    __syncthreads();
    if (wave == 0) {
        u32x4 sf[2]; sf[0] = sf[1] = (u32x4){0u, 0u, 0u, 0u};
        SeqS q0, q1, q2, q3;
        seq_load_s(q0, CH0, vs, lane); seq_load_s(q1, CH0 + (size_t)1 * 8 * 16384, vs, lane); seq_load_s(q2, CH0 + (size_t)2 * 8 * 16384, vs, lane);
        seq_load_s(q3, CH0 + (size_t)3 * 8 * 16384, vs, lane);
#define SEQ_USE_S(Q) asm volatile("" :: "v"(Q.mt[0][0]), "v"(Q.mt[0][1]), "v"(Q.mt[1][0]), "v"(Q.mt[1][1]), "v"(Q.mt[2][0]), "v"(Q.mt[2][1]), "v"(Q.mt[3][0]), "v"(Q.mt[3][1]), "v"(Q.nc[0]), "v"(Q.nc[1]), "v"(Q.nc[2]), "v"(Q.nc[3]))
        SEQ_USE_S(q0); SEQ_USE_S(q1); SEQ_USE_S(q2); SEQ_USE_S(q3);
#undef SEQ_USE_S
#define SEQ_S_STEP(Q, jj) do { const int j_ = (jj); \
            if (j_ >= 8) seq_wait_ge(flg + 1, j_ - 7); \
            ring[((j_ & 7) * 2 + 0) * 64 + lane] = sf[0]; ring[((j_ & 7) * 2 + 1) * 64 + lane] = sf[1]; \
            asm volatile("s_waitcnt lgkmcnt(0)" ::: "memory"); if (lane == 0) flg[0] = j_ + 1; \
            f32x4 accS[4]; \
            _Pragma("unroll") for (int t = 0; t < 4; ++t) { f32x4 as = (f32x4){blo(Q.nc[t].x), bhi(Q.nc[t].x), blo(Q.nc[t].y), bhi(Q.nc[t].y)}; \
                _Pragma("unroll") for (int s2 = 0; s2 < 2; ++s2) as = __builtin_amdgcn_mfma_f32_16x16x32_bf16(__builtin_bit_cast(bf16x8, Q.mt[t][s2]), __builtin_bit_cast(bf16x8, sf[s2]), as, 0, 0, 0); \
                accS[t] = as; } \
            _Pragma("unroll") for (int s2 = 0; s2 < 2; ++s2) { sf[s2].x = cvtpk(accS[2 * s2][0], accS[2 * s2][1]); sf[s2].y = cvtpk(accS[2 * s2][2], accS[2 * s2][3]); sf[s2].z = cvtpk(accS[2 * s2 + 1][0], accS[2 * s2 + 1][1]); sf[s2].w = cvtpk(accS[2 * s2 + 1][2], accS[2 * s2 + 1][3]); } \
            { const int jn_ = j_ + 4 < NCH ? j_ + 4 : NCH - 1; seq_load_s(Q, CH0 + (size_t)jn_ * 8 * 16384, vs, lane); } } while (0)
        for (int j = 0; j < NCH; j += 4) { SEQ_S_STEP(q0, j); SEQ_S_STEP(q1, j + 1); SEQ_S_STEP(q2, j + 2); SEQ_S_STEP(q3, j + 3); }
#undef SEQ_S_STEP
    } else if (wave == 1) {
        float* Y = (float*)(ws + WS_Y) + (size_t)d * T * 512 + h * 64 + 16 * vs + r;
        SeqY q0, q1, q2; const int sgs = d ? -1 : 1;
        seq_load_y(q0, CH0, vs, lane); seq_load_y(q1, CH0 + (size_t)1 * 8 * 16384, vs, lane); seq_load_y(q2, CH0 + (size_t)2 * 8 * 16384, vs, lane);
#define SEQ_USE_Y(Q) asm volatile("" :: "v"(Q.qe[0][0]), "v"(Q.qe[0][1]), "v"(Q.qe[1][0]), "v"(Q.qe[1][1]), "v"(Q.qe[2][0]), "v"(Q.qe[2][1]), "v"(Q.qe[3][0]), "v"(Q.qe[3][1]), "v"(Q.yl[0]), "v"(Q.yl[1]), "v"(Q.yl[2]), "v"(Q.yl[3]))
        SEQ_USE_Y(q0); SEQ_USE_Y(q1); SEQ_USE_Y(q2);
#undef SEQ_USE_Y
#define SEQ_Y_STEP(Q, jj) do { const int j_ = (jj); \
            float* Yc_ = Y + ((ptrdiff_t)row_of(b, d, j_ * 64) + (ptrdiff_t)(sgs * 4 * g)) * 512;     \
            seq_wait_ge(flg, j_ + 1); \
            const u32x4 s0_ = ring[((j_ & 7) * 2 + 0) * 64 + lane], s1_ = ring[((j_ & 7) * 2 + 1) * 64 + lane]; \
            asm volatile("s_waitcnt lgkmcnt(0)" ::: "memory"); if (lane == 0) flg[1] = j_ + 1; \
            _Pragma("unroll") for (int t = 0; t < 4; ++t) { f32x4 ay = (f32x4){blo(Q.yl[t].x), bhi(Q.yl[t].x), blo(Q.yl[t].y), bhi(Q.yl[t].y)}; \
                ay = __builtin_amdgcn_mfma_f32_16x16x32_bf16(__builtin_bit_cast(bf16x8, Q.qe[t][0]), __builtin_bit_cast(bf16x8, s0_), ay, 0, 0, 0); \
                ay = __builtin_amdgcn_mfma_f32_16x16x32_bf16(__builtin_bit_cast(bf16x8, Q.qe[t][1]), __builtin_bit_cast(bf16x8, s1_), ay, 0, 0, 0); \
                _Pragma("unroll") for (int qq = 0; qq < 4; ++qq) Yc_[(ptrdiff_t)((16 * t + qq) * sgs) * 512] = ay[qq]; } \
            { const int jn_ = j_ + 3 < NCH ? j_ + 3 : NCH - 1; seq_load_y(Q, CH0 + (size_t)jn_ * 8 * 16384, vs, lane); } } while (0)
        for (int j = 0; j < NCH; j += 3) { SEQ_Y_STEP(q0, j); SEQ_Y_STEP(q1, j + 1); SEQ_Y_STEP(q2, j + 2); }
#undef SEQ_Y_STEP
    }
}

struct S5Disc { float ar, ai; float br[16], bi[16]; };
__device__ __forceinline__ void s5_disc(const Params& p, int l, int d, int g, int lane, S5Disc& q) {
    const int gi = (l * 2 + d) * 32 + g; const size_t pi = (size_t)gi * 64 + lane;
    const float lr = fminf(p.in[I_LRE][pi], -1e-4f), li = p.in[I_LIM][pi], dt = __expf(p.in[I_LDT][gi]);
    const float mag = __expf(lr * dt); float sn, cs; sincosf(li * dt, &sn, &cs);
    q.ar = mag * cs; q.ai = mag * sn;
    const float den = lr * lr + li * li, xr = q.ar - 1.0f, cr = (xr * lr + q.ai * li) / den, ci = (q.ai * lr - xr * li) / den;
    const float* bre = p.in[I_BRE] + pi * 16; const float* bim = p.in[I_BIM] + pi * 16;
#pragma unroll
    for (int c = 0; c < 16; c += 4) { const f32x4 a = *(const f32x4*)(bre + c), b = *(const f32x4*)(bim + c);
#pragma unroll
        for (int j = 0; j < 4; ++j) { q.br[c + j] = cr * a[j] - ci * b[j]; q.bi[c + j] = cr * b[j] + ci * a[j]; } }
}
__device__ __forceinline__ void phase_s5_carry(const Params& p, int l, int lane, int wave) {
    unsigned char* ws = p.ws;
    const float2* XEND = (const float2*)(ws + WS_XEND); float2* CARRY = (float2*)(ws + WS_CARRY);
    const int gw = blockIdx.x * 8 + wave;
    if (gw >= 128) return;
    const int g = gw & 31, b = (gw >> 5) & 1, d = gw >> 6;
    const int gi = (l * 2 + d) * 32 + g; const size_t pi = (size_t)gi * 64 + lane;
    const float lr = fminf(p.in[I_LRE][pi], -1e-4f), li = p.in[I_LIM][pi], dt = __expf(p.in[I_LDT][gi]);
    const float mag = __expf(lr * dt); float sn, cs; sincosf(li * dt, &sn, &cs);
    float ar = mag * cs, ai = mag * sn;
#pragma unroll
    for (int i = 0; i < 6; ++i) { const float nr = ar * ar - ai * ai, ni = 2.0f * ar * ai; ar = nr; ai = ni; }
    const size_t base = ((size_t)((d * 2 + b) * NCH)) * 2048 + g * 64 + lane;
    float xr = 0.f, xi = 0.f;
    for (int j0 = 0; j0 < NCH; j0 += 12) {
        float2 e[12];
#pragma unroll
        for (int i = 0; i < 12; ++i) e[i] = XEND[base + (size_t)(j0 + i) * 2048];
#pragma unroll
        for (int i = 0; i < 12; ++i) { CARRY[base + (size_t)(j0 + i) * 2048] = make_float2(xr, xi); const float nr = ar * xr - ai * xi + e[i].x, ni = ar * xi + ai * xr + e[i].y; xr = nr; xi = ni; }
    }
}

__device__ __forceinline__ void phase_s5_tables(const Params& p, int l, int item2, int lane, LAS unsigned char* lds, int wave) {
    unsigned char* ws = p.ws;
    LAS bf16* es = (LAS bf16*)(lds + wave * 5120); LAS bf16* ksb = es + 2048;
    const int hm = item2 & 1, item = item2 >> 1;
    const int mr = item & 7, d = (item >> 3) & 1, g = item >> 4;
    const int gi = (l * 2 + d) * 32 + g; const size_t pi = (size_t)gi * 64 + lane;
    const float lr = fminf(p.in[I_LRE][pi], -1e-4f), li = p.in[I_LIM][pi], dt = __expf(p.in[I_LDT][gi]);
    S5Disc q; s5_disc(p, l, d, g, lane, q);
    float cre[16], cim[16];
    { const float* cr_ = p.in[I_CRE] + ((size_t)gi * 16) * 64 + lane; const float* ci_ = p.in[I_CIM] + ((size_t)gi * 16) * 64 + lane;
#pragma unroll
      for (int c = 0; c < 16; ++c) { cre[c] = cr_[c * 64]; cim[c] = ci_[c * 64]; } }
    bf16* Et = (bf16*)(ws + WS_S5E) + (size_t)(g * 2 + d) * 1024 * 128;
    bf16* Kt = (bf16*)(ws + WS_S5K) + (size_t)(g * 2 + d) * 72 * 256;
    if (mr == 0 && hm == 0) {
#pragma unroll
        for (int z = 0; z < 8; ++z) *(u32x2*)(Kt + z * 256 + lane * 4) = (u32x2){0u, 0u}; }
    const int m0 = 8 * mr + 4 * hm, m1 = (mr == 7 && hm == 1) ? 65 : m0 + 4;
    float pr, pim; { const float mg = __expf(lr * dt * (float)m0); float sn, cs; sincosf(li * dt * (float)m0, &sn, &cs); pr = mg * cs; pim = mg * sn; }
    for (int m = m0; m < m1; ++m) {
#pragma unroll 1
        for (int cp = 0; cp < 16; ++cp) {
            float c_r = 0.f, c_i = 0.f;
#pragma unroll
            for (int c = 0; c < 16; ++c) { c_r = (cp == c) ? cre[c] : c_r; c_i = (cp == c) ? cim[c] : c_i; }
            const float car = c_r * pr - c_i * pim, cai = c_r * pim + c_i * pr;
            if (m >= 1) {
                es[((lane >> 5) * 64 + ((lane >> 3) & 3) * 16 + cp) * 8 + (lane & 7)] = (bf16)f2bf(car);
                es[((2 + (lane >> 5)) * 64 + ((lane >> 3) & 3) * 16 + cp) * 8 + (lane & 7)] = (bf16)f2bf(-cai); }
            if (m <= 63) {
                float vals[16];
#pragma unroll
                for (int c = 0; c < 16; ++c) vals[c] = car * q.br[c] - cai * q.bi[c];
                { const bool hi = (lane & 32) != 0;
#pragma unroll
                  for (int i = 0; i < 8; ++i) { const float send = hi ? vals[i] : vals[i + 8], keep = hi ? vals[i + 8] : vals[i]; vals[i] = keep + __shfl_xor(send, 32); } }
                { const bool hi = (lane & 16) != 0;
#pragma unroll
                  for (int i = 0; i < 4; ++i) { const float send = hi ? vals[i] : vals[i + 4], keep = hi ? vals[i + 4] : vals[i]; vals[i] = keep + __shfl_xor(send, 16); } }
                { const bool hi = (lane & 8) != 0;
#pragma unroll
                  for (int i = 0; i < 2; ++i) { const float send = hi ? vals[i] : vals[i + 2], keep = hi ? vals[i + 2] : vals[i]; vals[i] = keep + __shfl_xor(send, 8); } }
                { const bool hi = (lane & 4) != 0; const float send = hi ? vals[0] : vals[1], keep = hi ? vals[1] : vals[0]; vals[0] = keep + __shfl_xor(send, 4); }
                vals[0] += __shfl_xor(vals[0], 2); vals[0] += __shfl_xor(vals[0], 1);
                if ((lane & 3) == 0) ksb[cp * 16 + (lane >> 2)] = (bf16)f2bf(vals[0]);
            }
        }
        asm volatile("s_waitcnt lgkmcnt(0)" ::: "memory");
        if (m >= 1) { bf16* eb = Et + (size_t)(m - 1) * 4 * 512;
#pragma unroll
            for (int qd = 0; qd < 4; ++qd) { const u32x4 v_ = *(const LAS u32x4*)(es + (qd * 64 + lane) * 8); *(u32x4*)(eb + (qd * 64 + lane) * 8) = v_; } }
        if (m <= 63 && lane < 32) { const u32x4 v_ = *(const LAS u32x4*)(ksb + lane * 8); *(u32x4*)(Kt + (size_t)(m + 8) * 256 + lane * 8) = v_; }
        asm volatile("s_waitcnt lgkmcnt(0)" ::: "memory");
        const float nr = pr * q.ar - pim * q.ai, ni = pr * q.ai + pim * q.ar; pr = nr; pim = ni;
    }
    { bf16* BP = (bf16*)(ws + WS_S5BP) + (size_t)(g * 2 + d) * 128 * 1024;
      for (int j = 8 * mr + 4 * hm; j < 8 * mr + 4 * hm + 4; ++j) { const float pw = (float)(d ? j : 63 - j); const float mg = __expf(lr * dt * pw); float sn, cs; sincosf(li * dt * pw, &sn, &cs); const float xr = mg * cs, xi = mg * sn;
          float re[16], im[16];
#pragma unroll
          for (int c = 0; c < 16; ++c) { re[c] = xr * q.br[c] - xi * q.bi[c]; im[c] = xr * q.bi[c] + xi * q.br[c]; }
          u32x4 o; bf16* fb = BP + (size_t)(j >> 1) * 8 * 512;
          bf16* dr = fb + ((size_t)(lane >> 4) * 64 + ((j & 1) * 2) * 16 + (lane & 15)) * 8; bf16* di = fb + ((size_t)(4 + (lane >> 4)) * 64 + ((j & 1) * 2) * 16 + (lane & 15)) * 8;
          o.x = cvtpk(re[0], re[1]); o.y = cvtpk(re[2], re[3]); o.z = cvtpk(re[4], re[5]); o.w = cvtpk(re[6], re[7]); *(u32x4*)dr = o;
          o.x = cvtpk(re[8], re[9]); o.y = cvtpk(re[10], re[11]); o.z = cvtpk(re[12], re[13]); o.w = cvtpk(re[14], re[15]); *(u32x4*)(dr + 128) = o;
          o.x = cvtpk(im[0], im[1]); o.y = cvtpk(im[2], im[3]); o.z = cvtpk(im[4], im[5]); o.w = cvtpk(im[6], im[7]); *(u32x4*)di = o;
          o.x = cvtpk(im[8], im[9]); o.y = cvtpk(im[10], im[11]); o.z = cvtpk(im[12], im[13]); o.w = cvtpk(im[14], im[15]); *(u32x4*)(di + 128) = o; } }
}
__device__ __forceinline__ int row_tb(int tb, int t) { const int b = tb >= NCH ? 1 : 0, k = tb - b * NCH; return k < 4 ? NLAT + b * CTXL + 64 * k + t : b * SEQ + 64 * (k - 4) + t; }
__device__ __forceinline__ bf16x8 s5_ufrag(const bf16* Ug, int ct, int j0, int r, int g4) { return *(const bf16x8*)(Ug + ((size_t)(j0 + (g4 >> 1)) * (2 * NCH) + 16 * ct + r) * 16 + 8 * (g4 & 1)); }
__device__ __forceinline__ void phase_s5_end(const Params& p, int lane, int wave) {
    unsigned char* ws = p.ws;
    float2* XEND = (float2*)(ws + WS_XEND);
    const int r = lane & 15, g4 = lane >> 4;
    for (int it = blockIdx.x * 8 + wave; it < 32 * 17 * 2; it += gridDim.x * 8) {
        const int d = it & 1, ct = (it >> 1) % 17, g = (it >> 1) / 17;
        const int tb = 16 * ct + r, tbc = tb < 2 * NCH ? tb : 2 * NCH - 1; const bool valid = tb < 2 * NCH;
        const int b = tbc >= NCH ? 1 : 0, k = tbc - b * NCH;
        const bf16* Ug = (const bf16*)(ws + WS_U) + (size_t)g * 64 * (2 * NCH) * 16;
        const bf16* BPf = (const bf16*)(ws + WS_S5BP) + (size_t)(g * 2 + d) * 128 * 1024 + lane * 8;
        f32x4 acc[8];
#pragma unroll
        for (int rt = 0; rt < 8; ++rt) acc[rt] = (f32x4){0.f, 0.f, 0.f, 0.f};
#pragma unroll 1
        for (int kb = 0; kb < 32; kb += 4) {
            bf16x8 bu[4];
#pragma unroll
            for (int i = 0; i < 4; ++i) bu[i] = s5_ufrag(Ug, ct, 2 * (kb + i), r, g4);
            bf16x8 a[4][8];
#pragma unroll
            for (int i = 0; i < 4; ++i)
#pragma unroll
                for (int rt = 0; rt < 8; ++rt) a[i][rt] = *(const bf16x8*)(BPf + ((size_t)(kb + i) * 8 + rt) * 512);
            asm volatile("" : "+v"(acc[0]), "+v"(acc[1]), "+v"(acc[2]), "+v"(acc[3]), "+v"(acc[4]), "+v"(acc[5]), "+v"(acc[6]), "+v"(acc[7]) :: "memory");
#pragma unroll
            for (int i = 0; i < 4; ++i)
#pragma unroll
                for (int rt = 0; rt < 8; ++rt) acc[rt] = __builtin_amdgcn_mfma_f32_16x16x32_bf16(a[i][rt], bu[i], acc[rt], 0, 0, 0);
            asm volatile("" ::: "memory");
        }
        if (valid) { const int js = d ? (k < 4 ? 3 - k : NCH + 3 - k) : k;
            float2* xe = XEND + ((size_t)((d * 2 + b) * NCH + js)) * 2048 + g * 64;
#pragma unroll
            for (int rt = 0; rt < 4; ++rt)
#pragma unroll
                for (int q = 0; q < 4; ++q) xe[16 * rt + 4 * g4 + q] = make_float2(acc[rt][q], acc[rt + 4][q]); }
    }
}
__device__ __forceinline__ void phase_s5_out(const Params& p, int l, LAS unsigned char* lds, int tid, int lane, int wave) {
    unsigned char* ws = p.ws;
    bf16* YG = (bf16*)(ws + WS_YG); const float2* CARRY = (const float2*)(ws + WS_CARRY);
    const int r = lane & 15, g4 = lane >> 4;
    for (int gb = blockIdx.x; gb < 256; gb += gridDim.x) {
        const int g = (gridDim.x == 256) ? ((gb & 7) * 4 + (gb >> 6)) : (gb >> 3), tg = (gridDim.x == 256) ? ((gb >> 3) & 7) : (gb & 7);
        __syncthreads();
        { const u32x4* src = (const u32x4*)((const bf16*)(ws + WS_S5K) + (size_t)g * 2 * 72 * 256);
          { u32x4 tk_[9];
#pragma unroll
            for (int q = 0; q < 9; ++q) tk_[q] = src[tid + 512 * q];
#pragma unroll
            for (int q = 0; q < 9; ++q) ((LAS u32x4*)lds)[tid + 512 * q] = tk_[q]; }
          const u32x4* e0s = (const u32x4*)((const bf16*)(ws + WS_S5E) + (size_t)(g * 2) * 1024 * 128 + (size_t)(8 * tg) * 4 * 512);
          const u32x4* e1s = (const u32x4*)((const bf16*)(ws + WS_S5E) + (size_t)(g * 2 + 1) * 1024 * 128 + (size_t)(56 - 8 * tg) * 4 * 512);
          u32x4 t0_[4], t1_[4];
#pragma unroll
          for (int q = 0; q < 4; ++q) { t0_[q] = e0s[tid + 512 * q]; t1_[q] = e1s[tid + 512 * q]; }
#pragma unroll
          for (int q = 0; q < 4; ++q) { *(LAS u32x4*)(lds + 73728 + (tid + 512 * q) * 16) = t0_[q]; *(LAS u32x4*)(lds + 73728 + 32768 + (tid + 512 * q) * 16) = t1_[q]; } }
        __syncthreads();
        const bf16* Ug = (const bf16*)(ws + WS_U) + (size_t)g * 64 * (2 * NCH) * 16;
        for (int ct = wave; ct < 17; ct += 8) {
            const int tb = 16 * ct + r, tbc = tb < 2 * NCH ? tb : 2 * NCH - 1; const bool valid = tb < 2 * NCH;
            const int b = tbc >= NCH ? 1 : 0, k = tbc - b * NCH;
            bf16x8 xc[2][4];
#pragma unroll
            for (int d = 0; d < 2; ++d) { const int js = d ? (k < 4 ? 3 - k : NCH + 3 - k) : k;
                const float2* cp = CARRY + ((size_t)((d * 2 + b) * NCH + js)) * 2048 + g * 64;
#pragma unroll
                for (int ks = 0; ks < 4; ++ks) { const int p0 = 32 * (ks & 1) + 8 * g4; const f32x4* c4 = (const f32x4*)(cp + p0);
                    const f32x4 a = c4[0], b2 = c4[1], c2 = c4[2], d2 = c4[3]; u32x4 o;
                    if (ks < 2) { o.x = cvtpk(a[0], a[2]); o.y = cvtpk(b2[0], b2[2]); o.z = cvtpk(c2[0], c2[2]); o.w = cvtpk(d2[0], d2[2]); }
                    else { o.x = cvtpk(a[1], a[3]); o.y = cvtpk(b2[1], b2[3]); o.z = cvtpk(c2[1], c2[3]); o.w = cvtpk(d2[1], d2[3]); }
                    xc[d][ks] = __builtin_bit_cast(bf16x8, o); } }
            u32x2 uu8[8];
#pragma unroll
            for (int tt = 0; tt < 8; ++tt) uu8[tt] = *(const u32x2*)(Ug + ((size_t)(8 * tg + tt) * (2 * NCH) + tbc) * 16 + 4 * g4);
            f32x4 acc[8];
#pragma unroll
            for (int tt = 0; tt < 8; ++tt) acc[tt] = (f32x4){0.f, 0.f, 0.f, 0.f};
            bf16x8 bu[4], bn[4];
#pragma unroll
            for (int i = 0; i < 4; ++i) bu[i] = s5_ufrag(Ug, ct, (2 * i) & 63, r, g4);
            for (int jb = 0; jb <= 8 * tg + 6; jb += 8) {
                { const int jn = jb + 8 <= 8 * tg + 6 ? jb + 8 : jb;
#pragma unroll
                  for (int i = 0; i < 4; ++i) bn[i] = s5_ufrag(Ug, ct, (jn + 2 * i) & 63, r, g4); }
#pragma unroll
                for (int i = 0; i < 4; ++i) { const int j = jb + 2 * i + (g4 >> 1);
                    if (jb + 2 * i <= 8 * tg + 6) {
                    const LAS unsigned char* ab = lds + (8 * tg - j + 8) * 512 + r * 32 + (g4 & 1) * 16;
                    bf16x8 a8[8];
#pragma unroll
                    for (int tt = 0; tt < 8; ++tt) a8[tt] = *(const LAS bf16x8*)(ab + tt * 512);
                    asm volatile("" : "+v"(acc[0]), "+v"(acc[1]), "+v"(acc[2]), "+v"(acc[3]), "+v"(acc[4]), "+v"(acc[5]), "+v"(acc[6]), "+v"(acc[7]) :: "memory");
#pragma unroll
                    for (int tt = 0; tt < 8; ++tt) acc[tt] = __builtin_amdgcn_mfma_f32_16x16x32_bf16(a8[tt], bu[i], acc[tt], 0, 0, 0); }
                    asm volatile("" ::: "memory"); }
#pragma unroll
                for (int i = 0; i < 4; ++i) bu[i] = bn[i];
            }
#pragma unroll
            for (int i = 0; i < 4; ++i) bu[i] = s5_ufrag(Ug, ct, 8 * tg + 2 * i, r, g4);
            for (int jb = 8 * tg; jb <= 62; jb += 8) {
                { const int jn = jb + 8 <= 62 ? jb + 8 : jb;
#pragma unroll
                  for (int i = 0; i < 4; ++i) bn[i] = s5_ufrag(Ug, ct, jn + 2 * i, r, g4); }
#pragma unroll
                for (int i = 0; i < 4; ++i) { const int j = jb + 2 * i + (g4 >> 1);
                    if (jb + 2 * i + 1 >= 8 * tg) {
                    const LAS unsigned char* ab = lds + 36864 + (j - 8 * tg + 8) * 512 + r * 32 + (g4 & 1) * 16;
                    bf16x8 a8[8];
#pragma unroll
                    for (int tt = 0; tt < 8; ++tt) a8[tt] = *(const LAS bf16x8*)(ab - tt * 512);
                    asm volatile("" : "+v"(acc[0]), "+v"(acc[1]), "+v"(acc[2]), "+v"(acc[3]), "+v"(acc[4]), "+v"(acc[5]), "+v"(acc[6]), "+v"(acc[7]) :: "memory");
#pragma unroll
                    for (int tt = 0; tt < 8; ++tt) acc[tt] = __builtin_amdgcn_mfma_f32_16x16x32_bf16(a8[tt], bu[i], acc[tt], 0, 0, 0); }
                    asm volatile("" ::: "memory"); }
#pragma unroll
                for (int i = 0; i < 4; ++i) bu[i] = bn[i];
            }
            const f32x4 dsk = *(const f32x4*)(p.in[I_S5D] + l * 512 + g * 16 + 4 * g4);
#pragma unroll
            for (int tt = 0; tt < 8; ++tt) { const int t = 8 * tg + tt;
                const u32x2 uu = uu8[tt];
#pragma unroll
                for (int ks = 0; ks < 4; ++ks) {
                    const bf16x8 e0 = *(const LAS bf16x8*)(lds + 73728 + ((tt * 4 + ks) * 64 + lane) * 16), e1 = *(const LAS bf16x8*)(lds + 73728 + 32768 + (((7 - tt) * 4 + ks) * 64 + lane) * 16);
                    acc[tt] = __builtin_amdgcn_mfma_f32_16x16x32_bf16(e0, xc[0][ks], acc[tt], 0, 0, 0); acc[tt] = __builtin_amdgcn_mfma_f32_16x16x32_bf16(e1, xc[1][ks], acc[tt], 0, 0, 0); }
                const float uf[4] = {blo(uu.x), bhi(uu.x), blo(uu.y), bhi(uu.y)}; float o[4];
#pragma unroll
                for (int q = 0; q < 4; ++q) { const float ys = acc[tt][q] + dsk[q] * uf[q]; o[q] = ys * __builtin_amdgcn_rcpf(1.0f + __expf(-1.5957691216f * (ys + 0.044715f * ys * ys * ys))); }
                if (valid) { u32x2 w2; w2.x = cvtpk(o[0], o[1]); w2.y = cvtpk(o[2], o[3]); *(u32x2*)(YG + (size_t)row_tb(tbc, t) * 512 + g * 16 + 4 * g4) = w2; }
                if (tt & 1) asm volatile("" ::: "memory");
            }
        }
    }
}

__device__ __forceinline__ void phase_readout(const Params& p, int l, int lane, int wave, int blk, int nblk) {
    unsigned char* ws = p.ws;
    const bf16* V = (const bf16*)(ws + WS_V); const bf16* GD = (const bf16*)(ws + WS_GD); const float* BON = (const float*)(ws + WS_BONUS);
    const float* Y = (const float*)(ws + WS_Y);
    bf16* A2 = (bf16*)(ws + WS_A2);
    const int c = lane * 8, h = lane >> 3;
    const f32x4 lw0 = *(const f32x4*)(p.in[I_LNW] + l * 512 + c), lw1 = *(const f32x4*)(p.in[I_LNW] + l * 512 + c + 4), lb0 = *(const f32x4*)(p.in[I_LNB] + l * 512 + c), lb1 = *(const f32x4*)(p.in[I_LNB] + l * 512 + c + 4);
    const float lnw[8] = {lw0[0], lw0[1], lw0[2], lw0[3], lw1[0], lw1[1], lw1[2], lw1[3]}, lnb[8] = {lb0[0], lb0[1], lb0[2], lb0[3], lb1[0], lb1[1], lb1[2], lb1[3]};
    const int gw = blk * 8 + wave, NGW = nblk * 8;
#define RO_FETCH(r_, V8, Y0, Y1, G8, BN) do { const int rf_ = (r_); V8 = *(const u32x4*)(V + (size_t)rf_ * 512 + c); \
        _Pragma("unroll") for (int d = 0; d < 2; ++d) { const size_t o_ = ((size_t)d * T + rf_) * 512 + c; Y0[d] = *(const f32x4*)(Y + o_); Y1[d] = *(const f32x4*)(Y + o_ + 4); G8[d] = *(const u32x4*)(GD + o_); BN[d] = BON[((size_t)d * T + rf_) * 8 + h]; } } while (0)
    u32x4 v8n, g8n[2]; f32x4 y0n[2], y1n[2]; float bnn[2];
    if (gw < T) RO_FETCH(gw, v8n, y0n, y1n, g8n, bnn);
    for (int row = gw; row < T; row += NGW) {
        const u32x4 v8 = v8n; const u32x4 g8c[2] = {g8n[0], g8n[1]}; const f32x4 y0c[2] = {y0n[0], y0n[1]}, y1c[2] = {y1n[0], y1n[1]}; const float bnc[2] = {bnn[0], bnn[1]};
        asm volatile("" ::: "memory");
        RO_FETCH(row + NGW < T ? row + NGW : row, v8n, y0n, y1n, g8n, bnn);
        asm volatile("" ::: "memory");
        const float vf[8] = {blo(v8.x), bhi(v8.x), blo(v8.y), bhi(v8.y), blo(v8.z), bhi(v8.z), blo(v8.w), bhi(v8.w)};
        float out[8] = {0.f, 0.f, 0.f, 0.f, 0.f, 0.f, 0.f, 0.f};
#pragma unroll
        for (int d = 0; d < 2; ++d) {
            const f32x4 y0 = y0c[d], y1 = y1c[d]; const u32x4 g8 = g8c[d];
            const float y[8] = {y0[0], y0[1], y0[2], y0[3], y1[0], y1[1], y1[2], y1[3]};
            const float gf[8] = {blo(g8.x), bhi(g8.x), blo(g8.y), bhi(g8.y), blo(g8.z), bhi(g8.z), blo(g8.w), bhi(g8.w)};
            float sm = ((y[0] + y[1]) + (y[2] + y[3])) + ((y[4] + y[5]) + (y[6] + y[7]));
            sm += __shfl_xor(sm, 1); sm += __shfl_xor(sm, 2); sm += __shfl_xor(sm, 4);
            const float mean = sm * (1.0f / 64.0f); float q = 0.f;
#pragma unroll
            for (int i = 0; i < 8; ++i) { const float dv = y[i] - mean; q += dv * dv; }
            q += __shfl_xor(q, 1); q += __shfl_xor(q, 2); q += __shfl_xor(q, 4);
            const float rs = rsqrtf(q * (1.0f / 64.0f) + 64e-5f), bon = bnc[d];
#pragma unroll
            for (int i = 0; i < 8; ++i) out[i] += ((y[i] - mean) * rs * lnw[i] + lnb[i] + bon * vf[i]) * gf[i]; }
        u32x4 w; w.x = cvtpk(out[0], out[1]); w.y = cvtpk(out[2], out[3]); w.z = cvtpk(out[4], out[5]); w.w = cvtpk(out[6], out[7]);
        *(u32x4*)(A2 + (size_t)row * 1024 + c) = w;
    }
#undef RO_FETCH
}

enum { PH_PRO = 0, PH_NORM1, PH_GIN, PH_STREAM, PH_GLR, PH_S5A, PH_S5B, PH_CHUNK, PH_SEQ, PH_S5C, PH_READOUT, PH_GGLU, PH_GOUT, PH_NORM2, PH_GFUP, PH_GFDN, PH_NORM2M, PH_MPREP, PH_GMUP, PH_GMDN, PH_FINAL, N_PH };
template <int PH>
__device__ __forceinline__ void run_phase(const Params& p, int l, int e, LAS unsigned char* lds, int tid, int lane, int wave) {
    unsigned char* ws = p.ws; const int G = gridDim.x;
    const float* MODl = (const float*)(ws + WS_MOD) + (size_t)l * 3 * 6144;
    if constexpr (PH == PH_PRO) phase_prologue(p, lds, tid, lane, wave);
    if constexpr (PH == PH_NORM1) { if (l == 0) phase_norm(p, l, 0, true, false, lane, wave); else phase_norm(p, l, 0, false, false, lane, wave, 11, (const float*)(ws + WS_PARTF), (const float*)(ws + WS_MOD) + 2 * 6144 + 5120); }
    if constexpr (PH == PH_GIN) {
        pg8::Gemm g{(const bf16*)(ws + WS_H), (const bf16*)(ws + WS_WIN) + (size_t)l * DIN * 1024, T, DIN, 1024, 1024}; pg8::StaticOrder S; S.init(T, DIN, G, (int)blockIdx.x);
        pg8::EpiBf16<0> E{(bf16*)(ws + WS_P), DIN, nullptr, 0, 0, 1.f};
        pg8::gemm_phase<pg8::EpiBf16<0>, pg8::StaticOrder, true, true>(lds, g, S, E, tid); }
    if constexpr (PH == PH_STREAM) phase_stream_lr(p, l, lds, tid, lane, wave);
    if constexpr (PH == PH_CHUNK) phase_chunk(p, l, lds, tid, lane, wave);
    if constexpr (PH == PH_SEQ) { if (blockIdx.x >= 128) { const int item = (blockIdx.x - 128) * 8 + wave; for (int it2 = item; it2 < 1024; it2 += (G - 128) * 8) phase_s5_tables(p, l, it2, lane, lds, wave); } else phase_seq(p, lds, lane, wave); }
    if constexpr (PH == PH_S5A) phase_s5_end(p, lane, wave);
    if constexpr (PH == PH_S5B) { if (blockIdx.x < 16) phase_s5_carry(p, l, lane, wave); else phase_readout(p, l, lane, wave, (int)blockIdx.x - 16, G - 16); }
    if constexpr (PH == PH_S5C) phase_s5_out(p, l, lds, tid, lane, wave);
    if constexpr (PH == PH_GGLU) {
        const int Mr = l == 0 ? T : NLAT; pg8::Gemm g{(const bf16*)(ws + WS_YG), (const bf16*)(ws + WS_WGLU) + (size_t)l * 512 * 512, Mr, 512, 512, 512}; pg8::StaticOrder S; S.init(Mr, 512, G, (int)blockIdx.x);
        pg8::EpiGLU E{(const bf16*)(ws + WS_YG), (bf16*)(ws + WS_A2), p.in[I_GLUB] + l * 512};
        pg8::gemm_phase<pg8::EpiGLU, pg8::StaticOrder, true, true>(lds, g, S, E, tid);
        if (l == 1 && G > 128 && (int)blockIdx.x >= 128) phase_moe_cvt(p, lds, lane, wave, MOE_CVT_SPLIT, MOE_CVT_ITEMS, ((int)blockIdx.x - 128) * 8 + wave, (G - 128) * 8); }
    if constexpr (PH == PH_GOUT) {
        { pg8::Gemm g{(const bf16*)(ws + WS_A2), (const bf16*)(ws + WS_WOUT) + (size_t)l * 1024 * 1024, NLAT, 1024, 1024, 1024}; pg8::StaticOrder S; S.init(NLAT, 1024, G, (int)blockIdx.x);
          pg8::EpiRes E{(float*)(ws + WS_X), MODl + 2048, nullptr, 0};
          pg8::gemm_phase<pg8::EpiRes, pg8::StaticOrder, true, true>(lds, g, S, E, tid); }
        if (l == 0) {
            pg8::Gemm g{(const bf16*)(ws + WS_A2), (const bf16*)(ws + WS_WOUT), NCTX, 1024, 256, 1024}; pg8::GroupOrder S;
#pragma unroll
            for (int q = 0; q < 9; ++q) S.toff[q] = q == 0 ? 0 : (1 << 20);
            S.t0 = NLAT / 256; S.a0 = 0; S.o0 = 0; S.nNr = 4; S.kslice = 256; S.init(NCTX, 1024 * 4, G, (int)blockIdx.x);
            pg8::EpiPartF32 E{(float*)(ws + WS_PARTO), NLAT, NCTX, 256};
            pg8::gemm_phase<pg8::EpiPartF32, pg8::GroupOrder, true, true>(lds, g, S, E, tid); }
    }
    if constexpr (PH == PH_NORM2) phase_norm(p, l, 1, false, false, lane, wave, 4, (const float*)(ws + WS_PARTO), (const float*)(ws + WS_MOD) + 2 * 6144 + 2048);
    if constexpr (PH == PH_GFUP) {
        pg8::Gemm g{(const bf16*)(ws + WS_H), (const bf16*)(ws + WS_WFUP), T, 2 * DFF, 1024, 1024}; pg8::StaticOrder S; S.init(T, 2 * DFF, G, (int)blockIdx.x);
        pg8::EpiSwiGLU E{(bf16*)(ws + WS_ACT), DFF};
        pg8::gemm_phase<pg8::EpiSwiGLU, pg8::StaticOrder, true, true>(lds, g, S, E, tid); }
    if constexpr (PH == PH_GFDN) {
        { pg8::Gemm g{(const bf16*)(ws + WS_ACT), (const bf16*)(ws + WS_WFDN), NLAT, 1024, DFF, DFF}; pg8::StaticOrder S; S.init(NLAT, 1024, G, (int)blockIdx.x);
          pg8::EpiRes E{(float*)(ws + WS_X), MODl + 5120, nullptr, 0};
          pg8::gemm_phase<pg8::EpiRes, pg8::StaticOrder, true, true>(lds, g, S, E, tid); }
        {
            pg8::Gemm g{(const bf16*)(ws + WS_ACT), (const bf16*)(ws + WS_WFDN), NCTX, 1024, 256, DFF}; pg8::GroupOrder S;
#pragma unroll
            for (int q = 0; q < 9; ++q) S.toff[q] = q == 0 ? 0 : (1 << 20);
            S.t0 = NLAT / 256; S.a0 = 0; S.o0 = 0; S.nNr = 4; S.kslice = 256; S.init(NCTX, 1024 * 11, G, (int)blockIdx.x);
            pg8::EpiPartF32 E{(float*)(ws + WS_PARTF), NLAT, NCTX, 256};
            pg8::gemm_phase<pg8::EpiPartF32, pg8::GroupOrder, true, true>(lds, g, S, E, tid); }
    }
    if constexpr (PH == PH_NORM2M) { phase_norm2_moe(p, lds, tid, lane, wave); phase_moe_cvt(p, lds, lane, wave, 0, G > 128 ? MOE_CVT_SPLIT : MOE_CVT_ITEMS, (int)blockIdx.x * 8 + wave, G * 8); }
    if constexpr (PH == PH_MPREP) phase_moe_prep(p, lds, tid, lane, wave);
    if constexpr (PH == PH_GMUP || PH == PH_GMDN) {
        const int* TOFF = (const int*)(ws + WS_TOFF);
        pg8::GroupOrder S;
#pragma unroll
        for (int q = 0; q < 9; ++q) S.toff[q] = __builtin_amdgcn_readfirstlane(TOFF[q]);
        const int nT = S.toff[8];
        const int t0 = e * MOE_PASS_TILES; int nt = e == 0 ? (nT < 64 ? nT : 64) : (nT > 64 ? nT - 64 : 0);
        S.t0 = t0;
        if constexpr (PH == PH_GMUP) {
            S.a0 = 0; S.o0 = t0; S.nNr = 2 * DFE / 256; S.kslice = 0; S.init(nt * 256, 2 * DFE, G, (int)blockIdx.x);
            pg8::Gemm g{(const bf16*)(ws + WS_APERM) + (size_t)t0 * 256 * 1024, (const bf16*)(ws + WS_WMUP), nt * 256, 2 * DFE, 1024, 1024};
            S.a0 = t0;
            pg8::EpiSwiGLU E{(bf16*)(ws + WS_ACT1), DFE};
            pg8::gemm_phase<pg8::EpiSwiGLU, pg8::GroupOrder, true, true>(lds, g, S, E, tid);
        } else {
            {
                const int ntA = nt < 64 ? nt : 64;
                S.a0 = t0; S.o0 = 0; S.nNr = 4; S.kslice = 0; S.init(ntA * 256, 1024, G, (int)blockIdx.x);
                pg8::Gemm g{(const bf16*)(ws + WS_ACT1), (const bf16*)(ws + WS_WMDN), ntA * 256, 1024, DFE, DFE};
                pg8::EpiBf16<0> E{(bf16*)(ws + WS_APERM), 1024, nullptr, 0, 0, 1.f};
                pg8::gemm_phase<pg8::EpiBf16<0>, pg8::GroupOrder, true, true>(lds, g, S, E, tid); }
            if (e == 1 && nT > 128) {
                S.t0 = 128; S.a0 = 64; S.o0 = 0; S.nNr = 4; S.kslice = DFE / 7; S.init((nT - 128) * 256, 1024 * 7, G, (int)blockIdx.x);
                pg8::Gemm g{(const bf16*)(ws + WS_ACT1), (const bf16*)(ws + WS_WMDN), (nT - 128) * 256, 1024, DFE / 7, DFE};
                pg8::EpiPartBf16 E{(bf16*)(ws + WS_PARTM), 128 * 256, 8 * 256, DFE / 7};
                pg8::gemm_phase<pg8::EpiPartBf16, pg8::GroupOrder, true, true>(lds, g, S, E, tid); }
        }
    }
    if constexpr (PH == PH_FINAL) phase_final(p, lane, wave);
}
template <int PH>
__global__ void __launch_bounds__(512, 2) k_ph(Params p, int l, int e) {
    extern __shared__ __attribute__((aligned(16))) unsigned char lds_raw[];
    LAS unsigned char* lds = (LAS unsigned char*)lds_raw;
    const int tid = threadIdx.x, lane = tid & 63, wave = __builtin_amdgcn_readfirstlane(tid >> 6);
    run_phase<PH>(p, l, e, lds, tid, lane, wave);
}

#ifndef MK_MULTI
#define MK_FUSED 1
#endif
#ifdef MK_FUSED
#ifndef MK_LOOP_L
#define MK_LOOP_L 0
#endif
__global__ void __launch_bounds__(512, 2) fwd_fused(Params p) {
    extern __shared__ __attribute__((aligned(16))) unsigned char lds_raw[];
    LAS unsigned char* lds = (LAS unsigned char*)lds_raw;
    const int tid = threadIdx.x, lane = tid & 63, wave = __builtin_amdgcn_readfirstlane(tid >> 6);
    volatile LAS unsigned* MISC = (volatile LAS unsigned*)(lds + MISC_OFF);
    if (tid < 32) MISC[tid] = 0u;
    __syncthreads();
    XcdBarrier bar = xcd_barrier_post((unsigned*)(p.ws + WS_CTL) + 4096, MISC + 8);
#define PHASE(PH, l, e) do { int t_ = threadIdx.x; asm volatile("" : "+v"(t_)); run_phase<PH>(p, l, e, lds, t_, t_ & 63, __builtin_amdgcn_readfirstlane(t_ >> 6)); xcd_barrier(bar); } while (0)
    PHASE(PH_PRO, 0, 0);
#if MK_LOOP_L
    for (int l = 0; l < 2; ++l) {
        PHASE(PH_NORM1, l, 0); PHASE(PH_GIN, l, 0); PHASE(PH_STREAM, l, 0); PHASE(PH_GLR, l, 0); PHASE(PH_S5A, l, 0); PHASE(PH_S5B, l, 0); PHASE(PH_CHUNK, l, 0); PHASE(PH_SEQ, l, 0); PHASE(PH_S5C, l, 0);
        PHASE(PH_READOUT, l, 0); PHASE(PH_GGLU, l, 0); PHASE(PH_GOUT, l, 0); PHASE(PH_NORM2, l, 0);
        if (l == 0) { PHASE(PH_GFUP, 0, 0); PHASE(PH_GFDN, 0, 0); }
        else { PHASE(PH_MPREP, 1, 0); for (int e = 0; e < 2; ++e) { PHASE(PH_GMUP, 1, e); PHASE(PH_GMDN, 1, e); } }
    }
#else
    PHASE(PH_NORM1, 0, 0); PHASE(PH_GIN, 0, 0); PHASE(PH_STREAM, 0, 0); PHASE(PH_CHUNK, 0, 0); PHASE(PH_SEQ, 0, 0); PHASE(PH_S5A, 0, 0); PHASE(PH_S5B, 0, 0); PHASE(PH_S5C, 0, 0);
    PHASE(PH_GGLU, 0, 0); PHASE(PH_GOUT, 0, 0); PHASE(PH_NORM2, 0, 0); PHASE(PH_GFUP, 0, 0); PHASE(PH_GFDN, 0, 0);
    PHASE(PH_NORM1, 1, 0); PHASE(PH_GIN, 1, 0); PHASE(PH_STREAM, 1, 0); PHASE(PH_CHUNK, 1, 0); PHASE(PH_SEQ, 1, 0); PHASE(PH_S5A, 1, 0); PHASE(PH_S5B, 1, 0); PHASE(PH_S5C, 1, 0);
    PHASE(PH_GGLU, 1, 0); PHASE(PH_GOUT, 1, 0); PHASE(PH_NORM2M, 1, 0); PHASE(PH_MPREP, 1, 0);
    for (int e = 0; e < 2; ++e) { PHASE(PH_GMUP, 1, e); PHASE(PH_GMDN, 1, e); }
#endif
    { int t_ = threadIdx.x; asm volatile("" : "+v"(t_)); run_phase<PH_FINAL>(p, 0, 0, lds, t_, t_ & 63, __builtin_amdgcn_readfirstlane(t_ >> 6)); }
#undef PHASE
}
#endif
}

#ifndef MK_FUSED
template <int PH> static void launch_ph(const mk::Params& a, int l, int e, int grid, hipStream_t stream) {
    static bool attr = false;
    if (!attr) { (void)hipFuncSetAttribute((const void*)mk::k_ph<PH>, hipFuncAttributeMaxDynamicSharedMemorySize, mk::LDS_BYTES); attr = true; }
    hipLaunchKernelGGL((mk::k_ph<PH>), dim3(grid), dim3(512), mk::LDS_BYTES, stream, a, l, e);
}
#endif
extern "C" void kernel_launch(void* const* d_in, const int* in_sizes, int n_in, void* d_out, int out_size, void* d_ws, size_t ws_size, hipStream_t stream) {
    using namespace mk;
    static int grid = 0;
    if (grid == 0) {
        if (n_in != N_IN || in_sizes[0] != NLAT * D || out_size != NLAT * D || ws_size < WS_END) { fprintf(stderr, "kernel_launch: unexpected shapes (n_in %d, ws %zu < %zu?)\n", n_in, ws_size, (size_t)WS_END); grid = -1; return; }
        int dev = 0, cus = 0;
        if (hipGetDevice(&dev) != hipSuccess || hipDeviceGetAttribute(&cus, hipDeviceAttributeMultiprocessorCount, dev) != hipSuccess) { grid = -1; return; }
        grid = cus;
    }
    if (grid < 0) return;
    (void)hipMemsetAsync((char*)d_ws + WS_CTL, 0, CTL_ZERO_BYTES, stream);
    Params a{};
    for (int i = 0; i < N_IN; ++i) a.in[i] = (const float*)d_in[i];
    a.out = (float*)d_out; a.ws = (unsigned char*)d_ws; a.lo = 0; a.hi = 0;
#ifdef MK_FUSED
    { static bool attr = false; if (!attr) { (void)hipFuncSetAttribute((const void*)fwd_fused, hipFuncAttributeMaxDynamicSharedMemorySize, LDS_BYTES); attr = true; }
      hipLaunchKernelGGL(fwd_fused, dim3(grid), dim3(512), LDS_BYTES, stream, a); return; }
#endif
#ifndef MK_FUSED
    launch_ph<PH_PRO>(a, 0, 0, grid, stream);
    for (int l = 0; l < 2; ++l) {
        launch_ph<PH_NORM1>(a, l, 0, grid, stream); launch_ph<PH_GIN>(a, l, 0, grid, stream); launch_ph<PH_STREAM>(a, l, 0, grid, stream);
        launch_ph<PH_CHUNK>(a, l, 0, grid, stream); launch_ph<PH_SEQ>(a, l, 0, grid, stream); launch_ph<PH_S5A>(a, l, 0, grid, stream); launch_ph<PH_S5B>(a, l, 0, grid, stream); launch_ph<PH_S5C>(a, l, 0, grid, stream);
        launch_ph<PH_GGLU>(a, l, 0, grid, stream); launch_ph<PH_GOUT>(a, l, 0, grid, stream); if (l == 0) launch_ph<PH_NORM2>(a, l, 0, grid, stream); else launch_ph<PH_NORM2M>(a, l, 0, grid, stream);
        if (l == 0) { launch_ph<PH_GFUP>(a, l, 0, grid, stream); launch_ph<PH_GFDN>(a, l, 0, grid, stream); }
        else { launch_ph<PH_MPREP>(a, l, 0, grid, stream); for (int e = 0; e < 2; ++e) { launch_ph<PH_GMUP>(a, l, e, grid, stream); launch_ph<PH_GMDN>(a, l, e, grid, stream); } }
    }
    launch_ph<PH_FINAL>(a, 0, 0, grid, stream);
#endif
}
```

```cpp
#include <hip/hip_runtime.h>
#include <cstdio>
#include <cstdint>
namespace pg8 {
#define PG8_LAS __attribute__((address_space(3)))
typedef unsigned short bf16_t;
typedef short bf16x8 __attribute__((ext_vector_type(8)));
typedef float f32x4 __attribute__((ext_vector_type(4)));
typedef unsigned u32x4 __attribute__((ext_vector_type(4)));
constexpr int BM = 256, BK = 64, HALF = 128, HTB = HALF * BK * 2  , STAGE_BYTES = 8 * HTB, NXCD = 8, WGM = 8;

__host__ __device__ __forceinline__ int lds_byte(int r, int c) { const int st = (r >> 4) * 2 + (c >> 5), rr = r & 15, cc = c & 31, ob = rr * 64 + cc * 2; return st * 1024 + (ob ^ (((ob >> 9) & 1) << 5)); }
__host__ __device__ __forceinline__ void stage_rc(int b, int& R, int& C) { const int st = b / 1024, sb = b % 1024, swz = sb ^ (((sb >> 9) & 1) << 5); R = (st >> 1) * 16 + swz / 64; C = (st & 1) * 32 + (swz % 64) / 2; }
__host__ __device__ __forceinline__ int perm32(int rho) { const int n = rho >> 4, i = rho & 15; return 8 * (i >> 2) + 4 * n + (i & 3); }

struct Unit { int pm, pn, pa, pb, po, ko; };
struct Gemm { const bf16_t* A; const bf16_t* Bt; int M, N, K, ld; };

struct StaticOrder {
    int nM, nN, nwg, G, c;
    __host__ __device__ void init(int M, int N, int G_, int c_) { nM = M / BM; nN = N / BM; nwg = nM * nN; G = G_; c = c_; }
    __host__ __device__ bool next(int i, Unit& u) const {
        const long L = (long)i * G + c; if (L >= nwg) return false;
        int wgid = (int)L; { const int q = nwg / NXCD, r = nwg % NXCD, xcd = wgid % NXCD, off = wgid / NXCD; wgid = (xcd < r ? xcd * (q + 1) : r * (q + 1) + (xcd - r) * q) + off; }
        const int nig = WGM * nN, gid = wgid / nig, fm = gid * WGM, gsz = (nM - fm) < WGM ? (nM - fm) : WGM;
        u.pm = fm + ((wgid % nig) % gsz); u.pn = (wgid % nig) / gsz; u.pa = u.pm; u.pb = u.pn; u.po = u.pm; u.ko = 0; return true;
    }
    __device__ __forceinline__ void a_ready(const Unit&) const {}
    __device__ __forceinline__ void done(const Unit&) const {}
};

struct GroupOrder : StaticOrder {
    int t0, a0, o0, nNr, kslice; int toff[9];
    __device__ __forceinline__ bool next(int i, Unit& u) const {
        if (!StaticOrder::next(i, u)) return false;
        u.pm += t0; int e = 0;
#pragma unroll
        for (int q = 1; q < 8; ++q) e += (u.pm >= toff[q]) ? 1 : 0;
        const int ks = u.pn / nNr; u.pn -= ks * nNr; u.ko = ks * kslice;
        u.pa = u.pm - a0; u.po = u.pm - o0; u.pb = e * nNr + u.pn; return true;
    }
};
__device__ __forceinline__ unsigned cvt_pk_bf16(float lo, float hi) { unsigned r; asm volatile("v_cvt_pk_bf16_f32 %0, %1, %2" : "=v"(r) : "v"(lo), "v"(hi)); return r; }
typedef float f32x2 __attribute__((ext_vector_type(2)));
__device__ __forceinline__ f32x2 gelu_pk(f32x2 v) {
    const f32x2 av = __builtin_elementwise_abs(v), d = av * 0.2316418882f + 1.0f;
    f32x2 t; t.x = __builtin_amdgcn_rcpf(d.x); t.y = __builtin_amdgcn_rcpf(d.y);
    f32x2 q = t * 0.5307027145f + (-0.7265760135f); q = q * t + 0.7107068705f; q = q * t + (-0.142248368f); q = q * t + 0.127414796f; q = q * t;
    const f32x2 s = (v * v) * (-0.72134752044f);
    f32x2 e; e.x = __builtin_amdgcn_exp2f(s.x); e.y = __builtin_amdgcn_exp2f(s.y);
    const f32x2 m = v * (q * e), r = v - m;
    f32x2 o; o.x = v.x < 0.f ? m.x : r.x; o.y = v.y < 0.f ? m.y : r.y; return o;
}

template <int ACT  > struct EpiBf16 {
    static constexpr bool PERM = true, AFTER_DRAIN = false; static_assert(ACT == 0 || ACT == 1, "EpiBf16: ACT is 0 (none) or 1 (gelu_pk)");
    bf16_t* O; int ldc; const float* bias; int split_cols; size_t split_stride; float scale0;
    __device__ __forceinline__ void operator()(const f32x4 (&acc)[2][2][4][2], const Unit& u, int wr, int wc, int fr, int fq) const {
        const int row0 = u.pm * BM + wr * 64 + fr; int colt = u.pn * BM; bf16_t* base = O;
        float sc = 1.f; if (split_cols) { const int t = colt / split_cols; base += (size_t)t * split_stride; colt -= t * split_cols; if (t == 0) sc = scale0; }
        const int col0 = colt + wc * 32 + 8 * fq, bcol0 = u.pn * BM + wc * 32 + 8 * fq;
        f32x4 bv[2][2];
#pragma unroll
        for (int bj = 0; bj < 2; ++bj)
#pragma unroll
            for (int n = 0; n < 2; ++n) bv[bj][n] = bias ? *(const f32x4*)(bias + bcol0 + bj * HALF + 4 * n) : (f32x4){0.f, 0.f, 0.f, 0.f};
#pragma unroll
        for (int ai = 0; ai < 2; ++ai)
#pragma unroll
            for (int m = 0; m < 4; ++m) { bf16_t* rowp = base + (size_t)(row0 + ai * HALF + m * 16) * ldc + col0;
#pragma unroll
                for (int bj = 0; bj < 2; ++bj) { f32x4 v0 = acc[ai][bj][m][0] + bv[bj][0], v1 = acc[ai][bj][m][1] + bv[bj][1];
                    if (ACT == 1) { f32x2 a = gelu_pk((f32x2){v0[0], v0[1]}), b = gelu_pk((f32x2){v0[2], v0[3]}), c = gelu_pk((f32x2){v1[0], v1[1]}), d = gelu_pk((f32x2){v1[2], v1[3]});
                        v0 = (f32x4){a.x, a.y, b.x, b.y}; v1 = (f32x4){c.x, c.y, d.x, d.y}; }
                    v0 = v0 * sc; v1 = v1 * sc; u32x4 w; w.x = cvt_pk_bf16(v0[0], v0[1]); w.y = cvt_pk_bf16(v0[2], v0[3]); w.z = cvt_pk_bf16(v1[0], v1[1]); w.w = cvt_pk_bf16(v1[2], v1[3]);
                    *(u32x4*)(rowp + bj * HALF) = w; } }
    }
};

__device__ __forceinline__ float bf_lo(unsigned w) { return __uint_as_float(w << 16); }
__device__ __forceinline__ float bf_hi(unsigned w) { return __uint_as_float(w & 0xffff0000u); }
__device__ __forceinline__ float sigm(float x) { return 1.0f / (1.0f + __expf(-x)); }
constexpr int T_ROWS = 16896, N_LAT = 16384;
struct EpiGLU {
    static constexpr bool PERM = true, AFTER_DRAIN = false;
    const bf16_t* YG; bf16_t* A2; const float* bias;
    __device__ __forceinline__ void operator()(const f32x4 (&acc)[2][2][4][2], const Unit& u, int wr, int wc, int fr, int fq) const {
        const int row0 = u.pm * BM + wr * 64 + fr, cb = u.pn * BM + wc * 32 + 8 * fq;
#pragma unroll
        for (int ai = 0; ai < 2; ++ai)
#pragma unroll
            for (int m = 0; m < 4; ++m) { const int row = row0 + ai * HALF + m * 16;
#pragma unroll
                for (int bj = 0; bj < 2; ++bj) { const int c = cb + bj * HALF; const f32x4 v0 = acc[ai][bj][m][0], v1 = acc[ai][bj][m][1];
                    const float v[8] = {v0[0], v0[1], v0[2], v0[3], v1[0], v1[1], v1[2], v1[3]};
                    const u32x4 y8 = *(const u32x4*)(YG + (size_t)row * 512 + c);
                    const float yf[8] = {bf_lo(y8.x), bf_hi(y8.x), bf_lo(y8.y), bf_hi(y8.y), bf_lo(y8.z), bf_hi(y8.z), bf_lo(y8.w), bf_hi(y8.w)};
                    float s[8];
#pragma unroll
                    for (int j = 0; j < 8; ++j) s[j] = yf[j] * sigm(v[j] + bias[c + j]);
                    u32x4 w1; w1.x = cvt_pk_bf16(s[0], s[1]); w1.y = cvt_pk_bf16(s[2], s[3]); w1.z = cvt_pk_bf16(s[4], s[5]); w1.w = cvt_pk_bf16(s[6], s[7]);
                    *(u32x4*)(A2 + (size_t)row * 1024 + 512 + c) = w1; } }
    }
};
struct EpiRes {
    static constexpr bool PERM = false, AFTER_DRAIN = false;
    float* X; const float* gate; const float* comb; int e;
    __device__ __forceinline__ void operator()(const f32x4 (&acc)[2][2][4][2], const Unit& u, int wr, int wc, int fr, int fq) const {
        const int midx = (u.pm < 64) ? (u.pm >> 5) : 2; const float* gp = gate + midx * 6144;
        const int row0 = u.pm * BM + wr * 64 + fr, col0 = u.pn * BM + wc * 32 + 4 * fq;
        f32x4 gv[2][2];
#pragma unroll
        for (int bj = 0; bj < 2; ++bj)
#pragma unroll
            for (int n = 0; n < 2; ++n) gv[bj][n] = *(const f32x4*)(gp + col0 + bj * HALF + n * 16);
#pragma unroll
        for (int ai = 0; ai < 2; ++ai) {
            f32x4 xv[4][2][2]; float cf4[4];
#pragma unroll
            for (int m = 0; m < 4; ++m) { const int row = row0 + ai * HALF + m * 16; cf4[m] = comb ? comb[(size_t)row * 8 + e] : 1.0f; const float* rowp = X + (size_t)row * 1024 + col0;
#pragma unroll
                for (int bj = 0; bj < 2; ++bj)
#pragma unroll
                    for (int n = 0; n < 2; ++n) xv[m][bj][n] = *(const f32x4*)(rowp + bj * HALF + n * 16); }
#pragma unroll
            for (int m = 0; m < 4; ++m) { const int row = row0 + ai * HALF + m * 16; float* rowp = X + (size_t)row * 1024 + col0;
#pragma unroll
                for (int bj = 0; bj < 2; ++bj)
#pragma unroll
                    for (int n = 0; n < 2; ++n) *(f32x4*)(rowp + bj * HALF + n * 16) = xv[m][bj][n] + gv[bj][n] * acc[ai][bj][m][n] * cf4[m]; }
        }
    }
};
struct EpiSwiGLU {
    static constexpr bool PERM = true, AFTER_DRAIN = false;
    bf16_t* ACT; int ldc;
    __device__ __forceinline__ void operator()(const f32x4 (&acc)[2][2][4][2], const Unit& u, int wr, int wc, int fr, int fq) const {
        const int row0 = u.po * BM + wr * 64 + fr, c = u.pn * HALF + wc * 32 + 8 * fq;
#pragma unroll
        for (int ai = 0; ai < 2; ++ai)
#pragma unroll
            for (int m = 0; m < 4; ++m) { const int row = row0 + ai * HALF + m * 16;
                const f32x4 g0 = acc[ai][0][m][0], g1 = acc[ai][0][m][1], u0 = acc[ai][1][m][0], u1 = acc[ai][1][m][1];
                float s[8];
#pragma unroll
                for (int j = 0; j < 4; ++j) { s[j] = g0[j] * sigm(g0[j]) * u0[j]; s[4 + j] = g1[j] * sigm(g1[j]) * u1[j]; }
                u32x4 w1; w1.x = cvt_pk_bf16(s[0], s[1]); w1.y = cvt_pk_bf16(s[2], s[3]); w1.z = cvt_pk_bf16(s[4], s[5]); w1.w = cvt_pk_bf16(s[6], s[7]);
                *(u32x4*)(ACT + (size_t)row * ldc + c) = w1; }
    }
};


struct EpiPartF32 {
    static constexpr bool PERM = false, AFTER_DRAIN = false;
    float* PART; int row_base, rows, kslice;
    __device__ __forceinline__ void operator()(const f32x4 (&acc)[2][2][4][2], const Unit& u, int wr, int wc, int fr, int fq) const {
        const int ks = u.ko / kslice; float* P0 = PART + (size_t)ks * rows * 1024;
        const int row0 = u.pm * BM - row_base + wr * 64 + fr, col0 = u.pn * BM + wc * 32 + 4 * fq;
#pragma unroll
        for (int ai = 0; ai < 2; ++ai)
#pragma unroll
            for (int m = 0; m < 4; ++m) { float* rowp = P0 + (size_t)(row0 + ai * HALF + m * 16) * 1024 + col0;
#pragma unroll
                for (int bj = 0; bj < 2; ++bj)
#pragma unroll
                    for (int n = 0; n < 2; ++n) *(f32x4*)(rowp + bj * HALF + n * 16) = acc[ai][bj][m][n]; }
    }
};

struct EpiPartBf16 {
    static constexpr bool PERM = true, AFTER_DRAIN = false;
    bf16_t* PART; int row_base, rows, kslice;
    __device__ __forceinline__ void operator()(const f32x4 (&acc)[2][2][4][2], const Unit& u, int wr, int wc, int fr, int fq) const {
        const int ks = u.ko / kslice; bf16_t* P0 = PART + (size_t)ks * rows * 1024;
        const int row0 = u.pm * BM - row_base + wr * 64 + fr, col0 = u.pn * BM + wc * 32 + 8 * fq;
#pragma unroll
        for (int ai = 0; ai < 2; ++ai)
#pragma unroll
            for (int m = 0; m < 4; ++m) { bf16_t* rowp = P0 + (size_t)(row0 + ai * HALF + m * 16) * 1024 + col0;
#pragma unroll
                for (int bj = 0; bj < 2; ++bj) { const f32x4 v0 = acc[ai][bj][m][0], v1 = acc[ai][bj][m][1];
                    u32x4 w; w.x = cvt_pk_bf16(v0[0], v0[1]); w.y = cvt_pk_bf16(v0[2], v0[3]); w.z = cvt_pk_bf16(v1[0], v1[1]); w.w = cvt_pk_bf16(v1[2], v1[3]);
                    *(u32x4*)(rowp + bj * HALF) = w; } }
    }
};
template <class Epi, class Sched, bool ALIGN_EPI = false, bool SP2 = false>
__device__ __forceinline__ void gemm_phase(PG8_LAS unsigned char* lds, const Gemm g, const Sched& S, const Epi& E, const int tid) {
    const int wid = __builtin_amdgcn_readfirstlane(tid >> 6), lane = tid & 63, wr = wid >> 2, wc = wid & 3, fr = lane & 15, fq = lane >> 4;
    const int K = g.ld, nt = g.K / BK;
    unsigned voffA[2], voffB[2];
#pragma unroll
    for (int i = 0; i < 2; ++i) { int R, C; stage_rc(tid * 16 + i * 8192, R, C); const int Rb = Epi::PERM ? ((R & ~31) + perm32(R & 31)) : R;
        voffA[i] = (unsigned)(R * K + C) * 2u; voffB[i] = (unsigned)(Rb * K + C) * 2u; }
    const size_t kstep = (size_t)(BK * 2);
    const size_t hstep = (size_t)HALF * K * 2;
    const size_t tstep = 2 * hstep;
    const unsigned ldsw = (unsigned)wid * 1024u;
    const int aoff = lds_byte(wr * 64 + fr, fq * 8), boff = lds_byte(wc * 32 + fr, fq * 8);
#define PG8_SA(b, h) (((b) * 2 + (h)) * HTB)
#define PG8_SB(b, h) ((4 + (b) * 2 + (h)) * HTB)
#define PG8_STAGE(bufoff, gbase, voff) do { _Pragma("unroll") for (int _i = 0; _i < 2; ++_i) \
        __builtin_amdgcn_global_load_lds((const unsigned*)((const char*)(gbase) + (voff)[_i]), (PG8_LAS unsigned*)(lds + (bufoff) + ldsw + _i * 8192), 16, 0, 0); } while (0)
#define PG8_LDA(dst, b, h) do { _Pragma("unroll") for (int m = 0; m < 4; ++m) _Pragma("unroll") for (int k = 0; k < 2; ++k) dst[m][k] = *(const PG8_LAS bf16x8*)(lds + PG8_SA(b, h) + aoff + m * 2048 + k * 1024); } while (0)
#define PG8_LDB(dst, b, h) do { _Pragma("unroll") for (int n = 0; n < 2; ++n) _Pragma("unroll") for (int k = 0; k < 2; ++k) dst[n][k] = *(const PG8_LAS bf16x8*)(lds + PG8_SB(b, h) + boff + n * 2048 + k * 1024); } while (0)
#define PG8_MMA(ai, bj, At, Bt) do { __builtin_amdgcn_s_setprio(1); _Pragma("unroll") for (int m = 0; m < 4; ++m) _Pragma("unroll") for (int n = 0; n < 2; ++n) _Pragma("unroll") for (int k = 0; k < 2; ++k) \
        acc[ai][bj][m][n] = __builtin_amdgcn_mfma_f32_16x16x32_bf16(Bt[n][k], At[m][k], acc[ai][bj][m][n], 0, 0, 0); __builtin_amdgcn_s_setprio(0); } while (0)
#define PG8_WAIT_V(n) asm volatile("s_waitcnt vmcnt(" #n ")" ::: "memory")
#define PG8_WAIT_L(n) asm volatile("s_waitcnt lgkmcnt(" #n ")" ::: "memory")
#define PG8_BAR __builtin_amdgcn_s_barrier()
#define PG8_SCHED __builtin_amdgcn_sched_barrier(0)
    Unit cur, nxt; int ui = 0;
    if (!S.next(0, cur)) return;
    f32x4 acc[2][2][4][2];
#pragma unroll
    for (int a = 0; a < 2; ++a)
#pragma unroll
        for (int b = 0; b < 2; ++b)
#pragma unroll
            for (int m = 0; m < 4; ++m)
#pragma unroll
                for (int n = 0; n < 2; ++n) acc[a][b][m][n] = (f32x4){0.f, 0.f, 0.f, 0.f};
    bf16x8 At[4][2], B0[2][2], B1[2][2];
    const char* cA = (const char*)g.A + (size_t)cur.pa * tstep + (size_t)cur.ko * 2; const char* cB = (const char*)g.Bt + (size_t)cur.pb * tstep + (size_t)cur.ko * 2;
    S.a_ready(cur);
    if constexpr (SP2) {
        PG8_STAGE(PG8_SB(0, 0), cB, voffB); PG8_STAGE(PG8_SB(0, 1), cB + hstep, voffB); PG8_STAGE(PG8_SA(0, 0), cA, voffA); PG8_STAGE(PG8_SA(0, 1), cA + hstep, voffA);
        if (wr == 1) PG8_BAR;
        PG8_WAIT_V(2); PG8_BAR;
        PG8_STAGE(PG8_SB(1, 0), cB + kstep, voffB); PG8_STAGE(PG8_SA(1, 0), cA + kstep, voffA); PG8_STAGE(PG8_SB(1, 1), cB + hstep + kstep, voffB);
        PG8_WAIT_V(6); PG8_BAR;
    } else {
        PG8_STAGE(PG8_SB(0, 0), cB, voffB); PG8_STAGE(PG8_SA(0, 0), cA, voffA); PG8_STAGE(PG8_SB(0, 1), cB + hstep, voffB); PG8_STAGE(PG8_SA(0, 1), cA + hstep, voffA);
        if (wr == 1) PG8_BAR;
        PG8_WAIT_V(4); PG8_BAR;
        PG8_STAGE(PG8_SB(1, 0), cB + kstep, voffB); PG8_STAGE(PG8_SA(1, 0), cA + kstep, voffA); PG8_STAGE(PG8_SB(1, 1), cB + hstep + kstep, voffB);
        PG8_WAIT_V(6); PG8_BAR;
    }
    for (;;) {
        const bool has_next = S.next(ui + 1, nxt);
        const char* nA = has_next ? (const char*)g.A + (size_t)nxt.pa * tstep + (size_t)nxt.ko * 2 : cA; const char* nB = has_next ? (const char*)g.Bt + (size_t)nxt.pb * tstep + (size_t)nxt.ko * 2 : cB;
        for (int t = 0; t < nt; t += 2) {
            const bool last = (t == nt - 2);
            const char* a1 = cA + (size_t)(t + 1) * kstep;
            const char* a2 = last ? nA : cA + (size_t)(t + 2) * kstep; const char* b2 = last ? nB : cB + (size_t)(t + 2) * kstep;
            const char* a3 = a2 + kstep; const char* b3 = b2 + kstep;
            if (last && has_next) S.a_ready(nxt);
            if constexpr (SP2) {
            PG8_LDB(B0, 0, 0); PG8_LDB(B1, 0, 1); PG8_SCHED; PG8_LDA(At, 0, 0); PG8_STAGE(PG8_SA(1, 1), a1 + hstep, voffA);
            PG8_WAIT_V(8); PG8_WAIT_L(0); PG8_BAR; PG8_MMA(0, 0, At, B0); PG8_MMA(0, 1, At, B1); PG8_BAR; PG8_SCHED;
            PG8_LDA(At, 0, 1); PG8_STAGE(PG8_SB(0, 0), b2, voffB); PG8_STAGE(PG8_SB(0, 1), b2 + hstep, voffB); PG8_STAGE(PG8_SA(0, 0), a2, voffA);
            PG8_WAIT_V(8); PG8_WAIT_L(0); PG8_BAR; PG8_MMA(1, 0, At, B0); PG8_MMA(1, 1, At, B1); PG8_BAR; PG8_SCHED;
            PG8_LDB(B0, 1, 0); PG8_LDB(B1, 1, 1); PG8_SCHED; PG8_LDA(At, 1, 0); PG8_STAGE(PG8_SA(0, 1), a2 + hstep, voffA);
            PG8_WAIT_V(8); PG8_WAIT_L(0); PG8_BAR; PG8_MMA(0, 0, At, B0); PG8_MMA(0, 1, At, B1); PG8_BAR; PG8_SCHED;
            PG8_LDA(At, 1, 1); PG8_STAGE(PG8_SB(1, 0), b3, voffB); PG8_STAGE(PG8_SB(1, 1), b3 + hstep, voffB); PG8_STAGE(PG8_SA(1, 0), a3, voffA);
            PG8_WAIT_V(8); PG8_WAIT_L(0); PG8_BAR; PG8_MMA(1, 0, At, B0); PG8_MMA(1, 1, At, B1); PG8_BAR; PG8_SCHED;
            } else {
            PG8_LDB(B0, 0, 0); PG8_SCHED; PG8_LDA(At, 0, 0); PG8_STAGE(PG8_SA(1, 1), a1 + hstep, voffA);
            PG8_WAIT_L(8); PG8_BAR; PG8_WAIT_L(0); PG8_MMA(0, 0, At, B0); PG8_BAR; PG8_SCHED;
            PG8_LDB(B1, 0, 1); PG8_STAGE(PG8_SB(0, 0), b2, voffB);
            PG8_BAR; PG8_WAIT_L(0); PG8_MMA(0, 1, At, B1); PG8_BAR;
            PG8_LDA(At, 0, 1); PG8_STAGE(PG8_SA(0, 0), a2, voffA);
            PG8_BAR; PG8_WAIT_L(0); PG8_MMA(1, 0, At, B0); PG8_BAR; PG8_SCHED;
            PG8_STAGE(PG8_SB(0, 1), b2 + hstep, voffB);
            PG8_WAIT_V(6); PG8_BAR; PG8_MMA(1, 1, At, B1); PG8_BAR;
            PG8_LDB(B0, 1, 0); PG8_SCHED; PG8_LDA(At, 1, 0); PG8_STAGE(PG8_SA(0, 1), a2 + hstep, voffA);
            PG8_WAIT_L(8); PG8_BAR; PG8_WAIT_L(0); PG8_MMA(0, 0, At, B0); PG8_BAR; PG8_SCHED;
            PG8_LDB(B1, 1, 1); PG8_STAGE(PG8_SB(1, 0), b3, voffB);
            PG8_BAR; PG8_WAIT_L(0); PG8_MMA(0, 1, At, B1); PG8_BAR;
            PG8_LDA(At, 1, 1); PG8_STAGE(PG8_SA(1, 0), a3, voffA);
            PG8_BAR; PG8_WAIT_L(0); PG8_MMA(1, 0, At, B0); PG8_BAR; PG8_SCHED;
            PG8_STAGE(PG8_SB(1, 1), b3 + hstep, voffB);
            PG8_WAIT_V(6); PG8_BAR; PG8_MMA(1, 1, At, B1); PG8_BAR;
            }
        }
        if constexpr (ALIGN_EPI) { if (wr == 0) PG8_BAR; }
        if constexpr (!Epi::AFTER_DRAIN) { E(acc, cur, wr, wc, fr, fq); S.done(cur); }
        if (!has_next) break;
#pragma unroll
        for (int a = 0; a < 2; ++a)
#pragma unroll
            for (int b = 0; b < 2; ++b)
#pragma unroll
                for (int m = 0; m < 4; ++m)
#pragma unroll
                    for (int n = 0; n < 2; ++n) acc[a][b][m][n] = (f32x4){0.f, 0.f, 0.f, 0.f};
        cur = nxt; cA = nA; cB = nB; ++ui;
        if constexpr (ALIGN_EPI) { if (wr == 1) PG8_BAR; }
    }
    PG8_WAIT_V(0);
    if constexpr (!ALIGN_EPI) { if (wr == 0) PG8_BAR; }
    PG8_BAR;
    if constexpr (Epi::AFTER_DRAIN) { E.fused(acc, cur, wr, wc, fr, fq, lds, wid, lane); S.done(cur); }
#undef PG8_SA
#undef PG8_SB
#undef PG8_STAGE
#undef PG8_LDA
#undef PG8_LDB
#undef PG8_MMA
#undef PG8_WAIT_V
#undef PG8_WAIT_L
#undef PG8_BAR
#undef PG8_SCHED
}
}

namespace mk {
typedef unsigned short bf16;
typedef float f32x4 __attribute__((ext_vector_type(4)));
typedef unsigned u32x4 __attribute__((ext_vector_type(4)));
typedef unsigned u32x2 __attribute__((ext_vector_type(2)));
#define LAS __attribute__((address_space(3)))
constexpr int D = 1024, NB = 2, SEQ = 8192, CTXL = 256, NLAT = NB * SEQ, NCTX = NB * CTXL, T = NLAT + NCTX;
constexpr int DIN = 2560, DFF = 2816, NE = 8, DFE = 3584, SPOS = SEQ + CTXL  , NCH = SPOS / 64;
static_assert(T == pg8::T_ROWS && NLAT == pg8::N_LAT, "rows");
enum { I_X = 0, I_C, I_CTX, I_CCTX, I_ADAW, I_ADAB, I_N1G, I_N2G, I_WIN, I_WOUT, I_MU, I_W0, I_WUP, I_A0, I_AUP, I_GUP, I_KK, I_KA, I_RK, I_LNW, I_LNB,
       I_LRE, I_LIM, I_LDT, I_BRE, I_BIM, I_CRE, I_CIM, I_S5D, I_GLUW, I_GLUB, I_FG, I_FU, I_FD, I_ROUT, I_MG, I_MU2, I_MD, I_FING, N_IN };
constexpr size_t MiB = 1u << 20, QMiB = 1u << 18;
constexpr size_t WS_CTL = 0, CTL_ZERO_BYTES = 65536;
constexpr size_t WS_MOD = 1 * MiB;
constexpr size_t WS_COMB = 1 * MiB + 2 * QMiB;
constexpr size_t WS_WIN = 2 * MiB;
constexpr size_t WS_WOUT = 12 * MiB;
constexpr size_t WS_WGLU = 16 * MiB;
constexpr size_t WS_WLR = 17 * MiB;
constexpr size_t WS_WFUP = 23 * MiB;
constexpr size_t WS_WFDN = 34 * MiB;
constexpr size_t WS_X = 40 * MiB;
constexpr size_t WS_H = 106 * MiB;
constexpr size_t WS_LRIN = 106 * MiB;
constexpr size_t WS_U = 122 * MiB + 2 * QMiB;
constexpr size_t WS_P = 370 * MiB;
constexpr size_t WS_LW = 139 * MiB;
constexpr size_t WS_XEND = 205 * MiB;
constexpr size_t WS_CARRY = 213 * MiB + QMiB;
constexpr size_t WS_Y = 139 * MiB;
constexpr size_t WS_YG = 221 * MiB + 2 * QMiB;
constexpr size_t WS_BONUS = 106 * MiB;
constexpr size_t WS_R = 221 * MiB + 2 * QMiB, WS_V = 238 * MiB, WS_KKN = 254 * MiB + 2 * QMiB;
constexpr size_t WS_KT = 271 * MiB, WS_BB = 304 * MiB, WS_GD = 337 * MiB;
constexpr size_t WS_K = 370 * MiB;
constexpr size_t WS_PARTO = 370 * MiB;
constexpr size_t WS_PARTF = 380 * MiB;
constexpr size_t WS_CH = 370 * MiB;
constexpr size_t WS_S5E = 271 * MiB;
constexpr size_t WS_S5BP = 304 * MiB;
constexpr size_t WS_S5K = 287 * MiB;
constexpr size_t WS_A2 = 304 * MiB;
constexpr size_t WS_ACT = 221 * MiB + 2 * QMiB;
constexpr size_t WS_RE = 1 * MiB + 2 * QMiB;
constexpr size_t WS_RP = WS_RE + 65536;
constexpr size_t WS_SEGCNT = WS_RE + 131072;
constexpr size_t WS_PROW = WS_RE + 196608;
constexpr size_t WS_PGW = WS_PROW + 147456;
constexpr size_t WS_TOFF = WS_PGW + 147456;
constexpr size_t WS_PPOS = 1 * MiB + QMiB;
constexpr size_t WS_APERM = 139 * MiB;
constexpr size_t WS_ACT1 = 207 * MiB;
constexpr int MOE_PASS_TILES = 64, MOE_MAX_TILES = 136, MOE_ACT_TILES = 72;
constexpr size_t WS_PARTM = 2 * MiB;
static_assert(WS_TOFF + 64 <= 2 * MiB && WS_APERM + (size_t)MOE_MAX_TILES * 256 * 2048 <= WS_ACT1 && WS_ACT1 + (size_t)MOE_ACT_TILES * 256 * DFE * 2 <= 333 * MiB + 2 * QMiB, "moe ws map");
constexpr size_t WS_WMUP = 333 * MiB + 2 * QMiB;
constexpr size_t WS_WMDN = 445 * MiB + 2 * QMiB;
constexpr size_t WS_END = 502 * MiB;
constexpr int NCC = 2 * NB * NCH * 8;
static_assert(WS_CH + (size_t)NCC * 32768 <= WS_END && WS_WMDN + (size_t)8 * 1024 * 3584 * 2 <= WS_END && WS_ACT + (size_t)NLAT * DFE * 2 <= WS_WMUP && WS_GD + (size_t)2 * T * 512 * 2 <= WS_K, "ws map");
constexpr int LDS_BYTES = 147456, RING_BYTES = 131072, MISC_OFF = LDS_BYTES - 1024, LDS_GC = LDS_BYTES - 2048;

struct Params { const float* in[N_IN]; float* out; unsigned char* ws; int lo, hi; };
static_assert(sizeof(Params) == 8 * N_IN + 24, "no padding");

__device__ __forceinline__ float bf2f(bf16 v) { return __uint_as_float(((unsigned)v) << 16); }
__device__ __forceinline__ unsigned f2bf(float f) { unsigned u = __float_as_uint(f); return (u + 0x7fffu + ((u >> 16) & 1u)) >> 16; }
__device__ __forceinline__ unsigned pk2(float lo, float hi) { return f2bf(lo) | (f2bf(hi) << 16); }
__device__ __forceinline__ float blo(unsigned w) { return __uint_as_float(w << 16); }
__device__ __forceinline__ float bhi(unsigned w) { return __uint_as_float(w & 0xffff0000u); }
__device__ __forceinline__ float sigm(float x) { return 1.0f / (1.0f + __expf(-x)); }
__device__ __forceinline__ float wave_sum(float v) {
#pragma unroll
    for (int o = 1; o < 64; o <<= 1) v += __shfl_xor(v, o);
    return v;
}
#define LDS_WAIT() asm volatile("s_waitcnt lgkmcnt(0)" ::: "memory")
__device__ __forceinline__ int row_of(int b, int d, int s) {
    return s < CTXL ? NLAT + b * CTXL + (d ? CTXL - 1 - s : s) : b * SEQ + (d ? SEQ - 1 - (s - CTXL) : (s - CTXL));
}

#define XB_TMO      128
#define XB_XCNT(j)  (256  + 64 * (j))
#define XB_XSUB(j)  (1280 + 64 * (j))
#define XB_XGEN(j)  (2304 + 64 * (j))
#define XB_TOP      3328
#define XB_TOPGEN   3392
#define XCD_BAR_WORDS 3456
#define XB_SPIN_CAP (1u << 25)
__device__ __forceinline__ unsigned xb_ld(unsigned* p)              { return __hip_atomic_load(p, __ATOMIC_RELAXED, __HIP_MEMORY_SCOPE_AGENT); }
__device__ __forceinline__ unsigned xb_add(unsigned* p, unsigned v) { return __hip_atomic_fetch_add(p, v, __ATOMIC_RELAXED, __HIP_MEMORY_SCOPE_AGENT); }
__device__ __forceinline__ unsigned xb_xcc_id() { return (unsigned)__builtin_amdgcn_s_getreg((3 << 11) | 20) & 0xFu; }
#define XB_SPIN(cond, bar) do { unsigned _sp = 0; while (cond) { __builtin_amdgcn_s_sleep(1); \
    if ((++_sp & 255u) == 0u) { if (xb_ld(&(bar)[XB_TMO])) break; if (_sp > XB_SPIN_CAP) { atomicAdd(&(bar)[XB_TMO], 1u); break; } } } } while (0)
struct XcdBarrier { unsigned* bar; unsigned x; volatile LAS unsigned* st; };
__device__ __forceinline__ XcdBarrier xcd_barrier_post(unsigned* bar, volatile LAS unsigned* st) {
    XcdBarrier b; b.bar = bar; b.x = xb_xcc_id(); b.st = st;
    if (threadIdx.x == 0) (void)xb_add(&bar[XB_XCNT(b.x)], 1u);
    return b;
}
__device__ __forceinline__ void xcd_barrier_complete(unsigned* bar, unsigned x, unsigned& nloc, unsigned& nx) {
    const unsigned G = gridDim.x * gridDim.y * gridDim.z;
    unsigned sum, cnt, mine, sp = 0u;
    for (;;) {
        sum = 0u; cnt = 0u; mine = 0u;
#pragma unroll
        for (unsigned j = 0; j < 16; ++j) { const unsigned c = xb_ld(&bar[XB_XCNT(j)]); sum += c; cnt += (c > 0u) ? 1u : 0u; mine = (j == x) ? c : mine; }
        if (sum == G) break;
        __builtin_amdgcn_s_sleep(1);
        if ((++sp & 255u) == 0u) { if (xb_ld(&bar[XB_TMO])) break; if (sp > XB_SPIN_CAP) { atomicAdd(&bar[XB_TMO], 1u); break; } }
    }
    nloc = mine > 0u ? mine : 1u; nx = cnt > 0u ? cnt : 1u;
}
__device__ __forceinline__ void xcd_barrier(const XcdBarrier& b) {
    asm volatile("s_waitcnt vmcnt(0)" ::: "memory");
    __syncthreads();
    if (threadIdx.x == 0) {
        unsigned* bar = b.bar;
        __builtin_amdgcn_s_waitcnt(0);
        unsigned nloc = b.st[0], nx = b.st[1];
        if (nloc == 0u) { xcd_barrier_complete(bar, b.x, nloc, nx); b.st[0] = nloc; b.st[1] = nx; }
        const unsigned old = xb_add(&bar[XB_XSUB(b.x)], 1u);
        const unsigned gen = old / nloc;
        if (old + 1u == (gen + 1u) * nloc) {
            __builtin_amdgcn_fence(__ATOMIC_RELEASE, "agent");
            asm volatile("s_waitcnt vmcnt(0)" ::: "memory");
            const unsigned og = xb_add(&bar[XB_TOP], 1u);
            const unsigned tg = og / nx;
            if (og + 1u == (tg + 1u) * nx) xb_add(&bar[XB_TOPGEN], 1u);
            else XB_SPIN(xb_ld(&bar[XB_TOPGEN]) == tg, bar);
            __builtin_amdgcn_fence(__ATOMIC_ACQUIRE, "agent");
            xb_add(&bar[XB_XGEN(b.x)], 1u);
            asm volatile("s_waitcnt vmcnt(0)" ::: "memory");
        } else {
            XB_SPIN(xb_ld(&bar[XB_XGEN(b.x)]) == gen, bar);
            __builtin_amdgcn_fence(__ATOMIC_ACQUIRE, "agent");
            asm volatile("s_waitcnt vmcnt(0)" ::: "memory");
        }
    }
    __syncthreads();
}

__device__ __forceinline__ void tr_item(const float* W, int Nsrc, int k0, int n0, bf16* dst, int ldk, int drow0, int dk0, bool zero, LAS float* scr, int lane) {
    if (!zero) {
#pragma unroll 8
        for (int i = 0; i < 32; ++i) { const int kk = 2 * i + (lane >> 5); scr[kk * 33 + (lane & 31)] = W[(size_t)(k0 + kk) * Nsrc + n0 + (lane & 31)]; }
    }
    LDS_WAIT(); asm volatile("" ::: "memory");
    const int c = lane & 7;
#pragma unroll
    for (int j = 0; j < 4; ++j) { const int n = (lane >> 3) + 8 * j; const LAS float* s = scr + (8 * c) * 33 + n;
        u32x4 o = (u32x4){0u, 0u, 0u, 0u};
        if (!zero) { o.x = pk2(s[0 * 33], s[1 * 33]); o.y = pk2(s[2 * 33], s[3 * 33]); o.z = pk2(s[4 * 33], s[5 * 33]); o.w = pk2(s[6 * 33], s[7 * 33]); }
        *(u32x4*)(dst + (size_t)(drow0 + n) * ldk + dk0 + 8 * c) = o; }
    LDS_WAIT(); asm volatile("" ::: "memory");
}

__device__ __forceinline__ void phase_prologue(const Params& p, LAS unsigned char* lds, int tid, int lane, int wave) {
    unsigned char* ws = p.ws;
    const int G = gridDim.x;
    {
        LAS float* act = (LAS float*)lds;
        LAS float* red = (LAS float*)(lds + 12288);
        for (int i = tid; i < 3 * 1024; i += 512) { const float v = i < 2048 ? p.in[I_C][i] : p.in[I_CCTX][i - 2048]; act[i] = v * sigm(v); }
        __syncthreads();
        float* MOD = (float*)(ws + WS_MOD);
        for (int task = blockIdx.x; task < 192; task += G) {
            const int l = task / 96, j = (task % 96) * 64 + lane;
            const float* Wp = p.in[I_ADAW] + (size_t)l * 1024 * 6144 + (size_t)(wave * 128) * 6144 + j;
            float a0 = 0.f, a1 = 0.f, a2 = 0.f;
#pragma unroll 8
            for (int k = 0; k < 128; ++k) { const float w = Wp[(size_t)k * 6144]; const int kk = wave * 128 + k; a0 += act[kk] * w; a1 += act[1024 + kk] * w; a2 += act[2048 + kk] * w; }
            red[(wave * 3 + 0) * 64 + lane] = a0; red[(wave * 3 + 1) * 64 + lane] = a1; red[(wave * 3 + 2) * 64 + lane] = a2;
            __syncthreads();
            if (wave < 3) { float s = p.in[I_ADAB][l * 6144 + j];
#pragma unroll
                for (int w = 0; w < 8; ++w) s += red[(w * 3 + wave) * 64 + lane];
                MOD[(size_t)(l * 3 + wave) * 6144 + j] = s; }
            __syncthreads();
        }
    }
    LAS float* scr = (LAS float*)(lds + 32768 + wave * 8448);
    const int gw = blockIdx.x * 8 + wave, NGW = G * 8;
    constexpr int PL = 1280 + 512 + 128 + 128, NIT = 2 * PL + 3 * 1408;
    for (int it0 = gw; it0 < NIT; it0 += NGW) {
        int it = it0;
        if (it < 2 * PL) {
            const int l = it / PL; it -= l * PL;
            if (it < 1280) { const int kb = it / 80, nb = it % 80; tr_item(p.in[I_WIN] + (size_t)l * 1024 * 2560, 2560, kb * 64, nb * 32, (bf16*)(ws + WS_WIN) + (size_t)l * 2560 * 1024, 1024, nb * 32, kb * 64, false, scr, lane); continue; }
            it -= 1280;
            if (it < 512) { const int kb = it / 32, nb = it % 32; tr_item(p.in[I_WOUT] + (size_t)l * 1024 * 1024, 1024, kb * 64, nb * 32, (bf16*)(ws + WS_WOUT) + (size_t)l * 1024 * 1024, 1024, nb * 32, kb * 64, false, scr, lane); continue; }
            it -= 512;
            if (it < 128) { const int kb = it / 16, nb = it % 16; tr_item(p.in[I_GLUW] + (size_t)l * 512 * 512, 512, kb * 64, nb * 32, (bf16*)(ws + WS_WGLU) + (size_t)l * 512 * 512, 512, nb * 32, kb * 64, false, scr, lane); continue; }
            it -= 128;
            {
                const int d = it / 64, q = it % 64; bf16* dst = (bf16*)(ws + WS_WLR) + (size_t)(l * 2 + d) * 131072;
                if (q < 16) tr_item(p.in[I_WUP] + (size_t)(l * 2 + d) * 64 * 512, 512, 0, q * 32, dst, 64, q * 32, 0, false, scr, lane);
                else if (q < 32) tr_item(p.in[I_AUP] + (size_t)(l * 2 + d) * 64 * 512, 512, 0, (q - 16) * 32, dst + 32768, 64, (q - 16) * 32, 0, false, scr, lane);
                else { const int kb = (q - 32) / 16, nb = (q - 32) % 16; tr_item(p.in[I_GUP] + (size_t)(l * 2 + d) * 128 * 512, 512, kb * 64, nb * 32, dst + 65536, 128, nb * 32, kb * 64, false, scr, lane); }
            }
            continue;
        }
        it -= 2 * PL;
        if (it < 1408) { const int kb = it / 88, nb = it % 88, n0 = nb * 32; tr_item(p.in[I_FG], 2816, kb * 64, n0, (bf16*)(ws + WS_WFUP), 1024, (n0 / 128) * 256 + n0 % 128, kb * 64, false, scr, lane); continue; }
        it -= 1408;
        if (it < 1408) { const int kb = it / 88, nb = it % 88, n0 = nb * 32; tr_item(p.in[I_FU], 2816, kb * 64, n0, (bf16*)(ws + WS_WFUP), 1024, (n0 / 128) * 256 + 128 + n0 % 128, kb * 64, false, scr, lane); continue; }
        it -= 1408;
        { const int kb = it / 32, nb = it % 32; tr_item(p.in[I_FD], 1024, kb * 64, nb * 32, (bf16*)(ws + WS_WFDN), 2816, nb * 32, kb * 64, false, scr, lane); }
    }
}
constexpr int MOE_CVT_ITEMS = 8 * 5376, MOE_CVT_SPLIT = 7 * 5376;
__device__ __forceinline__ void phase_moe_cvt(const Params& p, LAS unsigned char* lds, int lane, int wave, int it_begin, int it_end, int worker, int nworkers) {
    unsigned char* ws = p.ws;
    LAS float* scr = (LAS float*)(lds + 32768 + wave * 8448);
    for (int it0 = it_begin + worker; it0 < it_end; it0 += nworkers) {
        const int e = it0 / 5376; int it = it0 % 5376;
        if (it < 1792) { const int kb = it / 112, nb = it % 112, n0 = nb * 32; tr_item(p.in[I_MG] + (size_t)e * 1024 * 3584, 3584, kb * 64, n0, (bf16*)(ws + WS_WMUP) + (size_t)e * 7168 * 1024, 1024, (n0 / 128) * 256 + n0 % 128, kb * 64, false, scr, lane); continue; }
        it -= 1792;
        if (it < 1792) { const int kb = it / 112, nb = it % 112, n0 = nb * 32; tr_item(p.in[I_MU2] + (size_t)e * 1024 * 3584, 3584, kb * 64, n0, (bf16*)(ws + WS_WMUP) + (size_t)e * 7168 * 1024, 1024, (n0 / 128) * 256 + 128 + n0 % 128, kb * 64, false, scr, lane); continue; }
        it -= 1792;
        { const int kb = it / 32, nb = it % 32; tr_item(p.in[I_MD] + (size_t)e * 3584 * 1024, 1024, kb * 64, nb * 32, (bf16*)(ws + WS_WMDN) + (size_t)e * 1024 * 3584, 3584, nb * 32, kb * 64, false, scr, lane); }
    }
}

__device__ __forceinline__ void phase_norm(const Params& p, int l, int which, bool first, bool router, int lane, int wave, int npart = 0, const float* part = nullptr, const float* pgate = nullptr) {
    unsigned char* ws = p.ws;
    float* X = (float*)(ws + WS_X); bf16* H = (bf16*)(ws + WS_H); const float* MOD = (const float*)(ws + WS_MOD);
    const float* g = p.in[which ? I_N2G : I_N1G] + l * 1024;
    const int gw = blockIdx.x * 8 + wave, NGW = gridDim.x * 8;
    f32x4 gq[4];
#pragma unroll
    for (int j = 0; j < 4; ++j) gq[j] = *(const f32x4*)(g + 4 * lane + 256 * j);
#define NORM_FETCH(r_, V, SH, SC) do { const int rf_ = (r_); \
        const float* src_ = first ? (rf_ < NLAT ? p.in[I_X] + (size_t)rf_ * 1024 : p.in[I_CTX] + (size_t)(rf_ - NLAT) * 1024) : X + (size_t)rf_ * 1024; \
        const float* mp_ = MOD + (size_t)(l * 3 + (rf_ < NLAT ? (rf_ >> 13) : 2)) * 6144 + which * 3072; \
        _Pragma("unroll") for (int j = 0; j < 4; ++j) V[j] = *(const f32x4*)(src_ + 4 * lane + 256 * j); \
        _Pragma("unroll") for (int j = 0; j < 4; ++j) { SH[j] = *(const f32x4*)(mp_ + 4 * lane + 256 * j); SC[j] = *(const f32x4*)(mp_ + 1024 + 4 * lane + 256 * j); } } while (0)
    f32x4 vn[4], shn[4], scn[4];
    if (gw < T) NORM_FETCH(gw, vn, shn, scn);
    for (int row = gw; row < T; row += NGW) {
        f32x4 v[4], shq[4], scq[4]; float ss = 0.f;
#pragma unroll
        for (int j = 0; j < 4; ++j) { v[j] = vn[j]; shq[j] = shn[j]; scq[j] = scn[j]; }
        asm volatile("" ::: "memory");
        NORM_FETCH(row + NGW < T ? row + NGW : row, vn, shn, scn);
        asm volatile("" ::: "memory");
#pragma unroll
        for (int j = 0; j < 4; ++j) ss += (v[j][0] * v[j][0] + v[j][1] * v[j][1]) + (v[j][2] * v[j][2] + v[j][3] * v[j][3]);
        if (first) {
#pragma unroll
            for (int j = 0; j < 4; ++j) *(f32x4*)(X + (size_t)row * 1024 + 4 * lane + 256 * j) = v[j];
        }
        if (npart > 0 && row >= NLAT) {
            ss = 0.f;
#pragma unroll
            for (int j = 0; j < 4; ++j) { const int c = 4 * lane + 256 * j; f32x4 sacc = (f32x4){0.f, 0.f, 0.f, 0.f};
                for (int k = 0; k < npart; ++k) sacc += *(const f32x4*)(part + ((size_t)k * NCTX + (row - NLAT)) * 1024 + c);
                v[j] += *(const f32x4*)(pgate + c) * sacc; *(f32x4*)(X + (size_t)row * 1024 + c) = v[j];
                ss += (v[j][0] * v[j][0] + v[j][1] * v[j][1]) + (v[j][2] * v[j][2] + v[j][3] * v[j][3]); }
        }
        const float inv = rsqrtf(wave_sum(ss) * (1.0f / 1024.0f) + 1e-6f);
        f32x4 h[4];
#pragma unroll
        for (int j = 0; j < 4; ++j) { const int c = 4 * lane + 256 * j; const f32x4 gg = gq[j], sh = shq[j], sc = scq[j];
            h[j] = (v[j] * inv * gg) * (1.0f + sc) + sh;
            u32x2 o; o.x = pk2(h[j][0], h[j][1]); o.y = pk2(h[j][2], h[j][3]); *(u32x2*)(H + (size_t)row * 1024 + c) = o; }
        if (router && row < NLAT) {
            float lg[8] = {0.f, 0.f, 0.f, 0.f, 0.f, 0.f, 0.f, 0.f};
#pragma unroll
            for (int j = 0; j < 4; ++j)
#pragma unroll
                for (int q = 0; q < 4; ++q) { const float* rp = p.in[I_ROUT] + (size_t)(4 * lane + 256 * j + q) * 8; const f32x4 r0 = *(const f32x4*)rp, r1 = *(const f32x4*)(rp + 4); const float hv = h[j][q];
                    lg[0] += hv * r0[0]; lg[1] += hv * r0[1]; lg[2] += hv * r0[2]; lg[3] += hv * r0[3]; lg[4] += hv * r1[0]; lg[5] += hv * r1[1]; lg[6] += hv * r1[2]; lg[7] += hv * r1[3]; }
#pragma unroll
            for (int e = 0; e < 8; ++e) lg[e] = wave_sum(lg[e]);
            int e0 = 0; float v0 = lg[0];
#pragma unroll
            for (int e = 1; e < 8; ++e) if (lg[e] > v0) { v0 = lg[e]; e0 = e; }
            int e1 = -1; float v1 = -3.0e38f;
#pragma unroll
            for (int e = 0; e < 8; ++e) if (e != e0 && lg[e] > v1) { v1 = lg[e]; e1 = e; }
            const float p1 = 1.0f / (1.0f + __expf(v0 - v1)), p0 = 1.0f - p1;
            if (lane < 8) ((float*)(ws + WS_COMB))[(size_t)row * 8 + lane] = lane == e0 ? p0 : (lane == e1 ? p1 : 0.0f);
        }
    }
}
#undef NORM_FETCH
__device__ __forceinline__ void phase_final(const Params& p, int lane, int wave) {
    unsigned char* ws = p.ws;
    const float* X = (const float*)(ws + WS_X); const float* g = p.in[I_FING];
    const bf16* YP = (const bf16*)(ws + WS_APERM); const bf16* PM = (const bf16*)(ws + WS_PARTM); const int* PPOS = (const int*)(ws + WS_PPOS); const float* RP = (const float*)(ws + WS_RP);
    const float* MOD1 = (const float*)(ws + WS_MOD) + (size_t)3 * 6144 + 5120;
    const int gw = blockIdx.x * 8 + wave, NGW = gridDim.x * 8;
    f32x4 gq[4];
#pragma unroll
    for (int j = 0; j < 4; ++j) gq[j] = *(const f32x4*)(g + 4 * lane + 256 * j);
    int s0n = 0, s1n = 0; float p0n = 0.f;
    if (gw < NLAT) { s0n = PPOS[2 * gw]; s1n = PPOS[2 * gw + 1]; p0n = RP[gw]; }
    for (int row = gw; row < NLAT; row += NGW) {
        const int s0 = s0n, s1 = s1n; const float p0 = p0n, p1 = 1.0f - p0;
        { const int rn = row + NGW < NLAT ? row + NGW : row; s0n = PPOS[2 * rn]; s1n = PPOS[2 * rn + 1]; p0n = RP[rn]; }
        const float* gt = MOD1 + (size_t)(row >> 13) * 6144;
        const bool big0 = s0 >= 128 * 256, big1 = s1 >= 128 * 256;
        const bf16* y0p = YP + (size_t)(big0 ? 0 : s0) * 1024; const bf16* y1p = YP + (size_t)(big1 ? 0 : s1) * 1024;
        u32x2 y0r[4], y1r[4]; f32x4 xr[4], gvr[4];
#pragma unroll
        for (int j = 0; j < 4; ++j) { const int c = 4 * lane + 256 * j; y0r[j] = *(const u32x2*)(y0p + c); y1r[j] = *(const u32x2*)(y1p + c); xr[j] = *(const f32x4*)(X + (size_t)row * 1024 + c); gvr[j] = *(const f32x4*)(gt + c); }
        f32x4 v[4]; float ss = 0.f;
#pragma unroll
        for (int j = 0; j < 4; ++j) { const int c = 4 * lane + 256 * j;
            f32x4 e0v = (f32x4){blo(y0r[j].x), bhi(y0r[j].x), blo(y0r[j].y), bhi(y0r[j].y)}, e1v = (f32x4){blo(y1r[j].x), bhi(y1r[j].x), blo(y1r[j].y), bhi(y1r[j].y)};
            if (big0) { e0v = (f32x4){0.f, 0.f, 0.f, 0.f}; for (int k = 0; k < 7; ++k) { const u32x2 y0 = *(const u32x2*)(PM + ((size_t)k * 2048 + (s0 - 128 * 256)) * 1024 + c); e0v += (f32x4){blo(y0.x), bhi(y0.x), blo(y0.y), bhi(y0.y)}; } }
            if (big1) { e1v = (f32x4){0.f, 0.f, 0.f, 0.f}; for (int k = 0; k < 7; ++k) { const u32x2 y1 = *(const u32x2*)(PM + ((size_t)k * 2048 + (s1 - 128 * 256)) * 1024 + c); e1v += (f32x4){blo(y1.x), bhi(y1.x), blo(y1.y), bhi(y1.y)}; } }
            const f32x4 mix = e0v * p0 + e1v * p1;
            v[j] = xr[j] + gvr[j] * mix;
            ss += (v[j][0] * v[j][0] + v[j][1] * v[j][1]) + (v[j][2] * v[j][2] + v[j][3] * v[j][3]); }
        const float inv = rsqrtf(wave_sum(ss) * (1.0f / 1024.0f) + 1e-6f);
#pragma unroll
        for (int j = 0; j < 4; ++j) { const int c = 4 * lane + 256 * j; *(f32x4*)(p.out + (size_t)row * 1024 + c) = v[j] * inv * gq[j]; }
    }
}

__device__ __forceinline__ void phase_norm2_moe(const Params& p, LAS unsigned char* lds, int tid, int lane, int wave) {
    unsigned char* ws = p.ws; const int l = 1;
    const float* X = (const float*)(ws + WS_X); bf16* H = (bf16*)(ws + WS_H); const float* MOD = (const float*)(ws + WS_MOD);
    int* RE = (int*)(ws + WS_RE); float* RP = (float*)(ws + WS_RP); int* SEGCNT = (int*)(ws + WS_SEGCNT);
    const float* g = p.in[I_N2G] + l * 1024;
    LAS int* wc = (LAS int*)lds;
    LAS float* RT = (LAS float*)(lds + 1024);
    for (int ch = tid; ch < 1024; ch += 512) { const f32x4 r0 = *(const f32x4*)(p.in[I_ROUT] + (size_t)ch * 8), r1 = *(const f32x4*)(p.in[I_ROUT] + (size_t)ch * 8 + 4);
        RT[0 * 1024 + ch] = r0[0]; RT[1 * 1024 + ch] = r0[1]; RT[2 * 1024 + ch] = r0[2]; RT[3 * 1024 + ch] = r0[3]; RT[4 * 1024 + ch] = r1[0]; RT[5 * 1024 + ch] = r1[1]; RT[6 * 1024 + ch] = r1[2]; RT[7 * 1024 + ch] = r1[3]; }
    __syncthreads();
    for (int seg = blockIdx.x; seg < NLAT / 64; seg += gridDim.x) {
        int cnt[8] = {0, 0, 0, 0, 0, 0, 0, 0};
        const float* mp = MOD + (size_t)(l * 3 + ((seg * 64) >> 13)) * 6144 + 3072;
        f32x4 gq[4], shq[4], scq[4], vn[4];
#pragma unroll
        for (int j = 0; j < 4; ++j) { const int c = 4 * lane + 256 * j; gq[j] = *(const f32x4*)(g + c); shq[j] = *(const f32x4*)(mp + c); scq[j] = *(const f32x4*)(mp + 1024 + c); }
#pragma unroll
        for (int j = 0; j < 4; ++j) vn[j] = *(const f32x4*)(X + (size_t)(seg * 64 + wave * 8) * 1024 + 4 * lane + 256 * j);
        for (int rr = 0; rr < 8; ++rr) {
            const int row = seg * 64 + wave * 8 + rr;
            asm volatile("" ::: "memory");
            f32x4 v[4]; float ss = 0.f;
#pragma unroll
            for (int j = 0; j < 4; ++j) v[j] = vn[j];
            { const int rn = seg * 64 + wave * 8 + (rr < 7 ? rr + 1 : 7);
#pragma unroll
              for (int j = 0; j < 4; ++j) vn[j] = *(const f32x4*)(X + (size_t)rn * 1024 + 4 * lane + 256 * j); }
#pragma unroll
            for (int j = 0; j < 4; ++j) ss += (v[j][0] * v[j][0] + v[j][1] * v[j][1]) + (v[j][2] * v[j][2] + v[j][3] * v[j][3]);
            const float inv = rsqrtf(wave_sum(ss) * (1.0f / 1024.0f) + 1e-6f);
            float lg[8] = {0.f, 0.f, 0.f, 0.f, 0.f, 0.f, 0.f, 0.f};
#pragma unroll
            for (int j = 0; j < 4; ++j) { const int c = 4 * lane + 256 * j;
                const f32x4 h = (v[j] * inv * gq[j]) * (1.0f + scq[j]) + shq[j];
                u32x2 o; o.x = pk2(h[0], h[1]); o.y = pk2(h[2], h[3]); *(u32x2*)(H + (size_t)row * 1024 + c) = o;
#pragma unroll
                for (int e = 0; e < 8; ++e) { const f32x4 w = *(const LAS f32x4*)(RT + e * 1024 + c); lg[e] += (h[0] * w[0] + h[1] * w[1]) + (h[2] * w[2] + h[3] * w[3]); } }
#pragma unroll
            for (int e = 0; e < 8; ++e) lg[e] = wave_sum(lg[e]);
            int e0 = 0; float v0 = lg[0];
#pragma unroll
            for (int e = 1; e < 8; ++e) if (lg[e] > v0) { v0 = lg[e]; e0 = e; }
            int e1 = -1; float v1 = -3.0e38f;
#pragma unroll
            for (int e = 0; e < 8; ++e) if (e != e0 && lg[e] > v1) { v1 = lg[e]; e1 = e; }
            e0 = __builtin_amdgcn_readfirstlane(e0); e1 = __builtin_amdgcn_readfirstlane(e1);
            const float p1 = 1.0f / (1.0f + __expf(v0 - v1));
            if (lane == 0) { RE[row] = e0 | (e1 << 8); RP[row] = 1.0f - p1; }
#pragma unroll
            for (int e = 0; e < 8; ++e) cnt[e] += (e0 == e ? 1 : 0) + (e1 == e ? 1 : 0);
        }
        if (lane < 8) { int c = 0;
#pragma unroll
            for (int e = 0; e < 8; ++e) c = (lane == e) ? cnt[e] : c;
            wc[wave * 8 + lane] = c; }
        __syncthreads();
        if (tid < 8) { int c = 0;
#pragma unroll
            for (int w = 0; w < 8; ++w) c += wc[w * 8 + tid];
            SEGCNT[seg * 8 + tid] = c; }
        __syncthreads();
    }
}
__device__ __forceinline__ void phase_moe_prep(const Params& p, LAS unsigned char* lds, int tid, int lane, int wave) {
    unsigned char* ws = p.ws;
    const int* RE = (const int*)(ws + WS_RE); const float* RP = (const float*)(ws + WS_RP); const int* SEGCNT = (const int*)(ws + WS_SEGCNT);
    int* PROW = (int*)(ws + WS_PROW); float* PGW = (float*)(ws + WS_PGW); int* TOFF = (int*)(ws + WS_TOFF);
    const bf16* H = (const bf16*)(ws + WS_H); bf16* AP = (bf16*)(ws + WS_APERM);
    LAS int* sc = (LAS int*)lds;
    LAS int* tot = (LAS int*)(lds + 8192);
    LAS int* perm = (LAS int*)(lds + 8192 + 256);
    constexpr int NSEG = NLAT / 64;
    for (int i = tid; i < NSEG * 8; i += 512) sc[i] = SEGCNT[i];
    __syncthreads();
    if (tid < 8) { int t = 0; for (int s2 = 0; s2 < NSEG; ++s2) t += sc[s2 * 8 + tid]; tot[tid] = t; }
    __syncthreads();
    if (tid == 0) { int o = 0; for (int e = 0; e < 8; ++e) { tot[8 + e] = o; o += (tot[e] + 255) >> 8; } tot[16] = o;
        if (blockIdx.x == 0) { for (int e = 0; e <= 8; ++e) TOFF[e] = tot[8 + e]; } }
    __syncthreads();
    for (int seg = blockIdx.x; seg < NSEG; seg += gridDim.x) {
        if (tid < 8) { int bs = 0; for (int s2 = 0; s2 < seg; ++s2) bs += sc[s2 * 8 + tid]; tot[32 + tid] = bs; }
        __syncthreads();
        if (wave == 0) {
            const int row = seg * 64 + lane; const int re = RE[row], e0 = re & 0xff, e1 = re >> 8; const float p0 = RP[row];
            int s0 = 0, s1 = 0;
#pragma unroll
            for (int e = 0; e < 8; ++e) { const bool mine = (e0 == e) || (e1 == e); const unsigned long long m = __ballot(mine);
                const int rank = __popcll(m & ((1ull << lane) - 1ull)); const int slot = (tot[8 + e] << 8) + tot[32 + e] + rank;
                s0 = (e0 == e) ? slot : s0; s1 = (e1 == e) ? slot : s1; }
            PROW[s0] = row; PGW[s0] = p0; PROW[s1] = row; PGW[s1] = 1.0f - p0;
            ((int*)(ws + WS_PPOS))[2 * row] = s0; ((int*)(ws + WS_PPOS))[2 * row + 1] = s1;
            perm[lane * 2] = s0; perm[lane * 2 + 1] = s1;
        }
        __syncthreads();
        for (int rr = 0; rr < 8; ++rr) { const int lr = wave * 8 + rr, row = seg * 64 + lr; const int s0 = perm[lr * 2], s1 = perm[lr * 2 + 1];
            const u32x4 a = *(const u32x4*)(H + (size_t)row * 1024 + lane * 16), b2 = *(const u32x4*)(H + (size_t)row * 1024 + lane * 16 + 8);
            *(u32x4*)(AP + (size_t)s0 * 1024 + lane * 16) = a; *(u32x4*)(AP + (size_t)s0 * 1024 + lane * 16 + 8) = b2;
            *(u32x4*)(AP + (size_t)s1 * 1024 + lane * 16) = a; *(u32x4*)(AP + (size_t)s1 * 1024 + lane * 16 + 8) = b2; }
        __syncthreads();
    }
    for (int e = blockIdx.x; e < 8; e += gridDim.x) {
        const int lo = (tot[8 + e] << 8) + tot[e], hi = tot[9 + e] << 8;
        for (int r = lo + wave; r < hi; r += 8) { if (lane == 0) { PROW[r] = -1; PGW[r] = 0.f; }
            *(u32x4*)(AP + (size_t)r * 1024 + lane * 16) = (u32x4){0u, 0u, 0u, 0u}; *(u32x4*)(AP + (size_t)r * 1024 + lane * 16 + 8) = (u32x4){0u, 0u, 0u, 0u}; }
    }
}

typedef short bf16x8s __attribute__((ext_vector_type(8)));
__device__ __forceinline__ unsigned cvtpk_(float lo, float hi) { typedef float f2_ __attribute__((ext_vector_type(2))); typedef __bf16 b2_ __attribute__((ext_vector_type(2))); f2_ v = {lo, hi}; return __builtin_bit_cast(unsigned, __builtin_convertvector(v, b2_)); }
constexpr int SLR_ROWS = 33, SLR_PITCH = 520;
__device__ __forceinline__ void phase_stream_lr(const Params& p, int l, LAS unsigned char* lds, int tid, int lane, int wave) {
    unsigned char* ws = p.ws;
    const bf16* P = (const bf16*)(ws + WS_P);
    bf16* R = (bf16*)(ws + WS_R); bf16* V = (bf16*)(ws + WS_V); bf16* KKn = (bf16*)(ws + WS_KKN); bf16* U = (bf16*)(ws + WS_U);
    LAS bf16* lrin = (LAS bf16*)lds;
    LAS bf16* kbuf = (LAS bf16*)(lds + 48 * SLR_PITCH * 2);
    LAS bf16* kkbuf = (LAS bf16*)(lds + (48 + SLR_ROWS) * SLR_PITCH * 2);
    const int hrow = tid >> 8, t8 = tid & 255, c8 = 8 * t8;
    float mu8[8]; { const f32x4 m0 = *(const f32x4*)(p.in[I_MU] + l * 2048 + c8), m1 = *(const f32x4*)(p.in[I_MU] + l * 2048 + c8 + 4); mu8[0] = m0[0]; mu8[1] = m0[1]; mu8[2] = m0[2]; mu8[3] = m0[3]; mu8[4] = m1[0]; mu8[5] = m1[1]; mu8[6] = m1[2]; mu8[7] = m1[3]; }
    for (int i = tid; i < 15 * SLR_PITCH / 2; i += 512) ((LAS unsigned*)(lrin + SLR_ROWS * SLR_PITCH))[i] = 0u;
    const int r16 = lane & 15, g4 = lane >> 4;
    for (int tq = blockIdx.x; tq < T / SLR_ROWS; tq += gridDim.x) {
        const int tix = (gridDim.x == 256) ? ((tq & 7) * 64 + ((tq >> 3) & 31) + 32 * (tq >> 8)) : tq;
        const int row0 = tix * SLR_ROWS;
        for (int pr0 = 0; pr0 < 18; pr0 += 3) {
            u32x4 ow3[3], nb3[3][4], uw3[3];
#pragma unroll
            for (int u = 0; u < 3; ++u) { const int lr = 2 * (pr0 + u) + hrow, row = row0 + (lr < SLR_ROWS ? lr : 0); int nr[4];
                if (row < NLAT) { const int t = row & (SEQ - 1), gc = t & 63, gr = t >> 6; nr[0] = gc > 0 ? row - 1 : -1; nr[1] = gc < 63 ? row + 1 : -1; nr[2] = gr > 0 ? row - 64 : -1; nr[3] = gr < 127 ? row + 64 : -1; }
                else { const int t = (row - NLAT) & (CTXL - 1); nr[0] = nr[2] = t > 0 ? row - 1 : -1; nr[1] = nr[3] = t < CTXL - 1 ? row + 1 : -1; }
                ow3[u] = *(const u32x4*)(P + (size_t)row * DIN + c8);
#pragma unroll
                for (int j = 0; j < 4; ++j) nb3[u][j] = nr[j] >= 0 ? *(const u32x4*)(P + (size_t)nr[j] * DIN + c8) : (u32x4){0u, 0u, 0u, 0u};
                if (t8 < 64) uw3[u] = *(const u32x4*)(P + (size_t)row * DIN + 2048 + c8); }
#pragma unroll
            for (int u = 0; u < 3; ++u) { const int lr = 2 * (pr0 + u) + hrow, row = row0 + lr;
              if (lr < SLR_ROWS) {
                const u32x4 ow = ow3[u];
                const float own[8] = {blo(ow.x), bhi(ow.x), blo(ow.y), bhi(ow.y), blo(ow.z), bhi(ow.z), blo(ow.w), bhi(ow.w)};
                const float shv[8] = {blo(nb3[u][0].x), bhi(nb3[u][1].x), blo(nb3[u][2].y), bhi(nb3[u][3].y), blo(nb3[u][0].z), bhi(nb3[u][1].z), blo(nb3[u][2].w), bhi(nb3[u][3].w)};
                float sv[8];
#pragma unroll
                for (int q = 0; q < 8; ++q) sv[q] = own[q] + (shv[q] - own[q]) * mu8[q];
                if (c8 < 512) { u32x4 o; o.x = cvtpk_(sv[0], sv[1]); o.y = cvtpk_(sv[2], sv[3]); o.z = cvtpk_(sv[4], sv[5]); o.w = cvtpk_(sv[6], sv[7]); *(u32x4*)(R + (size_t)row * 512 + c8) = o; }
                else if (c8 < 1024) { const int cc = c8 - 512; u32x4 o; o.x = cvtpk_(sv[0], sv[1]); o.y = cvtpk_(sv[2], sv[3]); o.z = cvtpk_(sv[4], sv[5]); o.w = cvtpk_(sv[6], sv[7]); *(LAS u32x4*)(kbuf + lr * SLR_PITCH + cc) = o;
                    const f32x4 ka_ = *(const f32x4*)(p.in[I_KK] + l * 512 + cc), kb_ = *(const f32x4*)(p.in[I_KK] + l * 512 + cc + 4); const float kkw[8] = {ka_[0], ka_[1], ka_[2], ka_[3], kb_[0], kb_[1], kb_[2], kb_[3]};
                    float q8[8]; float ssq = 0.f;
#pragma unroll
                    for (int q = 0; q < 8; ++q) { q8[q] = sv[q] * kkw[q]; ssq += q8[q] * q8[q]; }
                    ssq += __shfl_xor(ssq, 1); ssq += __shfl_xor(ssq, 2); ssq += __shfl_xor(ssq, 4);
                    const float inv = 1.0f / fmaxf(sqrtf(ssq), 1e-12f);
                    u32x4 o2; o2.x = cvtpk_(q8[0] * inv, q8[1] * inv); o2.y = cvtpk_(q8[2] * inv, q8[3] * inv); o2.z = cvtpk_(q8[4] * inv, q8[5] * inv); o2.w = cvtpk_(q8[6] * inv, q8[7] * inv);
                    *(u32x4*)(KKn + (size_t)row * 512 + cc) = o2; *(LAS u32x4*)(kkbuf + lr * SLR_PITCH + cc) = o2; }
                else if (c8 < 1536) { u32x4 o; o.x = cvtpk_(sv[0], sv[1]); o.y = cvtpk_(sv[2], sv[3]); o.z = cvtpk_(sv[4], sv[5]); o.w = cvtpk_(sv[6], sv[7]); *(u32x4*)(V + (size_t)row * 512 + c8 - 1024) = o; }
                else { const int cc = c8 - 1536; float f[8];
#pragma unroll
                    for (int q = 0; q < 8; ++q) { const float e2 = __expf(2.0f * sv[q]); f[q] = cc < 128 ? 1.0f - 2.0f * __builtin_amdgcn_rcpf(e2 + 1.0f) : (cc < 256 ? sv[q] : sigm(sv[q])); }
                    u32x4 o; o.x = cvtpk_(f[0], f[1]); o.y = cvtpk_(f[2], f[3]); o.z = cvtpk_(f[4], f[5]); o.w = cvtpk_(f[6], f[7]); *(LAS u32x4*)(lrin + lr * SLR_PITCH + cc) = o; }
                if (t8 < 64) { int tbu, ju; if (row < NLAT) { const int bb_ = row >> 13, tt_ = row & (SEQ - 1); tbu = bb_ * NCH + 4 + (tt_ >> 6); ju = tt_ & 63; } else { const int rc = row - NLAT, bb_ = rc >> 8, tt_ = rc & 255; tbu = bb_ * NCH + (tt_ >> 6); ju = tt_ & 63; }
                    *(u32x4*)(U + ((size_t)((c8 >> 4) * 64 + ju) * (2 * NCH) + tbu) * 16 + (c8 & 15)) = uw3[u]; }
              }
            }
        }
        __syncthreads();
#pragma unroll 1
        for (int d = 0; d < 2; ++d) {
            const bf16* Wd = (const bf16*)(ws + WS_WLR) + (size_t)(l * 2 + d) * 131072 + 8 * g4;
            const size_t dT = (size_t)d * T * 512;
#pragma unroll
            for (int sec = 0; sec < 3; ++sec) {
                constexpr int dummy_ = 0; (void)dummy_;
                const int KK_ = sec == 2 ? 128 : 64, NKS = sec == 2 ? 4 : 2, koff = sec == 0 ? d * 64 : (sec == 1 ? 128 + d * 64 : 256 + d * 128);
                const bf16* Ws = Wd + (sec == 0 ? 0 : (sec == 1 ? 32768 : 65536));
#pragma unroll
                for (int i2 = 0; i2 < 4; i2 += 2) {
                bf16x8s wf[2][4];
#pragma unroll
                for (int i = 0; i < 2; ++i)
#pragma unroll
                    for (int ks = 0; ks < 4; ++ks) if (ks < NKS) wf[i][ks] = *(const bf16x8s*)(Ws + (size_t)(16 * (wave + 8 * (i2 + i)) + r16) * KK_ + 32 * ks);
#pragma unroll
                for (int ii = 0; ii < 2; ++ii) { const int i = i2 + ii;
                    const int c = 16 * (wave + 8 * i) + 4 * g4;
                    f32x4 acc[3];
#pragma unroll
                    for (int rt = 0; rt < 3; ++rt) acc[rt] = (f32x4){0.f, 0.f, 0.f, 0.f};
#pragma unroll
                    for (int ks = 0; ks < 4; ++ks) if (ks < NKS) {
#pragma unroll
                        for (int rt = 0; rt < 3; ++rt) { const bf16x8s bq = *(const LAS bf16x8s*)(lrin + (16 * rt + r16) * SLR_PITCH + koff + 32 * ks + 8 * g4);
                            acc[rt] = __builtin_amdgcn_mfma_f32_16x16x32_bf16(wf[ii][ks], bq, acc[rt], 0, 0, 0); } }
                    if (sec == 0) { const f32x4 w0 = *(const f32x4*)(p.in[I_W0] + l * 1024 + d * 512 + c); float* LW = (float*)(ws + WS_LW) + dT;
#pragma unroll
                        for (int rt = 0; rt < 3; ++rt) { const int lr = 16 * rt + r16; if (lr < SLR_ROWS) { f32x4 o;
#pragma unroll
                                for (int q = 0; q < 4; ++q) o[q] = -sigm(w0[q] + acc[rt][q]) * 0.60653065971f;
                                *(f32x4*)(LW + (size_t)(row0 + lr) * 512 + c) = o; } }
                    } else if (sec == 1) { const f32x4 a0 = *(const f32x4*)(p.in[I_A0] + l * 1024 + d * 512 + c), ka = *(const f32x4*)(p.in[I_KA] + l * 512 + c);
                        bf16* KT = (bf16*)(ws + WS_KT) + dT; bf16* BB = (bf16*)(ws + WS_BB) + dT;
#pragma unroll
                        for (int rt = 0; rt < 3; ++rt) { const int lr = 16 * rt + r16; if (lr < SLR_ROWS) {
                                const u32x2 k4 = *(const LAS u32x2*)(kbuf + lr * SLR_PITCH + c), q4 = *(const LAS u32x2*)(kkbuf + lr * SLR_PITCH + c);
                                const float kf[4] = {blo(k4.x), bhi(k4.x), blo(k4.y), bhi(k4.y)}, qf[4] = {blo(q4.x), bhi(q4.x), blo(q4.y), bhi(q4.y)}; float kt[4], bb[4];
#pragma unroll
                                for (int q = 0; q < 4; ++q) { const float a = sigm(a0[q] + acc[rt][q]); kt[q] = kf[q] * (1.0f + (a - 1.0f) * ka[q]); bb[q] = qf[q] * a; }
                                u32x2 o1, o2; o1.x = cvtpk_(kt[0], kt[1]); o1.y = cvtpk_(kt[2], kt[3]); o2.x = cvtpk_(bb[0], bb[1]); o2.y = cvtpk_(bb[2], bb[3]);
                                *(u32x2*)(KT + (size_t)(row0 + lr) * 512 + c) = o1; *(u32x2*)(BB + (size_t)(row0 + lr) * 512 + c) = o2; } }
                    } else { bf16* GD = (bf16*)(ws + WS_GD) + dT;
#pragma unroll
                        for (int rt = 0; rt < 3; ++rt) { const int lr = 16 * rt + r16; if (lr < SLR_ROWS) { u32x2 o; o.x = cvtpk_(acc[rt][0], acc[rt][1]); o.y = cvtpk_(acc[rt][2], acc[rt][3]);
                                *(u32x2*)(GD + (size_t)(row0 + lr) * 512 + c) = o; } }
                    }
                    asm volatile("" ::: "memory");
                }
                }
            }
        }
        __syncthreads();
    }
}

typedef short bf16x8 __attribute__((ext_vector_type(8)));
typedef float f32x2v __attribute__((ext_vector_type(2)));
typedef __bf16 bf16x2v __attribute__((ext_vector_type(2)));
__device__ __forceinline__ unsigned cvtpk(float lo, float hi) { f32x2v v = {lo, hi}; return __builtin_bit_cast(unsigned, __builtin_convertvector(v, bf16x2v)); }
__device__ __forceinline__ int lds_off(int slot, int row, int col) { return slot * 8192 + row * 128 + ((((col >> 3) ^ (row & 7) ^ ((row & 8) ? 7 : 0) ^ ((row >> 3) & 6))) << 4) + (col & 7) * 2; }
struct Acc2 { f32x4 t[2]; };
__device__ __forceinline__ void prod2(LAS unsigned char* lds, int aslot, int btslot, int wave, int lane, Acc2& acc) {
    const int tr = wave >> 1, r = lane & 15, g = lane >> 4;
#pragma unroll
    for (int ks = 0; ks < 2; ++ks) {
        const bf16x8 a = *(const LAS bf16x8*)(lds + lds_off(aslot, 16 * tr + r, 32 * ks + 8 * g));
#pragma unroll
        for (int t = 0; t < 2; ++t) { const int tc = 2 * (wave & 1) + t;
            const bf16x8 bb = *(const LAS bf16x8*)(lds + lds_off(btslot, 16 * tc + r, 32 * ks + 8 * g));
            acc.t[t] = __builtin_amdgcn_mfma_f32_16x16x32_bf16(a, bb, acc.t[t], 0, 0, 0); }
    }
}
__device__ __forceinline__ void wr_tr(LAS unsigned char* lds, int slot, int wave, int lane, const Acc2& acc) {
    const int tr = wave >> 1, r = lane & 15, g = lane >> 4;
#pragma unroll
    for (int t = 0; t < 2; ++t) { const int col = 16 * (2 * (wave & 1) + t) + r;
        u32x2 o; o.x = cvtpk(acc.t[t][0], acc.t[t][1]); o.y = cvtpk(acc.t[t][2], acc.t[t][3]);
        *(LAS u32x2*)(lds + lds_off(slot, col, 16 * tr + 4 * g)) = o; }
}
struct Frag2 { bf16x8 a[2]; bf16x8 b[2][2]; };
__device__ __forceinline__ void prod2_ld(LAS unsigned char* lds, int aslot, int btslot, int wave, int lane, Frag2& f) {
    const int tr = wave >> 1, r = lane & 15, g = lane >> 4;
#pragma unroll
    for (int ks = 0; ks < 2; ++ks) {
        f.a[ks] = *(const LAS bf16x8*)(lds + lds_off(aslot, 16 * tr + r, 32 * ks + 8 * g));
#pragma unroll
        for (int t = 0; t < 2; ++t) f.b[ks][t] = *(const LAS bf16x8*)(lds + lds_off(btslot, 16 * (2 * (wave & 1) + t) + r, 32 * ks + 8 * g)); }
}
__device__ __forceinline__ void prod2_mm(const Frag2& f, Acc2& acc) {
#pragma unroll
    for (int ks = 0; ks < 2; ++ks)
#pragma unroll
        for (int t = 0; t < 2; ++t) acc.t[t] = __builtin_amdgcn_mfma_f32_16x16x32_bf16(f.a[ks], f.b[ks][t], acc.t[t], 0, 0, 0);
}
__device__ __forceinline__ void phase_chunk(const Params& p, int l, LAS unsigned char* lds, int tid, int lane, int wave) {
    unsigned char* ws = p.ws;
    const bf16* R = (const bf16*)(ws + WS_R); const bf16* V = (const bf16*)(ws + WS_V); const bf16* KKn = (const bf16*)(ws + WS_KKN);
    LAS float* Lf = (LAS float*)(lds + 14 * 8192);
    LAS float* segtot = (LAS float*)(lds + 13 * 8192);
    LAS float* gc = (LAS float*)(lds + LDS_GC);
    const int tr = wave >> 1, r16 = lane & 15, g4 = lane >> 4;
    const int pos = tid >> 3, c8 = (tid & 7) * 8;
    u32x4 n_kk8, n_b8, n_kt8, n_r8, n_v8; f32x4 n_l0, n_l1;
#define CHUNK_FETCH(cc_) do { const int h_ = (cc_) & 7, j_ = ((cc_) >> 3) % NCH, db_ = ((cc_) >> 3) / NCH, b_ = db_ & 1, d_ = db_ >> 1; \
        const size_t go_ = (size_t)row_of(b_, d_, j_ * 64 + pos) * 512 + h_ * 64 + c8, do_ = (size_t)d_ * T * 512 + go_; \
        n_kk8 = *(const u32x4*)(KKn + go_); n_b8 = *(const u32x4*)((const bf16*)(ws + WS_BB) + do_); n_kt8 = *(const u32x4*)((const bf16*)(ws + WS_KT) + do_); n_r8 = *(const u32x4*)(R + go_); n_v8 = *(const u32x4*)(V + go_); \
        n_l0 = *(const f32x4*)((const float*)(ws + WS_LW) + do_); n_l1 = *(const f32x4*)((const float*)(ws + WS_LW) + do_ + 4); } while (0)
    if ((int)blockIdx.x < NCC) CHUNK_FETCH((int)blockIdx.x);
    asm volatile("" :: "v"(n_kk8), "v"(n_b8), "v"(n_kt8), "v"(n_r8), "v"(n_v8), "v"(n_l0), "v"(n_l1));
    for (int cc = blockIdx.x; cc < NCC; cc += gridDim.x) {
        const int h = cc & 7, j = (cc >> 3) % NCH, db = (cc >> 3) / NCH, b = db & 1, d = db >> 1;
        bf16* CH = (bf16*)(ws + WS_CH) + (size_t)cc * 16384;
        const int row = row_of(b, d, j * 64 + pos);
        const u32x4 kk8 = n_kk8, b8 = n_b8, kt8 = n_kt8, r8 = n_r8, v8 = n_v8; const f32x4 l0 = n_l0, l1 = n_l1;
        const f32x4 rk0_ = *(const f32x4*)(p.in[I_RK] + l * 512 + h * 64 + c8), rk1_ = *(const f32x4*)(p.in[I_RK] + l * 512 + h * 64 + c8 + 4);
        asm volatile("" ::: "memory");
        { const int ccn = cc + (int)gridDim.x < NCC ? cc + (int)gridDim.x : cc; CHUNK_FETCH(ccn); }
        *(LAS f32x4*)(Lf + pos * 64 + c8) = l0; *(LAS f32x4*)(Lf + pos * 64 + c8 + 4) = l1;
        __syncthreads();
        { const int ch = tid & 63, seg = tid >> 6; float pre[8]; float run = 0.f;
#pragma unroll
          for (int q = 0; q < 8; ++q) { run += Lf[(8 * seg + q) * 64 + ch]; pre[q] = run; }
          segtot[seg * 64 + ch] = run;
          __syncthreads();
          float off = 0.f;
#pragma unroll
          for (int s2 = 0; s2 < 8; ++s2) off += (s2 < seg) ? segtot[s2 * 64 + ch] : 0.f;
#pragma unroll
          for (int q = 0; q < 8; ++q) Lf[(8 * seg + q) * 64 + ch] = pre[q] + off;
          if (seg == 7) gc[ch] = pre[7] + off; }
        __syncthreads();
        {
            const f32x4 g0 = *(const LAS f32x4*)(Lf + pos * 64 + c8), g1 = *(const LAS f32x4*)(Lf + pos * 64 + c8 + 4);
            const f32x4 q0 = *(const LAS f32x4*)(gc + c8), q1 = *(const LAS f32x4*)(gc + c8 + 4);
            const float G[8] = {g0[0], g0[1], g0[2], g0[3], g1[0], g1[1], g1[2], g1[3]}, GC[8] = {q0[0], q0[1], q0[2], q0[3], q1[0], q1[1], q1[2], q1[3]};
            const float Lv[8] = {l0[0], l0[1], l0[2], l0[3], l1[0], l1[1], l1[2], l1[3]};
            const unsigned kkw[4] = {kk8.x, kk8.y, kk8.z, kk8.w}, bw[4] = {b8.x, b8.y, b8.z, b8.w}, ktw[4] = {kt8.x, kt8.y, kt8.z, kt8.w}, rw[4] = {r8.x, r8.y, r8.z, r8.w}, vw[4] = {v8.x, v8.y, v8.z, v8.w};
            float at[8], bt[8], kb[8], qt[8], bg[8], kg[8], vv[8]; float bon = 0.f;
            const float rk[8] = {rk0_[0], rk0_[1], rk0_[2], rk0_[3], rk1_[0], rk1_[1], rk1_[2], rk1_[3]};
#pragma unroll
            for (int q = 0; q < 8; ++q) { const int w2 = q >> 1; const bool hi = q & 1;
                const float kkv = hi ? bhi(kkw[w2]) : blo(kkw[w2]), bv = hi ? bhi(bw[w2]) : blo(bw[w2]), ktv = hi ? bhi(ktw[w2]) : blo(ktw[w2]), rv = hi ? bhi(rw[w2]) : blo(rw[w2]);
                vv[q] = hi ? bhi(vw[w2]) : blo(vw[w2]);
                const float eg = __expf(G[q]), egi = __expf(-G[q]), egp = __expf(G[q] - Lv[q]), egc = __expf(GC[q] - G[q]);
                at[q] = -kkv * egp; bt[q] = bv * egi; kb[q] = ktv * egi; qt[q] = rv * eg; bg[q] = bv * egc; kg[q] = ktv * egc;
                bon += rv * ktv * rk[q]; }
            bon += __shfl_xor(bon, 1); bon += __shfl_xor(bon, 2); bon += __shfl_xor(bon, 4);
            if ((tid & 7) == 0) ((float*)(ws + WS_BONUS))[((size_t)d * T + row) * 8 + h] = bon;
            u32x4 o;
            o.x = cvtpk(at[0], at[1]); o.y = cvtpk(at[2], at[3]); o.z = cvtpk(at[4], at[5]); o.w = cvtpk(at[6], at[7]); *(LAS u32x4*)(lds + lds_off(0, pos, c8)) = o;
            o.x = cvtpk(bt[0], bt[1]); o.y = cvtpk(bt[2], bt[3]); o.z = cvtpk(bt[4], bt[5]); o.w = cvtpk(bt[6], bt[7]); *(LAS u32x4*)(lds + lds_off(2, pos, c8)) = o;
            o.x = cvtpk(kb[0], kb[1]); o.y = cvtpk(kb[2], kb[3]); o.z = cvtpk(kb[4], kb[5]); o.w = cvtpk(kb[6], kb[7]); *(LAS u32x4*)(lds + lds_off(3, pos, c8)) = o;
            o.x = cvtpk(qt[0], qt[1]); o.y = cvtpk(qt[2], qt[3]); o.z = cvtpk(qt[4], qt[5]); o.w = cvtpk(qt[6], qt[7]); *(LAS u32x4*)(lds + lds_off(4, pos, c8)) = o;
            const unsigned atw[4] = {cvtpk(at[0], at[1]), cvtpk(at[2], at[3]), cvtpk(at[4], at[5]), cvtpk(at[6], at[7])};
            const unsigned bgw[4] = {cvtpk(bg[0], bg[1]), cvtpk(bg[2], bg[3]), cvtpk(bg[4], bg[5]), cvtpk(bg[6], bg[7])};
            const unsigned kgw[4] = {cvtpk(kg[0], kg[1]), cvtpk(kg[2], kg[3]), cvtpk(kg[4], kg[5]), cvtpk(kg[6], kg[7])};
#pragma unroll
            for (int q = 0; q < 8; ++q) { const int w2 = q >> 1, sh = (q & 1) * 16;
                *(LAS unsigned short*)(lds + lds_off(1, c8 + q, pos)) = (unsigned short)(atw[w2] >> sh);
                *(LAS unsigned short*)(lds + lds_off(5, c8 + q, pos)) = (unsigned short)(vw[w2] >> sh);
                *(LAS unsigned short*)(lds + lds_off(6, c8 + q, pos)) = (unsigned short)(bgw[w2] >> sh);
                *(LAS unsigned short*)(lds + lds_off(7, c8 + q, pos)) = (unsigned short)(kgw[w2] >> sh); }
        }
        __syncthreads();
        Acc2 accTt;
        { Frag2 f0, f1, f2, f3, f4;
          prod2_ld(lds, 0, 2, wave, lane, f0); prod2_ld(lds, 2, 0, wave, lane, f1); prod2_ld(lds, 3, 0, wave, lane, f2); prod2_ld(lds, 2, 4, wave, lane, f3); prod2_ld(lds, 3, 4, wave, lane, f4);
          Acc2 a0, a1, a2, a3, a4; a0.t[0] = a0.t[1] = a1.t[0] = a1.t[1] = a2.t[0] = a2.t[1] = a3.t[0] = a3.t[1] = a4.t[0] = a4.t[1] = (f32x4){0.f, 0.f, 0.f, 0.f};
          prod2_mm(f0, a0); prod2_mm(f1, a1); prod2_mm(f2, a2); prod2_mm(f3, a3); prod2_mm(f4, a4);
#pragma unroll
          for (int t = 0; t < 2; ++t) { const int col = 16 * (2 * (wave & 1) + t) + r16;
#pragma unroll
              for (int q = 0; q < 4; ++q) { const int rw_ = 16 * tr + 4 * g4 + q;
                  a0.t[t][q] = col < rw_ ? a0.t[t][q] : 0.f;
                  a1.t[t][q] = col > rw_ ? a1.t[t][q] : 0.f; accTt.t[t][q] = a1.t[t][q] + (col == rw_ ? 1.f : 0.f);
                  a2.t[t][q] = col > rw_ ? a2.t[t][q] : 0.f;
                  a3.t[t][q] = col >= rw_ ? a3.t[t][q] : 0.f;
                  a4.t[t][q] = col >= rw_ ? a4.t[t][q] : 0.f; } }
          wr_tr(lds, 9, wave, lane, a0);
          wr_tr(lds, 8, wave, lane, a1); wr_tr(lds, 10, wave, lane, accTt);
          wr_tr(lds, 11, wave, lane, a2);
          wr_tr(lds, 12, wave, lane, a3);
          wr_tr(lds, 13, wave, lane, a4); }
        __syncthreads();
        { Frag2 f1, f2, f3; prod2_ld(lds, 8, 9, wave, lane, f1); prod2_ld(lds, 9, 8, wave, lane, f2); prod2_ld(lds, 11, 5, wave, lane, f3);
          Acc2 a1, a2, a3; a1.t[0] = a1.t[1] = a2.t[0] = a2.t[1] = a3.t[0] = a3.t[1] = (f32x4){0.f, 0.f, 0.f, 0.f};
          prod2_mm(f1, a1); prod2_mm(f2, a2); prod2_mm(f3, a3);
          wr_tr(lds, 3, wave, lane, a1);
          wr_tr(lds, 2, wave, lane, a2);
          wr_tr(lds, 14, wave, lane, a3); }
        __syncthreads();
#pragma unroll
        for (int lvl = 1; lvl <= 4; ++lvl) {
            const int zc = (lvl & 1) ? 2 : 8, zn = (lvl & 1) ? 8 : 2, tc_ = (lvl & 1) ? 10 : 15, tn = (lvl & 1) ? 15 : 10;
            if (lvl < 4) { Frag2 f1, f2, f3; prod2_ld(lds, zc + 1, tc_, wave, lane, f1); prod2_ld(lds, zc, zc + 1, wave, lane, f2); prod2_ld(lds, zc + 1, zc, wave, lane, f3);
                Acc2 a2, a3; a2.t[0] = a2.t[1] = a3.t[0] = a3.t[1] = (f32x4){0.f, 0.f, 0.f, 0.f};
                prod2_mm(f1, accTt); prod2_mm(f2, a2); prod2_mm(f3, a3);
                wr_tr(lds, tn, wave, lane, accTt); wr_tr(lds, zn + 1, wave, lane, a2); wr_tr(lds, zn, wave, lane, a3); }
            else { prod2(lds, zc + 1, tc_, wave, lane, accTt); wr_tr(lds, tn, wave, lane, accTt); }
            __syncthreads();
        }
        { Frag2 f1, f2; prod2_ld(lds, 10, 1, wave, lane, f1); prod2_ld(lds, 10, 14, wave, lane, f2);
          Acc2 a1, a2; a1.t[0] = a1.t[1] = a2.t[0] = a2.t[1] = (f32x4){0.f, 0.f, 0.f, 0.f};
          prod2_mm(f1, a1); prod2_mm(f2, a2);
          wr_tr(lds, 8, wave, lane, a1); wr_tr(lds, 9, wave, lane, a2); }
        __syncthreads();
        { Acc2 a; a.t[0] = a.t[1] = (f32x4){0.f, 0.f, 0.f, 0.f}; prod2(lds, 8, 12, wave, lane, a);
#pragma unroll
          for (int t = 0; t < 2; ++t) { const int col = 16 * (2 * (wave & 1) + t) + r16, r0 = 16 * tr + 4 * g4;
              const u32x2 qq = *(const LAS u32x2*)(lds + lds_off(4, col, r0));
              u32x2 o; o.x = cvtpk(a.t[t][0] + blo(qq.x), a.t[t][1] + bhi(qq.x)); o.y = cvtpk(a.t[t][2] + blo(qq.y), a.t[t][3] + bhi(qq.y));
              *(u32x2*)(CH + 8192 + (((col >> 4) * 2 + (tr >> 1)) * 64 + g4 * 16 + (col & 15)) * 8 + (tr & 1) * 4) = o; } }
        { Acc2 a; a.t[0] = a.t[1] = (f32x4){0.f, 0.f, 0.f, 0.f}; prod2(lds, 12, 9, wave, lane, a); prod2(lds, 13, 5, wave, lane, a);
#pragma unroll
          for (int t = 0; t < 2; ++t) { const int col = 16 * (2 * (wave & 1) + t) + r16, r0 = 16 * tr + 4 * g4;
              u32x2 o; o.x = cvtpk(a.t[t][0], a.t[t][1]); o.y = cvtpk(a.t[t][2], a.t[t][3]); *(u32x2*)(CH + 12288 + (((col >> 4) * 4 + tr) * 64 + g4 * 16 + (col & 15)) * 4) = o; } }
        { Acc2 a; a.t[0] = a.t[1] = (f32x4){0.f, 0.f, 0.f, 0.f}; prod2(lds, 8, 6, wave, lane, a);
#pragma unroll
          for (int t = 0; t < 2; ++t) { const int col = 16 * (2 * (wave & 1) + t) + r16, r0 = 16 * tr + 4 * g4; const float dg = __expf(gc[col]);
#pragma unroll
              for (int q = 0; q < 4; ++q) a.t[t][q] += (r0 + q == col) ? dg : 0.f;
              u32x2 o; o.x = cvtpk(a.t[t][0], a.t[t][1]); o.y = cvtpk(a.t[t][2], a.t[t][3]); *(u32x2*)(CH + (((col >> 4) * 2 + (tr >> 1)) * 64 + g4 * 16 + (col & 15)) * 8 + (tr & 1) * 4) = o; } }
        { Acc2 a; a.t[0] = a.t[1] = (f32x4){0.f, 0.f, 0.f, 0.f}; prod2(lds, 6, 9, wave, lane, a); prod2(lds, 7, 5, wave, lane, a);
#pragma unroll
          for (int t = 0; t < 2; ++t) { const int col = 16 * (2 * (wave & 1) + t) + r16, r0 = 16 * tr + 4 * g4;
              u32x2 o; o.x = cvtpk(a.t[t][0], a.t[t][1]); o.y = cvtpk(a.t[t][2], a.t[t][3]); *(u32x2*)(CH + 4096 + (((col >> 4) * 4 + tr) * 64 + g4 * 16 + (col & 15)) * 4) = o; } }
        __syncthreads();
    }
}
#undef CHUNK_FETCH
struct SeqS { u32x4 mt[4][2]; u32x2 nc[4]; };
struct SeqY { u32x4 qe[4][2]; u32x2 yl[4]; };
__device__ __forceinline__ void seq_load_s(SeqS& B, const bf16* CH, int vs, int lane) {
#pragma unroll
    for (int t = 0; t < 4; ++t) {
#pragma unroll
        for (int s = 0; s < 2; ++s) B.mt[t][s] = *(const u32x4*)(CH + ((t * 2 + s) * 64 + lane) * 8);
        B.nc[t] = *(const u32x2*)(CH + 4096 + ((vs * 4 + t) * 64 + lane) * 4); }
}
__device__ __forceinline__ void seq_load_y(SeqY& B, const bf16* CH, int vs, int lane) {
#pragma unroll
    for (int t = 0; t < 4; ++t) {
#pragma unroll
        for (int s = 0; s < 2; ++s) B.qe[t][s] = *(const u32x4*)(CH + 8192 + ((t * 2 + s) * 64 + lane) * 8);
        B.yl[t] = *(const u32x2*)(CH + 12288 + ((vs * 4 + t) * 64 + lane) * 4); }
}
__device__ __forceinline__ void seq_wait_ge(volatile LAS int* w, int v) { while (*w < v) __builtin_amdgcn_s_sleep(1); asm volatile("" ::: "memory"); }
__device__ __forceinline__ void phase_seq(const Params& p, LAS unsigned char* lds, int lane, int wave) {
    if (blockIdx.x >= 128) return;
    unsigned char* ws = p.ws;
    const int chain = (blockIdx.x & 7) * 4 + (blockIdx.x >> 5), vs = (blockIdx.x >> 3) & 3, db = chain >> 3, h = chain & 7, b = db & 1, d = db >> 1;
    const int r = lane & 15, g = lane >> 4;
    const bf16* CH0 = (const bf16*)(ws + WS_CH) + ((size_t)(db * NCH) * 8 + h) * 16384;
    volatile LAS int* flg = (volatile LAS int*)(lds + 16384);
    LAS u32x4* ring = (LAS u32x4*)lds;
    if (wave == 0 && lane == 0) { flg[0] = 0; flg[1] = 0; }
    __syncthreads();
    if (wave == 0) {
        u32x4 sf[2]; sf[0] = sf[1] = (u32x4){0u, 0u, 0u, 0u};
        SeqS q0, q1, q2, q3;
        seq_load_s(q0, CH0, vs, lane); seq_load_s(q1, CH0 + (size_t)1 * 8 * 16384, vs, lane); seq_load_s(q2, CH0 + (size_t)2 * 8 * 16384, vs, lane);
        seq_load_s(q3, CH0 + (size_t)3 * 8 * 16384, vs, lane);
#define SEQ_USE_S(Q) asm volatile("" :: "v"(Q.mt[0][0]), "v"(Q.mt[0][1]), "v"(Q.mt[1][0]), "v"(Q.mt[1][1]), "v"(Q.mt[2][0]), "v"(Q.mt[2][1]), "v"(Q.mt[3][0]), "v"(Q.mt[3][1]), "v"(Q.nc[0]), "v"(Q.nc[1]), "v"(Q.nc[2]), "v"(Q.nc[3]))
        SEQ_USE_S(q0); SEQ_USE_S(q1); SEQ_USE_S(q2); SEQ_USE_S(q3);
#undef SEQ_USE_S
#define SEQ_S_STEP(Q, jj) do { const int j_ = (jj); \
            if (j_ >= 8) seq_wait_ge(flg + 1, j_ - 7); \
            ring[((j_ & 7) * 2 + 0) * 64 + lane] = sf[0]; ring[((j_ & 7) * 2 + 1) * 64 + lane] = sf[1]; \
            asm volatile("s_waitcnt lgkmcnt(0)" ::: "memory"); if (lane == 0) flg[0] = j_ + 1; \
            f32x4 accS[4]; \
            _Pragma("unroll") for (int t = 0; t < 4; ++t) { f32x4 as = (f32x4){blo(Q.nc[t].x), bhi(Q.nc[t].x), blo(Q.nc[t].y), bhi(Q.nc[t].y)}; \
                _Pragma("unroll") for (int s2 = 0; s2 < 2; ++s2) as = __builtin_amdgcn_mfma_f32_16x16x32_bf16(__builtin_bit_cast(bf16x8, Q.mt[t][s2]), __builtin_bit_cast(bf16x8, sf[s2]), as, 0, 0, 0); \
                accS[t] = as; } \
            _Pragma("unroll") for (int s2 = 0; s2 < 2; ++s2) { sf[s2].x = cvtpk(accS[2 * s2][0], accS[2 * s2][1]); sf[s2].y = cvtpk(accS[2 * s2][2], accS[2 * s2][3]); sf[s2].z = cvtpk(accS[2 * s2 + 1][0], accS[2 * s2 + 1][1]); sf[s2].w = cvtpk(accS[2 * s2 + 1][2], accS[2 * s2 + 1][3]); } \
            { const int jn_ = j_ + 4 < NCH ? j_ + 4 : NCH - 1; seq_load_s(Q, CH0 + (size_t)jn_ * 8 * 16384, vs, lane); } } while (0)
        for (int j = 0; j < NCH; j += 4) { SEQ_S_STEP(q0, j); SEQ_S_STEP(q1, j + 1); SEQ_S_STEP(q2, j + 2); SEQ_S_STEP(q3, j + 3); }
#undef SEQ_S_STEP
    } else if (wave == 1) {
        float* Y = (float*)(ws + WS_Y) + (size_t)d * T * 512 + h * 64 + 16 * vs + r;
        SeqY q0, q1, q2; const int sgs = d ? -1 : 1;
        seq_load_y(q0, CH0, vs, lane); seq_load_y(q1, CH0 + (size_t)1 * 8 * 16384, vs, lane); seq_load_y(q2, CH0 + (size_t)2 * 8 * 16384, vs, lane);
#define SEQ_USE_Y(Q) asm volatile("" :: "v"(Q.qe[0][0]), "v"(Q.qe[0][1]), "v"(Q.qe[1][0]), "v"(Q.qe[1][1]), "v"(Q.qe[2][0]), "v"(Q.qe[2][1]), "v"(Q.qe[3][0]), "v"(Q.qe[3][1]), "v"(Q.yl[0]), "v"(Q.yl[1]), "v"(Q.yl[2]), "v"(Q.yl[3]))
        SEQ_USE_Y(q0); SEQ_USE_Y(q1); SEQ_USE_Y(q2);
#undef SEQ_USE_Y
#define SEQ_Y_STEP(Q, jj) do { const int j_ = (jj); \
            float* Yc_ = Y + ((ptrdiff_t)row_of(b, d, j_ * 64) + (ptrdiff_t)(sgs * 4 * g)) * 512;     \
            seq_wait_ge(flg, j_ + 1); \
            const u32x4 s0_ = ring[((j_ & 7) * 2 + 0) * 64 + lane], s1_ = ring[((j_ & 7) * 2 + 1) * 64 + lane]; \
            asm volatile("s_waitcnt lgkmcnt(0)" ::: "memory"); if (lane == 0) flg[1] = j_ + 1; \
            _Pragma("unroll") for (int t = 0; t < 4; ++t) { f32x4 ay = (f32x4){blo(Q.yl[t].x), bhi(Q.yl[t].x), blo(Q.yl[t].y), bhi(Q.yl[t].y)}; \
                ay = __builtin_amdgcn_mfma_f32_16x16x32_bf16(__builtin_bit_cast(bf16x8, Q.qe[t][0]), __builtin_bit_cast(bf16x8, s0_), ay, 0, 0, 0); \
                ay = __builtin_amdgcn_mfma_f32_16x16x32_bf16(__builtin_bit_cast(bf16x8, Q.qe[t][1]), __builtin_bit_cast(bf16x8, s1_), ay, 0, 0, 0); \
                _Pragma("unroll") for (int qq = 0; qq < 4; ++qq) Yc_[(ptrdiff_t)((16 * t + qq) * sgs) * 512] = ay[qq]; } \
            { const int jn_ = j_ + 3 < NCH ? j_ + 3 : NCH - 1; seq_load_y(Q, CH0 + (size_t)jn_ * 8 * 16384, vs, lane); } } while (0)
        for (int j = 0; j < NCH; j += 3) { SEQ_Y_STEP(q0, j); SEQ_Y_STEP(q1, j + 1); SEQ_Y_STEP(q2, j + 2); }
#undef SEQ_Y_STEP
    }
}

struct S5Disc { float ar, ai; float br[16], bi[16]; };
__device__ __forceinline__ void s5_disc(const Params& p, int l, int d, int g, int lane, S5Disc& q) {
    const int gi = (l * 2 + d) * 32 + g; const size_t pi = (size_t)gi * 64 + lane;
    const float lr = fminf(p.in[I_LRE][pi], -1e-4f), li = p.in[I_LIM][pi], dt = __expf(p.in[I_LDT][gi]);
    const float mag = __expf(lr * dt); float sn, cs; sincosf(li * dt, &sn, &cs);
    q.ar = mag * cs; q.ai = mag * sn;
    const float den = lr * lr + li * li, xr = q.ar - 1.0f, cr = (xr * lr + q.ai * li) / den, ci = (q.ai * lr - xr * li) / den;
    const float* bre = p.in[I_BRE] + pi * 16; const float* bim = p.in[I_BIM] + pi * 16;
#pragma unroll
    for (int c = 0; c < 16; c += 4) { const f32x4 a = *(const f32x4*)(bre + c), b = *(const f32x4*)(bim + c);
#pragma unroll
        for (int j = 0; j < 4; ++j) { q.br[c + j] = cr * a[j] - ci * b[j]; q.bi[c + j] = cr * b[j] + ci * a[j]; } }
}
__device__ __forceinline__ void phase_s5_carry(const Params& p, int l, int lane, int wave) {
    unsigned char* ws = p.ws;
    const float2* XEND = (const float2*)(ws + WS_XEND); float2* CARRY = (float2*)(ws + WS_CARRY);
    const int gw = blockIdx.x * 8 + wave;
    if (gw >= 128) return;
    const int g = gw & 31, b = (gw >> 5) & 1, d = gw >> 6;
    const int gi = (l * 2 + d) * 32 + g; const size_t pi = (size_t)gi * 64 + lane;
    const float lr = fminf(p.in[I_LRE][pi], -1e-4f), li = p.in[I_LIM][pi], dt = __expf(p.in[I_LDT][gi]);
    const float mag = __expf(lr * dt); float sn, cs; sincosf(li * dt, &sn, &cs);
    float ar = mag * cs, ai = mag * sn;
#pragma unroll
    for (int i = 0; i < 6; ++i) { const float nr = ar * ar - ai * ai, ni = 2.0f * ar * ai; ar = nr; ai = ni; }
    const size_t base = ((size_t)((d * 2 + b) * NCH)) * 2048 + g * 64 + lane;
    float xr = 0.f, xi = 0.f;
    for (int j0 = 0; j0 < NCH; j0 += 12) {
        float2 e[12];
#pragma unroll
        for (int i = 0; i < 12; ++i) e[i] = XEND[base + (size_t)(j0 + i) * 2048];
#pragma unroll
        for (int i = 0; i < 12; ++i) { CARRY[base + (size_t)(j0 + i) * 2048] = make_float2(xr, xi); const float nr = ar * xr - ai * xi + e[i].x, ni = ar * xi + ai * xr + e[i].y; xr = nr; xi = ni; }
    }
}

__device__ __forceinline__ void phase_s5_tables(const Params& p, int l, int item2, int lane, LAS unsigned char* lds, int wave) {
    unsigned char* ws = p.ws;
    LAS bf16* es = (LAS bf16*)(lds + wave * 5120); LAS bf16* ksb = es + 2048;
    const int hm = item2 & 1, item = item2 >> 1;
    const int mr = item & 7, d = (item >> 3) & 1, g = item >> 4;
    const int gi = (l * 2 + d) * 32 + g; const size_t pi = (size_t)gi * 64 + lane;
    const float lr = fminf(p.in[I_LRE][pi], -1e-4f), li = p.in[I_LIM][pi], dt = __expf(p.in[I_LDT][gi]);
    S5Disc q; s5_disc(p, l, d, g, lane, q);
    LAS float* Bs = (LAS float*)(lds + 40960 + wave * 8704);
    LAS float* pws = Bs + 2048;
#pragma unroll
    for (int c = 0; c < 16; c += 4) { *(LAS f32x4*)(Bs + lane * 16 + c) = (f32x4){q.br[c], q.br[c + 1], q.br[c + 2], q.br[c + 3]}; *(LAS f32x4*)(Bs + 1024 + lane * 16 + c) = (f32x4){q.bi[c], q.bi[c + 1], q.bi[c + 2], q.bi[c + 3]}; }
    asm volatile("s_waitcnt lgkmcnt(0)" ::: "memory");
    const int r16 = lane & 15, k4 = lane >> 4;
    float brs[16], bis[16], crs[16], cis[16];
#pragma unroll
    for (int s2 = 0; s2 < 16; ++s2) { const int pp = 4 * s2 + k4; brs[s2] = Bs[pp * 16 + r16]; bis[s2] = Bs[1024 + pp * 16 + r16];
        crs[s2] = p.in[I_CRE][((size_t)gi * 16 + r16) * 64 + pp]; cis[s2] = p.in[I_CIM][((size_t)gi * 16 + r16) * 64 + pp]; }
    bf16* Et = (bf16*)(ws + WS_S5E) + (size_t)(g * 2 + d) * 1024 * 128;
    bf16* Kt = (bf16*)(ws + WS_S5K) + (size_t)(g * 2 + d) * 72 * 256;
    if (mr == 0 && hm == 0) {
#pragma unroll
        for (int z = 0; z < 8; ++z) *(u32x2*)(Kt + z * 256 + lane * 4) = (u32x2){0u, 0u}; }
    const int m0 = 8 * mr + 4 * hm, m1 = (mr == 7 && hm == 1) ? 65 : m0 + 4;
    float pr, pim; { const float mg = __expf(lr * dt * (float)m0); float sn, cs; sincosf(li * dt * (float)m0, &sn, &cs); pr = mg * cs; pim = mg * sn; }
#pragma unroll 1
    for (int m = m0; m < m1; ++m) {
        pws[2 * lane] = pr; pws[2 * lane + 1] = pim;
        asm volatile("s_waitcnt lgkmcnt(0)" ::: "memory");
        f32x4 acc = (f32x4){0.f, 0.f, 0.f, 0.f};
#pragma unroll
        for (int s2 = 0; s2 < 16; ++s2) { const int pp = 4 * s2 + k4; const float wr_ = pws[2 * pp], wi_ = pws[2 * pp + 1];
            const float are = crs[s2] * wr_ - cis[s2] * wi_, aim = crs[s2] * wi_ + cis[s2] * wr_;
            if (m >= 1) {
                es[((pp >> 5) * 64 + ((pp >> 3) & 3) * 16 + r16) * 8 + (pp & 7)] = (bf16)f2bf(are);
                es[((2 + (pp >> 5)) * 64 + ((pp >> 3) & 3) * 16 + r16) * 8 + (pp & 7)] = (bf16)f2bf(-aim); }
            acc = __builtin_amdgcn_mfma_f32_16x16x4f32(are, brs[s2], acc, 0, 0, 0);
            acc = __builtin_amdgcn_mfma_f32_16x16x4f32(-aim, bis[s2], acc, 0, 0, 0); }
        if (m <= 63) {
#pragma unroll
            for (int qd = 0; qd < 4; ++qd) ksb[(4 * k4 + qd) * 16 + r16] = (bf16)f2bf(acc[qd]); }
        asm volatile("s_waitcnt lgkmcnt(0)" ::: "memory");
        if (m >= 1) { bf16* eb = Et + (size_t)(m - 1) * 4 * 512;
#pragma unroll
            for (int qd = 0; qd < 4; ++qd) { const u32x4 v_ = *(const LAS u32x4*)(es + (qd * 64 + lane) * 8); *(u32x4*)(eb + (qd * 64 + lane) * 8) = v_; } }
        if (m <= 63 && lane < 32) { const u32x4 v_ = *(const LAS u32x4*)(ksb + lane * 8); *(u32x4*)(Kt + (size_t)(m + 8) * 256 + lane * 8) = v_; }
        asm volatile("s_waitcnt lgkmcnt(0)" ::: "memory");
        const float nr = pr * q.ar - pim * q.ai, ni = pr * q.ai + pim * q.ar; pr = nr; pim = ni;
    }
    { bf16* BP = (bf16*)(ws + WS_S5BP) + (size_t)(g * 2 + d) * 128 * 1024;
      for (int j = 8 * mr + 4 * hm; j < 8 * mr + 4 * hm + 4; ++j) { const float pw = (float)(d ? j : 63 - j); const float mg = __expf(lr * dt * pw); float sn, cs; sincosf(li * dt * pw, &sn, &cs); const float xr = mg * cs, xi = mg * sn;
          float re[16], im[16];
#pragma unroll
          for (int c = 0; c < 16; ++c) { re[c] = xr * q.br[c] - xi * q.bi[c]; im[c] = xr * q.bi[c] + xi * q.br[c]; }
          u32x4 o; bf16* fb = BP + (size_t)(j >> 1) * 8 * 512;
          bf16* dr = fb + ((size_t)(lane >> 4) * 64 + ((j & 1) * 2) * 16 + (lane & 15)) * 8; bf16* di = fb + ((size_t)(4 + (lane >> 4)) * 64 + ((j & 1) * 2) * 16 + (lane & 15)) * 8;
          o.x = cvtpk(re[0], re[1]); o.y = cvtpk(re[2], re[3]); o.z = cvtpk(re[4], re[5]); o.w = cvtpk(re[6], re[7]); *(u32x4*)dr = o;
          o.x = cvtpk(re[8], re[9]); o.y = cvtpk(re[10], re[11]); o.z = cvtpk(re[12], re[13]); o.w = cvtpk(re[14], re[15]); *(u32x4*)(dr + 128) = o;
          o.x = cvtpk(im[0], im[1]); o.y = cvtpk(im[2], im[3]); o.z = cvtpk(im[4], im[5]); o.w = cvtpk(im[6], im[7]); *(u32x4*)di = o;
          o.x = cvtpk(im[8], im[9]); o.y = cvtpk(im[10], im[11]); o.z = cvtpk(im[12], im[13]); o.w = cvtpk(im[14], im[15]); *(u32x4*)(di + 128) = o; } }
}
__device__ __forceinline__ int row_tb(int tb, int t) { const int b = tb >= NCH ? 1 : 0, k = tb - b * NCH; return k < 4 ? NLAT + b * CTXL + 64 * k + t : b * SEQ + 64 * (k - 4) + t; }
__device__ __forceinline__ bf16x8 s5_ufrag(const bf16* Ug, int ct, int j0, int r, int g4) { return *(const bf16x8*)(Ug + ((size_t)(j0 + (g4 >> 1)) * (2 * NCH) + 16 * ct + r) * 16 + 8 * (g4 & 1)); }
__device__ __forceinline__ void phase_s5_end(const Params& p, int lane, int wave) {
    unsigned char* ws = p.ws;
    float2* XEND = (float2*)(ws + WS_XEND);
    const int r = lane & 15, g4 = lane >> 4;
    for (int it = blockIdx.x * 8 + wave; it < 32 * 17 * 2; it += gridDim.x * 8) {
        const int d = it & 1, ct = (it >> 1) % 17, g = (it >> 1) / 17;
        const int tb = 16 * ct + r, tbc = tb < 2 * NCH ? tb : 2 * NCH - 1; const bool valid = tb < 2 * NCH;
        const int b = tbc >= NCH ? 1 : 0, k = tbc - b * NCH;
        const bf16* Ug = (const bf16*)(ws + WS_U) + (size_t)g * 64 * (2 * NCH) * 16;
        const bf16* BPf = (const bf16*)(ws + WS_S5BP) + (size_t)(g * 2 + d) * 128 * 1024 + lane * 8;
        f32x4 acc[8];
#pragma unroll
        for (int rt = 0; rt < 8; ++rt) acc[rt] = (f32x4){0.f, 0.f, 0.f, 0.f};
#pragma unroll 1
        for (int kb = 0; kb < 32; kb += 4) {
            bf16x8 bu[4];
#pragma unroll
            for (int i = 0; i < 4; ++i) bu[i] = s5_ufrag(Ug, ct, 2 * (kb + i), r, g4);
            bf16x8 a[4][8];
#pragma unroll
            for (int i = 0; i < 4; ++i)
#pragma unroll
                for (int rt = 0; rt < 8; ++rt) a[i][rt] = *(const bf16x8*)(BPf + ((size_t)(kb + i) * 8 + rt) * 512);
            asm volatile("" : "+v"(acc[0]), "+v"(acc[1]), "+v"(acc[2]), "+v"(acc[3]), "+v"(acc[4]), "+v"(acc[5]), "+v"(acc[6]), "+v"(acc[7]) :: "memory");
#pragma unroll
            for (int i = 0; i < 4; ++i)
#pragma unroll
                for (int rt = 0; rt < 8; ++rt) acc[rt] = __builtin_amdgcn_mfma_f32_16x16x32_bf16(a[i][rt], bu[i], acc[rt], 0, 0, 0);
            asm volatile("" ::: "memory");
        }
        if (valid) { const int js = d ? (k < 4 ? 3 - k : NCH + 3 - k) : k;
            float2* xe = XEND + ((size_t)((d * 2 + b) * NCH + js)) * 2048 + g * 64;
#pragma unroll
            for (int rt = 0; rt < 4; ++rt)
#pragma unroll
                for (int q = 0; q < 4; ++q) xe[16 * rt + 4 * g4 + q] = make_float2(acc[rt][q], acc[rt + 4][q]); }
    }
}
__device__ __forceinline__ void phase_s5_out(const Params& p, int l, LAS unsigned char* lds, int tid, int lane, int wave) {
    unsigned char* ws = p.ws;
    bf16* YG = (bf16*)(ws + WS_YG); const float2* CARRY = (const float2*)(ws + WS_CARRY);
    const int r = lane & 15, g4 = lane >> 4;
    for (int gb = blockIdx.x; gb < 256; gb += gridDim.x) {
        const int g = (gridDim.x == 256) ? ((gb & 7) * 4 + (gb >> 6)) : (gb >> 3), tg = (gridDim.x == 256) ? ((gb >> 3) & 7) : (gb & 7);
        __syncthreads();
        { const u32x4* src = (const u32x4*)((const bf16*)(ws + WS_S5K) + (size_t)g * 2 * 72 * 256);
          { u32x4 tk_[9];
#pragma unroll
            for (int q = 0; q < 9; ++q) tk_[q] = src[tid + 512 * q];
#pragma unroll
            for (int q = 0; q < 9; ++q) ((LAS u32x4*)lds)[tid + 512 * q] = tk_[q]; }
          const u32x4* e0s = (const u32x4*)((const bf16*)(ws + WS_S5E) + (size_t)(g * 2) * 1024 * 128 + (size_t)(8 * tg) * 4 * 512);
          const u32x4* e1s = (const u32x4*)((const bf16*)(ws + WS_S5E) + (size_t)(g * 2 + 1) * 1024 * 128 + (size_t)(56 - 8 * tg) * 4 * 512);
          u32x4 t0_[4], t1_[4];
#pragma unroll
          for (int q = 0; q < 4; ++q) { t0_[q] = e0s[tid + 512 * q]; t1_[q] = e1s[tid + 512 * q]; }
#pragma unroll
          for (int q = 0; q < 4; ++q) { *(LAS u32x4*)(lds + 73728 + (tid + 512 * q) * 16) = t0_[q]; *(LAS u32x4*)(lds + 73728 + 32768 + (tid + 512 * q) * 16) = t1_[q]; } }
        __syncthreads();
        const bf16* Ug = (const bf16*)(ws + WS_U) + (size_t)g * 64 * (2 * NCH) * 16;
        for (int ct = wave; ct < 17; ct += 8) {
            const int tb = 16 * ct + r, tbc = tb < 2 * NCH ? tb : 2 * NCH - 1; const bool valid = tb < 2 * NCH;
            const int b = tbc >= NCH ? 1 : 0, k = tbc - b * NCH;
            bf16x8 xc[2][4];
#pragma unroll
            for (int d = 0; d < 2; ++d) { const int js = d ? (k < 4 ? 3 - k : NCH + 3 - k) : k;
                const float2* cp = CARRY + ((size_t)((d * 2 + b) * NCH + js)) * 2048 + g * 64;
#pragma unroll
                for (int ks = 0; ks < 4; ++ks) { const int p0 = 32 * (ks & 1) + 8 * g4; const f32x4* c4 = (const f32x4*)(cp + p0);
                    const f32x4 a = c4[0], b2 = c4[1], c2 = c4[2], d2 = c4[3]; u32x4 o;
                    if (ks < 2) { o.x = cvtpk(a[0], a[2]); o.y = cvtpk(b2[0], b2[2]); o.z = cvtpk(c2[0], c2[2]); o.w = cvtpk(d2[0], d2[2]); }
                    else { o.x = cvtpk(a[1], a[3]); o.y = cvtpk(b2[1], b2[3]); o.z = cvtpk(c2[1], c2[3]); o.w = cvtpk(d2[1], d2[3]); }
                    xc[d][ks] = __builtin_bit_cast(bf16x8, o); } }
            u32x2 uu8[8];
#pragma unroll
            for (int tt = 0; tt < 8; ++tt) uu8[tt] = *(const u32x2*)(Ug + ((size_t)(8 * tg + tt) * (2 * NCH) + tbc) * 16 + 4 * g4);
            f32x4 acc[8];
#pragma unroll
            for (int tt = 0; tt < 8; ++tt) acc[tt] = (f32x4){0.f, 0.f, 0.f, 0.f};
            bf16x8 bu[4], bn[4];
#pragma unroll
            for (int i = 0; i < 4; ++i) bu[i] = s5_ufrag(Ug, ct, (2 * i) & 63, r, g4);
            for (int jb = 0; jb <= 8 * tg + 6; jb += 8) {
                { const int jn = jb + 8 <= 8 * tg + 6 ? jb + 8 : jb;
#pragma unroll
                  for (int i = 0; i < 4; ++i) bn[i] = s5_ufrag(Ug, ct, (jn + 2 * i) & 63, r, g4); }
#pragma unroll
                for (int i = 0; i < 4; ++i) { const int j = jb + 2 * i + (g4 >> 1);
                    if (jb + 2 * i <= 8 * tg + 6) {
                    const LAS unsigned char* ab = lds + (8 * tg - j + 8) * 512 + r * 32 + (g4 & 1) * 16;
                    bf16x8 a8[8];
#pragma unroll
                    for (int tt = 0; tt < 8; ++tt) a8[tt] = *(const LAS bf16x8*)(ab + tt * 512);
                    asm volatile("" : "+v"(acc[0]), "+v"(acc[1]), "+v"(acc[2]), "+v"(acc[3]), "+v"(acc[4]), "+v"(acc[5]), "+v"(acc[6]), "+v"(acc[7]) :: "memory");
#pragma unroll
                    for (int tt = 0; tt < 8; ++tt) acc[tt] = __builtin_amdgcn_mfma_f32_16x16x32_bf16(a8[tt], bu[i], acc[tt], 0, 0, 0); }
                    asm volatile("" ::: "memory"); }
#pragma unroll
                for (int i = 0; i < 4; ++i) bu[i] = bn[i];
            }
#pragma unroll
            for (int i = 0; i < 4; ++i) bu[i] = s5_ufrag(Ug, ct, 8 * tg + 2 * i, r, g4);
            for (int jb = 8 * tg; jb <= 62; jb += 8) {
                { const int jn = jb + 8 <= 62 ? jb + 8 : jb;
#pragma unroll
                  for (int i = 0; i < 4; ++i) bn[i] = s5_ufrag(Ug, ct, jn + 2 * i, r, g4); }
#pragma unroll
                for (int i = 0; i < 4; ++i) { const int j = jb + 2 * i + (g4 >> 1);
                    if (jb + 2 * i + 1 >= 8 * tg) {
                    const LAS unsigned char* ab = lds + 36864 + (j - 8 * tg + 8) * 512 + r * 32 + (g4 & 1) * 16;
                    bf16x8 a8[8];
#pragma unroll
                    for (int tt = 0; tt < 8; ++tt) a8[tt] = *(const LAS bf16x8*)(ab - tt * 512);
                    asm volatile("" : "+v"(acc[0]), "+v"(acc[1]), "+v"(acc[2]), "+v"(acc[3]), "+v"(acc[4]), "+v"(acc[5]), "+v"(acc[6]), "+v"(acc[7]) :: "memory");
#pragma unroll
                    for (int tt = 0; tt < 8; ++tt) acc[tt] = __builtin_amdgcn_mfma_f32_16x16x32_bf16(a8[tt], bu[i], acc[tt], 0, 0, 0); }
                    asm volatile("" ::: "memory"); }
#pragma unroll
                for (int i = 0; i < 4; ++i) bu[i] = bn[i];
            }
            const f32x4 dsk = *(const f32x4*)(p.in[I_S5D] + l * 512 + g * 16 + 4 * g4);
#pragma unroll
            for (int tt = 0; tt < 8; ++tt) { const int t = 8 * tg + tt;
                const u32x2 uu = uu8[tt];
#pragma unroll
                for (int ks = 0; ks < 4; ++ks) {
                    const bf16x8 e0 = *(const LAS bf16x8*)(lds + 73728 + ((tt * 4 + ks) * 64 + lane) * 16), e1 = *(const LAS bf16x8*)(lds + 73728 + 32768 + (((7 - tt) * 4 + ks) * 64 + lane) * 16);
                    acc[tt] = __builtin_amdgcn_mfma_f32_16x16x32_bf16(e0, xc[0][ks], acc[tt], 0, 0, 0); acc[tt] = __builtin_amdgcn_mfma_f32_16x16x32_bf16(e1, xc[1][ks], acc[tt], 0, 0, 0); }
                const float uf[4] = {blo(uu.x), bhi(uu.x), blo(uu.y), bhi(uu.y)}; float o[4];
#pragma unroll
                for (int q = 0; q < 4; ++q) { const float ys = acc[tt][q] + dsk[q] * uf[q]; o[q] = ys * __builtin_amdgcn_rcpf(1.0f + __expf(-1.5957691216f * (ys + 0.044715f * ys * ys * ys))); }
                if (valid) { u32x2 w2; w2.x = cvtpk(o[0], o[1]); w2.y = cvtpk(o[2], o[3]); *(u32x2*)(YG + (size_t)row_tb(tbc, t) * 512 + g * 16 + 4 * g4) = w2; }
                if (tt & 1) asm volatile("" ::: "memory");
            }
        }
    }
}

__device__ __forceinline__ void phase_readout(const Params& p, int l, int lane, int wave, int blk, int nblk) {
    unsigned char* ws = p.ws;
    const bf16* V = (const bf16*)(ws + WS_V); const bf16* GD = (const bf16*)(ws + WS_GD); const float* BON = (const float*)(ws + WS_BONUS);
    const float* Y = (const float*)(ws + WS_Y);
    bf16* A2 = (bf16*)(ws + WS_A2);
    const int c = lane * 8, h = lane >> 3;
    const f32x4 lw0 = *(const f32x4*)(p.in[I_LNW] + l * 512 + c), lw1 = *(const f32x4*)(p.in[I_LNW] + l * 512 + c + 4), lb0 = *(const f32x4*)(p.in[I_LNB] + l * 512 + c), lb1 = *(const f32x4*)(p.in[I_LNB] + l * 512 + c + 4);
    const float lnw[8] = {lw0[0], lw0[1], lw0[2], lw0[3], lw1[0], lw1[1], lw1[2], lw1[3]}, lnb[8] = {lb0[0], lb0[1], lb0[2], lb0[3], lb1[0], lb1[1], lb1[2], lb1[3]};
    const int gw = blk * 8 + wave, NGW = nblk * 8;
#define RO_FETCH(r_, V8, Y0, Y1, G8, BN) do { const int rf_ = (r_); V8 = *(const u32x4*)(V + (size_t)rf_ * 512 + c); \
        _Pragma("unroll") for (int d = 0; d < 2; ++d) { const size_t o_ = ((size_t)d * T + rf_) * 512 + c; Y0[d] = *(const f32x4*)(Y + o_); Y1[d] = *(const f32x4*)(Y + o_ + 4); G8[d] = *(const u32x4*)(GD + o_); BN[d] = BON[((size_t)d * T + rf_) * 8 + h]; } } while (0)
    u32x4 v8n, g8n[2]; f32x4 y0n[2], y1n[2]; float bnn[2];
    if (gw < T) RO_FETCH(gw, v8n, y0n, y1n, g8n, bnn);
    for (int row = gw; row < T; row += NGW) {
        const u32x4 v8 = v8n; const u32x4 g8c[2] = {g8n[0], g8n[1]}; const f32x4 y0c[2] = {y0n[0], y0n[1]}, y1c[2] = {y1n[0], y1n[1]}; const float bnc[2] = {bnn[0], bnn[1]};
        asm volatile("" ::: "memory");
        RO_FETCH(row + NGW < T ? row + NGW : row, v8n, y0n, y1n, g8n, bnn);
        asm volatile("" ::: "memory");
        const float vf[8] = {blo(v8.x), bhi(v8.x), blo(v8.y), bhi(v8.y), blo(v8.z), bhi(v8.z), blo(v8.w), bhi(v8.w)};
        float out[8] = {0.f, 0.f, 0.f, 0.f, 0.f, 0.f, 0.f, 0.f};
#pragma unroll
        for (int d = 0; d < 2; ++d) {
            const f32x4 y0 = y0c[d], y1 = y1c[d]; const u32x4 g8 = g8c[d];
            const float y[8] = {y0[0], y0[1], y0[2], y0[3], y1[0], y1[1], y1[2], y1[3]};
            const float gf[8] = {blo(g8.x), bhi(g8.x), blo(g8.y), bhi(g8.y), blo(g8.z), bhi(g8.z), blo(g8.w), bhi(g8.w)};
            float sm = ((y[0] + y[1]) + (y[2] + y[3])) + ((y[4] + y[5]) + (y[6] + y[7]));
            sm += __shfl_xor(sm, 1); sm += __shfl_xor(sm, 2); sm += __shfl_xor(sm, 4);
            const float mean = sm * (1.0f / 64.0f); float q = 0.f;
#pragma unroll
            for (int i = 0; i < 8; ++i) { const float dv = y[i] - mean; q += dv * dv; }
            q += __shfl_xor(q, 1); q += __shfl_xor(q, 2); q += __shfl_xor(q, 4);
            const float rs = rsqrtf(q * (1.0f / 64.0f) + 64e-5f), bon = bnc[d];
#pragma unroll
            for (int i = 0; i < 8; ++i) out[i] += ((y[i] - mean) * rs * lnw[i] + lnb[i] + bon * vf[i]) * gf[i]; }
        u32x4 w; w.x = cvtpk(out[0], out[1]); w.y = cvtpk(out[2], out[3]); w.z = cvtpk(out[4], out[5]); w.w = cvtpk(out[6], out[7]);
        *(u32x4*)(A2 + (size_t)row * 1024 + c) = w;
    }
#undef RO_FETCH
}

enum { PH_PRO = 0, PH_NORM1, PH_GIN, PH_STREAM, PH_GLR, PH_S5A, PH_S5B, PH_CHUNK, PH_SEQ, PH_S5C, PH_READOUT, PH_GGLU, PH_GOUT, PH_NORM2, PH_GFUP, PH_GFDN, PH_NORM2M, PH_MPREP, PH_GMUP, PH_GMDN, PH_FINAL, N_PH };
template <int PH>
__device__ __forceinline__ void run_phase(const Params& p, int l, int e, LAS unsigned char* lds, int tid, int lane, int wave) {
    unsigned char* ws = p.ws; const int G = gridDim.x;
    const float* MODl = (const float*)(ws + WS_MOD) + (size_t)l * 3 * 6144;
    if constexpr (PH == PH_PRO) phase_prologue(p, lds, tid, lane, wave);
    if constexpr (PH == PH_NORM1) { if (l == 0) phase_norm(p, l, 0, true, false, lane, wave); else phase_norm(p, l, 0, false, false, lane, wave, 11, (const float*)(ws + WS_PARTF), (const float*)(ws + WS_MOD) + 2 * 6144 + 5120); }
    if constexpr (PH == PH_GIN) {
        pg8::Gemm g{(const bf16*)(ws + WS_H), (const bf16*)(ws + WS_WIN) + (size_t)l * DIN * 1024, T, DIN, 1024, 1024}; pg8::StaticOrder S; S.init(T, DIN, G, (int)blockIdx.x);
        pg8::EpiBf16<0> E{(bf16*)(ws + WS_P), DIN, nullptr, 0, 0, 1.f};
        pg8::gemm_phase<pg8::EpiBf16<0>, pg8::StaticOrder, true, true>(lds, g, S, E, tid); }
    if constexpr (PH == PH_STREAM) phase_stream_lr(p, l, lds, tid, lane, wave);
    if constexpr (PH == PH_CHUNK) phase_chunk(p, l, lds, tid, lane, wave);
    if constexpr (PH == PH_SEQ) { if (blockIdx.x >= 128) { const int item = (blockIdx.x - 128) * 8 + wave; for (int it2 = item; it2 < 1024; it2 += (G - 128) * 8) phase_s5_tables(p, l, it2, lane, lds, wave); } else phase_seq(p, lds, lane, wave); }
    if constexpr (PH == PH_S5A) phase_s5_end(p, lane, wave);
    if constexpr (PH == PH_S5B) { if (blockIdx.x < 16) phase_s5_carry(p, l, lane, wave); else phase_readout(p, l, lane, wave, (int)blockIdx.x - 16, G - 16); }
    if constexpr (PH == PH_S5C) phase_s5_out(p, l, lds, tid, lane, wave);
    if constexpr (PH == PH_GGLU) {
        const int Mr = l == 0 ? T : NLAT; pg8::Gemm g{(const bf16*)(ws + WS_YG), (const bf16*)(ws + WS_WGLU) + (size_t)l * 512 * 512, Mr, 512, 512, 512}; pg8::StaticOrder S; S.init(Mr, 512, G, (int)blockIdx.x);
        pg8::EpiGLU E{(const bf16*)(ws + WS_YG), (bf16*)(ws + WS_A2), p.in[I_GLUB] + l * 512};
        pg8::gemm_phase<pg8::EpiGLU, pg8::StaticOrder, true, true>(lds, g, S, E, tid);
        if (l == 1 && G > 128 && (int)blockIdx.x >= 128) phase_moe_cvt(p, lds, lane, wave, MOE_CVT_SPLIT, MOE_CVT_ITEMS, ((int)blockIdx.x - 128) * 8 + wave, (G - 128) * 8); }
    if constexpr (PH == PH_GOUT) {
        { pg8::Gemm g{(const bf16*)(ws + WS_A2), (const bf16*)(ws + WS_WOUT) + (size_t)l * 1024 * 1024, NLAT, 1024, 1024, 1024}; pg8::StaticOrder S; S.init(NLAT, 1024, G, (int)blockIdx.x);
          pg8::EpiRes E{(float*)(ws + WS_X), MODl + 2048, nullptr, 0};
          pg8::gemm_phase<pg8::EpiRes, pg8::StaticOrder, true, true>(lds, g, S, E, tid); }
        if (l == 0) {
            pg8::Gemm g{(const bf16*)(ws + WS_A2), (const bf16*)(ws + WS_WOUT), NCTX, 1024, 256, 1024}; pg8::GroupOrder S;
#pragma unroll
            for (int q = 0; q < 9; ++q) S.toff[q] = q == 0 ? 0 : (1 << 20);
            S.t0 = NLAT / 256; S.a0 = 0; S.o0 = 0; S.nNr = 4; S.kslice = 256; S.init(NCTX, 1024 * 4, G, (int)blockIdx.x);
            pg8::EpiPartF32 E{(float*)(ws + WS_PARTO), NLAT, NCTX, 256};
            pg8::gemm_phase<pg8::EpiPartF32, pg8::GroupOrder, true, true>(lds, g, S, E, tid); }
    }
    if constexpr (PH == PH_NORM2) phase_norm(p, l, 1, false, false, lane, wave, 4, (const float*)(ws + WS_PARTO), (const float*)(ws + WS_MOD) + 2 * 6144 + 2048);
    if constexpr (PH == PH_GFUP) {
        pg8::Gemm g{(const bf16*)(ws + WS_H), (const bf16*)(ws + WS_WFUP), T, 2 * DFF, 1024, 1024}; pg8::StaticOrder S; S.init(T, 2 * DFF, G, (int)blockIdx.x);
        pg8::EpiSwiGLU E{(bf16*)(ws + WS_ACT), DFF};
        pg8::gemm_phase<pg8::EpiSwiGLU, pg8::StaticOrder, true, true>(lds, g, S, E, tid); }
    if constexpr (PH == PH_GFDN) {
        { pg8::Gemm g{(const bf16*)(ws + WS_ACT), (const bf16*)(ws + WS_WFDN), NLAT, 1024, DFF, DFF}; pg8::StaticOrder S; S.init(NLAT, 1024, G, (int)blockIdx.x);
          pg8::EpiRes E{(float*)(ws + WS_X), MODl + 5120, nullptr, 0};
          pg8::gemm_phase<pg8::EpiRes, pg8::StaticOrder, true, true>(lds, g, S, E, tid); }
        {
            pg8::Gemm g{(const bf16*)(ws + WS_ACT), (const bf16*)(ws + WS_WFDN), NCTX, 1024, 256, DFF}; pg8::GroupOrder S;
#pragma unroll
            for (int q = 0; q < 9; ++q) S.toff[q] = q == 0 ? 0 : (1 << 20);
            S.t0 = NLAT / 256; S.a0 = 0; S.o0 = 0; S.nNr = 4; S.kslice = 256; S.init(NCTX, 1024 * 11, G, (int)blockIdx.x);
            pg8::EpiPartF32 E{(float*)(ws + WS_PARTF), NLAT, NCTX, 256};
            pg8::gemm_phase<pg8::EpiPartF32, pg8::GroupOrder, true, true>(lds, g, S, E, tid); }
    }
    if constexpr (PH == PH_NORM2M) { phase_norm2_moe(p, lds, tid, lane, wave); phase_moe_cvt(p, lds, lane, wave, 0, G > 128 ? MOE_CVT_SPLIT : MOE_CVT_ITEMS, (int)blockIdx.x * 8 + wave, G * 8); }
    if constexpr (PH == PH_MPREP) phase_moe_prep(p, lds, tid, lane, wave);
    if constexpr (PH == PH_GMUP || PH == PH_GMDN) {
        const int* TOFF = (const int*)(ws + WS_TOFF);
        pg8::GroupOrder S;
#pragma unroll
        for (int q = 0; q < 9; ++q) S.toff[q] = __builtin_amdgcn_readfirstlane(TOFF[q]);
        const int nT = S.toff[8];
        const int t0 = e * MOE_PASS_TILES; int nt = e == 0 ? (nT < 64 ? nT : 64) : (nT > 64 ? nT - 64 : 0);
        S.t0 = t0;
        if constexpr (PH == PH_GMUP) {
            S.a0 = 0; S.o0 = t0; S.nNr = 2 * DFE / 256; S.kslice = 0; S.init(nt * 256, 2 * DFE, G, (int)blockIdx.x);
            pg8::Gemm g{(const bf16*)(ws + WS_APERM) + (size_t)t0 * 256 * 1024, (const bf16*)(ws + WS_WMUP), nt * 256, 2 * DFE, 1024, 1024};
            S.a0 = t0;
            pg8::EpiSwiGLU E{(bf16*)(ws + WS_ACT1), DFE};
            pg8::gemm_phase<pg8::EpiSwiGLU, pg8::GroupOrder, true, true>(lds, g, S, E, tid);
        } else {
            {
                const int ntA = nt < 64 ? nt : 64;
                S.a0 = t0; S.o0 = 0; S.nNr = 4; S.kslice = 0; S.init(ntA * 256, 1024, G, (int)blockIdx.x);
                pg8::Gemm g{(const bf16*)(ws + WS_ACT1), (const bf16*)(ws + WS_WMDN), ntA * 256, 1024, DFE, DFE};
                pg8::EpiBf16<0> E{(bf16*)(ws + WS_APERM), 1024, nullptr, 0, 0, 1.f};
                pg8::gemm_phase<pg8::EpiBf16<0>, pg8::GroupOrder, true, true>(lds, g, S, E, tid); }
            if (e == 1 && nT > 128) {
                S.t0 = 128; S.a0 = 64; S.o0 = 0; S.nNr = 4; S.kslice = DFE / 7; S.init((nT - 128) * 256, 1024 * 7, G, (int)blockIdx.x);
                pg8::Gemm g{(const bf16*)(ws + WS_ACT1), (const bf16*)(ws + WS_WMDN), (nT - 128) * 256, 1024, DFE / 7, DFE};
                pg8::EpiPartBf16 E{(bf16*)(ws + WS_PARTM), 128 * 256, 8 * 256, DFE / 7};
                pg8::gemm_phase<pg8::EpiPartBf16, pg8::GroupOrder, true, true>(lds, g, S, E, tid); }
        }
    }
    if constexpr (PH == PH_FINAL) phase_final(p, lane, wave);
}
template <int PH>
__global__ void __launch_bounds__(512, 2) k_ph(Params p, int l, int e) {
    extern __shared__ __attribute__((aligned(16))) unsigned char lds_raw[];
    LAS unsigned char* lds = (LAS unsigned char*)lds_raw;
    const int tid = threadIdx.x, lane = tid & 63, wave = __builtin_amdgcn_readfirstlane(tid >> 6);
    run_phase<PH>(p, l, e, lds, tid, lane, wave);
}

#ifndef MK_MULTI
#define MK_FUSED 1
#endif
#ifdef MK_FUSED
#ifndef MK_LOOP_L
#define MK_LOOP_L 0
#endif
__global__ void __launch_bounds__(512, 2) fwd_fused(Params p) {
    extern __shared__ __attribute__((aligned(16))) unsigned char lds_raw[];
    LAS unsigned char* lds = (LAS unsigned char*)lds_raw;
    const int tid = threadIdx.x, lane = tid & 63, wave = __builtin_amdgcn_readfirstlane(tid >> 6);
    volatile LAS unsigned* MISC = (volatile LAS unsigned*)(lds + MISC_OFF);
    if (tid < 32) MISC[tid] = 0u;
    __syncthreads();
    XcdBarrier bar = xcd_barrier_post((unsigned*)(p.ws + WS_CTL) + 4096, MISC + 8);
#define PHASE(PH, l, e) do { int t_ = threadIdx.x; asm volatile("" : "+v"(t_)); run_phase<PH>(p, l, e, lds, t_, t_ & 63, __builtin_amdgcn_readfirstlane(t_ >> 6)); xcd_barrier(bar); } while (0)
    PHASE(PH_PRO, 0, 0);
#if MK_LOOP_L
    for (int l = 0; l < 2; ++l) {
        PHASE(PH_NORM1, l, 0); PHASE(PH_GIN, l, 0); PHASE(PH_STREAM, l, 0); PHASE(PH_GLR, l, 0); PHASE(PH_S5A, l, 0); PHASE(PH_S5B, l, 0); PHASE(PH_CHUNK, l, 0); PHASE(PH_SEQ, l, 0); PHASE(PH_S5C, l, 0);
        PHASE(PH_READOUT, l, 0); PHASE(PH_GGLU, l, 0); PHASE(PH_GOUT, l, 0); PHASE(PH_NORM2, l, 0);
        if (l == 0) { PHASE(PH_GFUP, 0, 0); PHASE(PH_GFDN, 0, 0); }
        else { PHASE(PH_MPREP, 1, 0); for (int e = 0; e < 2; ++e) { PHASE(PH_GMUP, 1, e); PHASE(PH_GMDN, 1, e); } }
    }
#else
    PHASE(PH_NORM1, 0, 0); PHASE(PH_GIN, 0, 0); PHASE(PH_STREAM, 0, 0); PHASE(PH_CHUNK, 0, 0); PHASE(PH_SEQ, 0, 0); PHASE(PH_S5A, 0, 0); PHASE(PH_S5B, 0, 0); PHASE(PH_S5C, 0, 0);
    PHASE(PH_GGLU, 0, 0); PHASE(PH_GOUT, 0, 0); PHASE(PH_NORM2, 0, 0); PHASE(PH_GFUP, 0, 0); PHASE(PH_GFDN, 0, 0);
    PHASE(PH_NORM1, 1, 0); PHASE(PH_GIN, 1, 0); PHASE(PH_STREAM, 1, 0); PHASE(PH_CHUNK, 1, 0); PHASE(PH_SEQ, 1, 0); PHASE(PH_S5A, 1, 0); PHASE(PH_S5B, 1, 0); PHASE(PH_S5C, 1, 0);
    PHASE(PH_GGLU, 1, 0); PHASE(PH_GOUT, 1, 0); PHASE(PH_NORM2M, 1, 0); PHASE(PH_MPREP, 1, 0);
    for (int e = 0; e < 2; ++e) { PHASE(PH_GMUP, 1, e); PHASE(PH_GMDN, 1, e); }
#endif
    { int t_ = threadIdx.x; asm volatile("" : "+v"(t_)); run_phase<PH_FINAL>(p, 0, 0, lds, t_, t_ & 63, __builtin_amdgcn_readfirstlane(t_ >> 6)); }
#undef PHASE
}
#endif
}

#ifndef MK_FUSED
template <int PH> static void launch_ph(const mk::Params& a, int l, int e, int grid, hipStream_t stream) {
    static bool attr = false;
    if (!attr) { (void)hipFuncSetAttribute((const void*)mk::k_ph<PH>, hipFuncAttributeMaxDynamicSharedMemorySize, mk::LDS_BYTES); attr = true; }
    hipLaunchKernelGGL((mk::k_ph<PH>), dim3(grid), dim3(512), mk::LDS_BYTES, stream, a, l, e);
}
#endif
extern "C" void kernel_launch(void* const* d_in, const int* in_sizes, int n_in, void* d_out, int out_size, void* d_ws, size_t ws_size, hipStream_t stream) {
    using namespace mk;
    static int grid = 0;
    if (grid == 0) {
        if (n_in != N_IN || in_sizes[0] != NLAT * D || out_size != NLAT * D || ws_size < WS_END) { fprintf(stderr, "kernel_launch: unexpected shapes (n_in %d, ws %zu < %zu?)\n", n_in, ws_size, (size_t)WS_END); grid = -1; return; }
        int dev = 0, cus = 0;
        if (hipGetDevice(&dev) != hipSuccess || hipDeviceGetAttribute(&cus, hipDeviceAttributeMultiprocessorCount, dev) != hipSuccess) { grid = -1; return; }
        grid = cus;
    }
    if (grid < 0) return;
    (void)hipMemsetAsync((char*)d_ws + WS_CTL, 0, CTL_ZERO_BYTES, stream);
    Params a{};
    for (int i = 0; i < N_IN; ++i) a.in[i] = (const float*)d_in[i];
    a.out = (float*)d_out; a.ws = (unsigned char*)d_ws; a.lo = 0; a.hi = 0;
#ifdef MK_FUSED
    { static bool attr = false; if (!attr) { (void)hipFuncSetAttribute((const void*)fwd_fused, hipFuncAttributeMaxDynamicSharedMemorySize, LDS_BYTES); attr = true; }
      hipLaunchKernelGGL(fwd_fused, dim3(grid), dim3(512), LDS_BYTES, stream, a); return; }
#endif
#ifndef MK_FUSED
    launch_ph<PH_PRO>(a, 0, 0, grid, stream);
    for (int l = 0; l < 2; ++l) {
        launch_ph<PH_NORM1>(a, l, 0, grid, stream); launch_ph<PH_GIN>(a, l, 0, grid, stream); launch_ph<PH_STREAM>(a, l, 0, grid, stream);
        launch_ph<PH_CHUNK>(a, l, 0, grid, stream); launch_ph<PH_SEQ>(a, l, 0, grid, stream); launch_ph<PH_S5A>(a, l, 0, grid, stream); launch_ph<PH_S5B>(a, l, 0, grid, stream); launch_ph<PH_S5C>(a, l, 0, grid, stream);
        launch_ph<PH_GGLU>(a, l, 0, grid, stream); launch_ph<PH_GOUT>(a, l, 0, grid, stream); if (l == 0) launch_ph<PH_NORM2>(a, l, 0, grid, stream); else launch_ph<PH_NORM2M>(a, l, 0, grid, stream);
        if (l == 0) { launch_ph<PH_GFUP>(a, l, 0, grid, stream); launch_ph<PH_GFDN>(a, l, 0, grid, stream); }
        else { launch_ph<PH_MPREP>(a, l, 0, grid, stream); for (int e = 0; e < 2; ++e) { launch_ph<PH_GMUP>(a, l, e, grid, stream); launch_ph<PH_GMDN>(a, l, e, grid, stream); } }
    }
    launch_ph<PH_FINAL>(a, 0, 0, grid, stream);
#endif
}
```
